# Optimizing an MI355X kernel written in HIP

```python
import math
import jax, jax.numpy as jnp
from jax import lax
import numpy as np

D_MODEL = 1024
BATCH = 8
SEQ = 4096
DEPTH = 2

GRID_W = 64
CTX_LEN = 256
N_MOD = 6
EPS = 1e-6
ATTN_WIDTH = D_MODEL // 2
LRU_WIDTH = D_MODEL // 4
SGU_WIDTH = D_MODEL - ATTN_WIDTH - LRU_WIDTH
ATTN_HEADS = 4
ATTN_V_DIM = ATTN_WIDTH // ATTN_HEADS
ATTN_QK_DIM = ATTN_V_DIM // 2
ROPE_AXIS_DIM = ATTN_QK_DIM // 2
ROPE_THETA = 10000.0
Q_BLOCK = 128
LRU_HEADS = 4
LRU_BLOCK = LRU_WIDTH // LRU_HEADS
CONV_WIDTH = 4
CONV_PAD_L = 1
LRU_C = 8.0
SGU_GROUPS = 4
SGU_GROUP_DIM = SGU_WIDTH // SGU_GROUPS
CHUNK = 128
FFN_HIDDEN = -(-8 * D_MODEL // (3 * 256)) * 256
Q0 = 0
K0 = ATTN_WIDTH
V0 = 2 * ATTN_WIDTH
LX0 = 3 * ATTN_WIDTH
LG0 = LX0 + LRU_WIDTH
SU0 = LG0 + LRU_WIDTH
SV0 = SU0 + SGU_WIDTH
PROJ_WIDTH = SV0 + SGU_WIDTH

kernel_name = 'hybrid_diffattn_rglru_sgu_prefix_block'


def rmsnorm(x, g):
    xf = x.astype(jnp.float32)
    y = xf * lax.rsqrt(jnp.mean(xf * xf, axis=-1, keepdims=True) + EPS)
    return (y * g).astype(x.dtype)


def modulate(h, shift, scale):
    return h * (1 + scale) + shift


def axial_rope_tables(t_len):
    rows = t_len // GRID_W
    row = jnp.repeat(jnp.arange(rows), GRID_W).astype(jnp.float32)
    col = jnp.tile(jnp.arange(GRID_W), rows).astype(jnp.float32)
    n = ROPE_AXIS_DIM // 2
    inv = ROPE_THETA ** (-jnp.arange(n, dtype=jnp.float32) / n)
    ang_r = row[:, None] * inv[None, :]
    ang_c = col[:, None] * inv[None, :]
    return (jnp.cos(ang_r), jnp.sin(ang_r), jnp.cos(ang_c), jnp.sin(ang_c))


def _rotate(x, cos, sin):
    n = x.shape[-1] // 2
    x1, x2 = x[..., :n], x[..., n:]
    cos = cos[None, :, None, :]
    sin = sin[None, :, None, :]
    return jnp.concatenate([x1 * cos - x2 * sin, x1 * sin + x2 * cos], axis=-1)


def apply_rope(x, tabs):
    cr, sr, cc, sc = tabs
    xr = _rotate(x[..., :ROPE_AXIS_DIM], cr, sr)
    xc = _rotate(x[..., ROPE_AXIS_DIM:], cc, sc)
    return jnp.concatenate([xr, xc], axis=-1).astype(x.dtype)


def diff_attention(q1, q2, k1, k2, v, lam):
    scale = ATTN_QK_DIM ** -0.5
    s1 = jnp.einsum('bqhd,bkhd->bhqk', q1, k1).astype(jnp.float32) * scale
    s2 = jnp.einsum('bqhd,bkhd->bhqk', q2, k2).astype(jnp.float32) * scale
    w = jax.nn.softmax(s1, axis=-1) - lam * jax.nn.softmax(s2, axis=-1)
    return jnp.einsum('bhqk,bkhe->bqhe', w.astype(v.dtype), v)


def attention_mixer(pl, pc, lam_q, lam_k, g_attn, lam_init, tabs, need_ctx):
    B, T = pl.shape[0], pl.shape[1]
    Tc = pc.shape[1]
    H2 = 2 * ATTN_HEADS
    ql = apply_rope(pl[..., Q0:K0].reshape(B, T, H2, ATTN_QK_DIM), tabs)
    kl = apply_rope(pl[..., K0:V0].reshape(B, T, H2, ATTN_QK_DIM), tabs)
    vl = pl[..., V0:LX0].reshape(B, T, ATTN_HEADS, ATTN_V_DIM)
    qc = pc[..., Q0:K0].reshape(B, Tc, H2, ATTN_QK_DIM)
    kc = pc[..., K0:V0].reshape(B, Tc, H2, ATTN_QK_DIM)
    vc = pc[..., V0:LX0].reshape(B, Tc, ATTN_HEADS, ATTN_V_DIM)
    lq = lam_q.astype(jnp.float32)
    lk = lam_k.astype(jnp.float32)
    lam = jnp.exp(jnp.sum(lq[0] * lk[0])) - jnp.exp(jnp.sum(lq[1] * lk[1])) + lam_init
    k1 = jnp.concatenate([kc[:, :, 0::2], kl[:, :, 0::2]], axis=1)
    k2 = jnp.concatenate([kc[:, :, 1::2], kl[:, :, 1::2]], axis=1)
    v = jnp.concatenate([vc, vl], axis=1)
    nb = T // Q_BLOCK
    qb = ql.reshape(B, nb, Q_BLOCK, H2, ATTN_QK_DIM).swapaxes(0, 1)
    ol = lax.map(lambda q: diff_attention(q[:, :, 0::2], q[:, :, 1::2], k1, k2, v, lam), qb)
    ol = ol.swapaxes(0, 1).reshape(B, T, ATTN_HEADS, ATTN_V_DIM)

    def post(o):
        o = rmsnorm(o, g_attn) * (1.0 - lam_init)
        return o.reshape(o.shape[0], o.shape[1], ATTN_WIDTH)

    yl = post(ol)
    yc = None
    if need_ctx:
        oc = diff_attention(qc[:, :, 0::2], qc[:, :, 1::2], kc[:, :, 0::2], kc[:, :, 1::2], vc, lam)
        yc = post(oc)
    return yl, yc


def short_conv(x, w, b):
    T = x.shape[1]
    xp = jnp.pad(x, ((0, 0), (CONV_PAD_L, CONV_WIDTH - 1 - CONV_PAD_L), (0, 0)))
    return sum(xp[:, k:k + T] * w[k] for k in range(CONV_WIDTH)) + b


def block_diag(x, w):
    B, T = x.shape[0], x.shape[1]
    xh = x.reshape(B, T, LRU_HEADS, LRU_BLOCK)
    return jnp.einsum('bthi,hij->bthj', xh, w).reshape(B, T, LRU_WIDTH)


def _combine(e1, e2):
    a1, b1 = e1
    a2, b2 = e2
    return a1 * a2, a2 * b1 + b2


def linear_scan(a, bt, h0, reverse):
    idx = -1 if reverse else 0
    bt = bt.at[:, idx].add(a[:, idx] * h0)
    _, h = lax.associative_scan(_combine, (a, bt), reverse=reverse, axis=1)
    return h


def rglru_direction(xc, w_a, b_a, w_x, b_x, lam, h0, reverse):
    xf = xc.astype(jnp.float32)
    r = jax.nn.sigmoid(block_diag(xf, w_a) + b_a)
    i = jax.nn.sigmoid(block_diag(xf, w_x) + b_x)
    log_a = -LRU_C * r * jax.nn.softplus(-lam)
    a = jnp.exp(log_a)
    bt = jnp.sqrt(jnp.maximum(-jnp.expm1(2.0 * log_a), 0.0)) * (i * xf)
    h = linear_scan(a, bt, h0, reverse)
    final = h[:, 0] if reverse else h[:, -1]
    return h, final


def rglru_mixer(pl, pc, conv_w, conv_b, w_a, b_a, w_x, b_x, lam, need_ctx):
    cl = short_conv(pl[..., LX0:LG0], conv_w, conv_b)
    cc = short_conv(pc[..., LX0:LG0], conv_w, conv_b)
    B = pl.shape[0]
    h0 = jnp.zeros((B, LRU_WIDTH), jnp.float32)
    hl_sum = 0
    hc_sum = 0
    for d, rev in enumerate((False, True)):
        h_c, s_c = rglru_direction(cc, w_a[d], b_a[d], w_x[d], b_x[d], lam[d], h0, rev)
        h_l, _ = rglru_direction(cl, w_a[d], b_a[d], w_x[d], b_x[d], lam[d], s_c, rev)
        hl_sum = hl_sum + h_l
        hc_sum = hc_sum + h_c
    yl = hl_sum.astype(pl.dtype) * jax.nn.gelu(pl[..., LG0:SU0])
    yc = hc_sum.astype(pc.dtype) * jax.nn.gelu(pc[..., LG0:SU0]) if need_ctx else None
    return yl, yc


def sgu_mixer(p, g, w_s, b_s):
    B, T = p.shape[0], p.shape[1]
    u = jax.nn.gelu(p[..., SU0:SV0])
    v = jax.nn.gelu(p[..., SV0:PROJ_WIDTH])
    vn = rmsnorm(v.reshape(B, T, SGU_GROUPS, SGU_GROUP_DIM), g.reshape(SGU_GROUPS, SGU_GROUP_DIM))
    vc = vn.reshape(B, T // CHUNK, CHUNK, SGU_GROUPS, SGU_GROUP_DIM)
    m = jnp.einsum('gpq,bnqgc->bnpgc', w_s, vc) + b_s.T[:, :, None]
    return u * m.reshape(B, T, SGU_WIDTH)


def swiglu(h, wg, wu, wd):
    return (jax.nn.silu(h @ wg) * (h @ wu)) @ wd


def setup_inputs(seed: int = 0) -> dict:
    key = jax.random.key(seed)
    ks = jax.random.split(key, 28)
    f32 = jnp.float32
    L = DEPTH

    def nrm(k, shape, s):
        return jax.random.normal(k, shape, f32) * s

    u = jax.random.uniform(ks[16], (L, 2, LRU_WIDTH), f32, 0.9, 0.999)
    sig = u ** (1.0 / LRU_C)
    lru_lambda = jnp.log(sig) - jnp.log1p(-sig)
    return {
        'x': nrm(ks[0], (BATCH, SEQ, D_MODEL), 1.0),
        'c': nrm(ks[1], (BATCH, D_MODEL), 1.0),
        'ctx': nrm(ks[2], (BATCH, CTX_LEN, D_MODEL), 1.0),
        'c_ctx': nrm(ks[3], (D_MODEL,), 1.0),
        'w_ada': nrm(ks[4], (L, D_MODEL, N_MOD * D_MODEL), 0.5 * D_MODEL ** -0.5),
        'b_ada': nrm(ks[5], (L, N_MOD * D_MODEL), 0.02),
        'g_norm1': 1.0 + nrm(ks[6], (L, D_MODEL), 0.02),
        'g_norm2': 1.0 + nrm(ks[7], (L, D_MODEL), 0.02),
        'w_in': nrm(ks[8], (L, D_MODEL, PROJ_WIDTH), D_MODEL ** -0.5),
        'lam_q': nrm(ks[9], (L, 2, ATTN_QK_DIM), 0.1),
        'lam_k': nrm(ks[10], (L, 2, ATTN_QK_DIM), 0.1),
        'g_attn': 1.0 + nrm(ks[11], (L, ATTN_V_DIM), 0.02),
        'conv_w': nrm(ks[12], (L, CONV_WIDTH, LRU_WIDTH), CONV_WIDTH ** -0.5),
        'conv_b': nrm(ks[13], (L, LRU_WIDTH), 0.02),
        'w_rg_a': nrm(ks[14], (L, 2, LRU_HEADS, LRU_BLOCK, LRU_BLOCK), LRU_BLOCK ** -0.5),
        'b_rg_a': nrm(ks[15], (L, 2, LRU_WIDTH), 0.02),
        'w_rg_x': nrm(ks[17], (L, 2, LRU_HEADS, LRU_BLOCK, LRU_BLOCK), LRU_BLOCK ** -0.5),
        'b_rg_x': nrm(ks[18], (L, 2, LRU_WIDTH), 0.02),
        'lru_lambda': lru_lambda,
        'g_sgu': 1.0 + nrm(ks[19], (L, SGU_WIDTH), 0.02),
        'w_spatial': nrm(ks[20], (L, SGU_GROUPS, CHUNK, CHUNK), CHUNK ** -0.5),
        'b_spatial': 1.0 + nrm(ks[21], (L, SGU_GROUPS, CHUNK), 0.02),
        'w_out': nrm(ks[22], (L, D_MODEL, D_MODEL), D_MODEL ** -0.5),
        'w_ffn_gate': nrm(ks[23], (L, D_MODEL, FFN_HIDDEN), D_MODEL ** -0.5),
        'w_ffn_up': nrm(ks[24], (L, D_MODEL, FFN_HIDDEN), D_MODEL ** -0.5),
        'w_ffn_down': nrm(ks[25], (L, FFN_HIDDEN, D_MODEL), FFN_HIDDEN ** -0.5),
        'g_final': 1.0 + nrm(ks[26], (D_MODEL,), 0.02),
    }


def reference(x, c, ctx, c_ctx, w_ada, b_ada, g_norm1, g_norm2, w_in, lam_q, lam_k, g_attn,
              conv_w, conv_b, w_rg_a, b_rg_a, w_rg_x, b_rg_x, lru_lambda, g_sgu, w_spatial,
              b_spatial, w_out, w_ffn_gate, w_ffn_up, w_ffn_down, g_final):
    S = x.shape[1]
    tabs = axial_rope_tables(S)
    xl, xc = x, ctx
    for l in range(DEPTH):
        last = l == DEPTH - 1
        lam_init = 0.8 - 0.6 * math.exp(-0.3 * l)
        mod_l = jnp.split((jax.nn.silu(c) @ w_ada[l] + b_ada[l])[:, None, :], N_MOD, axis=-1)
        mod_c = jnp.split(jax.nn.silu(c_ctx) @ w_ada[l] + b_ada[l], N_MOD, axis=-1)
        hl = modulate(rmsnorm(xl, g_norm1[l]), mod_l[0], mod_l[1])
        hc = modulate(rmsnorm(xc, g_norm1[l]), mod_c[0], mod_c[1])
        pl = hl @ w_in[l]
        pc = hc @ w_in[l]
        al, ac = attention_mixer(pl, pc, lam_q[l], lam_k[l], g_attn[l], lam_init, tabs, not last)
        rl, rc = rglru_mixer(pl, pc, conv_w[l], conv_b[l], w_rg_a[l], b_rg_a[l], w_rg_x[l],
                             b_rg_x[l], lru_lambda[l], not last)
        sl = sgu_mixer(pl, g_sgu[l], w_spatial[l], b_spatial[l])
        xl = xl + mod_l[2] * (jnp.concatenate([al, rl, sl], axis=-1) @ w_out[l])
        hl2 = modulate(rmsnorm(xl, g_norm2[l]), mod_l[3], mod_l[4])
        xl = xl + mod_l[5] * swiglu(hl2, w_ffn_gate[l], w_ffn_up[l], w_ffn_down[l])
        if not last:
            sc = sgu_mixer(pc, g_sgu[l], w_spatial[l], b_spatial[l])
            xc = xc + mod_c[2] * (jnp.concatenate([ac, rc, sc], axis=-1) @ w_out[l])
            hc2 = modulate(rmsnorm(xc, g_norm2[l]), mod_c[3], mod_c[4])
            xc = xc + mod_c[5] * swiglu(hc2, w_ffn_gate[l], w_ffn_up[l], w_ffn_down[l])
    return rmsnorm(xl, g_final)
```

```cpp
#include <hip/hip_runtime.h>
#include <hip/hip_cooperative_groups.h>
#include <cstdio>
#include <cstdint>
namespace cg = cooperative_groups;

#ifndef MK_SINGLE
#define MK_SINGLE 1
#endif
#ifndef PH_MASK
#define PH_MASK 0xFFFF
#endif
#define EN(k) (((PH_MASK) >> (k)) & 1)
#ifndef ATT_VAR
#define ATT_VAR 0
#endif

constexpr int NB = 8, SEQ = 4096, CTXL = 256, TB = SEQ + CTXL, MROWS = NB * TB, DM = 1024, PW = 2560, FH = 2816, NF = 2 * FH, NLAYER = 2;
constexpr int Q0c = 0, K0c = 512, V0c = 1024, LX0 = 1536, LG0 = 1792, SU0 = 2048, SV0 = 2304;
constexpr int NMS = 9, NMOD = 6 * DM;
constexpr int NCHUNK = TB / 128;
constexpr size_t SZ_WIN = (size_t)PW * DM * 2, SZ_WOUT = (size_t)DM * DM * 2, SZ_WFFN = (size_t)NF * DM * 2, SZ_WDN = (size_t)DM * FH * 2;
constexpr size_t WS_WIN = 0, WS_WOUT = WS_WIN + 2 * SZ_WIN, WS_WFFN = WS_WOUT + 2 * SZ_WOUT, WS_WDN = WS_WFFN + 2 * SZ_WFFN;
constexpr size_t WS_WSP = WS_WDN + 2 * SZ_WDN;
constexpr size_t WS_WRG = WS_WSP + 262144;
constexpr size_t WS_MODS = WS_WRG + 262144;
constexpr size_t WS_SHWIN = WS_MODS + 442368;
constexpr size_t WS_SHWF = WS_SHWIN + 184320;
constexpr size_t WS_ROPE = WS_SHWF + 405504;
constexpr size_t WS_C8 = WS_ROPE + 8192;
constexpr size_t WS_LAM = WS_C8 + 4096;
constexpr size_t WS_ROWSS = WS_LAM + 256;
constexpr size_t WS_LRUS = WS_ROWSS + (size_t)MROWS * 64;
constexpr size_t WS_XC = WS_LRUS + (size_t)NB * NCHUNK * 2 * 2 * 256 * 4;
constexpr size_t WS_AP = WS_XC + (size_t)NB * CTXL * DM * 4;
constexpr size_t WS_P = WS_AP + (size_t)MROWS * DM * 2;
constexpr size_t WS_Y = WS_P + (size_t)MROWS * PW * 2;
constexpr size_t WS_END = WS_Y + (size_t)MROWS * DM * 2;
constexpr size_t WS_HMID = WS_P;
static_assert((size_t)MROWS * FH * 2 <= WS_END - WS_P, "hmid overlay");
static_assert(WS_WSP % 256 == 0 && WS_MODS % 256 == 0 && WS_ROWSS % 256 == 0 && WS_XC % 256 == 0 && WS_AP % 256 == 0 && WS_P % 256 == 0, "align");

#define LAS __attribute__((address_space(3)))
typedef float f32x2 __attribute__((ext_vector_type(2)));
typedef unsigned u32x2 __attribute__((ext_vector_type(2)));
__device__ __forceinline__ unsigned cvtpk(float lo, float hi) { unsigned r; asm("v_cvt_pk_bf16_f32 %0, %1, %2" : "=v"(r) : "v"(lo), "v"(hi)); return r; }
__device__ __forceinline__ float bflo(unsigned w) { return __uint_as_float(w << 16); }
__device__ __forceinline__ float bfhi(unsigned w) { return __uint_as_float(w & 0xffff0000u); }
__device__ __forceinline__ float bf2f(unsigned short h) { return __uint_as_float((unsigned)h << 16); }
__device__ __forceinline__ unsigned short f2bf(float v) { return (unsigned short)(cvtpk(v, v) & 0xffffu); }
__device__ __forceinline__ float gelu_tanh(float x) { const float u = 1.5957691216f * x * (1.f + 0.044715f * x * x); return x / (1.f + __expf(-u)); }
__device__ __forceinline__ float silu_f(float x) { return x / (1.f + __expf(-x)); }
__device__ __forceinline__ float sigm(float x) { return 1.f / (1.f + __expf(-x)); }

namespace pg8 {
#define PG8_LAS __attribute__((address_space(3)))
typedef unsigned short bf16_t;
typedef short bf16x8 __attribute__((ext_vector_type(8)));
typedef float f32x4 __attribute__((ext_vector_type(4)));
typedef unsigned u32x4 __attribute__((ext_vector_type(4)));
constexpr int BM = 256, BK = 64, HALF = 128, HTB = HALF * BK * 2  , STAGE_BYTES = 8 * HTB, NXCD = 8, WGM = 8;

__host__ __device__ __forceinline__ int lds_byte(int r, int c) { const int st = (r >> 4) * 2 + (c >> 5), rr = r & 15, cc = c & 31, ob = rr * 64 + cc * 2; return st * 1024 + (ob ^ (((ob >> 9) & 1) << 5)); }
__host__ __device__ __forceinline__ void stage_rc(int b, int& R, int& C) { const int st = b / 1024, sb = b % 1024, swz = sb ^ (((sb >> 9) & 1) << 5); R = (st >> 1) * 16 + swz / 64; C = (st & 1) * 32 + (swz % 64) / 2; }
__host__ __device__ __forceinline__ int perm32(int rho) { const int n = rho >> 4, i = rho & 15; return 8 * (i >> 2) + 4 * n + (i & 3); }

struct Unit { int pm, pn; };
struct Gemm { const bf16_t* A; const bf16_t* Bt; int M, N, K; };

struct StaticOrder {
    int nM, nN, nwg, G, c;
    __host__ __device__ void init(int M, int N, int G_, int c_) { nM = M / BM; nN = N / BM; nwg = nM * nN; G = G_; c = c_; }
    __host__ __device__ bool next(int i, Unit& u) const {
        const long L = (long)i * G + c; if (L >= nwg) return false;
        int wgid = (int)L; { const int q = nwg / NXCD, r = nwg % NXCD, xcd = wgid % NXCD, off = wgid / NXCD; wgid = (xcd < r ? xcd * (q + 1) : r * (q + 1) + (xcd - r) * q) + off; }
        const int nig = WGM * nN, gid = wgid / nig, fm = gid * WGM, gsz = (nM - fm) < WGM ? (nM - fm) : WGM;
        u.pm = fm + ((wgid % nig) % gsz); u.pn = (wgid % nig) / gsz; return true;
    }
    __device__ __forceinline__ void a_ready(const Unit&) const {}
    __device__ __forceinline__ void done(const Unit&) const {}
};

}
namespace pg8 {
template <class Epi, class Sched, bool ALIGN_EPI = false, bool SP2 = false>
__device__ __forceinline__ void gemm_phase(PG8_LAS unsigned char* lds, const Gemm g, const Sched& S, const Epi& E) {
    int tid_ = threadIdx.x; asm volatile("" : "+v"(tid_));
    const int tid = tid_, wid = __builtin_amdgcn_readfirstlane(tid >> 6), lane = tid & 63, wr = wid >> 2, wc = wid & 3, fr = lane & 15, fq = lane >> 4;
    const int K = g.K, nt = K / BK;
    unsigned voffA[2], voffB[2];
#pragma unroll
    for (int i = 0; i < 2; ++i) { int R, C; stage_rc(tid * 16 + i * 8192, R, C); const int Rb = Epi::PERM ? ((R & ~31) + perm32(R & 31)) : R;
        voffA[i] = (unsigned)(R * K + C) * 2u; voffB[i] = (unsigned)(Rb * K + C) * 2u; }
    const size_t kstep = (size_t)(BK * 2);
    const size_t hstep = (size_t)HALF * K * 2;
    const size_t tstep = 2 * hstep;
    const unsigned ldsw = (unsigned)wid * 1024u;
    const int aoff = lds_byte(wr * 64 + fr, fq * 8), boff = lds_byte(wc * 32 + fr, fq * 8);
#define PG8_SA(b, h) (((b) * 2 + (h)) * HTB)
#define PG8_SB(b, h) ((4 + (b) * 2 + (h)) * HTB)
#define PG8_STAGE(bufoff, gbase, voff) do { _Pragma("unroll") for (int _i = 0; _i < 2; ++_i) \
        __builtin_amdgcn_global_load_lds((const unsigned*)((const char*)(gbase) + (voff)[_i]), (PG8_LAS unsigned*)(lds + (bufoff) + ldsw + _i * 8192), 16, 0, 0); } while (0)
#define PG8_LDA(dst, b, h) do { _Pragma("unroll") for (int m = 0; m < 4; ++m) _Pragma("unroll") for (int k = 0; k < 2; ++k) dst[m][k] = *(const PG8_LAS bf16x8*)(lds + PG8_SA(b, h) + aoff + m * 2048 + k * 1024); } while (0)
#define PG8_LDB(dst, b, h) do { _Pragma("unroll") for (int n = 0; n < 2; ++n) _Pragma("unroll") for (int k = 0; k < 2; ++k) dst[n][k] = *(const PG8_LAS bf16x8*)(lds + PG8_SB(b, h) + boff + n * 2048 + k * 1024); } while (0)
#define PG8_MMA(ai, bj, At, Bt) do { __builtin_amdgcn_s_setprio(1); _Pragma("unroll") for (int m = 0; m < 4; ++m) _Pragma("unroll") for (int n = 0; n < 2; ++n) _Pragma("unroll") for (int k = 0; k < 2; ++k) \
        acc[ai][bj][m][n] = __builtin_amdgcn_mfma_f32_16x16x32_bf16(Bt[n][k], At[m][k], acc[ai][bj][m][n], 0, 0, 0); __builtin_amdgcn_s_setprio(0); } while (0)
#define PG8_WAIT_V(n) asm volatile("s_waitcnt vmcnt(" #n ")" ::: "memory")
#define PG8_WAIT_L(n) asm volatile("s_waitcnt lgkmcnt(" #n ")" ::: "memory")
#define PG8_BAR __builtin_amdgcn_s_barrier()
#define PG8_SCHED __builtin_amdgcn_sched_barrier(0)
    Unit cur, nxt; int ui = 0;
    if (!S.next(0, cur)) return;
    f32x4 acc[2][2][4][2];
#pragma unroll
    for (int a = 0; a < 2; ++a)
#pragma unroll
        for (int b = 0; b < 2; ++b)
#pragma unroll
            for (int m = 0; m < 4; ++m)
#pragma unroll
                for (int n = 0; n < 2; ++n) acc[a][b][m][n] = (f32x4){0.f, 0.f, 0.f, 0.f};
    bf16x8 At[4][2], B0[2][2], B1[2][2];
    const char* cA = (const char*)g.A + (size_t)cur.pm * tstep; const char* cB = (const char*)g.Bt + (size_t)cur.pn * tstep;
    S.a_ready(cur);
    if constexpr (SP2) {
        PG8_STAGE(PG8_SB(0, 0), cB, voffB); PG8_STAGE(PG8_SB(0, 1), cB + hstep, voffB); PG8_STAGE(PG8_SA(0, 0), cA, voffA); PG8_STAGE(PG8_SA(0, 1), cA + hstep, voffA);
        if (wr == 1) PG8_BAR;
        PG8_WAIT_V(2); PG8_BAR;
        PG8_STAGE(PG8_SB(1, 0), cB + kstep, voffB); PG8_STAGE(PG8_SA(1, 0), cA + kstep, voffA); PG8_STAGE(PG8_SB(1, 1), cB + hstep + kstep, voffB);
        PG8_WAIT_V(6); PG8_BAR;
    } else {
        PG8_STAGE(PG8_SB(0, 0), cB, voffB); PG8_STAGE(PG8_SA(0, 0), cA, voffA); PG8_STAGE(PG8_SB(0, 1), cB + hstep, voffB); PG8_STAGE(PG8_SA(0, 1), cA + hstep, voffA);
        if (wr == 1) PG8_BAR;
        PG8_WAIT_V(4); PG8_BAR;
        PG8_STAGE(PG8_SB(1, 0), cB + kstep, voffB); PG8_STAGE(PG8_SA(1, 0), cA + kstep, voffA); PG8_STAGE(PG8_SB(1, 1), cB + hstep + kstep, voffB);
        PG8_WAIT_V(6); PG8_BAR;
    }
    for (;;) {
        const bool has_next = S.next(ui + 1, nxt);
        const char* nA = has_next ? (const char*)g.A + (size_t)nxt.pm * tstep : cA; const char* nB = has_next ? (const char*)g.Bt + (size_t)nxt.pn * tstep : cB;
        for (int t = 0; t < nt; t += 2) {
            const bool last = (t == nt - 2);
            const char* a1 = cA + (size_t)(t + 1) * kstep;
            const char* a2 = last ? nA : cA + (size_t)(t + 2) * kstep; const char* b2 = last ? nB : cB + (size_t)(t + 2) * kstep;
            const char* a3 = a2 + kstep; const char* b3 = b2 + kstep;
            if (last && has_next) S.a_ready(nxt);
            if constexpr (SP2) {
            PG8_LDB(B0, 0, 0); PG8_LDB(B1, 0, 1); PG8_SCHED; PG8_LDA(At, 0, 0); PG8_STAGE(PG8_SA(1, 1), a1 + hstep, voffA);
            PG8_WAIT_V(8); PG8_WAIT_L(0); PG8_BAR; PG8_MMA(0, 0, At, B0); PG8_MMA(0, 1, At, B1); PG8_BAR; PG8_SCHED;
            PG8_LDA(At, 0, 1); PG8_STAGE(PG8_SB(0, 0), b2, voffB); PG8_STAGE(PG8_SB(0, 1), b2 + hstep, voffB); PG8_STAGE(PG8_SA(0, 0), a2, voffA);
            PG8_WAIT_V(8); PG8_WAIT_L(0); PG8_BAR; PG8_MMA(1, 0, At, B0); PG8_MMA(1, 1, At, B1); PG8_BAR; PG8_SCHED;
            PG8_LDB(B0, 1, 0); PG8_LDB(B1, 1, 1); PG8_SCHED; PG8_LDA(At, 1, 0); PG8_STAGE(PG8_SA(0, 1), a2 + hstep, voffA);
            PG8_WAIT_V(8); PG8_WAIT_L(0); PG8_BAR; PG8_MMA(0, 0, At, B0); PG8_MMA(0, 1, At, B1); PG8_BAR; PG8_SCHED;
            PG8_LDA(At, 1, 1); PG8_STAGE(PG8_SB(1, 0), b3, voffB); PG8_STAGE(PG8_SB(1, 1), b3 + hstep, voffB); PG8_STAGE(PG8_SA(1, 0), a3, voffA);
            PG8_WAIT_V(8); PG8_WAIT_L(0); PG8_BAR; PG8_MMA(1, 0, At, B0); PG8_MMA(1, 1, At, B1); PG8_BAR; PG8_SCHED;
            } else {
            PG8_LDB(B0, 0, 0); PG8_SCHED; PG8_LDA(At, 0, 0); PG8_STAGE(PG8_SA(1, 1), a1 + hstep, voffA);
            PG8_WAIT_L(8); PG8_BAR; PG8_WAIT_L(0); PG8_MMA(0, 0, At, B0); PG8_BAR; PG8_SCHED;
            PG8_LDB(B1, 0, 1); PG8_STAGE(PG8_SB(0, 0), b2, voffB);
            PG8_BAR; PG8_WAIT_L(0); PG8_MMA(0, 1, At, B1); PG8_BAR;
            PG8_LDA(At, 0, 1); PG8_STAGE(PG8_SA(0, 0), a2, voffA);
            PG8_BAR; PG8_WAIT_L(0); PG8_MMA(1, 0, At, B0); PG8_BAR; PG8_SCHED;
            PG8_STAGE(PG8_SB(0, 1), b2 + hstep, voffB);
            PG8_WAIT_V(6); PG8_BAR; PG8_MMA(1, 1, At, B1); PG8_BAR;
            PG8_LDB(B0, 1, 0); PG8_SCHED; PG8_LDA(At, 1, 0); PG8_STAGE(PG8_SA(0, 1), a2 + hstep, voffA);
            PG8_WAIT_L(8); PG8_BAR; PG8_WAIT_L(0); PG8_MMA(0, 0, At, B0); PG8_BAR; PG8_SCHED;
            PG8_LDB(B1, 1, 1); PG8_STAGE(PG8_SB(1, 0), b3, voffB);
            PG8_BAR; PG8_WAIT_L(0); PG8_MMA(0, 1, At, B1); PG8_BAR;
            PG8_LDA(At, 1, 1); PG8_STAGE(PG8_SA(1, 0), a3, voffA);
            PG8_BAR; PG8_WAIT_L(0); PG8_MMA(1, 0, At, B0); PG8_BAR; PG8_SCHED;
            PG8_STAGE(PG8_SB(1, 1), b3 + hstep, voffB);
            PG8_WAIT_V(6); PG8_BAR; PG8_MMA(1, 1, At, B1); PG8_BAR;
            }
        }
        if constexpr (ALIGN_EPI) { if (wr == 0) PG8_BAR; }
        if constexpr (!Epi::AFTER_DRAIN) { E(acc, cur, wr, wc, fr, fq); S.done(cur); }
        if (!has_next) break;
#pragma unroll
        for (int a = 0; a < 2; ++a)
#pragma unroll
            for (int b = 0; b < 2; ++b)
#pragma unroll
                for (int m = 0; m < 4; ++m)
#pragma unroll
                    for (int n = 0; n < 2; ++n) acc[a][b][m][n] = (f32x4){0.f, 0.f, 0.f, 0.f};
        cur = nxt; cA = nA; cB = nB; ++ui;
        if constexpr (ALIGN_EPI) { if (wr == 1) PG8_BAR; }
    }
    PG8_WAIT_V(0);
    if constexpr (!ALIGN_EPI) { if (wr == 0) PG8_BAR; }
    PG8_BAR;
    if constexpr (Epi::AFTER_DRAIN) { E.fused(acc, cur, wr, wc, fr, fq, lds, wid, lane); S.done(cur); }
#undef PG8_SA
#undef PG8_SB
#undef PG8_STAGE
#undef PG8_LDA
#undef PG8_LDB
#undef PG8_MMA
#undef PG8_WAIT_V
#undef PG8_WAIT_L
#undef PG8_BAR
#undef PG8_SCHED
}
}
namespace pg8 {
struct Order {
    int nM, nN, nwg, G, c, skip;
    __device__ void init(int nM_, int N, int G_, int c_, int skip_) { nM = nM_; nN = N / BM; nwg = nM * nN; G = G_; c = c_; skip = skip_; }
    __device__ bool next(int i, Unit& u) const {
        const long L = (long)i * G + c; if (L >= nwg) return false;
        int wgid = (int)L; { const int q = nwg / NXCD, r = nwg % NXCD, xcd = wgid % NXCD, off = wgid / NXCD; wgid = (xcd < r ? xcd * (q + 1) : r * (q + 1) + (xcd - r) * q) + off; }
        const int nig = WGM * nN, gid = wgid / nig, fm = gid * WGM, gsz = (nM - fm) < WGM ? (nM - fm) : WGM;
        u.pm = fm + ((wgid % nig) % gsz); u.pn = (wgid % nig) / gsz;
        if (skip) u.pm = u.pm + u.pm / 16 + 1;
        return true;
    }
    __device__ __forceinline__ void a_ready(const Unit&) const {}
    __device__ __forceinline__ void done(const Unit&) const {}
};
}

using pg8::f32x4; using pg8::u32x4; using pg8::bf16_t; using pg8::bf16x8;
__device__ __forceinline__ float row_rstd(const float* rowss, size_t row) {
    const f32x4* rs = (const f32x4*)(rowss + row * 16);
    const f32x4 s4 = (rs[0] + rs[1]) + (rs[2] + rs[3]);
    return rsqrtf(((s4.x + s4.y) + (s4.z + s4.w)) * (1.f / 1024.f) + 1e-6f);
}
struct EpiInProj {
    static constexpr bool PERM = false, AFTER_DRAIN = false;
    bf16_t* P; const float* rowss; const float* sW; const float* ropeC; const float* ropeS;
    __device__ __forceinline__ void operator()(const f32x4 (&acc)[2][2][4][2], const pg8::Unit& u, int wr, int wc, int fr, int fq) const {
        const int b = u.pm / 17, j17 = u.pm - b * 17; const bool ctx = (j17 == 0); const int ms = ctx ? 8 : b;
        const int colb = u.pn * 256 + wc * 32 + 4 * fq;
        const int mode = (u.pn < 4) ? (ctx ? 0 : 1) : (u.pn >= 7 ? 2 : 0);
        f32x4 bv[2][2];
#pragma unroll
        for (int bj = 0; bj < 2; ++bj)
#pragma unroll
            for (int n = 0; n < 2; ++n) bv[bj][n] = *(const f32x4*)(sW + ms * PW + colb + bj * 128 + n * 16);
#pragma unroll
        for (int ai = 0; ai < 2; ++ai)
#pragma unroll
            for (int m = 0; m < 4; ++m) {
                const int rt = ai * 128 + wr * 64 + m * 16 + fr; const size_t row = (size_t)u.pm * 256 + rt;
                const float rstd = row_rstd(rowss, row);
                f32x4 v[2][2];
#pragma unroll
                for (int bj = 0; bj < 2; ++bj)
#pragma unroll
                    for (int n = 0; n < 2; ++n) v[bj][n] = acc[ai][bj][m][n] * rstd + bv[bj][n];
                if (mode == 1) {
                    const int tl = (j17 - 1) * 256 + rt; const int pos = (wc & 1) ? (tl & 63) : (tl >> 6);
                    const f32x4 c4 = *(const f32x4*)(ropeC + pos * 16 + 4 * fq), s4 = *(const f32x4*)(ropeS + pos * 16 + 4 * fq);
#pragma unroll
                    for (int bj = 0; bj < 2; ++bj) { const f32x4 x1 = v[bj][0], x2 = v[bj][1]; v[bj][0] = x1 * c4 - x2 * s4; v[bj][1] = x1 * s4 + x2 * c4; }
                } else if (mode == 2) {
#pragma unroll
                    for (int bj = 0; bj < 2; ++bj)
#pragma unroll
                        for (int n = 0; n < 2; ++n) { f32x4 t = v[bj][n]; t.x = gelu_tanh(t.x); t.y = gelu_tanh(t.y); t.z = gelu_tanh(t.z); t.w = gelu_tanh(t.w); v[bj][n] = t; }
                }
                bf16_t* rp = P + row * PW + colb;
#pragma unroll
                for (int bj = 0; bj < 2; ++bj)
#pragma unroll
                    for (int n = 0; n < 2; ++n) { u32x2 w; w.x = cvtpk(v[bj][n].x, v[bj][n].y); w.y = cvtpk(v[bj][n].z, v[bj][n].w); *(u32x2*)(rp + bj * 128 + n * 16) = w; }
            }
    }
};
struct EpiSwiGLU {
    static constexpr bool PERM = true, AFTER_DRAIN = false;
    bf16_t* H; const float* rowss; const float* sW;
    __device__ __forceinline__ void operator()(const f32x4 (&acc)[2][2][4][2], const pg8::Unit& u, int wr, int wc, int fr, int fq) const {
        const int b = u.pm / 17, j17 = u.pm - b * 17; const int ms = (j17 == 0) ? 8 : b;
        const int colb = wc * 32 + 8 * fq;
        f32x4 bg[2], bu[2];
#pragma unroll
        for (int n = 0; n < 2; ++n) { bg[n] = *(const f32x4*)(sW + ms * NF + u.pn * 256 + colb + 4 * n); bu[n] = *(const f32x4*)(sW + ms * NF + u.pn * 256 + 128 + colb + 4 * n); }
#pragma unroll
        for (int ai = 0; ai < 2; ++ai)
#pragma unroll
            for (int m = 0; m < 4; ++m) {
                const int rt = ai * 128 + wr * 64 + m * 16 + fr; const size_t row = (size_t)u.pm * 256 + rt;
                const float rstd = row_rstd(rowss, row);
                f32x4 hm[2];
#pragma unroll
                for (int n = 0; n < 2; ++n) { const f32x4 g = acc[ai][0][m][n] * rstd + bg[n], up = acc[ai][1][m][n] * rstd + bu[n];
                    hm[n].x = silu_f(g.x) * up.x; hm[n].y = silu_f(g.y) * up.y; hm[n].z = silu_f(g.z) * up.z; hm[n].w = silu_f(g.w) * up.w; }
                u32x4 w; w.x = cvtpk(hm[0].x, hm[0].y); w.y = cvtpk(hm[0].z, hm[0].w); w.z = cvtpk(hm[1].x, hm[1].y); w.w = cvtpk(hm[1].z, hm[1].w);
                *(u32x4*)(H + row * FH + u.pn * 128 + colb) = w;
            }
    }
};
struct EpiRes {
    static constexpr bool PERM = true, AFTER_DRAIN = false;
    const float* xin_lat; const float* xin_ctx; float* xo_lat; float* xo_ctx;
    const float* gate; const float* gn; const float* scn; bf16_t* A; float* rowss; int write_a;
    __device__ __forceinline__ void operator()(const f32x4 (&acc)[2][2][4][2], const pg8::Unit& u, int wr, int wc, int fr, int fq) const {
        const int b = u.pm / 17, j17 = u.pm - b * 17; const bool ctx = (j17 == 0); const int ms = ctx ? 8 : b;
        const float* xi = ctx ? xin_ctx + (size_t)b * CTXL * DM : xin_lat + ((size_t)b * SEQ + (size_t)(j17 - 1) * 256) * DM;
        float* xo = ctx ? xo_ctx + (size_t)b * CTXL * DM : xo_lat + ((size_t)b * SEQ + (size_t)(j17 - 1) * 256) * DM;
        const int colb = u.pn * 256 + wc * 32 + 8 * fq;
        float ss[2][4];
#pragma unroll
        for (int ai = 0; ai < 2; ++ai)
#pragma unroll
            for (int m = 0; m < 4; ++m) ss[ai][m] = 0.f;
#pragma unroll
        for (int bj = 0; bj < 2; ++bj) {
            const int col = colb + bj * 128;
            f32x4 gv[2];
#pragma unroll
            for (int n = 0; n < 2; ++n) gv[n] = *(const f32x4*)(gate + ms * NMOD + col + 4 * n);
#pragma unroll
            for (int ai = 0; ai < 2; ++ai)
#pragma unroll
                for (int m = 0; m < 4; ++m) {
                    const int rt = ai * 128 + wr * 64 + m * 16 + fr;
                    const unsigned xo4 = ((unsigned)rt * DM + (unsigned)col) * 4u;
                    f32x4 xv[2];
#pragma unroll
                    for (int n = 0; n < 2; ++n) { xv[n] = *(const f32x4*)((const char*)xi + (xo4 + 16u * n)) + gv[n] * acc[ai][bj][m][n];
                        *(f32x4*)((char*)xo + (xo4 + 16u * n)) = xv[n];
                        ss[ai][m] += (xv[n].x * xv[n].x + xv[n].y * xv[n].y) + (xv[n].z * xv[n].z + xv[n].w * xv[n].w); }
                    if (write_a) { const f32x4 a0 = xv[0] * (*(const f32x4*)(gn + col) * (*(const f32x4*)(scn + ms * NMOD + col) + 1.f)), a1 = xv[1] * (*(const f32x4*)(gn + col + 4) * (*(const f32x4*)(scn + ms * NMOD + col + 4) + 1.f));
                        u32x4 w; w.x = cvtpk(a0.x, a0.y); w.y = cvtpk(a0.z, a0.w); w.z = cvtpk(a1.x, a1.y); w.w = cvtpk(a1.z, a1.w);
                        *(u32x4*)((char*)A + (((unsigned)u.pm * 256u + (unsigned)rt) * DM + (unsigned)col) * 2u) = w; }
                }
        }
#pragma unroll
        for (int ai = 0; ai < 2; ++ai)
#pragma unroll
            for (int m = 0; m < 4; ++m) { float s = ss[ai][m]; s += __shfl_xor(s, 16); s += __shfl_xor(s, 32);
                if (fq == 0) rowss[((size_t)u.pm * 256 + ai * 128 + wr * 64 + m * 16 + fr) * 16 + u.pn * 4 + wc] = s; }
    }
};
namespace att {
using s16x4 = __attribute__((ext_vector_type(4))) short;
using f32x16 = __attribute__((ext_vector_type(16))) float;
constexpr int SHM_V = 16384, SHM_K = 8192, OFF_V = 0, OFF_K = 32768, OFF_WS = 49152, OFF_ST = 51200, LDS_TOTAL = OFF_ST + 65536;
constexpr float SCALE = 0.125f, THR = 8.f;
#define KSWZ(row, colB) ((row) * 128 + ((colB) ^ (((row) & 7) << 4)))
#define SBAR() __builtin_amdgcn_sched_barrier(0)
__device__ __forceinline__ int crow(int r, int hi) { return (r & 3) + 8 * (r >> 2) + 4 * hi; }
__device__ __forceinline__ void partialSM(f32x16& p0, f32x16& p1, float& m_reg, float& mn, float& alpha) {
  constexpr float C = SCALE * 1.4426950408889634f;
  float pmax = p0[0];
#pragma unroll
  for (int r = 1; r < 16; ++r) pmax = fmaxf(pmax, p0[r]);
#pragma unroll
  for (int r = 0; r < 16; ++r) pmax = fmaxf(pmax, p1[r]);
  { auto rr = __builtin_amdgcn_permlane32_swap(__float_as_uint(pmax), __float_as_uint(pmax), false, false);
    pmax = fmaxf(__uint_as_float(rr[0]), __uint_as_float(rr[1])); }
  if (__builtin_expect(__all(pmax - m_reg <= THR / SCALE), 1)) { mn = m_reg; alpha = 1.f; }
  else { mn = fmaxf(m_reg, pmax); alpha = __builtin_amdgcn_exp2f((m_reg - mn) * C); m_reg = mn; }
  const float mnC = -mn * C;
#pragma unroll
  for (int r = 0; r < 16; ++r) p0[r] = fmaf(p0[r], C, mnC);
#pragma unroll
  for (int r = 0; r < 16; ++r) p1[r] = fmaf(p1[r], C, mnC);
#pragma unroll
  for (int r = 0; r < 16; ++r) p0[r] = __builtin_amdgcn_exp2f(p0[r]);
}
__device__ __forceinline__ void finishSM(f32x16& p0, f32x16& p1, float alpha, float& l_reg, bf16x8& pa0, bf16x8& pa1, bf16x8& pa2, bf16x8& pa3) {
#pragma unroll
  for (int r = 0; r < 16; ++r) p1[r] = __builtin_amdgcn_exp2f(p1[r]);
  float ps = 0;
#pragma unroll
  for (int r = 0; r < 16; ++r) ps += p0[r];
#pragma unroll
  for (int r = 0; r < 16; ++r) ps += p1[r];
  { auto rr = __builtin_amdgcn_permlane32_swap(__float_as_uint(ps), __float_as_uint(ps), false, false);
    ps = __uint_as_float(rr[0]) + __uint_as_float(rr[1]); }
  l_reg = l_reg * alpha + ps;
#define PK4(P, BASE, OUT) do { unsigned a0 = cvtpk(P[BASE + 0], P[BASE + 1]), a1 = cvtpk(P[BASE + 2], P[BASE + 3]);   \
    unsigned b0 = cvtpk(P[BASE + 4], P[BASE + 5]), b1 = cvtpk(P[BASE + 6], P[BASE + 7]);                              \
    auto r0 = __builtin_amdgcn_permlane32_swap(a0, b0, false, false); auto r1 = __builtin_amdgcn_permlane32_swap(a1, b1, false, false); \
    u32x4 w = {r0[0], r1[0], r0[1], r1[1]}; OUT = *reinterpret_cast<bf16x8*>(&w); } while (0)
  PK4(p0, 0, pa0); PK4(p0, 8, pa1); PK4(p1, 0, pa2); PK4(p1, 8, pa3);
#undef PK4
}
__device__ __forceinline__ void qkt(f32x16& p0, f32x16& p1, const char* Ks, const bf16x8* qr, int r32, int hi) {
  p0 = f32x16{}; p1 = f32x16{};
#pragma unroll
  for (int d0 = 0; d0 < 4; ++d0) { const int cb = d0 * 32 + hi * 16;
    const bf16x8 b0 = *reinterpret_cast<const bf16x8*>(Ks + KSWZ(r32, cb));
    const bf16x8 b1 = *reinterpret_cast<const bf16x8*>(Ks + KSWZ(32 + r32, cb));
    p0 = __builtin_amdgcn_mfma_f32_32x32x16_bf16(b0, qr[d0], p0, 0, 0, 0);
    p1 = __builtin_amdgcn_mfma_f32_32x32x16_bf16(b1, qr[d0], p1, 0, 0, 0); }
}
__device__ __forceinline__ int v_st(int k, int c) { const int kk = (k & ~0xC) | ((k & 4) << 1) | ((k & 8) >> 1); return ((kk >> 3) * 4 + (c >> 5)) * 512 + ((kk & 7) * 32 + (c & 31)) * 2; }
__device__ __forceinline__ int v_rd_base(int lane) { return ((lane & 3) << 3) | (((lane >> 2) & 3) << 6) | (((lane >> 4) & 1) << 5) | (((lane >> 5) & 1) << 8); }
constexpr int v_rd_off(int d0, int ks, int half) { return d0 * 512 + ks * 4096 + half * 2048; }
template <int OFF> __device__ __forceinline__ s16x4 tr_read(int vb) {
  s16x4 r; asm volatile("ds_read_b64_tr_b16 %0, %1 offset:%2" : "=&v"(r) : "v"(vb), "i"(OFF) : "memory"); return r;
}
template <int D0> __device__ __forceinline__ void pv_one(f32x16& od, int vb, bf16x8 pa0, bf16x8 pa1, bf16x8 pa2, bf16x8 pa3) {
  const s16x4 l0 = tr_read<v_rd_off(D0, 0, 0)>(vb), h0 = tr_read<v_rd_off(D0, 0, 1)>(vb), l1 = tr_read<v_rd_off(D0, 1, 0)>(vb), h1 = tr_read<v_rd_off(D0, 1, 1)>(vb);
  const s16x4 l2 = tr_read<v_rd_off(D0, 2, 0)>(vb), h2 = tr_read<v_rd_off(D0, 2, 1)>(vb), l3 = tr_read<v_rd_off(D0, 3, 0)>(vb), h3 = tr_read<v_rd_off(D0, 3, 1)>(vb);
  asm volatile("s_waitcnt lgkmcnt(0)" ::: "memory"); SBAR();
#define PK(L, H) (bf16x8){L[0], L[1], L[2], L[3], H[0], H[1], H[2], H[3]}
  od = __builtin_amdgcn_mfma_f32_32x32x16_bf16(pa0, PK(l0, h0), od, 0, 0, 0);
  od = __builtin_amdgcn_mfma_f32_32x32x16_bf16(pa1, PK(l1, h1), od, 0, 0, 0);
  od = __builtin_amdgcn_mfma_f32_32x32x16_bf16(pa2, PK(l2, h2), od, 0, 0, 0);
  od = __builtin_amdgcn_mfma_f32_32x32x16_bf16(pa3, PK(l3, h3), od, 0, 0, 0);
#undef PK
}
__device__ __forceinline__ void pv_d0(f32x16* o, int vb, bf16x8 pa0, bf16x8 pa1, bf16x8 pa2, bf16x8 pa3) {
  pv_one<0>(o[0], vb, pa0, pa1, pa2, pa3); pv_one<1>(o[1], vb, pa0, pa1, pa2, pa3); pv_one<2>(o[2], vb, pa0, pa1, pa2, pa3); pv_one<3>(o[3], vb, pa0, pa1, pa2, pa3);
}
__device__ __forceinline__ void attn_unit(char* lds, const bf16_t* __restrict__ P, bf16_t* __restrict__ Y, int b, int h, int qb, float lam, const float* __restrict__ gattn, float oscale) {
  int tid_ = threadIdx.x; asm volatile("" : "+v"(tid_));
  const int tid = tid_, wid = tid >> 6, lane = tid & 63, r32 = lane & 31, hi = lane >> 5;
  const unsigned rowb = (unsigned)b * TB, q0 = rowb + (unsigned)qb * 256;
  const int seq = (qb == 0) ? CTXL : TB, NT = seq / 64;
  char* V_lds = lds + OFF_V; char* K_lds = lds + OFF_K;
  float* ws = (float*)(lds + OFF_WS) + wid * 64; float* li_l = ws; float* al_l = ws + 32;
  unsigned* stash = (unsigned*)(lds + OFF_ST) + wid * 2048;
  const int sr = tid >> 4, sc = (tid & 15) * 8, vst0 = v_st(sr, sc), vst1 = v_st(32 + sr, sc);
  const int kr = tid >> 3, kc = (tid & 7) * 8, kst = KSWZ(kr, kc * 2);
  const int vb0 = (int)(uintptr_t)V_lds + v_rd_base(lane);
  const char* Pc = (const char*)P;
  const unsigned voff = ((rowb + sr) * PW + V0c + h * 128 + sc) * 2u;
#pragma unroll 1
  for (int map = 0; map < 2; ++map) {
    const unsigned qoff = ((q0 + wid * 32 + r32) * PW + Q0c + h * 128 + map * 64 + hi * 8) * 2u;
    const unsigned koff = ((rowb + kr) * PW + K0c + h * 128 + map * 64 + kc) * 2u;
    bf16x8 qr[4];
#pragma unroll
    for (int d0 = 0; d0 < 4; ++d0) qr[d0] = *reinterpret_cast<const bf16x8*>(Pc + (qoff + d0 * 32));
    float m_reg = -1e30f, l_reg = 0; f32x16 o[4] = {};
    struct { bf16x8 vs0, vs1, ks; } sr_[1];
#define SLOAD(i, k0) do { const unsigned ko_ = (unsigned)(k0) * (PW * 2u); sr_[i].vs0 = *reinterpret_cast<const bf16x8*>(Pc + (voff + ko_)); sr_[i].vs1 = *reinterpret_cast<const bf16x8*>(Pc + (voff + ko_ + 32u * PW * 2u)); \
    sr_[i].ks = *reinterpret_cast<const bf16x8*>(Pc + (koff + ko_)); } while (0)
#define SWRITE(bf, i) do { *(bf16x8*)(V_lds + (bf) * SHM_V + vst0) = sr_[i].vs0; *(bf16x8*)(V_lds + (bf) * SHM_V + vst1) = sr_[i].vs1; \
    *(bf16x8*)(K_lds + (bf) * SHM_K + kst) = sr_[i].ks; } while (0)
#define SWAIT() asm volatile("s_waitcnt vmcnt(0)" ::: "memory")
#define RESC(a) do { if (__any((a) < 1.f)) { if (hi == 0) al_l[r32] = (a); asm volatile("s_waitcnt lgkmcnt(0)" ::: "memory"); \
    _Pragma("unroll") for (int d = 0; d < 4; ++d) _Pragma("unroll") for (int r = 0; r < 16; ++r) o[d][r] *= al_l[crow(r, hi)]; } } while (0)
    f32x16 pA0, pA1, pB0, pB1; float mnA, mnB, alA, alB; bf16x8 pa0, pa1, pa2, pa3;
    constexpr int SE = 0, SO = 0;
    SLOAD(SE, 0); asm volatile("s_waitcnt vmcnt(0)" ::: "memory"); SWRITE(0, SE); __syncthreads();
    qkt(pA0, pA1, K_lds, qr, r32, hi); partialSM(pA0, pA1, m_reg, mnA, alA);
    SLOAD(SO, 64);
    SWAIT(); SWRITE(1, SO); __syncthreads();
    for (int j = 1; j + 1 < NT; j += 2) {
      SBAR(); qkt(pB0, pB1, K_lds + SHM_K, qr, r32, hi);
      finishSM(pA0, pA1, alA, l_reg, pa0, pa1, pa2, pa3); SBAR();
      SLOAD(SO, (j + 1) * 64); SBAR();
      pv_d0(o, vb0, pa0, pa1, pa2, pa3); partialSM(pB0, pB1, m_reg, mnB, alB);
      __syncthreads(); SWAIT(); SWRITE(0, SE);
      RESC(alB); __syncthreads();
      SBAR(); qkt(pA0, pA1, K_lds, qr, r32, hi);
      finishSM(pB0, pB1, alB, l_reg, pa0, pa1, pa2, pa3); SBAR();
      SLOAD(SE, (j + 2) * 64); SBAR();
      pv_d0(o, vb0 + SHM_V, pa0, pa1, pa2, pa3); partialSM(pA0, pA1, m_reg, mnA, alA);
      __syncthreads(); SWAIT(); SWRITE(1, SO);
      RESC(alA); __syncthreads();
    }
    SBAR(); qkt(pB0, pB1, K_lds + SHM_K, qr, r32, hi);
    finishSM(pA0, pA1, alA, l_reg, pa0, pa1, pa2, pa3); SBAR();
    pv_d0(o, vb0, pa0, pa1, pa2, pa3); partialSM(pB0, pB1, m_reg, mnB, alB);
    __syncthreads(); RESC(alB);
    finishSM(pB0, pB1, alB, l_reg, pa0, pa1, pa2, pa3); SBAR();
    pv_d0(o, vb0 + SHM_V, pa0, pa1, pa2, pa3);
    if (hi == 0) li_l[r32] = l_reg; asm volatile("s_waitcnt lgkmcnt(0)" ::: "memory");
    if (map == 0) {
#pragma unroll
      for (int r = 0; r < 16; ++r) { const float rl = __builtin_amdgcn_rcpf(li_l[crow(r, hi)]);
        stash[(r * 2 + 0) * 64 + lane] = cvtpk(o[0][r] * rl, o[1][r] * rl); stash[(r * 2 + 1) * 64 + lane] = cvtpk(o[2][r] * rl, o[3][r] * rl); SBAR(); }
    } else if (ATT_VAR != 1) {
      char* Yc = (char*)Y; const unsigned yoff = ((q0 + wid * 32) * DM + h * 128 + r32) * 2u;
      float gv[4];
#pragma unroll
      for (int d0 = 0; d0 < 4; ++d0) gv[d0] = gattn[d0 * 32 + r32] * oscale;
      SBAR();
#pragma unroll
      for (int r = 0; r < 16; ++r) { const float rl = lam * __builtin_amdgcn_rcpf(li_l[crow(r, hi)]);
        const unsigned w0 = stash[(r * 2 + 0) * 64 + lane], w1 = stash[(r * 2 + 1) * 64 + lane];
        const float e0 = bflo(w0) - o[0][r] * rl, e1 = bfhi(w0) - o[1][r] * rl, e2 = bflo(w1) - o[2][r] * rl, e3 = bfhi(w1) - o[3][r] * rl;
        float ssq = (e0 * e0 + e1 * e1) + (e2 * e2 + e3 * e3);
        if (ATT_VAR != 3) { ssq += __shfl_xor(ssq, 1); ssq += __shfl_xor(ssq, 2); ssq += __shfl_xor(ssq, 4); ssq += __shfl_xor(ssq, 8); ssq += __shfl_xor(ssq, 16); }
        const float rs = rsqrtf(ssq * (1.f / 128.f) + 1e-6f);
        bf16_t* yr = (bf16_t*)(Yc + (yoff + (unsigned)crow(r, hi) * (DM * 2u)));
        if (ATT_VAR != 4) { yr[0] = f2bf(e0 * rs * gv[0]); yr[32] = f2bf(e1 * rs * gv[1]); yr[64] = f2bf(e2 * rs * gv[2]); yr[96] = f2bf(e3 * rs * gv[3]); } else { yr[0] = f2bf(e0 * rs + e1 + e2 + e3); } SBAR(); }
    }
    __syncthreads();
#undef SLOAD
#undef SWRITE
#undef SWAIT
#undef RESC
  }
}
#undef KSWZ
}
namespace lru {
using att::f32x16; using att::crow;
constexpr int RS = 528;
constexpr int OFF_CL = 0, OFF_YS = 128 * RS;
template <bool PASS2>
__device__ __forceinline__ void lru_unit(char* lds, const bf16_t* __restrict__ P, bf16_t* __restrict__ Y, int b, int c, const float* __restrict__ convw, const float* __restrict__ convb,
                                         const bf16_t* __restrict__ wrg, const float* __restrict__ ba, const float* __restrict__ bx, const float* __restrict__ c8, float* lrus) {
  int tid_ = threadIdx.x; asm volatile("" : "+v"(tid_));
  const int tid = tid_, wid = tid >> 6, lane = tid & 63, r32 = lane & 31, hi = lane >> 5;
  const size_t R0 = (size_t)b * TB + (size_t)c * 128;
  const int seg_lo = (c < 2) ? 0 : CTXL, seg_hi = (c < 2) ? CTXL : TB;
  { const int ch8 = (tid & 31) * 8;
    float w[4][8], bb[8];
#pragma unroll
    for (int k = 0; k < 4; ++k) { const f32x4 a = *(const f32x4*)(convw + k * 256 + ch8), d = *(const f32x4*)(convw + k * 256 + ch8 + 4);
      w[k][0] = a.x; w[k][1] = a.y; w[k][2] = a.z; w[k][3] = a.w; w[k][4] = d.x; w[k][5] = d.y; w[k][6] = d.z; w[k][7] = d.w; }
    { const f32x4 a = *(const f32x4*)(convb + ch8), d = *(const f32x4*)(convb + ch8 + 4); bb[0] = a.x; bb[1] = a.y; bb[2] = a.z; bb[3] = a.w; bb[4] = d.x; bb[5] = d.y; bb[6] = d.z; bb[7] = d.w; }
#pragma unroll 2
    for (int it = tid; it < 4096; it += 512) { const int t = it >> 5; float acc[8];
#pragma unroll
      for (int e = 0; e < 8; ++e) acc[e] = bb[e];
#pragma unroll
      for (int k = 0; k < 4; ++k) { const int tt = c * 128 + t - 1 + k;
        if (tt >= seg_lo && tt < seg_hi) { const u32x4 xv = *(const u32x4*)(P + ((size_t)b * TB + tt) * PW + LX0 + ch8);
          acc[0] += bflo(xv.x) * w[k][0]; acc[1] += bfhi(xv.x) * w[k][1]; acc[2] += bflo(xv.y) * w[k][2]; acc[3] += bfhi(xv.y) * w[k][3];
          acc[4] += bflo(xv.z) * w[k][4]; acc[5] += bfhi(xv.z) * w[k][5]; acc[6] += bflo(xv.w) * w[k][6]; acc[7] += bfhi(xv.w) * w[k][7]; } }
      u32x4 o; o.x = cvtpk(acc[0], acc[1]); o.y = cvtpk(acc[2], acc[3]); o.z = cvtpk(acc[4], acc[5]); o.w = cvtpk(acc[6], acc[7]);
      *(u32x4*)(lds + OFF_CL + t * RS + ch8 * 2) = o; }
  }
  __syncthreads();
  const int hh = wid >> 1, jh = wid & 1, chb = hh * 64 + jh * 32;
#pragma unroll 1
  for (int d = 0; d < 2; ++d) {
    const bf16_t* wa = wrg + ((0 * 2 + d) * 4 + hh) * 4096 + (jh * 32 + r32) * 64 + hi * 8;
    const bf16_t* wx = wrg + ((1 * 2 + d) * 4 + hh) * 4096 + (jh * 32 + r32) * 64 + hi * 8;
    bf16x8 fa[4], fx[4];
#pragma unroll
    for (int k = 0; k < 4; ++k) { fa[k] = *reinterpret_cast<const bf16x8*>(wa + k * 16); fx[k] = *reinterpret_cast<const bf16x8*>(wx + k * 16); }
    float carry[16], Pc[16];
#pragma unroll
    for (int r = 0; r < 16; ++r) { carry[r] = 0.f; Pc[r] = 1.f; }
    if (PASS2) {
#define LRU_STEP(u_) do { const float* sb = lrus + ((((size_t)b * NCHUNK + (u_)) * 2 + d) * 2) * 256 + chb + 4 * hi; \
        _Pragma("unroll") for (int q = 0; q < 4; ++q) { const f32x4 A = *(const f32x4*)(sb + 8 * q), H = *(const f32x4*)(sb + 256 + 8 * q); \
          carry[4 * q] = A.x * carry[4 * q] + H.x; carry[4 * q + 1] = A.y * carry[4 * q + 1] + H.y; carry[4 * q + 2] = A.z * carry[4 * q + 2] + H.z; carry[4 * q + 3] = A.w * carry[4 * q + 3] + H.w; } } while (0)
      if (d == 0) { for (int u = 0; u < c; ++u) LRU_STEP(u); }
      else if (c < 2) { for (int u = 1; u > c; --u) LRU_STEP(u); }
      else { LRU_STEP(1); LRU_STEP(0); for (int u = NCHUNK - 1; u > c; --u) LRU_STEP(u); }
#undef LRU_STEP
    }
    const int lastl = d ? 0 : 31;
#pragma unroll 1
    for (int ti = 0; ti < 4; ++ti) {
      const int tt = d ? 3 - ti : ti;
      char* rowp = lds + OFF_CL + (tt * 32 + r32) * RS;
      f32x16 za = {}, zx = {};
#pragma unroll
      for (int k = 0; k < 4; ++k) { const bf16x8 xb = *reinterpret_cast<const bf16x8*>(rowp + (hh * 64 + k * 16 + hi * 8) * 2);
        za = __builtin_amdgcn_mfma_f32_32x32x16_bf16(fa[k], xb, za, 0, 0, 0); zx = __builtin_amdgcn_mfma_f32_32x32x16_bf16(fx[k], xb, zx, 0, 0, 0); }
      float av[16], bv[16];
#pragma unroll
      for (int q = 0; q < 4; ++q) { const u32x2 cw = *(const u32x2*)(rowp + (chb + 8 * q + 4 * hi) * 2);
        const float clv[4] = {bflo(cw.x), bfhi(cw.x), bflo(cw.y), bfhi(cw.y)};
        const int co = d * 256 + chb + 8 * q + 4 * hi;
        const f32x4 b4 = *(const f32x4*)(ba + co), x4 = *(const f32x4*)(bx + co), c4 = *(const f32x4*)(c8 + co);
        const float bav[4] = {b4.x, b4.y, b4.z, b4.w}, bxv[4] = {x4.x, x4.y, x4.z, x4.w}, c8v[4] = {c4.x, c4.y, c4.z, c4.w};
#pragma unroll
        for (int i = 0; i < 4; ++i) { const int r = 4 * q + i;
          const float rg = sigm(za[r] + bav[i]), ig = sigm(zx[r] + bxv[i]);
          const float a = __expf(-c8v[i] * rg);
          av[r] = a; bv[r] = sqrtf(fmaxf(1.f - a * a, 0.f)) * ig * clv[i]; } }
#pragma unroll
      for (int s = 1; s < 32; s <<= 1) {
        const int srcl = d ? (r32 + s) : (r32 - s);
        const bool valid = (srcl >= 0) && (srcl < 32);
#pragma unroll
        for (int r = 0; r < 16; ++r) {
          const float ap = __shfl(av[r], srcl, 32), bp = __shfl(bv[r], srcl, 32);
          if (valid) { bv[r] = av[r] * bp + bv[r]; av[r] = av[r] * ap; } }
      }
#pragma unroll
      for (int q = 0; q < 4; ++q) { float hv[4];
#pragma unroll
        for (int i = 0; i < 4; ++i) { const int r = 4 * q + i; hv[i] = bv[r] + av[r] * carry[r];
          carry[r] = __shfl(hv[i], lastl, 32);
          if (!PASS2) Pc[r] *= __shfl(av[r], lastl, 32); }
        if (PASS2) { u32x2* yp = (u32x2*)(lds + OFF_YS + (tt * 32 + r32) * RS + (chb + 8 * q + 4 * hi) * 2);
          if (d) { const u32x2 o = *yp; hv[0] += bflo(o.x); hv[1] += bfhi(o.x); hv[2] += bflo(o.y); hv[3] += bfhi(o.y); }
          u32x2 w; w.x = cvtpk(hv[0], hv[1]); w.y = cvtpk(hv[2], hv[3]); *yp = w; } }
    }
    if (!PASS2) { if (r32 == 0) { float* sb = lrus + ((((size_t)b * NCHUNK + c) * 2 + d) * 2) * 256 + chb + 4 * hi;
#pragma unroll
        for (int q = 0; q < 4; ++q) { *(f32x4*)(sb + 8 * q) = (f32x4){Pc[4 * q], Pc[4 * q + 1], Pc[4 * q + 2], Pc[4 * q + 3]};
          *(f32x4*)(sb + 256 + 8 * q) = (f32x4){carry[4 * q], carry[4 * q + 1], carry[4 * q + 2], carry[4 * q + 3]}; } } }
  }
  if (PASS2) {
    __syncthreads();
    const int ch8 = (tid & 31) * 8;
#pragma unroll 2
    for (int it = tid; it < 4096; it += 512) { const int t = it >> 5;
      const u32x4 hv = *(const u32x4*)(lds + OFF_YS + t * RS + ch8 * 2), gv = *(const u32x4*)(P + (R0 + t) * PW + LG0 + ch8);
      u32x4 o; o.x = cvtpk(bflo(hv.x) * bflo(gv.x), bfhi(hv.x) * bfhi(gv.x)); o.y = cvtpk(bflo(hv.y) * bflo(gv.y), bfhi(hv.y) * bfhi(gv.y));
      o.z = cvtpk(bflo(hv.z) * bflo(gv.z), bfhi(hv.z) * bfhi(gv.z)); o.w = cvtpk(bflo(hv.w) * bflo(gv.w), bfhi(hv.w) * bfhi(gv.w));
      *(u32x4*)(Y + (R0 + t) * DM + 512 + ch8) = o; }
  }
  __syncthreads();
}
}

namespace sgu {
using att::f32x16; using att::crow;
constexpr int VS = 272;
__device__ __forceinline__ void sgu_unit(char* lds, const bf16_t* __restrict__ P, bf16_t* __restrict__ Y, int b, int c, const bf16_t* __restrict__ wsp, const float* __restrict__ gsgu, const float* __restrict__ bsp) {
  int tid_ = threadIdx.x; asm volatile("" : "+v"(tid_));
  const int tid = tid_, wid = tid >> 6, lane = tid & 63, r32 = lane & 31, hi = lane >> 5;
  const size_t R0 = (size_t)b * TB + (size_t)c * 128;
  { const int q = tid & 127, g = tid >> 7;
    const bf16_t* vp = P + (R0 + q) * PW + SV0 + g * 64;
    u32x4 xv[8]; float ss = 0.f;
#pragma unroll
    for (int i = 0; i < 8; ++i) { xv[i] = *(const u32x4*)(vp + i * 8);
      const float a0 = bflo(xv[i].x), a1 = bfhi(xv[i].x), a2 = bflo(xv[i].y), a3 = bfhi(xv[i].y), a4 = bflo(xv[i].z), a5 = bfhi(xv[i].z), a6 = bflo(xv[i].w), a7 = bfhi(xv[i].w);
      ss += (a0 * a0 + a1 * a1) + (a2 * a2 + a3 * a3) + (a4 * a4 + a5 * a5) + (a6 * a6 + a7 * a7); }
    const float rs = rsqrtf(ss * (1.f / 64.f) + 1e-6f);
    char* dst = lds + (g * 64) * VS + q * 2;
#pragma unroll
    for (int i = 0; i < 8; ++i) { const float* gp = gsgu + g * 64 + i * 8; const f32x4 g0 = *(const f32x4*)gp, g1 = *(const f32x4*)(gp + 4);
      *(bf16_t*)(dst + (i * 8 + 0) * VS) = f2bf(bflo(xv[i].x) * rs * g0.x); *(bf16_t*)(dst + (i * 8 + 1) * VS) = f2bf(bfhi(xv[i].x) * rs * g0.y);
      *(bf16_t*)(dst + (i * 8 + 2) * VS) = f2bf(bflo(xv[i].y) * rs * g0.z); *(bf16_t*)(dst + (i * 8 + 3) * VS) = f2bf(bfhi(xv[i].y) * rs * g0.w);
      *(bf16_t*)(dst + (i * 8 + 4) * VS) = f2bf(bflo(xv[i].z) * rs * g1.x); *(bf16_t*)(dst + (i * 8 + 5) * VS) = f2bf(bfhi(xv[i].z) * rs * g1.y);
      *(bf16_t*)(dst + (i * 8 + 6) * VS) = f2bf(bflo(xv[i].w) * rs * g1.z); *(bf16_t*)(dst + (i * 8 + 7) * VS) = f2bf(bfhi(xv[i].w) * rs * g1.w); }
  }
  __syncthreads();
  { const int gg = wid >> 1, chalf = wid & 1, cc = gg * 64 + chalf * 32 + r32;
    bf16x8 vb[8];
#pragma unroll
    for (int k = 0; k < 8; ++k) vb[k] = *reinterpret_cast<const bf16x8*>(lds + cc * VS + (k * 16 + hi * 8) * 2);
#pragma unroll 1
    for (int pt = 0; pt < 4; ++pt) { f32x16 acc = {};
      const bf16_t* ap = wsp + (gg * 128 + pt * 32 + r32) * 128 + hi * 8;
#pragma unroll
      for (int k = 0; k < 8; ++k) { const bf16x8 A = *reinterpret_cast<const bf16x8*>(ap + k * 16); acc = __builtin_amdgcn_mfma_f32_32x32x16_bf16(A, vb[k], acc, 0, 0, 0); }
#pragma unroll
      for (int r = 0; r < 16; ++r) { const int p = pt * 32 + crow(r, hi); const float m = acc[r] + bsp[gg * 128 + p];
        const float uu = bf2f(P[(R0 + p) * PW + SU0 + cc]); Y[(R0 + p) * DM + 768 + cc] = f2bf(uu * m); } }
  }
  __syncthreads();
}
}
__device__ __forceinline__ unsigned pk2(float lo, float hi) { return cvtpk(lo, hi); }
__device__ __forceinline__ void transpose_item(const float* __restrict__ W, int K, int N, bf16_t* __restrict__ WT, int row_base, LAS float* scr, int kb, int nb, int lane) {
    const int k0 = 64 * kb, n0 = 32 * nb;
#pragma unroll 8
    for (int i = 0; i < 32; ++i) { const int kk = 2 * i + (lane >> 5); scr[kk * 33 + (lane & 31)] = W[(size_t)(k0 + kk) * N + n0 + (lane & 31)]; }
    asm volatile("s_waitcnt lgkmcnt(0)" ::: "memory");
    const int c = lane & 7;
#pragma unroll
    for (int j = 0; j < 4; ++j) { const int n = (lane >> 3) + 8 * j; const LAS float* s = scr + (8 * c) * 33 + n;
        u32x4 o; o.x = pk2(s[0 * 33], s[1 * 33]); o.y = pk2(s[2 * 33], s[3 * 33]); o.z = pk2(s[4 * 33], s[5 * 33]); o.w = pk2(s[6 * 33], s[7 * 33]);
        *(u32x4*)(WT + (size_t)(row_base + n) * K + k0 + 8 * c) = o; }
    asm volatile("s_waitcnt lgkmcnt(0)" ::: "memory");
}
__device__ __forceinline__ void gemv_item(const LAS float* a_lds, LAS float* red, const float* __restrict__ W, int N, int n0, float* __restrict__ out, int ldo, int obase, const float* __restrict__ bias) {
    const int tid = threadIdx.x, wid = tid >> 6, lane = tid & 63, c4 = (lane & 15) * 4, ks = lane >> 4;
    f32x4 acc[NMS];
#pragma unroll
    for (int ms = 0; ms < NMS; ++ms) acc[ms] = (f32x4){0.f, 0.f, 0.f, 0.f};
    const float* wp = W + (size_t)(wid * 128 + ks) * N + n0 + c4;
#pragma unroll 8
    for (int st = 0; st < 32; ++st) { const f32x4 wv = *(const f32x4*)(wp + (size_t)st * 4 * N); const int k = wid * 128 + st * 4 + ks;
#pragma unroll
        for (int ms = 0; ms < NMS; ++ms) acc[ms] += wv * a_lds[ms * 1024 + k]; }
#pragma unroll
    for (int ms = 0; ms < NMS; ++ms) {
        f32x4 v = acc[ms];
        v.x += __shfl_xor(v.x, 16); v.y += __shfl_xor(v.y, 16); v.z += __shfl_xor(v.z, 16); v.w += __shfl_xor(v.w, 16);
        v.x += __shfl_xor(v.x, 32); v.y += __shfl_xor(v.y, 32); v.z += __shfl_xor(v.z, 32); v.w += __shfl_xor(v.w, 32);
        if (ks == 0) { LAS float* rp = red + (wid * NMS + ms) * 64 + c4; rp[0] = v.x; rp[1] = v.y; rp[2] = v.z; rp[3] = v.w; }
    }
    __syncthreads();
    for (int i = tid; i < NMS * 64; i += 512) { const int ms = i >> 6, c = i & 63; float s = 0.f;
#pragma unroll
        for (int w = 0; w < 8; ++w) s += red[(w * NMS + ms) * 64 + c];
        if (bias) s += bias[n0 + c];
        out[(size_t)ms * ldo + obase + c] = s; }
    __syncthreads();
}
__device__ __forceinline__ float wave_sum(float v) {
#pragma unroll
    for (int o = 1; o < 64; o <<= 1) v += __shfl_xor(v, o);
    return v;
}

constexpr int NPHASE = 15;
constexpr int LDS_BYTES = 147456;
struct Args { const float* in[27]; float* out; unsigned char* ws; int ph_lo, ph_hi; };
__global__ void __launch_bounds__(512, 2) hybrid_fwd(Args args) {
    extern __shared__ __attribute__((aligned(16))) unsigned char lds_raw[];
    char* lds = (char*)lds_raw;
    LAS unsigned char* ldsl = (LAS unsigned char*)lds_raw;
    const int tid = threadIdx.x, lane = tid & 63, wave = __builtin_amdgcn_readfirstlane(tid >> 6);
    const int G = gridDim.x, bx = blockIdx.x, vcu = (G % 8 == 0) ? (bx % 8) * (G / 8) + bx / 8 : bx;
    unsigned char* ws = args.ws;
    const float* const* in = args.in;
    float* mods = (float*)(ws + WS_MODS); float* shwin = (float*)(ws + WS_SHWIN); float* shwf = (float*)(ws + WS_SHWF);
    float* ropeC = (float*)(ws + WS_ROPE); float* ropeS = ropeC + 1024; float* c8 = (float*)(ws + WS_C8); float* lamv = (float*)(ws + WS_LAM);
    float* rowss = (float*)(ws + WS_ROWSS); float* lrus = (float*)(ws + WS_LRUS); float* xc = (float*)(ws + WS_XC);
    bf16_t* AP = (bf16_t*)(ws + WS_AP); bf16_t* Pb = (bf16_t*)(ws + WS_P); bf16_t* Yb = (bf16_t*)(ws + WS_Y); bf16_t* HM = (bf16_t*)(ws + WS_HMID);
    bf16_t* WSP = (bf16_t*)(ws + WS_WSP); bf16_t* WRG = (bf16_t*)(ws + WS_WRG);
    const int lo = args.ph_lo, hi_ = args.ph_hi;
    int phase = 0;
#define IN(k) (lo <= (k) && (k) < hi_)
#define SEAM(k) do { if (IN(k) && IN((k) + 1)) cg::this_grid().sync(); } while (0)

    if (EN(0) && IN(0)) {
        { LAS float* scr = (LAS float*)(ldsl + wave * 16384);
          const int gw = vcu * 8 + wave, NGW = G * 8;
          constexpr int I_IN = 16 * 80, I_OUT = 16 * 32, I_G = 16 * 88, I_D = 44 * 32, I_L = I_IN + I_OUT + 2 * I_G + I_D;
          for (int it = gw; it < NLAYER * I_L; it += NGW) {
              const int l = it / I_L; int r = it - l * I_L;
              if (r < I_IN) { transpose_item(in[8] + (size_t)l * DM * PW, DM, PW, (bf16_t*)(ws + WS_WIN + l * SZ_WIN), 32 * (r % 80), scr, r / 80, r % 80, lane); continue; } r -= I_IN;
              if (r < I_OUT) { transpose_item(in[22] + (size_t)l * DM * DM, DM, DM, (bf16_t*)(ws + WS_WOUT + l * SZ_WOUT), 32 * (r % 32), scr, r / 32, r % 32, lane); continue; } r -= I_OUT;
              if (r < 2 * I_G) { const int up = r >= I_G; if (up) r -= I_G; const int nb = r % 88, n0 = 32 * nb;
                  transpose_item(in[up ? 24 : 23] + (size_t)l * DM * FH, DM, FH, (bf16_t*)(ws + WS_WFFN + l * SZ_WFFN), (n0 / 128) * 256 + (n0 % 128) + (up ? 128 : 0), scr, r / 88, nb, lane); continue; } r -= 2 * I_G;
              transpose_item(in[25] + (size_t)l * FH * DM, FH, DM, (bf16_t*)(ws + WS_WDN + l * SZ_WDN), 32 * (r % 32), scr, r / 32, r % 32, lane);
          }
        }
        { const int gt = vcu * 512 + tid, NT = G * 512;
          for (int i = gt; i < 131072; i += NT) WSP[i] = f2bf(in[20][i]);
          for (int i = gt; i < 131072; i += NT) { const int ii = i & 63, j = (i >> 6) & 63, h = (i >> 12) & 3, d = (i >> 14) & 1, mat = (i >> 15) & 1, l = i >> 16;
              WRG[i] = f2bf(in[mat ? 16 : 14][((((size_t)l * 2 + d) * 4 + h) * 64 + ii) * 64 + j]); }
          if (gt < 1024) { const int pos = gt >> 4, j = gt & 15; const float inv = powf(10000.f, -(float)j / 16.f); const float ang = (float)pos * inv; ropeC[gt] = cosf(ang); ropeS[gt] = sinf(ang);
              const float lv = in[18][gt]; c8[gt] = 8.f * log1pf(expf(-lv)); }
          if (gt < NLAYER) { float s0 = 0.f, s1 = 0.f; for (int k = 0; k < 64; ++k) { s0 += in[9][(gt * 2 + 0) * 64 + k] * in[10][(gt * 2 + 0) * 64 + k]; s1 += in[9][(gt * 2 + 1) * 64 + k] * in[10][(gt * 2 + 1) * 64 + k]; }
              lamv[gt] = expf(s0) - expf(s1) + (0.8f - 0.6f * expf(-0.3f * (float)gt)); }
        }
        __syncthreads();
        { LAS float* a_lds = (LAS float*)ldsl; LAS float* red = (LAS float*)(ldsl + 36864);
          for (int i = tid; i < NMS * 1024; i += 512) { const int ms = i >> 10, k = i & 1023; const float v = (ms < 8) ? in[1][ms * 1024 + k] : in[3][k]; a_lds[i] = silu_f(v); }
          __syncthreads();
          for (int it = vcu; it < NLAYER * 96; it += G) { const int l = it / 96, n0 = (it % 96) * 64;
              gemv_item(a_lds, red, in[4] + (size_t)l * DM * NMOD, NMOD, n0, mods + (size_t)l * NMS * NMOD, NMOD, n0, in[5] + (size_t)l * NMOD); }
        }
    }
    SEAM(0);
    if (EN(1) && IN(1)) {
        { LAS float* a_lds = (LAS float*)ldsl; LAS float* red = (LAS float*)(ldsl + 36864);
          for (int it = vcu; it < NLAYER * 128; it += G) { const int l = it / 128, r = it % 128; const int soff = (r < 40) ? 0 : 3 * DM;
              __syncthreads();
              for (int i = tid; i < NMS * 1024; i += 512) a_lds[i] = mods[((size_t)l * NMS + (i >> 10)) * NMOD + soff + (i & 1023)];
              __syncthreads();
              if (r < 40) gemv_item(a_lds, red, in[8] + (size_t)l * DM * PW, PW, r * 64, shwin + (size_t)l * NMS * PW, PW, r * 64, nullptr);
              else { const int up = r >= 84, nb = (r - 40) % 44, n0 = nb * 64;
                  gemv_item(a_lds, red, in[up ? 24 : 23] + (size_t)l * DM * FH, FH, n0, shwf + (size_t)l * NMS * NF, NF, (n0 / 128) * 256 + (n0 % 128) + (up ? 128 : 0), nullptr); } }
        }
        { const int gw = vcu * 8 + wave, NGW = G * 8;
          for (int m = gw; m < MROWS; m += NGW) { const int b = m / TB, t = m - b * TB; const bool ctx = t < CTXL; const int ms = ctx ? 8 : b;
              const float* xr = ctx ? in[2] + ((size_t)b * CTXL + t) * DM : in[0] + ((size_t)b * SEQ + (t - CTXL)) * DM;
              f32x4 v[4]; float s = 0.f;
#pragma unroll
              for (int j = 0; j < 4; ++j) { v[j] = ((const f32x4*)xr)[lane + 64 * j]; s += (v[j].x * v[j].x + v[j].y * v[j].y) + (v[j].z * v[j].z + v[j].w * v[j].w); }
              s = wave_sum(s);
#pragma unroll
              for (int j = 0; j < 4; ++j) { const int col = 4 * lane + 256 * j; const f32x4 g = *(const f32x4*)(in[6] + col), sc = *(const f32x4*)(mods + (size_t)ms * NMOD + DM + col);
                  const f32x4 a = v[j] * g * (sc + 1.f); u32x2 w; w.x = cvtpk(a.x, a.y); w.y = cvtpk(a.z, a.w); *(u32x2*)(AP + (size_t)m * DM + col) = w; }
              if (lane < 16) rowss[(size_t)m * 16 + lane] = (lane == 0) ? s : 0.f; }
        }
    }
    SEAM(1);
#pragma unroll 1
    for (int l = 0; l < NLAYER; ++l) {
        const int pb = 2 + 6 * l; const bool last = (l == NLAYER - 1);
        const float* modl = mods + (size_t)l * NMS * NMOD;
        if (EN(2) && IN(pb)) {
            pg8::Gemm g{AP, (const bf16_t*)(ws + WS_WIN + l * SZ_WIN), MROWS, PW, DM}; pg8::Order S; S.init(MROWS / 256, PW, G, bx, 0);
            EpiInProj E{Pb, rowss, shwin + (size_t)l * NMS * PW, ropeC, ropeS};
            pg8::gemm_phase<EpiInProj, pg8::Order, true, true>(ldsl, g, S, E);
        }
        SEAM(pb);
        if (IN(pb + 1)) {
            if (EN(3)) for (int u = vcu; u < NB * NCHUNK; u += G)
                lru::lru_unit<false>(lds, Pb, Yb, u / NCHUNK, u % NCHUNK, in[12] + l * 1024, in[13] + l * 256, WRG + (size_t)l * 65536, in[15] + l * 512, in[17] + l * 512, c8 + l * 512, lrus);
            if (EN(4)) for (int u = G - 1 - vcu; u < NB * NCHUNK; u += G) { const int c = u % NCHUNK; if (last && c < 2) continue;
                sgu::sgu_unit(lds, Pb, Yb, u / NCHUNK, c, WSP + (size_t)l * 65536, in[19] + l * 256, in[21] + l * 512); }
            const float lam = lamv[l], li = 0.8f - 0.6f * __expf(-0.3f * (float)l);
            if (EN(5)) { const int nu = last ? NB * 4 * 16 : NB * 4 * 17;
                for (int u = vcu; u < nu; u += G) { int bh, qb; if (u < NB * 4 * 16) { bh = u >> 4; qb = (u & 15) + 1; } else { bh = u - NB * 4 * 16; qb = 0; }
                    att::attn_unit(lds, Pb, Yb, bh >> 2, bh & 3, qb, lam, in[11] + l * 128, 1.f - li); } }
        }
        SEAM(pb + 1);
        if (EN(6) && IN(pb + 2)) {
            for (int u = vcu; u < NB * NCHUNK; u += G) { const int c = u % NCHUNK; if (last && c < 2) continue;
                lru::lru_unit<true>(lds, Pb, Yb, u / NCHUNK, c, in[12] + l * 1024, in[13] + l * 256, WRG + (size_t)l * 65536, in[15] + l * 512, in[17] + l * 512, c8 + l * 512, lrus); }
        }
        SEAM(pb + 2);
        if (EN(7) && IN(pb + 3)) {
            pg8::Gemm g{Yb, (const bf16_t*)(ws + WS_WOUT + l * SZ_WOUT), MROWS, DM, DM}; pg8::Order S; S.init(last ? 128 : 136, DM, G, bx, last ? 1 : 0);
            EpiRes E{l == 0 ? in[0] : args.out, l == 0 ? in[2] : xc, args.out, xc, modl + 2 * DM, in[7] + l * DM, modl + 4 * DM, AP, rowss, 1};
            pg8::gemm_phase<EpiRes, pg8::Order, true, true>(ldsl, g, S, E);
        }
        SEAM(pb + 3);
        if (EN(8) && IN(pb + 4)) {
            pg8::Gemm g{AP, (const bf16_t*)(ws + WS_WFFN + l * SZ_WFFN), MROWS, NF, DM}; pg8::Order S; S.init(last ? 128 : 136, NF, G, bx, last ? 1 : 0);
            EpiSwiGLU E{HM, rowss, shwf + (size_t)l * NMS * NF};
            pg8::gemm_phase<EpiSwiGLU, pg8::Order, true, true>(ldsl, g, S, E);
        }
        SEAM(pb + 4);
        if (EN(9) && IN(pb + 5)) {
            pg8::Gemm g{HM, (const bf16_t*)(ws + WS_WDN + l * SZ_WDN), MROWS, DM, FH}; pg8::Order S; S.init(last ? 128 : 136, DM, G, bx, last ? 1 : 0);
            const int ln = last ? l : l + 1;
            EpiRes E{args.out, xc, args.out, xc, modl + 5 * DM, in[6] + ln * DM, mods + (size_t)ln * NMS * NMOD + DM, AP, rowss, last ? 0 : 1};
            pg8::gemm_phase<EpiRes, pg8::Order, true, true>(ldsl, g, S, E);
        }
        SEAM(pb + 5);
    }
    if (EN(10) && IN(14)) {
        const int gw = vcu * 8 + wave, NGW = G * 8;
        for (int m = gw; m < NB * SEQ; m += NGW) { const int b = m / SEQ, t = m - b * SEQ; const size_t row = (size_t)b * TB + CTXL + t;
            const float rstd = row_rstd(rowss, row); f32x4* xr = (f32x4*)(args.out + (size_t)m * DM);
#pragma unroll
            for (int j = 0; j < 4; ++j) { const f32x4 g = *(const f32x4*)(in[26] + 4 * lane + 256 * j); xr[lane + 64 * j] = xr[lane + 64 * j] * rstd * g; } }
    }
#undef IN
#undef SEAM
}

extern "C" void kernel_launch(void* const* d_in, const int* in_sizes, int n_in, void* d_out, int out_size, void* d_ws, size_t ws_size, hipStream_t stream) {
    static int grid = 0;
    if (grid == 0) {
        if (n_in != 27 || out_size != NB * SEQ * DM || ws_size < WS_END) { fprintf(stderr, "kernel_launch: unexpected shapes (n_in %d out %d ws %zu need %zu)\n", n_in, out_size, ws_size, (size_t)WS_END); grid = -1; return; }
        int dev = 0, cus = 0, per_cu = 0;
        (void)hipGetDevice(&dev); (void)hipDeviceGetAttribute(&cus, hipDeviceAttributeMultiprocessorCount, dev);
        if (hipFuncSetAttribute((const void*)hybrid_fwd, hipFuncAttributeMaxDynamicSharedMemorySize, LDS_BYTES) != hipSuccess) { fprintf(stderr, "kernel_launch: hipFuncSetAttribute failed\n"); grid = -1; return; }
        (void)hipOccupancyMaxActiveBlocksPerMultiprocessor(&per_cu, (const void*)hybrid_fwd, 512, LDS_BYTES);
        if (per_cu < 1) { fprintf(stderr, "kernel_launch: occupancy query says %d blocks per CU\n", per_cu); per_cu = 1; }
        (void)hipGetLastError();
        grid = cus;
    }
    if (grid < 0) return;
    Args a{};
    for (int i = 0; i < 27; ++i) a.in[i] = (const float*)d_in[i];
    a.out = (float*)d_out; a.ws = (unsigned char*)d_ws;
#if MK_SINGLE
    a.ph_lo = 0; a.ph_hi = NPHASE;
    { void* kargs[] = {&a}; hipError_t e = hipLaunchCooperativeKernel((const void*)hybrid_fwd, dim3(grid), dim3(512), kargs, LDS_BYTES, stream);
      if (e != hipSuccess) fprintf(stderr, "cooperative launch failed: %s (grid %d)\n", hipGetErrorString(e), grid); }
#else
    for (int p = 0; p < NPHASE; ++p) { a.ph_lo = p; a.ph_hi = p + 1;
        void* kargs[] = {&a}; hipError_t e = hipLaunchCooperativeKernel((const void*)hybrid_fwd, dim3(grid), dim3(512), kargs, LDS_BYTES, stream);
        if (e != hipSuccess) { fprintf(stderr, "cooperative launch %d failed: %s (grid %d)\n", p, hipGetErrorString(e), grid); break; } }
#endif
}
```

```cpp
#include <hip/hip_runtime.h>
#include <hip/hip_cooperative_groups.h>
#include <cstdio>
#include <cstdint>
namespace cg = cooperative_groups;

#ifndef MK_SINGLE
#define MK_SINGLE 1
#endif
#ifndef PH_MASK
#define PH_MASK 0xFFFF
#endif
#define EN(k) (((PH_MASK) >> (k)) & 1)
#ifndef PROBE_NDUP
#define PROBE_NDUP 0
#define PROBE_DUP0 0
#define PROBE_DUPSTEP 6
#endif
#ifndef ATT_VAR
#define ATT_VAR 0
#endif

constexpr int NB = 8, SEQ = 4096, CTXL = 256, TB = SEQ + CTXL, MROWS = NB * TB, DM = 1024, PW = 2560, FH = 2816, NF = 2 * FH, NLAYER = 2;
constexpr int Q0c = 0, K0c = 512, V0c = 1024, LX0 = 1536, LG0 = 1792, SU0 = 2048, SV0 = 2304;
constexpr int NMS = 9, NMOD = 6 * DM;
constexpr int NCHUNK = TB / 128;
constexpr size_t SZ_WIN = (size_t)PW * DM * 2, SZ_WOUT = (size_t)DM * DM * 2, SZ_WFFN = (size_t)NF * DM * 2, SZ_WDN = (size_t)DM * FH * 2;
constexpr size_t WS_WIN = 0, WS_WOUT = WS_WIN + 2 * SZ_WIN, WS_WFFN = WS_WOUT + 2 * SZ_WOUT, WS_WDN = WS_WFFN + 2 * SZ_WFFN;
constexpr size_t WS_WSP = WS_WDN + 2 * SZ_WDN;
constexpr size_t WS_WRG = WS_WSP + 262144;
constexpr size_t WS_MODS = WS_WRG + 262144;
constexpr size_t WS_SHWIN = WS_MODS + 442368;
constexpr size_t WS_SHWF = WS_SHWIN + 184320;
constexpr size_t WS_ROPE = WS_SHWF + 405504;
constexpr size_t WS_C8 = WS_ROPE + 8192;
constexpr size_t WS_LAM = WS_C8 + 4096;
constexpr size_t WS_ROWSS = WS_LAM + 256;
constexpr size_t WS_LRUS = WS_ROWSS + (size_t)MROWS * 64;
constexpr size_t WS_XC = WS_LRUS + (size_t)NB * NCHUNK * 2 * 2 * 256 * 4;
constexpr size_t WS_AP = WS_XC + (size_t)NB * CTXL * DM * 4;
constexpr size_t WS_P = WS_AP + (size_t)MROWS * DM * 2;
constexpr size_t WS_Y = WS_P + (size_t)MROWS * PW * 2;
constexpr size_t WS_END = WS_Y + (size_t)MROWS * DM * 2;
constexpr size_t WS_CTL = WS_END, WS_CTL_BYTES = 16384, WS_TOTAL = WS_END + WS_CTL_BYTES;
constexpr size_t WS_HMID = WS_P;
static_assert((size_t)MROWS * FH * 2 <= WS_END - WS_P, "hmid overlay");
static_assert(WS_WSP % 256 == 0 && WS_MODS % 256 == 0 && WS_ROWSS % 256 == 0 && WS_XC % 256 == 0 && WS_AP % 256 == 0 && WS_P % 256 == 0, "align");

#define LAS __attribute__((address_space(3)))
typedef float f32x2 __attribute__((ext_vector_type(2)));
typedef unsigned u32x2 __attribute__((ext_vector_type(2)));
__device__ __forceinline__ unsigned cvtpk(float lo, float hi) { unsigned r; asm("v_cvt_pk_bf16_f32 %0, %1, %2" : "=v"(r) : "v"(lo), "v"(hi)); return r; }
__device__ __forceinline__ float bflo(unsigned w) { return __uint_as_float(w << 16); }
__device__ __forceinline__ float bfhi(unsigned w) { return __uint_as_float(w & 0xffff0000u); }
__device__ __forceinline__ float bf2f(unsigned short h) { return __uint_as_float((unsigned)h << 16); }
__device__ __forceinline__ unsigned short f2bf(float v) { return (unsigned short)(cvtpk(v, v) & 0xffffu); }
__device__ __forceinline__ float gelu_tanh(float x) { const float u = 1.5957691216f * x * (1.f + 0.044715f * x * x); return x / (1.f + __expf(-u)); }
__device__ __forceinline__ float silu_f(float x) { return x / (1.f + __expf(-x)); }
__device__ __forceinline__ float sigm(float x) { return 1.f / (1.f + __expf(-x)); }

namespace pg8 {
#define PG8_LAS __attribute__((address_space(3)))
typedef unsigned short bf16_t;
typedef short bf16x8 __attribute__((ext_vector_type(8)));
typedef float f32x4 __attribute__((ext_vector_type(4)));
typedef unsigned u32x4 __attribute__((ext_vector_type(4)));
constexpr int BM = 256, BK = 64, HALF = 128, HTB = HALF * BK * 2  , STAGE_BYTES = 8 * HTB, NXCD = 8, WGM = 8;

__host__ __device__ __forceinline__ int lds_byte(int r, int c) { const int st = (r >> 4) * 2 + (c >> 5), rr = r & 15, cc = c & 31, ob = rr * 64 + cc * 2; return st * 1024 + (ob ^ (((ob >> 9) & 1) << 5)); }
__host__ __device__ __forceinline__ void stage_rc(int b, int& R, int& C) { const int st = b / 1024, sb = b % 1024, swz = sb ^ (((sb >> 9) & 1) << 5); R = (st >> 1) * 16 + swz / 64; C = (st & 1) * 32 + (swz % 64) / 2; }
__host__ __device__ __forceinline__ int perm32(int rho) { const int n = rho >> 4, i = rho & 15; return 8 * (i >> 2) + 4 * n + (i & 3); }

struct Unit { int pm, pn; };
struct Gemm { const bf16_t* A; const bf16_t* Bt; int M, N, K; };

struct StaticOrder {
    int nM, nN, nwg, G, c;
    __host__ __device__ void init(int M, int N, int G_, int c_) { nM = M / BM; nN = N / BM; nwg = nM * nN; G = G_; c = c_; }
    __host__ __device__ bool next(int i, Unit& u) const {
        const long L = (long)i * G + c; if (L >= nwg) return false;
        int wgid = (int)L; { const int q = nwg / NXCD, r = nwg % NXCD, xcd = wgid % NXCD, off = wgid / NXCD; wgid = (xcd < r ? xcd * (q + 1) : r * (q + 1) + (xcd - r) * q) + off; }
        const int nig = WGM * nN, gid = wgid / nig, fm = gid * WGM, gsz = (nM - fm) < WGM ? (nM - fm) : WGM;
        u.pm = fm + ((wgid % nig) % gsz); u.pn = (wgid % nig) / gsz; return true;
    }
    __device__ __forceinline__ void a_ready(const Unit&) const {}
    __device__ __forceinline__ void done(const Unit&) const {}
};

}
namespace pg8 {
template <class Epi, class Sched, bool ALIGN_EPI = false, bool SP2 = false>
__device__ __forceinline__ void gemm_phase(PG8_LAS unsigned char* lds, const Gemm g, const Sched& S, const Epi& E) {
    int tid_ = threadIdx.x; asm volatile("" : "+v"(tid_));
    const int tid = tid_, wid = __builtin_amdgcn_readfirstlane(tid >> 6), lane = tid & 63, wr = wid >> 2, wc = wid & 3, fr = lane & 15, fq = lane >> 4;
    const int K = g.K, nt = K / BK;
    unsigned voffA[2], voffB[2];
#pragma unroll
    for (int i = 0; i < 2; ++i) { int R, C; stage_rc(tid * 16 + i * 8192, R, C); const int Rb = Epi::PERM ? ((R & ~31) + perm32(R & 31)) : R;
        voffA[i] = (unsigned)(R * K + C) * 2u; voffB[i] = (unsigned)(Rb * K + C) * 2u; }
    const size_t kstep = (size_t)(BK * 2);
    const size_t hstep = (size_t)HALF * K * 2;
    const size_t tstep = 2 * hstep;
    const unsigned ldsw = (unsigned)wid * 1024u;
    const int aoff = lds_byte(wr * 64 + fr, fq * 8), boff = lds_byte(wc * 32 + fr, fq * 8);
#define PG8_SA(b, h) (((b) * 2 + (h)) * HTB)
#define PG8_SB(b, h) ((4 + (b) * 2 + (h)) * HTB)
#define PG8_STAGE(bufoff, gbase, voff) do { _Pragma("unroll") for (int _i = 0; _i < 2; ++_i) \
        __builtin_amdgcn_global_load_lds((const unsigned*)((const char*)(gbase) + (voff)[_i]), (PG8_LAS unsigned*)(lds + (bufoff) + ldsw + _i * 8192), 16, 0, 0); } while (0)
#define PG8_LDA(dst, b, h) do { _Pragma("unroll") for (int m = 0; m < 4; ++m) _Pragma("unroll") for (int k = 0; k < 2; ++k) dst[m][k] = *(const PG8_LAS bf16x8*)(lds + PG8_SA(b, h) + aoff + m * 2048 + k * 1024); } while (0)
#define PG8_LDB(dst, b, h) do { _Pragma("unroll") for (int n = 0; n < 2; ++n) _Pragma("unroll") for (int k = 0; k < 2; ++k) dst[n][k] = *(const PG8_LAS bf16x8*)(lds + PG8_SB(b, h) + boff + n * 2048 + k * 1024); } while (0)
#define PG8_MMA(ai, bj, At, Bt) do { __builtin_amdgcn_s_setprio(1); _Pragma("unroll") for (int m = 0; m < 4; ++m) _Pragma("unroll") for (int n = 0; n < 2; ++n) _Pragma("unroll") for (int k = 0; k < 2; ++k) \
        acc[ai][bj][m][n] = __builtin_amdgcn_mfma_f32_16x16x32_bf16(Bt[n][k], At[m][k], acc[ai][bj][m][n], 0, 0, 0); __builtin_amdgcn_s_setprio(0); } while (0)
#define PG8_WAIT_V(n) asm volatile("s_waitcnt vmcnt(" #n ")" ::: "memory")
#define PG8_WAIT_L(n) asm volatile("s_waitcnt lgkmcnt(" #n ")" ::: "memory")
#define PG8_BAR __builtin_amdgcn_s_barrier()
#define PG8_SCHED __builtin_amdgcn_sched_barrier(0)
    Unit cur, nxt; int ui = 0;
    if (!S.next(0, cur)) return;
    f32x4 acc[2][2][4][2];
#pragma unroll
    for (int a = 0; a < 2; ++a)
#pragma unroll
        for (int b = 0; b < 2; ++b)
#pragma unroll
            for (int m = 0; m < 4; ++m)
#pragma unroll
                for (int n = 0; n < 2; ++n) acc[a][b][m][n] = (f32x4){0.f, 0.f, 0.f, 0.f};
    bf16x8 At[4][2], B0[2][2], B1[2][2];
    const char* cA = (const char*)g.A + (size_t)cur.pm * tstep; const char* cB = (const char*)g.Bt + (size_t)cur.pn * tstep;
    S.a_ready(cur);
    if constexpr (SP2) {
        PG8_STAGE(PG8_SB(0, 0), cB, voffB); PG8_STAGE(PG8_SB(0, 1), cB + hstep, voffB); PG8_STAGE(PG8_SA(0, 0), cA, voffA); PG8_STAGE(PG8_SA(0, 1), cA + hstep, voffA);
        if (wr == 1) PG8_BAR;
        PG8_WAIT_V(2); PG8_BAR;
        PG8_STAGE(PG8_SB(1, 0), cB + kstep, voffB); PG8_STAGE(PG8_SA(1, 0), cA + kstep, voffA); PG8_STAGE(PG8_SB(1, 1), cB + hstep + kstep, voffB);
        PG8_WAIT_V(6); PG8_BAR;
    } else {
        PG8_STAGE(PG8_SB(0, 0), cB, voffB); PG8_STAGE(PG8_SA(0, 0), cA, voffA); PG8_STAGE(PG8_SB(0, 1), cB + hstep, voffB); PG8_STAGE(PG8_SA(0, 1), cA + hstep, voffA);
        if (wr == 1) PG8_BAR;
        PG8_WAIT_V(4); PG8_BAR;
        PG8_STAGE(PG8_SB(1, 0), cB + kstep, voffB); PG8_STAGE(PG8_SA(1, 0), cA + kstep, voffA); PG8_STAGE(PG8_SB(1, 1), cB + hstep + kstep, voffB);
        PG8_WAIT_V(6); PG8_BAR;
    }
    for (;;) {
        const bool has_next = S.next(ui + 1, nxt);
        const char* nA = has_next ? (const char*)g.A + (size_t)nxt.pm * tstep : cA; const char* nB = has_next ? (const char*)g.Bt + (size_t)nxt.pn * tstep : cB;
        for (int t = 0; t < nt; t += 2) {
            const bool last = (t == nt - 2);
            const char* a1 = cA + (size_t)(t + 1) * kstep;
            const char* a2 = last ? nA : cA + (size_t)(t + 2) * kstep; const char* b2 = last ? nB : cB + (size_t)(t + 2) * kstep;
            const char* a3 = a2 + kstep; const char* b3 = b2 + kstep;
            if (last && has_next) S.a_ready(nxt);
            if constexpr (SP2) {
            PG8_LDB(B0, 0, 0); PG8_LDB(B1, 0, 1); PG8_SCHED; PG8_LDA(At, 0, 0); PG8_STAGE(PG8_SA(1, 1), a1 + hstep, voffA);
            PG8_WAIT_V(8); PG8_WAIT_L(0); PG8_BAR; PG8_MMA(0, 0, At, B0); PG8_MMA(0, 1, At, B1); PG8_BAR; PG8_SCHED;
            PG8_LDA(At, 0, 1); PG8_STAGE(PG8_SB(0, 0), b2, voffB); PG8_STAGE(PG8_SB(0, 1), b2 + hstep, voffB); PG8_STAGE(PG8_SA(0, 0), a2, voffA);
            PG8_WAIT_V(8); PG8_WAIT_L(0); PG8_BAR; PG8_MMA(1, 0, At, B0); PG8_MMA(1, 1, At, B1); PG8_BAR; PG8_SCHED;
            PG8_LDB(B0, 1, 0); PG8_LDB(B1, 1, 1); PG8_SCHED; PG8_LDA(At, 1, 0); PG8_STAGE(PG8_SA(0, 1), a2 + hstep, voffA);
            PG8_WAIT_V(8); PG8_WAIT_L(0); PG8_BAR; PG8_MMA(0, 0, At, B0); PG8_MMA(0, 1, At, B1); PG8_BAR; PG8_SCHED;
            PG8_LDA(At, 1, 1); PG8_STAGE(PG8_SB(1, 0), b3, voffB); PG8_STAGE(PG8_SB(1, 1), b3 + hstep, voffB); PG8_STAGE(PG8_SA(1, 0), a3, voffA);
            PG8_WAIT_V(8); PG8_WAIT_L(0); PG8_BAR; PG8_MMA(1, 0, At, B0); PG8_MMA(1, 1, At, B1); PG8_BAR; PG8_SCHED;
            } else {
            PG8_LDB(B0, 0, 0); PG8_SCHED; PG8_LDA(At, 0, 0); PG8_STAGE(PG8_SA(1, 1), a1 + hstep, voffA);
            PG8_WAIT_L(8); PG8_BAR; PG8_WAIT_L(0); PG8_MMA(0, 0, At, B0); PG8_BAR; PG8_SCHED;
            PG8_LDB(B1, 0, 1); PG8_STAGE(PG8_SB(0, 0), b2, voffB);
            PG8_BAR; PG8_WAIT_L(0); PG8_MMA(0, 1, At, B1); PG8_BAR;
            PG8_LDA(At, 0, 1); PG8_STAGE(PG8_SA(0, 0), a2, voffA);
            PG8_BAR; PG8_WAIT_L(0); PG8_MMA(1, 0, At, B0); PG8_BAR; PG8_SCHED;
            PG8_STAGE(PG8_SB(0, 1), b2 + hstep, voffB);
            PG8_WAIT_V(6); PG8_BAR; PG8_MMA(1, 1, At, B1); PG8_BAR;
            PG8_LDB(B0, 1, 0); PG8_SCHED; PG8_LDA(At, 1, 0); PG8_STAGE(PG8_SA(0, 1), a2 + hstep, voffA);
            PG8_WAIT_L(8); PG8_BAR; PG8_WAIT_L(0); PG8_MMA(0, 0, At, B0); PG8_BAR; PG8_SCHED;
            PG8_LDB(B1, 1, 1); PG8_STAGE(PG8_SB(1, 0), b3, voffB);
            PG8_BAR; PG8_WAIT_L(0); PG8_MMA(0, 1, At, B1); PG8_BAR;
            PG8_LDA(At, 1, 1); PG8_STAGE(PG8_SA(1, 0), a3, voffA);
            PG8_BAR; PG8_WAIT_L(0); PG8_MMA(1, 0, At, B0); PG8_BAR; PG8_SCHED;
            PG8_STAGE(PG8_SB(1, 1), b3 + hstep, voffB);
            PG8_WAIT_V(6); PG8_BAR; PG8_MMA(1, 1, At, B1); PG8_BAR;
            }
        }
        if constexpr (ALIGN_EPI) { if (wr == 0) PG8_BAR; }
        if constexpr (!Epi::AFTER_DRAIN) { E(acc, cur, wr, wc, fr, fq); S.done(cur); }
        if (!has_next) break;
#pragma unroll
        for (int a = 0; a < 2; ++a)
#pragma unroll
            for (int b = 0; b < 2; ++b)
#pragma unroll
                for (int m = 0; m < 4; ++m)
#pragma unroll
                    for (int n = 0; n < 2; ++n) acc[a][b][m][n] = (f32x4){0.f, 0.f, 0.f, 0.f};
        cur = nxt; cA = nA; cB = nB; ++ui;
        if constexpr (ALIGN_EPI) { if (wr == 1) PG8_BAR; }
    }
    PG8_WAIT_V(0);
    if constexpr (!ALIGN_EPI) { if (wr == 0) PG8_BAR; }
    PG8_BAR;
    if constexpr (Epi::AFTER_DRAIN) { E.fused(acc, cur, wr, wc, fr, fq, lds, wid, lane); S.done(cur); }
#undef PG8_SA
#undef PG8_SB
#undef PG8_STAGE
#undef PG8_LDA
#undef PG8_LDB
#undef PG8_MMA
#undef PG8_WAIT_V
#undef PG8_WAIT_L
#undef PG8_BAR
#undef PG8_SCHED
}
}
namespace pg8 {
struct Order {
    int nM, nN, nwg, G, c, skip;
    __device__ void init(int nM_, int N, int G_, int c_, int skip_) { nM = nM_; nN = N / BM; nwg = nM * nN; G = G_; c = c_; skip = skip_; }
    __device__ bool next(int i, Unit& u) const {
        const long L = (long)i * G + c; if (L >= nwg) return false;
        int wgid = (int)L; { const int q = nwg / NXCD, r = nwg % NXCD, xcd = wgid % NXCD, off = wgid / NXCD; wgid = (xcd < r ? xcd * (q + 1) : r * (q + 1) + (xcd - r) * q) + off; }
        const int nig = WGM * nN, gid = wgid / nig, fm = gid * WGM, gsz = (nM - fm) < WGM ? (nM - fm) : WGM;
        u.pm = fm + ((wgid % nig) % gsz); u.pn = (wgid % nig) / gsz;
        if (skip) u.pm = u.pm + u.pm / 16 + 1;
        return true;
    }
    __device__ __forceinline__ void a_ready(const Unit&) const {}
    __device__ __forceinline__ void done(const Unit&) const {}
};
}

using pg8::f32x4; using pg8::u32x4; using pg8::bf16_t; using pg8::bf16x8;
__device__ __forceinline__ float row_rstd(const float* rowss, size_t row) {
    const f32x4* rs = (const f32x4*)(rowss + row * 16);
    const f32x4 s4 = (rs[0] + rs[1]) + (rs[2] + rs[3]);
    return rsqrtf(((s4.x + s4.y) + (s4.z + s4.w)) * (1.f / 1024.f) + 1e-6f);
}
struct EpiInProj {
    static constexpr bool PERM = false, AFTER_DRAIN = false;
    bf16_t* P; const float* rowss; const float* sW; const float* ropeC; const float* ropeS;
    __device__ __forceinline__ void operator()(const f32x4 (&acc)[2][2][4][2], const pg8::Unit& u, int wr, int wc, int fr, int fq) const {
        const int b = u.pm / 17, j17 = u.pm - b * 17; const bool ctx = (j17 == 0); const int ms = ctx ? 8 : b;
        const int colb = u.pn * 256 + wc * 32 + 4 * fq;
        const int mode = (u.pn < 4) ? (ctx ? 0 : 1) : (u.pn >= 7 ? 2 : 0);
        f32x4 bv[2][2];
#pragma unroll
        for (int bj = 0; bj < 2; ++bj)
#pragma unroll
            for (int n = 0; n < 2; ++n) bv[bj][n] = *(const f32x4*)(sW + ms * PW + colb + bj * 128 + n * 16);
#pragma unroll
        for (int ai = 0; ai < 2; ++ai)
#pragma unroll
            for (int m = 0; m < 4; ++m) {
                const int rt = ai * 128 + wr * 64 + m * 16 + fr; const size_t row = (size_t)u.pm * 256 + rt;
                const float rstd = row_rstd(rowss, row);
                f32x4 v[2][2];
#pragma unroll
                for (int bj = 0; bj < 2; ++bj)
#pragma unroll
                    for (int n = 0; n < 2; ++n) v[bj][n] = acc[ai][bj][m][n] * rstd + bv[bj][n];
                if (mode == 1) {
                    const int tl = (j17 - 1) * 256 + rt; const int pos = (wc & 1) ? (tl & 63) : (tl >> 6);
                    const f32x4 c4 = *(const f32x4*)(ropeC + pos * 16 + 4 * fq), s4 = *(const f32x4*)(ropeS + pos * 16 + 4 * fq);
#pragma unroll
                    for (int bj = 0; bj < 2; ++bj) { const f32x4 x1 = v[bj][0], x2 = v[bj][1]; v[bj][0] = x1 * c4 - x2 * s4; v[bj][1] = x1 * s4 + x2 * c4; }
                } else if (mode == 2) {
#pragma unroll
                    for (int bj = 0; bj < 2; ++bj)
#pragma unroll
                        for (int n = 0; n < 2; ++n) { f32x4 t = v[bj][n]; t.x = gelu_tanh(t.x); t.y = gelu_tanh(t.y); t.z = gelu_tanh(t.z); t.w = gelu_tanh(t.w); v[bj][n] = t; }
                }
                bf16_t* rp = P + row * PW + colb;
#pragma unroll
                for (int bj = 0; bj < 2; ++bj)
#pragma unroll
                    for (int n = 0; n < 2; ++n) { u32x2 w; w.x = cvtpk(v[bj][n].x, v[bj][n].y); w.y = cvtpk(v[bj][n].z, v[bj][n].w); *(u32x2*)(rp + bj * 128 + n * 16) = w; }
            }
    }
};
struct EpiSwiGLU {
    static constexpr bool PERM = true, AFTER_DRAIN = false;
    bf16_t* H; const float* rowss; const float* sW;
    __device__ __forceinline__ void operator()(const f32x4 (&acc)[2][2][4][2], const pg8::Unit& u, int wr, int wc, int fr, int fq) const {
        const int b = u.pm / 17, j17 = u.pm - b * 17; const int ms = (j17 == 0) ? 8 : b;
        const int colb = wc * 32 + 8 * fq;
        f32x4 bg[2], bu[2];
#pragma unroll
        for (int n = 0; n < 2; ++n) { bg[n] = *(const f32x4*)(sW + ms * NF + u.pn * 256 + colb + 4 * n); bu[n] = *(const f32x4*)(sW + ms * NF + u.pn * 256 + 128 + colb + 4 * n); }
#pragma unroll
        for (int ai = 0; ai < 2; ++ai)
#pragma unroll
            for (int m = 0; m < 4; ++m) {
                const int rt = ai * 128 + wr * 64 + m * 16 + fr; const size_t row = (size_t)u.pm * 256 + rt;
                const float rstd = row_rstd(rowss, row);
                f32x4 hm[2];
#pragma unroll
                for (int n = 0; n < 2; ++n) { const f32x4 g = acc[ai][0][m][n] * rstd + bg[n], up = acc[ai][1][m][n] * rstd + bu[n];
                    hm[n].x = silu_f(g.x) * up.x; hm[n].y = silu_f(g.y) * up.y; hm[n].z = silu_f(g.z) * up.z; hm[n].w = silu_f(g.w) * up.w; }
                u32x4 w; w.x = cvtpk(hm[0].x, hm[0].y); w.y = cvtpk(hm[0].z, hm[0].w); w.z = cvtpk(hm[1].x, hm[1].y); w.w = cvtpk(hm[1].z, hm[1].w);
                *(u32x4*)(H + row * FH + u.pn * 128 + colb) = w;
            }
    }
};
struct EpiRes {
    static constexpr bool PERM = true, AFTER_DRAIN = false;
    const float* xin_lat; const float* xin_ctx; float* xo_lat; float* xo_ctx;
    const float* gate; const float* gn; const float* scn; bf16_t* A; float* rowss; int write_a;
    __device__ __forceinline__ void operator()(const f32x4 (&acc)[2][2][4][2], const pg8::Unit& u, int wr, int wc, int fr, int fq) const {
        const int b = u.pm / 17, j17 = u.pm - b * 17; const bool ctx = (j17 == 0); const int ms = ctx ? 8 : b;
        const float* xi = ctx ? xin_ctx + (size_t)b * CTXL * DM : xin_lat + ((size_t)b * SEQ + (size_t)(j17 - 1) * 256) * DM;
        float* xo = ctx ? xo_ctx + (size_t)b * CTXL * DM : xo_lat + ((size_t)b * SEQ + (size_t)(j17 - 1) * 256) * DM;
        const int colb = u.pn * 256 + wc * 32 + 8 * fq;
        float ss[2][4];
#pragma unroll
        for (int ai = 0; ai < 2; ++ai)
#pragma unroll
            for (int m = 0; m < 4; ++m) ss[ai][m] = 0.f;
#pragma unroll
        for (int bj = 0; bj < 2; ++bj) {
            const int col = colb + bj * 128;
            f32x4 gv[2];
#pragma unroll
            for (int n = 0; n < 2; ++n) gv[n] = *(const f32x4*)(gate + ms * NMOD + col + 4 * n);
#pragma unroll
            for (int ai = 0; ai < 2; ++ai)
#pragma unroll
                for (int m = 0; m < 4; ++m) {
                    const int rt = ai * 128 + wr * 64 + m * 16 + fr;
                    const unsigned xo4 = ((unsigned)rt * DM + (unsigned)col) * 4u;
                    f32x4 xv[2];
#pragma unroll
                    for (int n = 0; n < 2; ++n) { xv[n] = *(const f32x4*)((const char*)xi + (xo4 + 16u * n)) + gv[n] * acc[ai][bj][m][n];
                        *(f32x4*)((char*)xo + (xo4 + 16u * n)) = xv[n];
                        ss[ai][m] += (xv[n].x * xv[n].x + xv[n].y * xv[n].y) + (xv[n].z * xv[n].z + xv[n].w * xv[n].w); }
                    if (write_a) { const f32x4 a0 = xv[0] * (*(const f32x4*)(gn + col) * (*(const f32x4*)(scn + ms * NMOD + col) + 1.f)), a1 = xv[1] * (*(const f32x4*)(gn + col + 4) * (*(const f32x4*)(scn + ms * NMOD + col + 4) + 1.f));
                        u32x4 w; w.x = cvtpk(a0.x, a0.y); w.y = cvtpk(a0.z, a0.w); w.z = cvtpk(a1.x, a1.y); w.w = cvtpk(a1.z, a1.w);
                        *(u32x4*)((char*)A + (((unsigned)u.pm * 256u + (unsigned)rt) * DM + (unsigned)col) * 2u) = w; }
                }
        }
#pragma unroll
        for (int ai = 0; ai < 2; ++ai)
#pragma unroll
            for (int m = 0; m < 4; ++m) { float s = ss[ai][m]; s += __shfl_xor(s, 16); s += __shfl_xor(s, 32);
                if (fq == 0) rowss[((size_t)u.pm * 256 + ai * 128 + wr * 64 + m * 16 + fr) * 16 + u.pn * 4 + wc] = s; }
    }
};
namespace att {
using s16x4 = __attribute__((ext_vector_type(4))) short;
using f32x16 = __attribute__((ext_vector_type(16))) float;
constexpr int SHM_V = 16384, SHM_K = 8192, OFF_V = 0, OFF_K = 32768, OFF_WS = 49152, OFF_ST = 51200, LDS_TOTAL = OFF_ST + 65536;
constexpr float SCALE = 0.125f, THR = 8.f;
#define KSWZ(row, colB) ((row) * 128 + ((colB) ^ (((row) & 7) << 4)))
#define SBAR() __builtin_amdgcn_sched_barrier(0)
__device__ __forceinline__ int crow(int r, int hi) { return (r & 3) + 8 * (r >> 2) + 4 * hi; }
__device__ __forceinline__ void partialSM(f32x16& p0, f32x16& p1, float& m_reg, float& mn, float& alpha) {
  constexpr float C = SCALE * 1.4426950408889634f;
  float pmax = p0[0];
#pragma unroll
  for (int r = 1; r < 16; ++r) pmax = fmaxf(pmax, p0[r]);
#pragma unroll
  for (int r = 0; r < 16; ++r) pmax = fmaxf(pmax, p1[r]);
  { auto rr = __builtin_amdgcn_permlane32_swap(__float_as_uint(pmax), __float_as_uint(pmax), false, false);
    pmax = fmaxf(__uint_as_float(rr[0]), __uint_as_float(rr[1])); }
  if (__builtin_expect(__all(pmax - m_reg <= THR / SCALE), 1)) { mn = m_reg; alpha = 1.f; }
  else { mn = fmaxf(m_reg, pmax); alpha = __builtin_amdgcn_exp2f((m_reg - mn) * C); m_reg = mn; }
  const float mnC = -mn * C;
#pragma unroll
  for (int r = 0; r < 16; ++r) p0[r] = fmaf(p0[r], C, mnC);
#pragma unroll
  for (int r = 0; r < 16; ++r) p1[r] = fmaf(p1[r], C, mnC);
#pragma unroll
  for (int r = 0; r < 16; ++r) p0[r] = __builtin_amdgcn_exp2f(p0[r]);
}
__device__ __forceinline__ void finishSM(f32x16& p0, f32x16& p1, float alpha, float& l_reg, bf16x8& pa0, bf16x8& pa1, bf16x8& pa2, bf16x8& pa3) {
#pragma unroll
  for (int r = 0; r < 16; ++r) p1[r] = __builtin_amdgcn_exp2f(p1[r]);
  float ps = 0;
#pragma unroll
  for (int r = 0; r < 16; ++r) ps += p0[r];
#pragma unroll
  for (int r = 0; r < 16; ++r) ps += p1[r];
  { auto rr = __builtin_amdgcn_permlane32_swap(__float_as_uint(ps), __float_as_uint(ps), false, false);
    ps = __uint_as_float(rr[0]) + __uint_as_float(rr[1]); }
  l_reg = l_reg * alpha + ps;
#define PK4(P, BASE, OUT) do { unsigned a0 = cvtpk(P[BASE + 0], P[BASE + 1]), a1 = cvtpk(P[BASE + 2], P[BASE + 3]);   \
    unsigned b0 = cvtpk(P[BASE + 4], P[BASE + 5]), b1 = cvtpk(P[BASE + 6], P[BASE + 7]);                              \
    auto r0 = __builtin_amdgcn_permlane32_swap(a0, b0, false, false); auto r1 = __builtin_amdgcn_permlane32_swap(a1, b1, false, false); \
    u32x4 w = {r0[0], r1[0], r0[1], r1[1]}; OUT = *reinterpret_cast<bf16x8*>(&w); } while (0)
  PK4(p0, 0, pa0); PK4(p0, 8, pa1); PK4(p1, 0, pa2); PK4(p1, 8, pa3);
#undef PK4
}
__device__ __forceinline__ void qkt(f32x16& p0, f32x16& p1, const char* Ks, const bf16x8* qr, int r32, int hi) {
  p0 = f32x16{}; p1 = f32x16{};
#pragma unroll
  for (int d0 = 0; d0 < 4; ++d0) { const int cb = d0 * 32 + hi * 16;
    const bf16x8 b0 = *reinterpret_cast<const bf16x8*>(Ks + KSWZ(r32, cb));
    const bf16x8 b1 = *reinterpret_cast<const bf16x8*>(Ks + KSWZ(32 + r32, cb));
    p0 = __builtin_amdgcn_mfma_f32_32x32x16_bf16(b0, qr[d0], p0, 0, 0, 0);
    p1 = __builtin_amdgcn_mfma_f32_32x32x16_bf16(b1, qr[d0], p1, 0, 0, 0); }
}
__device__ __forceinline__ int v_st(int k, int c) { const int kk = (k & ~0xC) | ((k & 4) << 1) | ((k & 8) >> 1); return ((kk >> 3) * 4 + (c >> 5)) * 512 + ((kk & 7) * 32 + (c & 31)) * 2; }
__device__ __forceinline__ int v_rd_base(int lane) { return ((lane & 3) << 3) | (((lane >> 2) & 3) << 6) | (((lane >> 4) & 1) << 5) | (((lane >> 5) & 1) << 8); }
constexpr int v_rd_off(int d0, int ks, int half) { return d0 * 512 + ks * 4096 + half * 2048; }
template <int OFF> __device__ __forceinline__ s16x4 tr_read(int vb) {
  s16x4 r; asm volatile("ds_read_b64_tr_b16 %0, %1 offset:%2" : "=&v"(r) : "v"(vb), "i"(OFF) : "memory"); return r;
}
template <int D0> __device__ __forceinline__ void pv_one(f32x16& od, int vb, bf16x8 pa0, bf16x8 pa1, bf16x8 pa2, bf16x8 pa3) {
  const s16x4 l0 = tr_read<v_rd_off(D0, 0, 0)>(vb), h0 = tr_read<v_rd_off(D0, 0, 1)>(vb), l1 = tr_read<v_rd_off(D0, 1, 0)>(vb), h1 = tr_read<v_rd_off(D0, 1, 1)>(vb);
  const s16x4 l2 = tr_read<v_rd_off(D0, 2, 0)>(vb), h2 = tr_read<v_rd_off(D0, 2, 1)>(vb), l3 = tr_read<v_rd_off(D0, 3, 0)>(vb), h3 = tr_read<v_rd_off(D0, 3, 1)>(vb);
  asm volatile("s_waitcnt lgkmcnt(0)" ::: "memory"); SBAR();
#define PK(L, H) (bf16x8){L[0], L[1], L[2], L[3], H[0], H[1], H[2], H[3]}
  od = __builtin_amdgcn_mfma_f32_32x32x16_bf16(pa0, PK(l0, h0), od, 0, 0, 0);
  od = __builtin_amdgcn_mfma_f32_32x32x16_bf16(pa1, PK(l1, h1), od, 0, 0, 0);
  od = __builtin_amdgcn_mfma_f32_32x32x16_bf16(pa2, PK(l2, h2), od, 0, 0, 0);
  od = __builtin_amdgcn_mfma_f32_32x32x16_bf16(pa3, PK(l3, h3), od, 0, 0, 0);
#undef PK
}
__device__ __forceinline__ void pv_d0(f32x16* o, int vb, bf16x8 pa0, bf16x8 pa1, bf16x8 pa2, bf16x8 pa3) {
  pv_one<0>(o[0], vb, pa0, pa1, pa2, pa3); pv_one<1>(o[1], vb, pa0, pa1, pa2, pa3); pv_one<2>(o[2], vb, pa0, pa1, pa2, pa3); pv_one<3>(o[3], vb, pa0, pa1, pa2, pa3);
}
__device__ __forceinline__ void attn_unit(char* lds, const bf16_t* __restrict__ P, bf16_t* __restrict__ Y, int b, int h, int qb, float lam, const float* __restrict__ gattn, float oscale) {
  int tid_ = threadIdx.x; asm volatile("" : "+v"(tid_));
  const int tid = tid_, wid = tid >> 6, lane = tid & 63, r32 = lane & 31, hi = lane >> 5;
  const unsigned rowb = (unsigned)b * TB, q0 = rowb + (unsigned)qb * 256;
  const int seq = (qb == 0) ? CTXL : TB, NT = seq / 64;
  char* V_lds = lds + OFF_V; char* K_lds = lds + OFF_K;
  float* ws = (float*)(lds + OFF_WS) + wid * 64; float* li_l = ws; float* al_l = ws + 32;
  unsigned* stash = (unsigned*)(lds + OFF_ST) + wid * 2048;
  const int sr = tid >> 4, sc = (tid & 15) * 8, vst0 = v_st(sr, sc), vst1 = v_st(32 + sr, sc);
  const int kr = tid >> 3, kc = (tid & 7) * 8, kst = KSWZ(kr, kc * 2);
  const int vb0 = (int)(uintptr_t)V_lds + v_rd_base(lane);
  const char* Pc = (const char*)P;
  const unsigned voff = ((rowb + sr) * PW + V0c + h * 128 + sc) * 2u;
#pragma unroll 1
  for (int map = 0; map < 2; ++map) {
    const unsigned qoff = ((q0 + wid * 32 + r32) * PW + Q0c + h * 128 + map * 64 + hi * 8) * 2u;
    const unsigned koff = ((rowb + kr) * PW + K0c + h * 128 + map * 64 + kc) * 2u;
    bf16x8 qr[4];
#pragma unroll
    for (int d0 = 0; d0 < 4; ++d0) qr[d0] = *reinterpret_cast<const bf16x8*>(Pc + (qoff + d0 * 32));
    float m_reg = -1e30f, l_reg = 0; f32x16 o[4] = {};
    struct { bf16x8 vs0, vs1, ks; } sr_[1];
#define SLOAD(i, k0) do { const unsigned ko_ = (unsigned)(k0) * (PW * 2u); sr_[i].vs0 = *reinterpret_cast<const bf16x8*>(Pc + (voff + ko_)); sr_[i].vs1 = *reinterpret_cast<const bf16x8*>(Pc + (voff + ko_ + 32u * PW * 2u)); \
    sr_[i].ks = *reinterpret_cast<const bf16x8*>(Pc + (koff + ko_)); } while (0)
#define SWRITE(bf, i) do { *(bf16x8*)(V_lds + (bf) * SHM_V + vst0) = sr_[i].vs0; *(bf16x8*)(V_lds + (bf) * SHM_V + vst1) = sr_[i].vs1; \
    *(bf16x8*)(K_lds + (bf) * SHM_K + kst) = sr_[i].ks; } while (0)
#define SWAIT() asm volatile("s_waitcnt vmcnt(0)" ::: "memory")
#define RESC(a) do { if (__any((a) < 1.f)) { if (hi == 0) al_l[r32] = (a); asm volatile("s_waitcnt lgkmcnt(0)" ::: "memory"); \
    _Pragma("unroll") for (int d = 0; d < 4; ++d) _Pragma("unroll") for (int r = 0; r < 16; ++r) o[d][r] *= al_l[crow(r, hi)]; } } while (0)
    f32x16 pA0, pA1, pB0, pB1; float mnA, mnB, alA, alB; bf16x8 pa0, pa1, pa2, pa3;
    constexpr int SE = 0, SO = 0;
    SLOAD(SE, 0); asm volatile("s_waitcnt vmcnt(0)" ::: "memory"); SWRITE(0, SE); __syncthreads();
    qkt(pA0, pA1, K_lds, qr, r32, hi); partialSM(pA0, pA1, m_reg, mnA, alA);
    SLOAD(SO, 64);
    SWAIT(); SWRITE(1, SO); __syncthreads();
    for (int j = 1; j + 1 < NT; j += 2) {
      SBAR(); qkt(pB0, pB1, K_lds + SHM_K, qr, r32, hi);
      finishSM(pA0, pA1, alA, l_reg, pa0, pa1, pa2, pa3); SBAR();
      SLOAD(SO, (j + 1) * 64); SBAR();
      pv_d0(o, vb0, pa0, pa1, pa2, pa3); partialSM(pB0, pB1, m_reg, mnB, alB);
      __syncthreads(); SWAIT(); SWRITE(0, SE);
      RESC(alB); __syncthreads();
      SBAR(); qkt(pA0, pA1, K_lds, qr, r32, hi);
      finishSM(pB0, pB1, alB, l_reg, pa0, pa1, pa2, pa3); SBAR();
      SLOAD(SE, (j + 2) * 64); SBAR();
      pv_d0(o, vb0 + SHM_V, pa0, pa1, pa2, pa3); partialSM(pA0, pA1, m_reg, mnA, alA);
      __syncthreads(); SWAIT(); SWRITE(1, SO);
      RESC(alA); __syncthreads();
    }
    SBAR(); qkt(pB0, pB1, K_lds + SHM_K, qr, r32, hi);
    finishSM(pA0, pA1, alA, l_reg, pa0, pa1, pa2, pa3); SBAR();
    pv_d0(o, vb0, pa0, pa1, pa2, pa3); partialSM(pB0, pB1, m_reg, mnB, alB);
    __syncthreads(); RESC(alB);
    finishSM(pB0, pB1, alB, l_reg, pa0, pa1, pa2, pa3); SBAR();
    pv_d0(o, vb0 + SHM_V, pa0, pa1, pa2, pa3);
    if (hi == 0) li_l[r32] = l_reg; asm volatile("s_waitcnt lgkmcnt(0)" ::: "memory");
    if (map == 0) {
#pragma unroll
      for (int r = 0; r < 16; ++r) { const float rl = __builtin_amdgcn_rcpf(li_l[crow(r, hi)]);
        stash[(r * 2 + 0) * 64 + lane] = cvtpk(o[0][r] * rl, o[1][r] * rl); stash[(r * 2 + 1) * 64 + lane] = cvtpk(o[2][r] * rl, o[3][r] * rl); SBAR(); }
    } else if (ATT_VAR != 1) {
      char* Yc = (char*)Y; const unsigned yoff = ((q0 + wid * 32) * DM + h * 128 + r32) * 2u;
      float gv[4];
#pragma unroll
      for (int d0 = 0; d0 < 4; ++d0) gv[d0] = gattn[d0 * 32 + r32] * oscale;
      SBAR();
#pragma unroll
      for (int r = 0; r < 16; ++r) { const float rl = lam * __builtin_amdgcn_rcpf(li_l[crow(r, hi)]);
        const unsigned w0 = stash[(r * 2 + 0) * 64 + lane], w1 = stash[(r * 2 + 1) * 64 + lane];
        const float e0 = bflo(w0) - o[0][r] * rl, e1 = bfhi(w0) - o[1][r] * rl, e2 = bflo(w1) - o[2][r] * rl, e3 = bfhi(w1) - o[3][r] * rl;
        float ssq = (e0 * e0 + e1 * e1) + (e2 * e2 + e3 * e3);
        if (ATT_VAR != 3) { ssq += __shfl_xor(ssq, 1); ssq += __shfl_xor(ssq, 2); ssq += __shfl_xor(ssq, 4); ssq += __shfl_xor(ssq, 8); ssq += __shfl_xor(ssq, 16); }
        const float rs = rsqrtf(ssq * (1.f / 128.f) + 1e-6f);
        bf16_t* yr = (bf16_t*)(Yc + (yoff + (unsigned)crow(r, hi) * (DM * 2u)));
        if (ATT_VAR != 4) { yr[0] = f2bf(e0 * rs * gv[0]); yr[32] = f2bf(e1 * rs * gv[1]); yr[64] = f2bf(e2 * rs * gv[2]); yr[96] = f2bf(e3 * rs * gv[3]); } else { yr[0] = f2bf(e0 * rs + e1 + e2 + e3); } SBAR(); }
    }
    __syncthreads();
#undef SLOAD
#undef SWRITE
#undef SWAIT
#undef RESC
  }
}
#undef KSWZ
}
namespace lru {
using att::f32x16; using att::crow;
constexpr int RS = 528;
constexpr int OFF_CL = 0, OFF_YS = 128 * RS;
template <bool PASS2>
__device__ __forceinline__ void lru_unit(char* lds, const bf16_t* __restrict__ P, bf16_t* __restrict__ Y, int b, int c, const float* __restrict__ convw, const float* __restrict__ convb,
                                         const bf16_t* __restrict__ wrg, const float* __restrict__ ba, const float* __restrict__ bx, const float* __restrict__ c8, float* lrus) {
  int tid_ = threadIdx.x; asm volatile("" : "+v"(tid_));
  const int tid = tid_, wid = tid >> 6, lane = tid & 63, r32 = lane & 31, hi = lane >> 5;
  const size_t R0 = (size_t)b * TB + (size_t)c * 128;
  const int seg_lo = (c < 2) ? 0 : CTXL, seg_hi = (c < 2) ? CTXL : TB;
  { const int ch8 = (tid & 31) * 8;
    float w[4][8], bb[8];
#pragma unroll
    for (int k = 0; k < 4; ++k) { const f32x4 a = *(const f32x4*)(convw + k * 256 + ch8), d = *(const f32x4*)(convw + k * 256 + ch8 + 4);
      w[k][0] = a.x; w[k][1] = a.y; w[k][2] = a.z; w[k][3] = a.w; w[k][4] = d.x; w[k][5] = d.y; w[k][6] = d.z; w[k][7] = d.w; }
    { const f32x4 a = *(const f32x4*)(convb + ch8), d = *(const f32x4*)(convb + ch8 + 4); bb[0] = a.x; bb[1] = a.y; bb[2] = a.z; bb[3] = a.w; bb[4] = d.x; bb[5] = d.y; bb[6] = d.z; bb[7] = d.w; }
#pragma unroll 2
    for (int it = tid; it < 4096; it += 512) { const int t = it >> 5; float acc[8];
#pragma unroll
      for (int e = 0; e < 8; ++e) acc[e] = bb[e];
#pragma unroll
      for (int k = 0; k < 4; ++k) { const int tt = c * 128 + t - 1 + k;
        if (tt >= seg_lo && tt < seg_hi) { const u32x4 xv = *(const u32x4*)(P + ((size_t)b * TB + tt) * PW + LX0 + ch8);
          acc[0] += bflo(xv.x) * w[k][0]; acc[1] += bfhi(xv.x) * w[k][1]; acc[2] += bflo(xv.y) * w[k][2]; acc[3] += bfhi(xv.y) * w[k][3];
          acc[4] += bflo(xv.z) * w[k][4]; acc[5] += bfhi(xv.z) * w[k][5]; acc[6] += bflo(xv.w) * w[k][6]; acc[7] += bfhi(xv.w) * w[k][7]; } }
      u32x4 o; o.x = cvtpk(acc[0], acc[1]); o.y = cvtpk(acc[2], acc[3]); o.z = cvtpk(acc[4], acc[5]); o.w = cvtpk(acc[6], acc[7]);
      *(u32x4*)(lds + OFF_CL + t * RS + ch8 * 2) = o; }
  }
  __syncthreads();
  const int hh = wid >> 1, jh = wid & 1, chb = hh * 64 + jh * 32;
#pragma unroll 1
  for (int d = 0; d < 2; ++d) {
    const bf16_t* wa = wrg + ((0 * 2 + d) * 4 + hh) * 4096 + (jh * 32 + r32) * 64 + hi * 8;
    const bf16_t* wx = wrg + ((1 * 2 + d) * 4 + hh) * 4096 + (jh * 32 + r32) * 64 + hi * 8;
    bf16x8 fa[4], fx[4];
#pragma unroll
    for (int k = 0; k < 4; ++k) { fa[k] = *reinterpret_cast<const bf16x8*>(wa + k * 16); fx[k] = *reinterpret_cast<const bf16x8*>(wx + k * 16); }
    float carry[16], Pc[16];
#pragma unroll
    for (int r = 0; r < 16; ++r) { carry[r] = 0.f; Pc[r] = 1.f; }
    if (PASS2) {
#define LRU_STEP(u_) do { const float* sb = lrus + ((((size_t)b * NCHUNK + (u_)) * 2 + d) * 2) * 256 + chb + 4 * hi; \
        _Pragma("unroll") for (int q = 0; q < 4; ++q) { const f32x4 A = *(const f32x4*)(sb + 8 * q), H = *(const f32x4*)(sb + 256 + 8 * q); \
          carry[4 * q] = A.x * carry[4 * q] + H.x; carry[4 * q + 1] = A.y * carry[4 * q + 1] + H.y; carry[4 * q + 2] = A.z * carry[4 * q + 2] + H.z; carry[4 * q + 3] = A.w * carry[4 * q + 3] + H.w; } } while (0)
      if (d == 0) { for (int u = 0; u < c; ++u) LRU_STEP(u); }
      else if (c < 2) { for (int u = 1; u > c; --u) LRU_STEP(u); }
      else { LRU_STEP(1); LRU_STEP(0); for (int u = NCHUNK - 1; u > c; --u) LRU_STEP(u); }
#undef LRU_STEP
    }
    const int lastl = d ? 0 : 31;
#pragma unroll 1
    for (int ti = 0; ti < 4; ++ti) {
      const int tt = d ? 3 - ti : ti;
      char* rowp = lds + OFF_CL + (tt * 32 + r32) * RS;
      f32x16 za = {}, zx = {};
#pragma unroll
      for (int k = 0; k < 4; ++k) { const bf16x8 xb = *reinterpret_cast<const bf16x8*>(rowp + (hh * 64 + k * 16 + hi * 8) * 2);
        za = __builtin_amdgcn_mfma_f32_32x32x16_bf16(fa[k], xb, za, 0, 0, 0); zx = __builtin_amdgcn_mfma_f32_32x32x16_bf16(fx[k], xb, zx, 0, 0, 0); }
      float av[16], bv[16];
#pragma unroll
      for (int q = 0; q < 4; ++q) { const u32x2 cw = *(const u32x2*)(rowp + (chb + 8 * q + 4 * hi) * 2);
        const float clv[4] = {bflo(cw.x), bfhi(cw.x), bflo(cw.y), bfhi(cw.y)};
        const int co = d * 256 + chb + 8 * q + 4 * hi;
        const f32x4 b4 = *(const f32x4*)(ba + co), x4 = *(const f32x4*)(bx + co), c4 = *(const f32x4*)(c8 + co);
        const float bav[4] = {b4.x, b4.y, b4.z, b4.w}, bxv[4] = {x4.x, x4.y, x4.z, x4.w}, c8v[4] = {c4.x, c4.y, c4.z, c4.w};
#pragma unroll
        for (int i = 0; i < 4; ++i) { const int r = 4 * q + i;
          const float rg = sigm(za[r] + bav[i]), ig = sigm(zx[r] + bxv[i]);
          const float a = __expf(-c8v[i] * rg);
          av[r] = a; bv[r] = sqrtf(fmaxf(1.f - a * a, 0.f)) * ig * clv[i]; } }
#pragma unroll
      for (int s = 1; s < 32; s <<= 1) {
        const int srcl = d ? (r32 + s) : (r32 - s);
        const bool valid = (srcl >= 0) && (srcl < 32);
#pragma unroll
        for (int r = 0; r < 16; ++r) {
          const float ap = __shfl(av[r], srcl, 32), bp = __shfl(bv[r], srcl, 32);
          if (valid) { bv[r] = av[r] * bp + bv[r]; av[r] = av[r] * ap; } }
      }
#pragma unroll
      for (int q = 0; q < 4; ++q) { float hv[4];
#pragma unroll
        for (int i = 0; i < 4; ++i) { const int r = 4 * q + i; hv[i] = bv[r] + av[r] * carry[r];
          carry[r] = __shfl(hv[i], lastl, 32);
          if (!PASS2) Pc[r] *= __shfl(av[r], lastl, 32); }
        if (PASS2) { u32x2* yp = (u32x2*)(lds + OFF_YS + (tt * 32 + r32) * RS + (chb + 8 * q + 4 * hi) * 2);
          if (d) { const u32x2 o = *yp; hv[0] += bflo(o.x); hv[1] += bfhi(o.x); hv[2] += bflo(o.y); hv[3] += bfhi(o.y); }
          u32x2 w; w.x = cvtpk(hv[0], hv[1]); w.y = cvtpk(hv[2], hv[3]); *yp = w; } }
    }
    if (!PASS2) { if (r32 == 0) { float* sb = lrus + ((((size_t)b * NCHUNK + c) * 2 + d) * 2) * 256 + chb + 4 * hi;
#pragma unroll
        for (int q = 0; q < 4; ++q) { *(f32x4*)(sb + 8 * q) = (f32x4){Pc[4 * q], Pc[4 * q + 1], Pc[4 * q + 2], Pc[4 * q + 3]};
          *(f32x4*)(sb + 256 + 8 * q) = (f32x4){carry[4 * q], carry[4 * q + 1], carry[4 * q + 2], carry[4 * q + 3]}; } } }
  }
  if (PASS2) {
    __syncthreads();
    const int ch8 = (tid & 31) * 8;
#pragma unroll 2
    for (int it = tid; it < 4096; it += 512) { const int t = it >> 5;
      const u32x4 hv = *(const u32x4*)(lds + OFF_YS + t * RS + ch8 * 2), gv = *(const u32x4*)(P + (R0 + t) * PW + LG0 + ch8);
      u32x4 o; o.x = cvtpk(bflo(hv.x) * bflo(gv.x), bfhi(hv.x) * bfhi(gv.x)); o.y = cvtpk(bflo(hv.y) * bflo(gv.y), bfhi(hv.y) * bfhi(gv.y));
      o.z = cvtpk(bflo(hv.z) * bflo(gv.z), bfhi(hv.z) * bfhi(gv.z)); o.w = cvtpk(bflo(hv.w) * bflo(gv.w), bfhi(hv.w) * bfhi(gv.w));
      *(u32x4*)(Y + (R0 + t) * DM + 512 + ch8) = o; }
  }
  __syncthreads();
}
}

namespace sgu {
using att::f32x16; using att::crow;
constexpr int VS = 272;
__device__ __forceinline__ void sgu_unit(char* lds, const bf16_t* __restrict__ P, bf16_t* __restrict__ Y, int b, int c, const bf16_t* __restrict__ wsp, const float* __restrict__ gsgu, const float* __restrict__ bsp) {
  int tid_ = threadIdx.x; asm volatile("" : "+v"(tid_));
  const int tid = tid_, wid = tid >> 6, lane = tid & 63, r32 = lane & 31, hi = lane >> 5;
  const size_t R0 = (size_t)b * TB + (size_t)c * 128;
  { const int q = tid & 127, g = tid >> 7;
    const bf16_t* vp = P + (R0 + q) * PW + SV0 + g * 64;
    u32x4 xv[8]; float ss = 0.f;
#pragma unroll
    for (int i = 0; i < 8; ++i) { xv[i] = *(const u32x4*)(vp + i * 8);
      const float a0 = bflo(xv[i].x), a1 = bfhi(xv[i].x), a2 = bflo(xv[i].y), a3 = bfhi(xv[i].y), a4 = bflo(xv[i].z), a5 = bfhi(xv[i].z), a6 = bflo(xv[i].w), a7 = bfhi(xv[i].w);
      ss += (a0 * a0 + a1 * a1) + (a2 * a2 + a3 * a3) + (a4 * a4 + a5 * a5) + (a6 * a6 + a7 * a7); }
    const float rs = rsqrtf(ss * (1.f / 64.f) + 1e-6f);
    char* dst = lds + (g * 64) * VS + q * 2;
#pragma unroll
    for (int i = 0; i < 8; ++i) { const float* gp = gsgu + g * 64 + i * 8; const f32x4 g0 = *(const f32x4*)gp, g1 = *(const f32x4*)(gp + 4);
      *(bf16_t*)(dst + (i * 8 + 0) * VS) = f2bf(bflo(xv[i].x) * rs * g0.x); *(bf16_t*)(dst + (i * 8 + 1) * VS) = f2bf(bfhi(xv[i].x) * rs * g0.y);
      *(bf16_t*)(dst + (i * 8 + 2) * VS) = f2bf(bflo(xv[i].y) * rs * g0.z); *(bf16_t*)(dst + (i * 8 + 3) * VS) = f2bf(bfhi(xv[i].y) * rs * g0.w);
      *(bf16_t*)(dst + (i * 8 + 4) * VS) = f2bf(bflo(xv[i].z) * rs * g1.x); *(bf16_t*)(dst + (i * 8 + 5) * VS) = f2bf(bfhi(xv[i].z) * rs * g1.y);
      *(bf16_t*)(dst + (i * 8 + 6) * VS) = f2bf(bflo(xv[i].w) * rs * g1.z); *(bf16_t*)(dst + (i * 8 + 7) * VS) = f2bf(bfhi(xv[i].w) * rs * g1.w); }
  }
  __syncthreads();
  { const int gg = wid >> 1, chalf = wid & 1, cc = gg * 64 + chalf * 32 + r32;
    bf16x8 vb[8];
#pragma unroll
    for (int k = 0; k < 8; ++k) vb[k] = *reinterpret_cast<const bf16x8*>(lds + cc * VS + (k * 16 + hi * 8) * 2);
#pragma unroll 1
    for (int pt = 0; pt < 4; ++pt) { f32x16 acc = {};
      const bf16_t* ap = wsp + (gg * 128 + pt * 32 + r32) * 128 + hi * 8;
#pragma unroll
      for (int k = 0; k < 8; ++k) { const bf16x8 A = *reinterpret_cast<const bf16x8*>(ap + k * 16); acc = __builtin_amdgcn_mfma_f32_32x32x16_bf16(A, vb[k], acc, 0, 0, 0); }
#pragma unroll
      for (int r = 0; r < 16; ++r) { const int p = pt * 32 + crow(r, hi); const float m = acc[r] + bsp[gg * 128 + p];
        const float uu = bf2f(P[(R0 + p) * PW + SU0 + cc]); Y[(R0 + p) * DM + 768 + cc] = f2bf(uu * m); } }
  }
  __syncthreads();
}
}
__device__ __forceinline__ unsigned pk2(float lo, float hi) { return cvtpk(lo, hi); }
__device__ __forceinline__ void transpose_item(const float* __restrict__ W, int K, int N, bf16_t* __restrict__ WT, int row_base, LAS float* scr, int kb, int nb, int lane) {
    const int k0 = 64 * kb, n0 = 32 * nb;
#pragma unroll 8
    for (int i = 0; i < 32; ++i) { const int kk = 2 * i + (lane >> 5); scr[kk * 33 + (lane & 31)] = W[(size_t)(k0 + kk) * N + n0 + (lane & 31)]; }
    asm volatile("s_waitcnt lgkmcnt(0)" ::: "memory");
    const int c = lane & 7;
#pragma unroll
    for (int j = 0; j < 4; ++j) { const int n = (lane >> 3) + 8 * j; const LAS float* s = scr + (8 * c) * 33 + n;
        u32x4 o; o.x = pk2(s[0 * 33], s[1 * 33]); o.y = pk2(s[2 * 33], s[3 * 33]); o.z = pk2(s[4 * 33], s[5 * 33]); o.w = pk2(s[6 * 33], s[7 * 33]);
        *(u32x4*)(WT + (size_t)(row_base + n) * K + k0 + 8 * c) = o; }
    asm volatile("s_waitcnt lgkmcnt(0)" ::: "memory");
}
__device__ __forceinline__ void gemv_item(const LAS float* a_lds, LAS float* red, const float* __restrict__ W, int N, int n0, float* __restrict__ out, int ldo, int obase, const float* __restrict__ bias) {
    const int tid = threadIdx.x, wid = tid >> 6, lane = tid & 63, c4 = (lane & 15) * 4, ks = lane >> 4;
    f32x4 acc[NMS];
#pragma unroll
    for (int ms = 0; ms < NMS; ++ms) acc[ms] = (f32x4){0.f, 0.f, 0.f, 0.f};
    const float* wp = W + (size_t)(wid * 128 + ks) * N + n0 + c4;
#pragma unroll 8
    for (int st = 0; st < 32; ++st) { const f32x4 wv = *(const f32x4*)(wp + (size_t)st * 4 * N); const int k = wid * 128 + st * 4 + ks;
#pragma unroll
        for (int ms = 0; ms < NMS; ++ms) acc[ms] += wv * a_lds[ms * 1024 + k]; }
#pragma unroll
    for (int ms = 0; ms < NMS; ++ms) {
        f32x4 v = acc[ms];
        v.x += __shfl_xor(v.x, 16); v.y += __shfl_xor(v.y, 16); v.z += __shfl_xor(v.z, 16); v.w += __shfl_xor(v.w, 16);
        v.x += __shfl_xor(v.x, 32); v.y += __shfl_xor(v.y, 32); v.z += __shfl_xor(v.z, 32); v.w += __shfl_xor(v.w, 32);
        if (ks == 0) { LAS float* rp = red + (wid * NMS + ms) * 64 + c4; rp[0] = v.x; rp[1] = v.y; rp[2] = v.z; rp[3] = v.w; }
    }
    __syncthreads();
    for (int i = tid; i < NMS * 64; i += 512) { const int ms = i >> 6, c = i & 63; float s = 0.f;
#pragma unroll
        for (int w = 0; w < 8; ++w) s += red[(w * NMS + ms) * 64 + c];
        if (bias) s += bias[n0 + c];
        out[(size_t)ms * ldo + obase + c] = s; }
    __syncthreads();
}
__device__ __forceinline__ float wave_sum(float v) {
#pragma unroll
    for (int o = 1; o < 64; o <<= 1) v += __shfl_xor(v, o);
    return v;
}

#define XB_TMO      128
#define XB_XCNT(j)  (256  + 64 * (j))
#define XB_XSUB(j)  (1280 + 64 * (j))
#define XB_XGEN(j)  (2304 + 64 * (j))
#define XB_TOP      3328
#define XB_TOPGEN   3392
#define XCD_BAR_WORDS 3456
#define XB_SPIN_CAP (1u << 18)

__device__ __forceinline__ unsigned xb_ld(unsigned* p)              { return __hip_atomic_load(p, __ATOMIC_RELAXED, __HIP_MEMORY_SCOPE_AGENT); }
__device__ __forceinline__ unsigned xb_add(unsigned* p, unsigned v) { return __hip_atomic_fetch_add(p, v, __ATOMIC_RELAXED, __HIP_MEMORY_SCOPE_AGENT); }
__device__ __forceinline__ unsigned xb_xcc_id() { return (unsigned)__builtin_amdgcn_s_getreg((3 << 11) | 20) & 0xFu; }
#define XB_SPIN(cond, bar) do { unsigned _sp = 0; while (cond) { __builtin_amdgcn_s_sleep(1); \
    if ((++_sp & 255u) == 0u) { if (xb_ld(&(bar)[XB_TMO])) break; if (_sp > XB_SPIN_CAP) { atomicAdd(&(bar)[XB_TMO], 1u); break; } } } } while (0)

struct XcdBarrier {
    unsigned* bar; unsigned x;
    volatile LAS unsigned* st;
};

__device__ __forceinline__ XcdBarrier xcd_barrier_post(unsigned* bar, volatile LAS unsigned* st) {
    XcdBarrier b; b.bar = bar; b.x = xb_xcc_id(); b.st = st;
    if (threadIdx.x == 0) (void)xb_add(&bar[XB_XCNT(b.x)], 1u);
    return b;
}
__device__ __forceinline__ void xcd_barrier_complete(unsigned* bar, unsigned x, unsigned& nloc, unsigned& nx) {
    const unsigned G = gridDim.x * gridDim.y * gridDim.z;
    unsigned sum, cnt, mine, sp = 0u;
    for (;;) {
        sum = 0u; cnt = 0u; mine = 0u;
#pragma unroll
        for (unsigned j = 0; j < 16; ++j) { const unsigned c = xb_ld(&bar[XB_XCNT(j)]); sum += c; cnt += (c > 0u) ? 1u : 0u; mine = (j == x) ? c : mine; }
        if (sum == G) break;
        __builtin_amdgcn_s_sleep(1);
        if ((++sp & 255u) == 0u) { if (xb_ld(&bar[XB_TMO])) break; if (sp > XB_SPIN_CAP) { atomicAdd(&bar[XB_TMO], 1u); break; } }
    }
    nloc = mine > 0u ? mine : 1u; nx = cnt > 0u ? cnt : 1u;
}

__device__ __forceinline__ void xcd_barrier(const XcdBarrier& b) {
    asm volatile("s_waitcnt vmcnt(0)" ::: "memory");
    __syncthreads();
    if (threadIdx.x == 0) {
        unsigned* bar = b.bar;
        __builtin_amdgcn_s_waitcnt(0);
        unsigned nloc = b.st[0], nx = b.st[1];
        if (nloc == 0u) { xcd_barrier_complete(bar, b.x, nloc, nx); b.st[0] = nloc; b.st[1] = nx; }
        const unsigned old = xb_add(&bar[XB_XSUB(b.x)], 1u);
        const unsigned gen = old / nloc;
        if (old + 1u == (gen + 1u) * nloc) {
            __builtin_amdgcn_fence(__ATOMIC_RELEASE, "agent");
            asm volatile("s_waitcnt vmcnt(0)" ::: "memory");
            const unsigned og = xb_add(&bar[XB_TOP], 1u);
            const unsigned tg = og / nx;
            if (og + 1u == (tg + 1u) * nx) xb_add(&bar[XB_TOPGEN], 1u);
            else XB_SPIN(xb_ld(&bar[XB_TOPGEN]) == tg, bar);
            __builtin_amdgcn_fence(__ATOMIC_ACQUIRE, "agent");
            xb_add(&bar[XB_XGEN(b.x)], 1u);
            asm volatile("s_waitcnt vmcnt(0)" ::: "memory");
        } else {
            XB_SPIN(xb_ld(&bar[XB_XGEN(b.x)]) == gen, bar);
            __builtin_amdgcn_fence(__ATOMIC_ACQUIRE, "agent");
            asm volatile("s_waitcnt vmcnt(0)" ::: "memory");
        }
    }
    __syncthreads();
}
constexpr int NPHASE = 15;
constexpr int LDS_BYTES = 147456;
struct Args { const float* in[27]; float* out; unsigned char* ws; int ph_lo, ph_hi; };
__global__ void __launch_bounds__(512, 2) hybrid_fwd(Args args) {
    extern __shared__ __attribute__((aligned(16))) unsigned char lds_raw[];
    char* lds = (char*)lds_raw;
    LAS unsigned char* ldsl = (LAS unsigned char*)lds_raw;
    const int tid = threadIdx.x, lane = tid & 63, wave = __builtin_amdgcn_readfirstlane(tid >> 6);
    const int G = gridDim.x, bx = blockIdx.x, vcu = (G % 8 == 0) ? (bx % 8) * (G / 8) + bx / 8 : bx;
    unsigned char* ws = args.ws;
    const float* const* in = args.in;
    float* mods = (float*)(ws + WS_MODS); float* shwin = (float*)(ws + WS_SHWIN); float* shwf = (float*)(ws + WS_SHWF);
    float* ropeC = (float*)(ws + WS_ROPE); float* ropeS = ropeC + 1024; float* c8 = (float*)(ws + WS_C8); float* lamv = (float*)(ws + WS_LAM);
    float* rowss = (float*)(ws + WS_ROWSS); float* lrus = (float*)(ws + WS_LRUS); float* xc = (float*)(ws + WS_XC);
    bf16_t* AP = (bf16_t*)(ws + WS_AP); bf16_t* Pb = (bf16_t*)(ws + WS_P); bf16_t* Yb = (bf16_t*)(ws + WS_Y); bf16_t* HM = (bf16_t*)(ws + WS_HMID);
    bf16_t* WSP = (bf16_t*)(ws + WS_WSP); bf16_t* WRG = (bf16_t*)(ws + WS_WRG);
    const int lo = args.ph_lo, hi_ = args.ph_hi;
    volatile LAS unsigned* MISC = (volatile LAS unsigned*)(ldsl + LDS_BYTES - 64);
    if (tid < 16) MISC[tid] = 0u;
    __syncthreads();
    XcdBarrier bar; bar.bar = (unsigned*)(ws + WS_CTL); bar.x = 0; bar.st = nullptr;
    if (hi_ - lo > 1) bar = xcd_barrier_post((unsigned*)(ws + WS_CTL), MISC);
#define IN(k) (lo <= (k) && (k) < hi_)
#define SEAM(k) do { if (IN(k) && IN((k) + 1)) { if ((k) == 0) cg::this_grid().sync(); else xcd_barrier(bar); } } while (0)

    if (EN(0) && IN(0)) {
        { LAS float* scr = (LAS float*)(ldsl + wave * 16384);
          const int gw = vcu * 8 + wave, NGW = G * 8;
          constexpr int I_IN = 16 * 80, I_OUT = 16 * 32, I_G = 16 * 88, I_D = 44 * 32, I_L = I_IN + I_OUT + 2 * I_G + I_D;
          for (int it = gw; it < NLAYER * I_L; it += NGW) {
              const int l = it / I_L; int r = it - l * I_L;
              if (r < I_IN) { transpose_item(in[8] + (size_t)l * DM * PW, DM, PW, (bf16_t*)(ws + WS_WIN + l * SZ_WIN), 32 * (r % 80), scr, r / 80, r % 80, lane); continue; } r -= I_IN;
              if (r < I_OUT) { transpose_item(in[22] + (size_t)l * DM * DM, DM, DM, (bf16_t*)(ws + WS_WOUT + l * SZ_WOUT), 32 * (r % 32), scr, r / 32, r % 32, lane); continue; } r -= I_OUT;
              if (r < 2 * I_G) { const int up = r >= I_G; if (up) r -= I_G; const int nb = r % 88, n0 = 32 * nb;
                  transpose_item(in[up ? 24 : 23] + (size_t)l * DM * FH, DM, FH, (bf16_t*)(ws + WS_WFFN + l * SZ_WFFN), (n0 / 128) * 256 + (n0 % 128) + (up ? 128 : 0), scr, r / 88, nb, lane); continue; } r -= 2 * I_G;
              transpose_item(in[25] + (size_t)l * FH * DM, FH, DM, (bf16_t*)(ws + WS_WDN + l * SZ_WDN), 32 * (r % 32), scr, r / 32, r % 32, lane);
          }
        }
        { const int gt = vcu * 512 + tid, NT = G * 512;
          for (int i = gt; i < 131072; i += NT) WSP[i] = f2bf(in[20][i]);
          for (int i = gt; i < 131072; i += NT) { const int ii = i & 63, j = (i >> 6) & 63, h = (i >> 12) & 3, d = (i >> 14) & 1, mat = (i >> 15) & 1, l = i >> 16;
              WRG[i] = f2bf(in[mat ? 16 : 14][((((size_t)l * 2 + d) * 4 + h) * 64 + ii) * 64 + j]); }
          if (gt < 1024) { const int pos = gt >> 4, j = gt & 15; const float inv = powf(10000.f, -(float)j / 16.f); const float ang = (float)pos * inv; ropeC[gt] = cosf(ang); ropeS[gt] = sinf(ang);
              const float lv = in[18][gt]; c8[gt] = 8.f * log1pf(expf(-lv)); }
          if (gt < NLAYER) { float s0 = 0.f, s1 = 0.f; for (int k = 0; k < 64; ++k) { s0 += in[9][(gt * 2 + 0) * 64 + k] * in[10][(gt * 2 + 0) * 64 + k]; s1 += in[9][(gt * 2 + 1) * 64 + k] * in[10][(gt * 2 + 1) * 64 + k]; }
              lamv[gt] = expf(s0) - expf(s1) + (0.8f - 0.6f * expf(-0.3f * (float)gt)); }
        }
        __syncthreads();
        { LAS float* a_lds = (LAS float*)ldsl; LAS float* red = (LAS float*)(ldsl + 36864);
          for (int i = tid; i < NMS * 1024; i += 512) { const int ms = i >> 10, k = i & 1023; const float v = (ms < 8) ? in[1][ms * 1024 + k] : in[3][k]; a_lds[i] = silu_f(v); }
          __syncthreads();
          for (int it = vcu; it < NLAYER * 96; it += G) { const int l = it / 96, n0 = (it % 96) * 64;
              gemv_item(a_lds, red, in[4] + (size_t)l * DM * NMOD, NMOD, n0, mods + (size_t)l * NMS * NMOD, NMOD, n0, in[5] + (size_t)l * NMOD); }
        }
    }
    SEAM(0);
    if (EN(1) && IN(1)) {
        { LAS float* a_lds = (LAS float*)ldsl; LAS float* red = (LAS float*)(ldsl + 36864);
          for (int it = vcu; it < NLAYER * 128; it += G) { const int l = it / 128, r = it % 128; const int soff = (r < 40) ? 0 : 3 * DM;
              __syncthreads();
              for (int i = tid; i < NMS * 1024; i += 512) a_lds[i] = mods[((size_t)l * NMS + (i >> 10)) * NMOD + soff + (i & 1023)];
              __syncthreads();
              if (r < 40) gemv_item(a_lds, red, in[8] + (size_t)l * DM * PW, PW, r * 64, shwin + (size_t)l * NMS * PW, PW, r * 64, nullptr);
              else { const int up = r >= 84, nb = (r - 40) % 44, n0 = nb * 64;
                  gemv_item(a_lds, red, in[up ? 24 : 23] + (size_t)l * DM * FH, FH, n0, shwf + (size_t)l * NMS * NF, NF, (n0 / 128) * 256 + (n0 % 128) + (up ? 128 : 0), nullptr); } }
        }
        { const int gw = vcu * 8 + wave, NGW = G * 8;
          for (int m = gw; m < MROWS; m += NGW) { const int b = m / TB, t = m - b * TB; const bool ctx = t < CTXL; const int ms = ctx ? 8 : b;
              const float* xr = ctx ? in[2] + ((size_t)b * CTXL + t) * DM : in[0] + ((size_t)b * SEQ + (t - CTXL)) * DM;
              f32x4 v[4]; float s = 0.f;
#pragma unroll
              for (int j = 0; j < 4; ++j) { v[j] = ((const f32x4*)xr)[lane + 64 * j]; s += (v[j].x * v[j].x + v[j].y * v[j].y) + (v[j].z * v[j].z + v[j].w * v[j].w); }
              s = wave_sum(s);
#pragma unroll
              for (int j = 0; j < 4; ++j) { const int col = 4 * lane + 256 * j; const f32x4 g = *(const f32x4*)(in[6] + col), sc = *(const f32x4*)(mods + (size_t)ms * NMOD + DM + col);
                  const f32x4 a = v[j] * g * (sc + 1.f); u32x2 w; w.x = cvtpk(a.x, a.y); w.y = cvtpk(a.z, a.w); *(u32x2*)(AP + (size_t)m * DM + col) = w; }
              if (lane < 16) rowss[(size_t)m * 16 + lane] = (lane == 0) ? s : 0.f; }
        }
    }
    SEAM(1);
#pragma unroll 1
    for (int l = 0; l < NLAYER; ++l) {
        const int pb = 2 + 6 * l; const bool last = (l == NLAYER - 1);
        const float* modl = mods + (size_t)l * NMS * NMOD;
        if (EN(2) && IN(pb)) {
            pg8::Gemm g{AP, (const bf16_t*)(ws + WS_WIN + l * SZ_WIN), MROWS, PW, DM}; pg8::Order S; S.init(MROWS / 256, PW, G, bx, 0);
            EpiInProj E{Pb, rowss, shwin + (size_t)l * NMS * PW, ropeC, ropeS};
            pg8::gemm_phase<EpiInProj, pg8::Order, true, true>(ldsl, g, S, E);
        }
        SEAM(pb);
        if (IN(pb + 1)) {
            if (EN(3)) for (int u = vcu; u < NB * NCHUNK; u += G)
                lru::lru_unit<false>(lds, Pb, Yb, u / NCHUNK, u % NCHUNK, in[12] + l * 1024, in[13] + l * 256, WRG + (size_t)l * 65536, in[15] + l * 512, in[17] + l * 512, c8 + l * 512, lrus);
            if (EN(4)) for (int u = G - 1 - vcu; u < NB * NCHUNK; u += G) { const int c = u % NCHUNK; if (last && c < 2) continue;
                sgu::sgu_unit(lds, Pb, Yb, u / NCHUNK, c, WSP + (size_t)l * 65536, in[19] + l * 256, in[21] + l * 512); }
            const float lam = lamv[l], li = 0.8f - 0.6f * __expf(-0.3f * (float)l);
            if (EN(5)) { const int nu = last ? NB * 4 * 16 : NB * 4 * 17;
                for (int u = vcu; u < nu; u += G) { int bh, qb; if (u < NB * 4 * 16) { bh = u >> 4; qb = (u & 15) + 1; } else { bh = u - NB * 4 * 16; qb = 0; }
                    att::attn_unit(lds, Pb, Yb, bh >> 2, bh & 3, qb, lam, in[11] + l * 128, 1.f - li); } }
        }
        SEAM(pb + 1);
        if (EN(6) && IN(pb + 2)) {
            for (int u = vcu; u < NB * NCHUNK; u += G) { const int c = u % NCHUNK; if (last && c < 2) continue;
                lru::lru_unit<true>(lds, Pb, Yb, u / NCHUNK, c, in[12] + l * 1024, in[13] + l * 256, WRG + (size_t)l * 65536, in[15] + l * 512, in[17] + l * 512, c8 + l * 512, lrus); }
        }
        SEAM(pb + 2);
        if (EN(7) && IN(pb + 3)) {
            pg8::Gemm g{Yb, (const bf16_t*)(ws + WS_WOUT + l * SZ_WOUT), MROWS, DM, DM}; pg8::Order S; S.init(last ? 128 : 136, DM, G, bx, last ? 1 : 0);
            EpiRes E{l == 0 ? in[0] : args.out, l == 0 ? in[2] : xc, args.out, xc, modl + 2 * DM, in[7] + l * DM, modl + 4 * DM, AP, rowss, 1};
            pg8::gemm_phase<EpiRes, pg8::Order, true, true>(ldsl, g, S, E);
        }
        SEAM(pb + 3);
        if (EN(8) && IN(pb + 4)) {
            pg8::Gemm g{AP, (const bf16_t*)(ws + WS_WFFN + l * SZ_WFFN), MROWS, NF, DM}; pg8::Order S; S.init(last ? 128 : 136, NF, G, bx, last ? 1 : 0);
            EpiSwiGLU E{HM, rowss, shwf + (size_t)l * NMS * NF};
            pg8::gemm_phase<EpiSwiGLU, pg8::Order, true, true>(ldsl, g, S, E);
        }
        SEAM(pb + 4);
        if (EN(9) && IN(pb + 5)) {
            pg8::Gemm g{HM, (const bf16_t*)(ws + WS_WDN + l * SZ_WDN), MROWS, DM, FH}; pg8::Order S; S.init(last ? 128 : 136, DM, G, bx, last ? 1 : 0);
            const int ln = last ? l : l + 1;
            EpiRes E{args.out, xc, args.out, xc, modl + 5 * DM, in[6] + ln * DM, mods + (size_t)ln * NMS * NMOD + DM, AP, rowss, last ? 0 : 1};
            pg8::gemm_phase<EpiRes, pg8::Order, true, true>(ldsl, g, S, E);
        }
        SEAM(pb + 5);
    }
    if (EN(10) && IN(14)) {
        const int gw = vcu * 8 + wave, NGW = G * 8;
        for (int m = gw; m < NB * SEQ; m += NGW) { const int b = m / SEQ, t = m - b * SEQ; const size_t row = (size_t)b * TB + CTXL + t;
            const float rstd = row_rstd(rowss, row); f32x4* xr = (f32x4*)(args.out + (size_t)m * DM);
#pragma unroll
            for (int j = 0; j < 4; ++j) { const f32x4 g = *(const f32x4*)(in[26] + 4 * lane + 256 * j); xr[lane + 64 * j] = xr[lane + 64 * j] * rstd * g; } }
    }
#undef IN
#undef SEAM
}

extern "C" void kernel_launch(void* const* d_in, const int* in_sizes, int n_in, void* d_out, int out_size, void* d_ws, size_t ws_size, hipStream_t stream) {
    static int grid = 0;
    if (grid == 0) {
        if (n_in != 27 || out_size != NB * SEQ * DM || ws_size < WS_TOTAL) { fprintf(stderr, "kernel_launch: unexpected shapes (n_in %d out %d ws %zu need %zu)\n", n_in, out_size, ws_size, (size_t)WS_END); grid = -1; return; }
        int dev = 0, cus = 0, per_cu = 0;
        (void)hipGetDevice(&dev); (void)hipDeviceGetAttribute(&cus, hipDeviceAttributeMultiprocessorCount, dev);
        if (hipFuncSetAttribute((const void*)hybrid_fwd, hipFuncAttributeMaxDynamicSharedMemorySize, LDS_BYTES) != hipSuccess) { fprintf(stderr, "kernel_launch: hipFuncSetAttribute failed\n"); grid = -1; return; }
        (void)hipOccupancyMaxActiveBlocksPerMultiprocessor(&per_cu, (const void*)hybrid_fwd, 512, LDS_BYTES);
        if (per_cu < 1) { fprintf(stderr, "kernel_launch: occupancy query says %d blocks per CU\n", per_cu); per_cu = 1; }
        (void)hipGetLastError();
        grid = cus;
    }
    if (grid < 0) return;
    if (hipMemsetAsync((char*)d_ws + WS_CTL, 0, WS_CTL_BYTES, stream) != hipSuccess) { fprintf(stderr, "kernel_launch: memset failed\n"); return; }
    Args a{};
    for (int i = 0; i < 27; ++i) a.in[i] = (const float*)d_in[i];
    a.out = (float*)d_out; a.ws = (unsigned char*)d_ws;
#if MK_SINGLE
    a.ph_lo = 0; a.ph_hi = NPHASE;
    { void* kargs[] = {&a}; hipError_t e = hipLaunchCooperativeKernel((const void*)hybrid_fwd, dim3(grid), dim3(512), kargs, LDS_BYTES, stream);
      if (e != hipSuccess) fprintf(stderr, "cooperative launch failed: %s (grid %d)\n", hipGetErrorString(e), grid); }
#else
    for (int pp = 0; pp < NPHASE + PROBE_NDUP; ++pp) { const int p = pp < NPHASE ? pp : PROBE_DUP0 + (pp - NPHASE) * PROBE_DUPSTEP; a.ph_lo = p; a.ph_hi = p + 1;
        void* kargs[] = {&a}; hipError_t e = hipLaunchCooperativeKernel((const void*)hybrid_fwd, dim3(grid), dim3(512), kargs, LDS_BYTES, stream);
        if (e != hipSuccess) { fprintf(stderr, "cooperative launch %d failed: %s (grid %d)\n", p, hipGetErrorString(e), grid); break; } }
#endif
}
```

```cpp
#include <hip/hip_runtime.h>
#include <hip/hip_cooperative_groups.h>
#include <cstdio>
#include <cstdint>
namespace cg = cooperative_groups;

#ifndef MK_SINGLE
#define MK_SINGLE 1
#endif
#ifndef PH_MASK
#define PH_MASK 0xFFFF
#endif
#define EN(k) (((PH_MASK) >> (k)) & 1)
#ifndef PROBE_NDUP
#define PROBE_NDUP 0
#define PROBE_DUP0 0
#define PROBE_DUPSTEP 6
#endif
#ifndef ATT_VAR
#define ATT_VAR 0
#endif

constexpr int NB = 8, SEQ = 4096, CTXL = 256, TB = SEQ + CTXL, MROWS = NB * TB, DM = 1024, PW = 2560, FH = 2816, NF = 2 * FH, NLAYER = 2;
constexpr int Q0c = 0, K0c = 512, V0c = 1024, LX0 = 1536, LG0 = 1792, SU0 = 2048, SV0 = 2304;
constexpr int NMS = 9, NMOD = 6 * DM;
constexpr int NCHUNK = TB / 128;
constexpr size_t SZ_WIN = (size_t)PW * DM * 2, SZ_WOUT = (size_t)DM * DM * 2, SZ_WFFN = (size_t)NF * DM * 2, SZ_WDN = (size_t)DM * FH * 2;
constexpr size_t WS_WIN = 0, WS_WOUT = WS_WIN + 2 * SZ_WIN, WS_WFFN = WS_WOUT + 2 * SZ_WOUT, WS_WDN = WS_WFFN + 2 * SZ_WFFN;
constexpr size_t WS_WSP = WS_WDN + 2 * SZ_WDN;
constexpr size_t WS_WRG = WS_WSP + 262144;
constexpr size_t WS_MODS = WS_WRG + 262144;
constexpr size_t WS_SHWIN = WS_MODS + 442368;
constexpr size_t WS_SHWF = WS_SHWIN + 184320;
constexpr size_t WS_ROPE = WS_SHWF + 405504;
constexpr size_t WS_C8 = WS_ROPE + 8192;
constexpr size_t WS_LAM = WS_C8 + 4096;
constexpr size_t WS_ROWSS = WS_LAM + 256;
constexpr size_t WS_LRUS = WS_ROWSS + (size_t)MROWS * 64;
constexpr size_t WS_XC = WS_LRUS + (size_t)NB * NCHUNK * 2 * 2 * 256 * 4;
constexpr size_t WS_AP = WS_XC + (size_t)NB * CTXL * DM * 4;
constexpr size_t WS_P = WS_AP + (size_t)MROWS * DM * 2;
constexpr size_t WS_Y = WS_P + (size_t)MROWS * PW * 2;
constexpr size_t WS_END = WS_Y + (size_t)MROWS * DM * 2;
constexpr size_t WS_CTL = WS_END, WS_CTL_BYTES = 16384, WS_TOTAL = WS_END + WS_CTL_BYTES;
constexpr size_t WS_HMID = WS_P;
static_assert((size_t)MROWS * FH * 2 <= WS_END - WS_P, "hmid overlay");
static_assert(WS_WSP % 256 == 0 && WS_MODS % 256 == 0 && WS_ROWSS % 256 == 0 && WS_XC % 256 == 0 && WS_AP % 256 == 0 && WS_P % 256 == 0, "align");

#define LAS __attribute__((address_space(3)))
typedef float f32x2 __attribute__((ext_vector_type(2)));
typedef unsigned u32x2 __attribute__((ext_vector_type(2)));
__device__ __forceinline__ unsigned cvtpk(float lo, float hi) { unsigned r; asm("v_cvt_pk_bf16_f32 %0, %1, %2" : "=v"(r) : "v"(lo), "v"(hi)); return r; }
__device__ __forceinline__ float bflo(unsigned w) { return __uint_as_float(w << 16); }
__device__ __forceinline__ float bfhi(unsigned w) { return __uint_as_float(w & 0xffff0000u); }
__device__ __forceinline__ float bf2f(unsigned short h) { return __uint_as_float((unsigned)h << 16); }
__device__ __forceinline__ unsigned short f2bf(float v) { return (unsigned short)(cvtpk(v, v) & 0xffffu); }
__device__ __forceinline__ float gelu_tanh(float x) { const float u = 1.5957691216f * x * (1.f + 0.044715f * x * x); return x / (1.f + __expf(-u)); }
__device__ __forceinline__ float silu_f(float x) { return x / (1.f + __expf(-x)); }
__device__ __forceinline__ float sigm(float x) { return 1.f / (1.f + __expf(-x)); }

namespace pg8 {
#define PG8_LAS __attribute__((address_space(3)))
typedef unsigned short bf16_t;
typedef short bf16x8 __attribute__((ext_vector_type(8)));
typedef float f32x4 __attribute__((ext_vector_type(4)));
typedef unsigned u32x4 __attribute__((ext_vector_type(4)));
constexpr int BM = 256, BK = 64, HALF = 128, HTB = HALF * BK * 2  , STAGE_BYTES = 8 * HTB, NXCD = 8, WGM = 8;

__host__ __device__ __forceinline__ int lds_byte(int r, int c) { const int st = (r >> 4) * 2 + (c >> 5), rr = r & 15, cc = c & 31, ob = rr * 64 + cc * 2; return st * 1024 + (ob ^ (((ob >> 9) & 1) << 5)); }
__host__ __device__ __forceinline__ void stage_rc(int b, int& R, int& C) { const int st = b / 1024, sb = b % 1024, swz = sb ^ (((sb >> 9) & 1) << 5); R = (st >> 1) * 16 + swz / 64; C = (st & 1) * 32 + (swz % 64) / 2; }
__host__ __device__ __forceinline__ int perm32(int rho) { const int n = rho >> 4, i = rho & 15; return 8 * (i >> 2) + 4 * n + (i & 3); }

struct Unit { int pm, pn; };
struct Gemm { const bf16_t* A; const bf16_t* Bt; int M, N, K; };

struct StaticOrder {
    int nM, nN, nwg, G, c;
    __host__ __device__ void init(int M, int N, int G_, int c_) { nM = M / BM; nN = N / BM; nwg = nM * nN; G = G_; c = c_; }
    __host__ __device__ bool next(int i, Unit& u) const {
        const long L = (long)i * G + c; if (L >= nwg) return false;
        int wgid = (int)L; { const int q = nwg / NXCD, r = nwg % NXCD, xcd = wgid % NXCD, off = wgid / NXCD; wgid = (xcd < r ? xcd * (q + 1) : r * (q + 1) + (xcd - r) * q) + off; }
        const int nig = WGM * nN, gid = wgid / nig, fm = gid * WGM, gsz = (nM - fm) < WGM ? (nM - fm) : WGM;
        u.pm = fm + ((wgid % nig) % gsz); u.pn = (wgid % nig) / gsz; return true;
    }
    __device__ __forceinline__ void a_ready(const Unit&) const {}
    __device__ __forceinline__ void done(const Unit&) const {}
};

}
namespace pg8 {
template <class Epi, class Sched, bool ALIGN_EPI = false, bool SP2 = false>
__device__ __forceinline__ void gemm_phase(PG8_LAS unsigned char* lds, const Gemm g, const Sched& S, const Epi& E) {
    int tid_ = threadIdx.x; asm volatile("" : "+v"(tid_));
    const int tid = tid_, wid = __builtin_amdgcn_readfirstlane(tid >> 6), lane = tid & 63, wr = wid >> 2, wc = wid & 3, fr = lane & 15, fq = lane >> 4;
    const int K = g.K, nt = K / BK;
    unsigned voffA[2], voffB[2];
#pragma unroll
    for (int i = 0; i < 2; ++i) { int R, C; stage_rc(tid * 16 + i * 8192, R, C); const int Rb = Epi::PERM ? ((R & ~31) + perm32(R & 31)) : R;
        voffA[i] = (unsigned)(R * K + C) * 2u; voffB[i] = (unsigned)(Rb * K + C) * 2u; }
    const size_t kstep = (size_t)(BK * 2);
    const size_t hstep = (size_t)HALF * K * 2;
    const size_t tstep = 2 * hstep;
    const unsigned ldsw = (unsigned)wid * 1024u;
    const int aoff = lds_byte(wr * 64 + fr, fq * 8), boff = lds_byte(wc * 32 + fr, fq * 8);
#define PG8_SA(b, h) (((b) * 2 + (h)) * HTB)
#define PG8_SB(b, h) ((4 + (b) * 2 + (h)) * HTB)
#define PG8_STAGE(bufoff, gbase, voff) do { _Pragma("unroll") for (int _i = 0; _i < 2; ++_i) \
        __builtin_amdgcn_global_load_lds((const unsigned*)((const char*)(gbase) + (voff)[_i]), (PG8_LAS unsigned*)(lds + (bufoff) + ldsw + _i * 8192), 16, 0, 0); } while (0)
#define PG8_LDA(dst, b, h) do { _Pragma("unroll") for (int m = 0; m < 4; ++m) _Pragma("unroll") for (int k = 0; k < 2; ++k) dst[m][k] = *(const PG8_LAS bf16x8*)(lds + PG8_SA(b, h) + aoff + m * 2048 + k * 1024); } while (0)
#define PG8_LDB(dst, b, h) do { _Pragma("unroll") for (int n = 0; n < 2; ++n) _Pragma("unroll") for (int k = 0; k < 2; ++k) dst[n][k] = *(const PG8_LAS bf16x8*)(lds + PG8_SB(b, h) + boff + n * 2048 + k * 1024); } while (0)
#define PG8_MMA(ai, bj, At, Bt) do { __builtin_amdgcn_s_setprio(1); _Pragma("unroll") for (int m = 0; m < 4; ++m) _Pragma("unroll") for (int n = 0; n < 2; ++n) _Pragma("unroll") for (int k = 0; k < 2; ++k) \
        acc[ai][bj][m][n] = __builtin_amdgcn_mfma_f32_16x16x32_bf16(Bt[n][k], At[m][k], acc[ai][bj][m][n], 0, 0, 0); __builtin_amdgcn_s_setprio(0); } while (0)
#define PG8_WAIT_V(n) asm volatile("s_waitcnt vmcnt(" #n ")" ::: "memory")
#define PG8_WAIT_L(n) asm volatile("s_waitcnt lgkmcnt(" #n ")" ::: "memory")
#define PG8_BAR __builtin_amdgcn_s_barrier()
#define PG8_SCHED __builtin_amdgcn_sched_barrier(0)
    Unit cur, nxt; int ui = 0;
    if (!S.next(0, cur)) return;
    f32x4 acc[2][2][4][2];
#pragma unroll
    for (int a = 0; a < 2; ++a)
#pragma unroll
        for (int b = 0; b < 2; ++b)
#pragma unroll
            for (int m = 0; m < 4; ++m)
#pragma unroll
                for (int n = 0; n < 2; ++n) acc[a][b][m][n] = (f32x4){0.f, 0.f, 0.f, 0.f};
    bf16x8 At[4][2], B0[2][2], B1[2][2];
    const char* cA = (const char*)g.A + (size_t)cur.pm * tstep; const char* cB = (const char*)g.Bt + (size_t)cur.pn * tstep;
    S.a_ready(cur);
    if constexpr (SP2) {
        PG8_STAGE(PG8_SB(0, 0), cB, voffB); PG8_STAGE(PG8_SB(0, 1), cB + hstep, voffB); PG8_STAGE(PG8_SA(0, 0), cA, voffA); PG8_STAGE(PG8_SA(0, 1), cA + hstep, voffA);
        if (wr == 1) PG8_BAR;
        PG8_WAIT_V(2); PG8_BAR;
        PG8_STAGE(PG8_SB(1, 0), cB + kstep, voffB); PG8_STAGE(PG8_SA(1, 0), cA + kstep, voffA); PG8_STAGE(PG8_SB(1, 1), cB + hstep + kstep, voffB);
        PG8_WAIT_V(6); PG8_BAR;
    } else {
        PG8_STAGE(PG8_SB(0, 0), cB, voffB); PG8_STAGE(PG8_SA(0, 0), cA, voffA); PG8_STAGE(PG8_SB(0, 1), cB + hstep, voffB); PG8_STAGE(PG8_SA(0, 1), cA + hstep, voffA);
        if (wr == 1) PG8_BAR;
        PG8_WAIT_V(4); PG8_BAR;
        PG8_STAGE(PG8_SB(1, 0), cB + kstep, voffB); PG8_STAGE(PG8_SA(1, 0), cA + kstep, voffA); PG8_STAGE(PG8_SB(1, 1), cB + hstep + kstep, voffB);
        PG8_WAIT_V(6); PG8_BAR;
    }
    for (;;) {
        const bool has_next = S.next(ui + 1, nxt);
        const char* nA = has_next ? (const char*)g.A + (size_t)nxt.pm * tstep : cA; const char* nB = has_next ? (const char*)g.Bt + (size_t)nxt.pn * tstep : cB;
        for (int t = 0; t < nt; t += 2) {
            const bool last = (t == nt - 2);
            const char* a1 = cA + (size_t)(t + 1) * kstep;
            const char* a2 = last ? nA : cA + (size_t)(t + 2) * kstep; const char* b2 = last ? nB : cB + (size_t)(t + 2) * kstep;
            const char* a3 = a2 + kstep; const char* b3 = b2 + kstep;
            if (last && has_next) S.a_ready(nxt);
            if constexpr (SP2) {
            PG8_LDB(B0, 0, 0); PG8_LDB(B1, 0, 1); PG8_SCHED; PG8_LDA(At, 0, 0); PG8_STAGE(PG8_SA(1, 1), a1 + hstep, voffA);
            PG8_WAIT_V(8); PG8_WAIT_L(0); PG8_BAR; PG8_MMA(0, 0, At, B0); PG8_MMA(0, 1, At, B1); PG8_BAR; PG8_SCHED;
            PG8_LDA(At, 0, 1); PG8_STAGE(PG8_SB(0, 0), b2, voffB); PG8_STAGE(PG8_SB(0, 1), b2 + hstep, voffB); PG8_STAGE(PG8_SA(0, 0), a2, voffA);
            PG8_WAIT_V(8); PG8_WAIT_L(0); PG8_BAR; PG8_MMA(1, 0, At, B0); PG8_MMA(1, 1, At, B1); PG8_BAR; PG8_SCHED;
            PG8_LDB(B0, 1, 0); PG8_LDB(B1, 1, 1); PG8_SCHED; PG8_LDA(At, 1, 0); PG8_STAGE(PG8_SA(0, 1), a2 + hstep, voffA);
            PG8_WAIT_V(8); PG8_WAIT_L(0); PG8_BAR; PG8_MMA(0, 0, At, B0); PG8_MMA(0, 1, At, B1); PG8_BAR; PG8_SCHED;
            PG8_LDA(At, 1, 1); PG8_STAGE(PG8_SB(1, 0), b3, voffB); PG8_STAGE(PG8_SB(1, 1), b3 + hstep, voffB); PG8_STAGE(PG8_SA(1, 0), a3, voffA);
            PG8_WAIT_V(8); PG8_WAIT_L(0); PG8_BAR; PG8_MMA(1, 0, At, B0); PG8_MMA(1, 1, At, B1); PG8_BAR; PG8_SCHED;
            } else {
            PG8_LDB(B0, 0, 0); PG8_SCHED; PG8_LDA(At, 0, 0); PG8_STAGE(PG8_SA(1, 1), a1 + hstep, voffA);
            PG8_WAIT_L(8); PG8_BAR; PG8_WAIT_L(0); PG8_MMA(0, 0, At, B0); PG8_BAR; PG8_SCHED;
            PG8_LDB(B1, 0, 1); PG8_STAGE(PG8_SB(0, 0), b2, voffB);
            PG8_BAR; PG8_WAIT_L(0); PG8_MMA(0, 1, At, B1); PG8_BAR;
            PG8_LDA(At, 0, 1); PG8_STAGE(PG8_SA(0, 0), a2, voffA);
            PG8_BAR; PG8_WAIT_L(0); PG8_MMA(1, 0, At, B0); PG8_BAR; PG8_SCHED;
            PG8_STAGE(PG8_SB(0, 1), b2 + hstep, voffB);
            PG8_WAIT_V(6); PG8_BAR; PG8_MMA(1, 1, At, B1); PG8_BAR;
            PG8_LDB(B0, 1, 0); PG8_SCHED; PG8_LDA(At, 1, 0); PG8_STAGE(PG8_SA(0, 1), a2 + hstep, voffA);
            PG8_WAIT_L(8); PG8_BAR; PG8_WAIT_L(0); PG8_MMA(0, 0, At, B0); PG8_BAR; PG8_SCHED;
            PG8_LDB(B1, 1, 1); PG8_STAGE(PG8_SB(1, 0), b3, voffB);
            PG8_BAR; PG8_WAIT_L(0); PG8_MMA(0, 1, At, B1); PG8_BAR;
            PG8_LDA(At, 1, 1); PG8_STAGE(PG8_SA(1, 0), a3, voffA);
            PG8_BAR; PG8_WAIT_L(0); PG8_MMA(1, 0, At, B0); PG8_BAR; PG8_SCHED;
            PG8_STAGE(PG8_SB(1, 1), b3 + hstep, voffB);
            PG8_WAIT_V(6); PG8_BAR; PG8_MMA(1, 1, At, B1); PG8_BAR;
            }
        }
        if constexpr (ALIGN_EPI) { if (wr == 0) PG8_BAR; }
        if constexpr (!Epi::AFTER_DRAIN) { E(acc, cur, wr, wc, fr, fq); S.done(cur); }
        if (!has_next) break;
#pragma unroll
        for (int a = 0; a < 2; ++a)
#pragma unroll
            for (int b = 0; b < 2; ++b)
#pragma unroll
                for (int m = 0; m < 4; ++m)
#pragma unroll
                    for (int n = 0; n < 2; ++n) acc[a][b][m][n] = (f32x4){0.f, 0.f, 0.f, 0.f};
        cur = nxt; cA = nA; cB = nB; ++ui;
        if constexpr (ALIGN_EPI) { if (wr == 1) PG8_BAR; }
    }
    PG8_WAIT_V(0);
    if constexpr (!ALIGN_EPI) { if (wr == 0) PG8_BAR; }
    PG8_BAR;
    if constexpr (Epi::AFTER_DRAIN) { E.fused(acc, cur, wr, wc, fr, fq, lds, wid, lane); S.done(cur); }
#undef PG8_SA
#undef PG8_SB
#undef PG8_STAGE
#undef PG8_LDA
#undef PG8_LDB
#undef PG8_MMA
#undef PG8_WAIT_V
#undef PG8_WAIT_L
#undef PG8_BAR
#undef PG8_SCHED
}
}
namespace pg8 {
struct Order {
    int nM, nN, nwg, G, c, skip;
    __device__ void init(int nM_, int N, int G_, int c_, int skip_) { nM = nM_; nN = N / BM; nwg = nM * nN; G = G_; c = c_; skip = skip_; }
    __device__ bool next(int i, Unit& u) const {
        const long L = (long)i * G + c; if (L >= nwg) return false;
        int wgid = (int)L; { const int q = nwg / NXCD, r = nwg % NXCD, xcd = wgid % NXCD, off = wgid / NXCD; wgid = (xcd < r ? xcd * (q + 1) : r * (q + 1) + (xcd - r) * q) + off; }
        const int nig = WGM * nN, gid = wgid / nig, fm = gid * WGM, gsz = (nM - fm) < WGM ? (nM - fm) : WGM;
        u.pm = fm + ((wgid % nig) % gsz); u.pn = (wgid % nig) / gsz;
        if (skip) u.pm = u.pm + u.pm / 16 + 1;
        return true;
    }
    __device__ __forceinline__ void a_ready(const Unit&) const {}
    __device__ __forceinline__ void done(const Unit&) const {}
};
}

using pg8::f32x4; using pg8::u32x4; using pg8::bf16_t; using pg8::bf16x8;
__device__ __forceinline__ float row_rstd(const float* rowss, size_t row) {
    const f32x4* rs = (const f32x4*)(rowss + row * 16);
    const f32x4 s4 = (rs[0] + rs[1]) + (rs[2] + rs[3]);
    return rsqrtf(((s4.x + s4.y) + (s4.z + s4.w)) * (1.f / 1024.f) + 1e-6f);
}
struct EpiInProj {
    static constexpr bool PERM = false, AFTER_DRAIN = false;
    bf16_t* P; const float* rowss; const float* sW; const float* ropeC; const float* ropeS;
    __device__ __forceinline__ void operator()(const f32x4 (&acc)[2][2][4][2], const pg8::Unit& u, int wr, int wc, int fr, int fq) const {
        const int b = u.pm / 17, j17 = u.pm - b * 17; const bool ctx = (j17 == 0); const int ms = ctx ? 8 : b;
        const int colb = u.pn * 256 + wc * 32 + 4 * fq;
        const int mode = (u.pn < 4) ? (ctx ? 0 : 1) : (u.pn >= 7 ? 2 : 0);
        f32x4 bv[2][2];
#pragma unroll
        for (int bj = 0; bj < 2; ++bj)
#pragma unroll
            for (int n = 0; n < 2; ++n) bv[bj][n] = *(const f32x4*)(sW + ms * PW + colb + bj * 128 + n * 16);
#pragma unroll
        for (int ai = 0; ai < 2; ++ai)
#pragma unroll
            for (int m = 0; m < 4; ++m) {
                const int rt = ai * 128 + wr * 64 + m * 16 + fr; const size_t row = (size_t)u.pm * 256 + rt;
                const float rstd = row_rstd(rowss, row);
                f32x4 v[2][2];
#pragma unroll
                for (int bj = 0; bj < 2; ++bj)
#pragma unroll
                    for (int n = 0; n < 2; ++n) v[bj][n] = acc[ai][bj][m][n] * rstd + bv[bj][n];
                if (mode == 1) {
                    const int tl = (j17 - 1) * 256 + rt; const int pos = (wc & 1) ? (tl & 63) : (tl >> 6);
                    const f32x4 c4 = *(const f32x4*)(ropeC + pos * 16 + 4 * fq), s4 = *(const f32x4*)(ropeS + pos * 16 + 4 * fq);
#pragma unroll
                    for (int bj = 0; bj < 2; ++bj) { const f32x4 x1 = v[bj][0], x2 = v[bj][1]; v[bj][0] = x1 * c4 - x2 * s4; v[bj][1] = x1 * s4 + x2 * c4; }
                } else if (mode == 2) {
#pragma unroll
                    for (int bj = 0; bj < 2; ++bj)
#pragma unroll
                        for (int n = 0; n < 2; ++n) { f32x4 t = v[bj][n]; t.x = gelu_tanh(t.x); t.y = gelu_tanh(t.y); t.z = gelu_tanh(t.z); t.w = gelu_tanh(t.w); v[bj][n] = t; }
                }
                bf16_t* rp = P + row * PW + colb;
#pragma unroll
                for (int bj = 0; bj < 2; ++bj)
#pragma unroll
                    for (int n = 0; n < 2; ++n) { u32x2 w; w.x = cvtpk(v[bj][n].x, v[bj][n].y); w.y = cvtpk(v[bj][n].z, v[bj][n].w); *(u32x2*)(rp + bj * 128 + n * 16) = w; }
            }
    }
};
struct EpiSwiGLU {
    static constexpr bool PERM = true, AFTER_DRAIN = false;
    bf16_t* H; const float* rowss; const float* sW;
    __device__ __forceinline__ void operator()(const f32x4 (&acc)[2][2][4][2], const pg8::Unit& u, int wr, int wc, int fr, int fq) const {
        const int b = u.pm / 17, j17 = u.pm - b * 17; const int ms = (j17 == 0) ? 8 : b;
        const int colb = wc * 32 + 8 * fq;
        f32x4 bg[2], bu[2];
#pragma unroll
        for (int n = 0; n < 2; ++n) { bg[n] = *(const f32x4*)(sW + ms * NF + u.pn * 256 + colb + 4 * n); bu[n] = *(const f32x4*)(sW + ms * NF + u.pn * 256 + 128 + colb + 4 * n); }
#pragma unroll
        for (int ai = 0; ai < 2; ++ai)
#pragma unroll
            for (int m = 0; m < 4; ++m) {
                const int rt = ai * 128 + wr * 64 + m * 16 + fr; const size_t row = (size_t)u.pm * 256 + rt;
                const float rstd = row_rstd(rowss, row);
                f32x4 hm[2];
#pragma unroll
                for (int n = 0; n < 2; ++n) { const f32x4 g = acc[ai][0][m][n] * rstd + bg[n], up = acc[ai][1][m][n] * rstd + bu[n];
                    hm[n].x = silu_f(g.x) * up.x; hm[n].y = silu_f(g.y) * up.y; hm[n].z = silu_f(g.z) * up.z; hm[n].w = silu_f(g.w) * up.w; }
                u32x4 w; w.x = cvtpk(hm[0].x, hm[0].y); w.y = cvtpk(hm[0].z, hm[0].w); w.z = cvtpk(hm[1].x, hm[1].y); w.w = cvtpk(hm[1].z, hm[1].w);
                *(u32x4*)(H + row * FH + u.pn * 128 + colb) = w;
            }
    }
};
struct EpiRes {
    static constexpr bool PERM = true, AFTER_DRAIN = false;
    const float* xin_lat; const float* xin_ctx; float* xo_lat; float* xo_ctx;
    const float* gate; const float* gn; const float* scn; bf16_t* A; float* rowss; int write_a;
    __device__ __forceinline__ void operator()(const f32x4 (&acc)[2][2][4][2], const pg8::Unit& u, int wr, int wc, int fr, int fq) const {
        const int b = u.pm / 17, j17 = u.pm - b * 17; const bool ctx = (j17 == 0); const int ms = ctx ? 8 : b;
        const float* xi = ctx ? xin_ctx + (size_t)b * CTXL * DM : xin_lat + ((size_t)b * SEQ + (size_t)(j17 - 1) * 256) * DM;
        float* xo = ctx ? xo_ctx + (size_t)b * CTXL * DM : xo_lat + ((size_t)b * SEQ + (size_t)(j17 - 1) * 256) * DM;
        const int colb = u.pn * 256 + wc * 32 + 8 * fq;
        float ss[2][4];
#pragma unroll
        for (int ai = 0; ai < 2; ++ai)
#pragma unroll
            for (int m = 0; m < 4; ++m) ss[ai][m] = 0.f;
#pragma unroll
        for (int bj = 0; bj < 2; ++bj) {
            const int col = colb + bj * 128;
            f32x4 gv[2];
#pragma unroll
            for (int n = 0; n < 2; ++n) gv[n] = *(const f32x4*)(gate + ms * NMOD + col + 4 * n);
#pragma unroll
            for (int ai = 0; ai < 2; ++ai)
#pragma unroll
                for (int m = 0; m < 4; ++m) {
                    const int rt = ai * 128 + wr * 64 + m * 16 + fr;
                    const unsigned xo4 = ((unsigned)rt * DM + (unsigned)col) * 4u;
                    f32x4 xv[2];
#pragma unroll
                    for (int n = 0; n < 2; ++n) { xv[n] = *(const f32x4*)((const char*)xi + (xo4 + 16u * n)) + gv[n] * acc[ai][bj][m][n];
                        *(f32x4*)((char*)xo + (xo4 + 16u * n)) = xv[n];
                        ss[ai][m] += (xv[n].x * xv[n].x + xv[n].y * xv[n].y) + (xv[n].z * xv[n].z + xv[n].w * xv[n].w); }
                    if (write_a) { const f32x4 a0 = xv[0] * (*(const f32x4*)(gn + col) * (*(const f32x4*)(scn + ms * NMOD + col) + 1.f)), a1 = xv[1] * (*(const f32x4*)(gn + col + 4) * (*(const f32x4*)(scn + ms * NMOD + col + 4) + 1.f));
                        u32x4 w; w.x = cvtpk(a0.x, a0.y); w.y = cvtpk(a0.z, a0.w); w.z = cvtpk(a1.x, a1.y); w.w = cvtpk(a1.z, a1.w);
                        *(u32x4*)((char*)A + (((unsigned)u.pm * 256u + (unsigned)rt) * DM + (unsigned)col) * 2u) = w; }
                }
        }
#pragma unroll
        for (int ai = 0; ai < 2; ++ai)
#pragma unroll
            for (int m = 0; m < 4; ++m) { float s = ss[ai][m]; s += __shfl_xor(s, 16); s += __shfl_xor(s, 32);
                if (fq == 0) rowss[((size_t)u.pm * 256 + ai * 128 + wr * 64 + m * 16 + fr) * 16 + u.pn * 4 + wc] = s; }
    }
};
namespace att {
using s16x4 = __attribute__((ext_vector_type(4))) short;
using f32x16 = __attribute__((ext_vector_type(16))) float;
constexpr int SHM_V = 16384, SHM_K = 8192, OFF_V = 0, OFF_K = 32768, OFF_WS = 49152, OFF_ST = 51200, LDS_TOTAL = OFF_ST + 65536;
constexpr float SCALE = 0.125f, THR = 8.f;
#define KSWZ(row, colB) ((row) * 128 + ((colB) ^ (((row) & 7) << 4)))
#define SBAR() __builtin_amdgcn_sched_barrier(0)
__device__ __forceinline__ int crow(int r, int hi) { return (r & 3) + 8 * (r >> 2) + 4 * hi; }
__device__ __forceinline__ void partialSM(f32x16& p0, f32x16& p1, float& m_reg, float& mn, float& alpha) {
  constexpr float C = SCALE * 1.4426950408889634f;
  float pmax = p0[0];
#pragma unroll
  for (int r = 1; r < 16; ++r) pmax = fmaxf(pmax, p0[r]);
#pragma unroll
  for (int r = 0; r < 16; ++r) pmax = fmaxf(pmax, p1[r]);
  { auto rr = __builtin_amdgcn_permlane32_swap(__float_as_uint(pmax), __float_as_uint(pmax), false, false);
    pmax = fmaxf(__uint_as_float(rr[0]), __uint_as_float(rr[1])); }
  if (__builtin_expect(__all(pmax - m_reg <= THR / SCALE), 1)) { mn = m_reg; alpha = 1.f; }
  else { mn = fmaxf(m_reg, pmax); alpha = __builtin_amdgcn_exp2f((m_reg - mn) * C); m_reg = mn; }
  const float mnC = -mn * C;
#pragma unroll
  for (int r = 0; r < 16; ++r) p0[r] = fmaf(p0[r], C, mnC);
#pragma unroll
  for (int r = 0; r < 16; ++r) p1[r] = fmaf(p1[r], C, mnC);
#pragma unroll
  for (int r = 0; r < 16; ++r) p0[r] = __builtin_amdgcn_exp2f(p0[r]);
}
__device__ __forceinline__ void finishSM(f32x16& p0, f32x16& p1, float alpha, float& l_reg, bf16x8& pa0, bf16x8& pa1, bf16x8& pa2, bf16x8& pa3) {
#pragma unroll
  for (int r = 0; r < 16; ++r) p1[r] = __builtin_amdgcn_exp2f(p1[r]);
  float ps = 0;
#pragma unroll
  for (int r = 0; r < 16; ++r) ps += p0[r];
#pragma unroll
  for (int r = 0; r < 16; ++r) ps += p1[r];
  { auto rr = __builtin_amdgcn_permlane32_swap(__float_as_uint(ps), __float_as_uint(ps), false, false);
    ps = __uint_as_float(rr[0]) + __uint_as_float(rr[1]); }
  l_reg = l_reg * alpha + ps;
#define PK4(P, BASE, OUT) do { unsigned a0 = cvtpk(P[BASE + 0], P[BASE + 1]), a1 = cvtpk(P[BASE + 2], P[BASE + 3]);   \
    unsigned b0 = cvtpk(P[BASE + 4], P[BASE + 5]), b1 = cvtpk(P[BASE + 6], P[BASE + 7]);                              \
    auto r0 = __builtin_amdgcn_permlane32_swap(a0, b0, false, false); auto r1 = __builtin_amdgcn_permlane32_swap(a1, b1, false, false); \
    u32x4 w = {r0[0], r1[0], r0[1], r1[1]}; OUT = *reinterpret_cast<bf16x8*>(&w); } while (0)
  PK4(p0, 0, pa0); PK4(p0, 8, pa1); PK4(p1, 0, pa2); PK4(p1, 8, pa3);
#undef PK4
}
__device__ __forceinline__ void qkt(f32x16& p0, f32x16& p1, const char* Ks, const bf16x8* qr, int r32, int hi) {
  p0 = f32x16{}; p1 = f32x16{};
#pragma unroll
  for (int d0 = 0; d0 < 4; ++d0) { const int cb = d0 * 32 + hi * 16;
    const bf16x8 b0 = *reinterpret_cast<const bf16x8*>(Ks + KSWZ(r32, cb));
    const bf16x8 b1 = *reinterpret_cast<const bf16x8*>(Ks + KSWZ(32 + r32, cb));
    p0 = __builtin_amdgcn_mfma_f32_32x32x16_bf16(b0, qr[d0], p0, 0, 0, 0);
    p1 = __builtin_amdgcn_mfma_f32_32x32x16_bf16(b1, qr[d0], p1, 0, 0, 0); }
}
__device__ __forceinline__ int v_st(int k, int c) { const int kk = (k & ~0xC) | ((k & 4) << 1) | ((k & 8) >> 1); return ((kk >> 3) * 4 + (c >> 5)) * 512 + ((kk & 7) * 32 + (c & 31)) * 2; }
__device__ __forceinline__ int v_rd_base(int lane) { return ((lane & 3) << 3) | (((lane >> 2) & 3) << 6) | (((lane >> 4) & 1) << 5) | (((lane >> 5) & 1) << 8); }
constexpr int v_rd_off(int d0, int ks, int half) { return d0 * 512 + ks * 4096 + half * 2048; }
template <int OFF> __device__ __forceinline__ s16x4 tr_read(int vb) {
  s16x4 r; asm volatile("ds_read_b64_tr_b16 %0, %1 offset:%2" : "=&v"(r) : "v"(vb), "i"(OFF) : "memory"); return r;
}
template <int D0> __device__ __forceinline__ void pv_one(f32x16& od, int vb, bf16x8 pa0, bf16x8 pa1, bf16x8 pa2, bf16x8 pa3) {
  const s16x4 l0 = tr_read<v_rd_off(D0, 0, 0)>(vb), h0 = tr_read<v_rd_off(D0, 0, 1)>(vb), l1 = tr_read<v_rd_off(D0, 1, 0)>(vb), h1 = tr_read<v_rd_off(D0, 1, 1)>(vb);
  const s16x4 l2 = tr_read<v_rd_off(D0, 2, 0)>(vb), h2 = tr_read<v_rd_off(D0, 2, 1)>(vb), l3 = tr_read<v_rd_off(D0, 3, 0)>(vb), h3 = tr_read<v_rd_off(D0, 3, 1)>(vb);
  asm volatile("s_waitcnt lgkmcnt(0)" ::: "memory"); SBAR();
#define PK(L, H) (bf16x8){L[0], L[1], L[2], L[3], H[0], H[1], H[2], H[3]}
  od = __builtin_amdgcn_mfma_f32_32x32x16_bf16(pa0, PK(l0, h0), od, 0, 0, 0);
  od = __builtin_amdgcn_mfma_f32_32x32x16_bf16(pa1, PK(l1, h1), od, 0, 0, 0);
  od = __builtin_amdgcn_mfma_f32_32x32x16_bf16(pa2, PK(l2, h2), od, 0, 0, 0);
  od = __builtin_amdgcn_mfma_f32_32x32x16_bf16(pa3, PK(l3, h3), od, 0, 0, 0);
#undef PK
}
__device__ __forceinline__ void pv_d0(f32x16* o, int vb, bf16x8 pa0, bf16x8 pa1, bf16x8 pa2, bf16x8 pa3) {
  pv_one<0>(o[0], vb, pa0, pa1, pa2, pa3); pv_one<1>(o[1], vb, pa0, pa1, pa2, pa3); pv_one<2>(o[2], vb, pa0, pa1, pa2, pa3); pv_one<3>(o[3], vb, pa0, pa1, pa2, pa3);
}
__device__ __forceinline__ void attn_unit(char* lds, const bf16_t* __restrict__ P, bf16_t* __restrict__ Y, int b, int h, int qb, float lam, const float* __restrict__ gattn, float oscale) {
  int tid_ = threadIdx.x; asm volatile("" : "+v"(tid_));
  const int tid = tid_, wid = tid >> 6, lane = tid & 63, r32 = lane & 31, hi = lane >> 5;
  const unsigned rowb = (unsigned)b * TB, q0 = rowb + (unsigned)qb * 256;
  const int seq = (qb == 0) ? CTXL : TB, NT = seq / 64;
  char* V_lds = lds + OFF_V; char* K_lds = lds + OFF_K;
  float* ws = (float*)(lds + OFF_WS) + wid * 64; float* li_l = ws; float* al_l = ws + 32;
  unsigned* stash = (unsigned*)(lds + OFF_ST) + wid * 2048;
  const int sr = tid >> 4, sc = (tid & 15) * 8, vst0 = v_st(sr, sc), vst1 = v_st(32 + sr, sc);
  const int kr = tid >> 3, kc = (tid & 7) * 8, kst = KSWZ(kr, kc * 2);
  const int vb0 = (int)(uintptr_t)V_lds + v_rd_base(lane);
  const char* Pc = (const char*)P;
  const unsigned voff = ((rowb + sr) * PW + V0c + h * 128 + sc) * 2u;
#pragma unroll 1
  for (int map = 0; map < 2; ++map) {
    const unsigned qoff = ((q0 + wid * 32 + r32) * PW + Q0c + h * 128 + map * 64 + hi * 8) * 2u;
    const unsigned koff = ((rowb + kr) * PW + K0c + h * 128 + map * 64 + kc) * 2u;
    bf16x8 qr[4];
#pragma unroll
    for (int d0 = 0; d0 < 4; ++d0) qr[d0] = *reinterpret_cast<const bf16x8*>(Pc + (qoff + d0 * 32));
    float m_reg = -1e30f, l_reg = 0; f32x16 o[4] = {};
    struct { bf16x8 vs0, vs1, ks; } sr_[1];
#define SLOAD(i, k0) do { const unsigned ko_ = (unsigned)(k0) * (PW * 2u); sr_[i].vs0 = *reinterpret_cast<const bf16x8*>(Pc + (voff + ko_)); sr_[i].vs1 = *reinterpret_cast<const bf16x8*>(Pc + (voff + ko_ + 32u * PW * 2u)); \
    sr_[i].ks = *reinterpret_cast<const bf16x8*>(Pc + (koff + ko_)); } while (0)
#define SWRITE(bf, i) do { *(bf16x8*)(V_lds + (bf) * SHM_V + vst0) = sr_[i].vs0; *(bf16x8*)(V_lds + (bf) * SHM_V + vst1) = sr_[i].vs1; \
    *(bf16x8*)(K_lds + (bf) * SHM_K + kst) = sr_[i].ks; } while (0)
#define SWAIT() asm volatile("s_waitcnt vmcnt(0)" ::: "memory")
#define RESC(a) do { if (__any((a) < 1.f)) { if (hi == 0) al_l[r32] = (a); asm volatile("s_waitcnt lgkmcnt(0)" ::: "memory"); \
    _Pragma("unroll") for (int d = 0; d < 4; ++d) _Pragma("unroll") for (int r = 0; r < 16; ++r) o[d][r] *= al_l[crow(r, hi)]; } } while (0)
    f32x16 pA0, pA1, pB0, pB1; float mnA, mnB, alA, alB; bf16x8 pa0, pa1, pa2, pa3;
    constexpr int SE = 0, SO = 0;
    SLOAD(SE, 0); asm volatile("s_waitcnt vmcnt(0)" ::: "memory"); SWRITE(0, SE); __syncthreads();
    qkt(pA0, pA1, K_lds, qr, r32, hi); partialSM(pA0, pA1, m_reg, mnA, alA);
    SLOAD(SO, 64);
    SWAIT(); SWRITE(1, SO); __syncthreads();
    for (int j = 1; j + 1 < NT; j += 2) {
      SBAR(); qkt(pB0, pB1, K_lds + SHM_K, qr, r32, hi);
      finishSM(pA0, pA1, alA, l_reg, pa0, pa1, pa2, pa3); SBAR();
      SLOAD(SO, (j + 1) * 64); SBAR();
      pv_d0(o, vb0, pa0, pa1, pa2, pa3); partialSM(pB0, pB1, m_reg, mnB, alB);
      __syncthreads(); SWAIT(); SWRITE(0, SE);
      RESC(alB); __syncthreads();
      SBAR(); qkt(pA0, pA1, K_lds, qr, r32, hi);
      finishSM(pB0, pB1, alB, l_reg, pa0, pa1, pa2, pa3); SBAR();
      SLOAD(SE, (j + 2) * 64); SBAR();
      pv_d0(o, vb0 + SHM_V, pa0, pa1, pa2, pa3); partialSM(pA0, pA1, m_reg, mnA, alA);
      __syncthreads(); SWAIT(); SWRITE(1, SO);
      RESC(alA); __syncthreads();
    }
    SBAR(); qkt(pB0, pB1, K_lds + SHM_K, qr, r32, hi);
    finishSM(pA0, pA1, alA, l_reg, pa0, pa1, pa2, pa3); SBAR();
    pv_d0(o, vb0, pa0, pa1, pa2, pa3); partialSM(pB0, pB1, m_reg, mnB, alB);
    __syncthreads(); RESC(alB);
    finishSM(pB0, pB1, alB, l_reg, pa0, pa1, pa2, pa3); SBAR();
    pv_d0(o, vb0 + SHM_V, pa0, pa1, pa2, pa3);
    if (hi == 0) li_l[r32] = l_reg; asm volatile("s_waitcnt lgkmcnt(0)" ::: "memory");
    if (map == 0) {
#pragma unroll
      for (int r = 0; r < 16; ++r) { const float rl = __builtin_amdgcn_rcpf(li_l[crow(r, hi)]);
        stash[(r * 2 + 0) * 64 + lane] = cvtpk(o[0][r] * rl, o[1][r] * rl); stash[(r * 2 + 1) * 64 + lane] = cvtpk(o[2][r] * rl, o[3][r] * rl); SBAR(); }
    } else if (ATT_VAR != 1) {
      char* Yc = (char*)Y; const unsigned yoff = ((q0 + wid * 32) * DM + h * 128 + r32) * 2u;
      float gv[4];
#pragma unroll
      for (int d0 = 0; d0 < 4; ++d0) gv[d0] = gattn[d0 * 32 + r32] * oscale;
      SBAR();
#pragma unroll
      for (int r = 0; r < 16; ++r) { const float rl = lam * __builtin_amdgcn_rcpf(li_l[crow(r, hi)]);
        const unsigned w0 = stash[(r * 2 + 0) * 64 + lane], w1 = stash[(r * 2 + 1) * 64 + lane];
        const float e0 = bflo(w0) - o[0][r] * rl, e1 = bfhi(w0) - o[1][r] * rl, e2 = bflo(w1) - o[2][r] * rl, e3 = bfhi(w1) - o[3][r] * rl;
        float ssq = (e0 * e0 + e1 * e1) + (e2 * e2 + e3 * e3);
        if (ATT_VAR != 3) { ssq += __shfl_xor(ssq, 1); ssq += __shfl_xor(ssq, 2); ssq += __shfl_xor(ssq, 4); ssq += __shfl_xor(ssq, 8); ssq += __shfl_xor(ssq, 16); }
        const float rs = rsqrtf(ssq * (1.f / 128.f) + 1e-6f);
        bf16_t* yr = (bf16_t*)(Yc + (yoff + (unsigned)crow(r, hi) * (DM * 2u)));
        if (ATT_VAR != 4) { yr[0] = f2bf(e0 * rs * gv[0]); yr[32] = f2bf(e1 * rs * gv[1]); yr[64] = f2bf(e2 * rs * gv[2]); yr[96] = f2bf(e3 * rs * gv[3]); } else { yr[0] = f2bf(e0 * rs + e1 + e2 + e3); } SBAR(); }
    }
    __syncthreads();
#undef SLOAD
#undef SWRITE
#undef SWAIT
#undef RESC
  }
}
#undef KSWZ
}
namespace lru {
using att::f32x16; using att::crow;
constexpr int RS = 528;
constexpr int OFF_CL = 0, OFF_YS = 128 * RS, OFF_CY = 2 * 128 * RS;
template <int CTRL, int RMASK> __device__ __forceinline__ float dppf(float oldv, float src) {
  return __int_as_float(__builtin_amdgcn_update_dpp(__float_as_int(oldv), __float_as_int(src), CTRL, RMASK, 0xF, false));
}
template <bool PASS2>
__device__ __forceinline__ void lru_unit(char* lds, const bf16_t* __restrict__ P, bf16_t* __restrict__ Y, int b, int c, const float* __restrict__ convw, const float* __restrict__ convb,
                                         const bf16_t* __restrict__ wrg, const float* __restrict__ ba, const float* __restrict__ bx, const float* __restrict__ c8, float* lrus) {
  int tid_ = threadIdx.x; asm volatile("" : "+v"(tid_));
  const int tid = tid_, wid = tid >> 6, lane = tid & 63, r32 = lane & 31, hi = lane >> 5;
  const unsigned R0 = (unsigned)b * TB + (unsigned)c * 128;
  const int seg_lo = (c < 2) ? 0 : CTXL, seg_hi = (c < 2) ? CTXL : TB;
  const char* Pc = (const char*)P;
  {
    const int ch8 = (tid & 31) * 8, t0 = (tid >> 5) * 8;
    u32x4 xr[11];
#pragma unroll
    for (int i = 0; i < 11; ++i) { const int tt = c * 128 + t0 - 1 + i;
      if (tt >= seg_lo && tt < seg_hi) xr[i] = *(const u32x4*)(Pc + (((unsigned)b * TB + (unsigned)tt) * PW + LX0 + ch8) * 2u); else xr[i] = (u32x4){0u, 0u, 0u, 0u}; }
    float w[4][8], bb[8];
#pragma unroll
    for (int k = 0; k < 4; ++k) { const f32x4 a = *(const f32x4*)(convw + k * 256 + ch8), d = *(const f32x4*)(convw + k * 256 + ch8 + 4);
      w[k][0] = a.x; w[k][1] = a.y; w[k][2] = a.z; w[k][3] = a.w; w[k][4] = d.x; w[k][5] = d.y; w[k][6] = d.z; w[k][7] = d.w; }
    { const f32x4 a = *(const f32x4*)(convb + ch8), d = *(const f32x4*)(convb + ch8 + 4); bb[0] = a.x; bb[1] = a.y; bb[2] = a.z; bb[3] = a.w; bb[4] = d.x; bb[5] = d.y; bb[6] = d.z; bb[7] = d.w; }
#pragma unroll
    for (int i = 0; i < 8; ++i) { float acc[8];
#pragma unroll
      for (int e = 0; e < 8; ++e) acc[e] = bb[e];
#pragma unroll
      for (int k = 0; k < 4; ++k) { const u32x4 xv = xr[i + k];
        acc[0] += bflo(xv.x) * w[k][0]; acc[1] += bfhi(xv.x) * w[k][1]; acc[2] += bflo(xv.y) * w[k][2]; acc[3] += bfhi(xv.y) * w[k][3];
        acc[4] += bflo(xv.z) * w[k][4]; acc[5] += bfhi(xv.z) * w[k][5]; acc[6] += bflo(xv.w) * w[k][6]; acc[7] += bfhi(xv.w) * w[k][7]; }
      u32x4 o; o.x = cvtpk(acc[0], acc[1]); o.y = cvtpk(acc[2], acc[3]); o.z = cvtpk(acc[4], acc[5]); o.w = cvtpk(acc[6], acc[7]);
      *(u32x4*)(lds + OFF_CL + (t0 + i) * RS + ch8 * 2) = o; }
  }
  if (PASS2) {
    const int d = tid >> 8, ch = tid & 255;
    const int np = d ? (c < 2 ? 1 - c : NCHUNK + 1 - c) : c;
    float cy = 0.f;
    const float* sb = lrus + ((size_t)b * NCHUNK * 4 + (size_t)d * 2) * 256 + ch;
    if (np > 0) { float A[NCHUNK], H[NCHUNK];
#pragma unroll
      for (int i = 0; i < NCHUNK; ++i) { int p = i < np ? i : np - 1;
        const int u = d ? (c < 2 ? 1 - p : (p == 0 ? 1 : (p == 1 ? 0 : NCHUNK + 1 - p))) : p;
        A[i] = sb[(size_t)u * 1024]; H[i] = sb[(size_t)u * 1024 + 256]; }
#pragma unroll
      for (int i = 0; i < NCHUNK; ++i) if (i < np) cy = A[i] * cy + H[i];
    }
    ((float*)(lds + OFF_CY))[tid] = cy;
  }
  __syncthreads();
  const int hh = wid >> 1, jh = wid & 1, chb = hh * 64 + jh * 32;
#pragma unroll 1
  for (int d = 0; d < 2; ++d) {
    const bf16_t* wa = wrg + ((0 * 2 + d) * 4 + hh) * 4096 + (jh * 32 + r32) * 64 + hi * 8;
    const bf16_t* wx = wrg + ((1 * 2 + d) * 4 + hh) * 4096 + (jh * 32 + r32) * 64 + hi * 8;
    bf16x8 fa[4], fx[4];
#pragma unroll
    for (int k = 0; k < 4; ++k) { fa[k] = *reinterpret_cast<const bf16x8*>(wa + k * 16); fx[k] = *reinterpret_cast<const bf16x8*>(wx + k * 16); }
    float carry[16], Pc_[16], bav[16], bxv[16], c8v[16];
#pragma unroll
    for (int q = 0; q < 4; ++q) { const int co = d * 256 + chb + 8 * q + 4 * hi;
      const f32x4 b4 = *(const f32x4*)(ba + co), x4 = *(const f32x4*)(bx + co), c4 = *(const f32x4*)(c8 + co);
      bav[4 * q] = b4.x; bav[4 * q + 1] = b4.y; bav[4 * q + 2] = b4.z; bav[4 * q + 3] = b4.w; bxv[4 * q] = x4.x; bxv[4 * q + 1] = x4.y; bxv[4 * q + 2] = x4.z; bxv[4 * q + 3] = x4.w;
      c8v[4 * q] = c4.x; c8v[4 * q + 1] = c4.y; c8v[4 * q + 2] = c4.z; c8v[4 * q + 3] = c4.w; }
#pragma unroll
    for (int r = 0; r < 16; ++r) { carry[r] = 0.f; Pc_[r] = 1.f; }
    if (PASS2) { const float* cyp = (const float*)(lds + OFF_CY) + d * 256 + chb + 4 * hi;
#pragma unroll
      for (int q = 0; q < 4; ++q) { const f32x4 v = *(const f32x4*)(cyp + 8 * q); carry[4 * q] = v.x; carry[4 * q + 1] = v.y; carry[4 * q + 2] = v.z; carry[4 * q + 3] = v.w; } }
    const int tokl = d ? 31 - r32 : r32;
#pragma unroll 1
    for (int ti = 0; ti < 4; ++ti) {
      const int tt = d ? 3 - ti : ti;
      char* rowp = lds + OFF_CL + (tt * 32 + tokl) * RS;
      f32x16 za = {}, zx = {};
#pragma unroll
      for (int k = 0; k < 4; ++k) { const bf16x8 xb = *reinterpret_cast<const bf16x8*>(rowp + (hh * 64 + k * 16 + hi * 8) * 2);
        za = __builtin_amdgcn_mfma_f32_32x32x16_bf16(fa[k], xb, za, 0, 0, 0); zx = __builtin_amdgcn_mfma_f32_32x32x16_bf16(fx[k], xb, zx, 0, 0, 0); }
      float av[16], bv[16];
#pragma unroll
      for (int q = 0; q < 4; ++q) { const u32x2 cw = *(const u32x2*)(rowp + (chb + 8 * q + 4 * hi) * 2);
        const float clv[4] = {bflo(cw.x), bfhi(cw.x), bflo(cw.y), bfhi(cw.y)};
#pragma unroll
        for (int i = 0; i < 4; ++i) { const int r = 4 * q + i;
          const float rg = sigm(za[r] + bav[r]), ig = sigm(zx[r] + bxv[r]);
          const float a = __expf(-c8v[r] * rg);
          av[r] = a; bv[r] = sqrtf(fmaxf(1.f - a * a, 0.f)) * ig * clv[i]; } }
#define LRU_SCAN(CTRL, RM) _Pragma("unroll") for (int r = 0; r < 16; ++r) { const float ap = dppf<CTRL, RM>(1.f, av[r]), bp = dppf<CTRL, RM>(0.f, bv[r]); bv[r] = av[r] * bp + bv[r]; av[r] = av[r] * ap; }
      LRU_SCAN(0x111, 0xF) LRU_SCAN(0x112, 0xF) LRU_SCAN(0x114, 0xF) LRU_SCAN(0x118, 0xF) LRU_SCAN(0x142, 0xA)
#undef LRU_SCAN
#pragma unroll
      for (int q = 0; q < 4; ++q) { float hv[4];
#pragma unroll
        for (int i = 0; i < 4; ++i) { const int r = 4 * q + i; hv[i] = bv[r] + av[r] * carry[r];
          carry[r] = __shfl(hv[i], 31, 32);
          if (!PASS2) Pc_[r] *= __shfl(av[r], 31, 32); }
        if (PASS2) { u32x2* yp = (u32x2*)(lds + OFF_YS + (tt * 32 + tokl) * RS + (chb + 8 * q + 4 * hi) * 2);
          if (d) { const u32x2 o = *yp; hv[0] += bflo(o.x); hv[1] += bfhi(o.x); hv[2] += bflo(o.y); hv[3] += bfhi(o.y); }
          u32x2 w; w.x = cvtpk(hv[0], hv[1]); w.y = cvtpk(hv[2], hv[3]); *yp = w; } }
    }
    if (!PASS2) { if (r32 == 0) { float* sb = lrus + ((((size_t)b * NCHUNK + c) * 2 + d) * 2) * 256 + chb + 4 * hi;
#pragma unroll
        for (int q = 0; q < 4; ++q) { *(f32x4*)(sb + 8 * q) = (f32x4){Pc_[4 * q], Pc_[4 * q + 1], Pc_[4 * q + 2], Pc_[4 * q + 3]};
          *(f32x4*)(sb + 256 + 8 * q) = (f32x4){carry[4 * q], carry[4 * q + 1], carry[4 * q + 2], carry[4 * q + 3]}; } } }
  }
  if (PASS2) {
    __syncthreads();
    const int ch8 = (tid & 31) * 8;
#pragma unroll
    for (int i = 0; i < 8; ++i) { const int t = (tid >> 5) + 16 * i;
      const u32x4 hv = *(const u32x4*)(lds + OFF_YS + t * RS + ch8 * 2), gv = *(const u32x4*)(Pc + ((R0 + t) * PW + LG0 + ch8) * 2u);
      u32x4 o; o.x = cvtpk(bflo(hv.x) * bflo(gv.x), bfhi(hv.x) * bfhi(gv.x)); o.y = cvtpk(bflo(hv.y) * bflo(gv.y), bfhi(hv.y) * bfhi(gv.y));
      o.z = cvtpk(bflo(hv.z) * bflo(gv.z), bfhi(hv.z) * bfhi(gv.z)); o.w = cvtpk(bflo(hv.w) * bflo(gv.w), bfhi(hv.w) * bfhi(gv.w));
      *(u32x4*)((char*)Y + ((R0 + t) * DM + 512 + ch8) * 2u) = o; }
  }
  __syncthreads();
}
}

namespace sgu {
using att::f32x16; using att::crow;
constexpr int VS = 272;
__device__ __forceinline__ void sgu_unit(char* lds, const bf16_t* __restrict__ P, bf16_t* __restrict__ Y, int b, int c, const bf16_t* __restrict__ wsp, const float* __restrict__ gsgu, const float* __restrict__ bsp) {
  int tid_ = threadIdx.x; asm volatile("" : "+v"(tid_));
  const int tid = tid_, wid = tid >> 6, lane = tid & 63, r32 = lane & 31, hi = lane >> 5;
  const size_t R0 = (size_t)b * TB + (size_t)c * 128;
  { const int q = tid & 127, g = tid >> 7;
    const bf16_t* vp = P + (R0 + q) * PW + SV0 + g * 64;
    u32x4 xv[8]; float ss = 0.f;
#pragma unroll
    for (int i = 0; i < 8; ++i) { xv[i] = *(const u32x4*)(vp + i * 8);
      const float a0 = bflo(xv[i].x), a1 = bfhi(xv[i].x), a2 = bflo(xv[i].y), a3 = bfhi(xv[i].y), a4 = bflo(xv[i].z), a5 = bfhi(xv[i].z), a6 = bflo(xv[i].w), a7 = bfhi(xv[i].w);
      ss += (a0 * a0 + a1 * a1) + (a2 * a2 + a3 * a3) + (a4 * a4 + a5 * a5) + (a6 * a6 + a7 * a7); }
    const float rs = rsqrtf(ss * (1.f / 64.f) + 1e-6f);
    char* dst = lds + (g * 64) * VS + q * 2;
#pragma unroll
    for (int i = 0; i < 8; ++i) { const float* gp = gsgu + g * 64 + i * 8; const f32x4 g0 = *(const f32x4*)gp, g1 = *(const f32x4*)(gp + 4);
      *(bf16_t*)(dst + (i * 8 + 0) * VS) = f2bf(bflo(xv[i].x) * rs * g0.x); *(bf16_t*)(dst + (i * 8 + 1) * VS) = f2bf(bfhi(xv[i].x) * rs * g0.y);
      *(bf16_t*)(dst + (i * 8 + 2) * VS) = f2bf(bflo(xv[i].y) * rs * g0.z); *(bf16_t*)(dst + (i * 8 + 3) * VS) = f2bf(bfhi(xv[i].y) * rs * g0.w);
      *(bf16_t*)(dst + (i * 8 + 4) * VS) = f2bf(bflo(xv[i].z) * rs * g1.x); *(bf16_t*)(dst + (i * 8 + 5) * VS) = f2bf(bfhi(xv[i].z) * rs * g1.y);
      *(bf16_t*)(dst + (i * 8 + 6) * VS) = f2bf(bflo(xv[i].w) * rs * g1.z); *(bf16_t*)(dst + (i * 8 + 7) * VS) = f2bf(bfhi(xv[i].w) * rs * g1.w); }
  }
  __syncthreads();
  { const int gg = wid >> 1, chalf = wid & 1, cc = gg * 64 + chalf * 32 + r32;
    bf16x8 vb[8];
#pragma unroll
    for (int k = 0; k < 8; ++k) vb[k] = *reinterpret_cast<const bf16x8*>(lds + cc * VS + (k * 16 + hi * 8) * 2);
#pragma unroll 1
    for (int pt = 0; pt < 4; ++pt) { f32x16 acc = {};
      const bf16_t* ap = wsp + (gg * 128 + pt * 32 + r32) * 128 + hi * 8;
#pragma unroll
      for (int k = 0; k < 8; ++k) { const bf16x8 A = *reinterpret_cast<const bf16x8*>(ap + k * 16); acc = __builtin_amdgcn_mfma_f32_32x32x16_bf16(A, vb[k], acc, 0, 0, 0); }
#pragma unroll
      for (int r = 0; r < 16; ++r) { const int p = pt * 32 + crow(r, hi); const float m = acc[r] + bsp[gg * 128 + p];
        const float uu = bf2f(P[(R0 + p) * PW + SU0 + cc]); Y[(R0 + p) * DM + 768 + cc] = f2bf(uu * m); } }
  }
  __syncthreads();
}
}
__device__ __forceinline__ unsigned pk2(float lo, float hi) { return cvtpk(lo, hi); }
__device__ __forceinline__ void transpose_item(const float* __restrict__ W, int K, int N, bf16_t* __restrict__ WT, int row_base, LAS float* scr, int kb, int nb, int lane) {
    const int k0 = 64 * kb, n0 = 32 * nb;
#pragma unroll 8
    for (int i = 0; i < 32; ++i) { const int kk = 2 * i + (lane >> 5); scr[kk * 33 + (lane & 31)] = W[(size_t)(k0 + kk) * N + n0 + (lane & 31)]; }
    asm volatile("s_waitcnt lgkmcnt(0)" ::: "memory");
    const int c = lane & 7;
#pragma unroll
    for (int j = 0; j < 4; ++j) { const int n = (lane >> 3) + 8 * j; const LAS float* s = scr + (8 * c) * 33 + n;
        u32x4 o; o.x = pk2(s[0 * 33], s[1 * 33]); o.y = pk2(s[2 * 33], s[3 * 33]); o.z = pk2(s[4 * 33], s[5 * 33]); o.w = pk2(s[6 * 33], s[7 * 33]);
        *(u32x4*)(WT + (size_t)(row_base + n) * K + k0 + 8 * c) = o; }
    asm volatile("s_waitcnt lgkmcnt(0)" ::: "memory");
}
__device__ __forceinline__ void gemv_item(const LAS float* a_lds, LAS float* red, const float* __restrict__ W, int N, int n0, float* __restrict__ out, int ldo, int obase, const float* __restrict__ bias) {
    const int tid = threadIdx.x, wid = tid >> 6, lane = tid & 63, c4 = (lane & 15) * 4, ks = lane >> 4;
    f32x4 acc[NMS];
#pragma unroll
    for (int ms = 0; ms < NMS; ++ms) acc[ms] = (f32x4){0.f, 0.f, 0.f, 0.f};
    const float* wp = W + (size_t)(wid * 128 + ks) * N + n0 + c4;
#pragma unroll 8
    for (int st = 0; st < 32; ++st) { const f32x4 wv = *(const f32x4*)(wp + (size_t)st * 4 * N); const int k = wid * 128 + st * 4 + ks;
#pragma unroll
        for (int ms = 0; ms < NMS; ++ms) acc[ms] += wv * a_lds[ms * 1024 + k]; }
#pragma unroll
    for (int ms = 0; ms < NMS; ++ms) {
        f32x4 v = acc[ms];
        v.x += __shfl_xor(v.x, 16); v.y += __shfl_xor(v.y, 16); v.z += __shfl_xor(v.z, 16); v.w += __shfl_xor(v.w, 16);
        v.x += __shfl_xor(v.x, 32); v.y += __shfl_xor(v.y, 32); v.z += __shfl_xor(v.z, 32); v.w += __shfl_xor(v.w, 32);
        if (ks == 0) { LAS float* rp = red + (wid * NMS + ms) * 64 + c4; rp[0] = v.x; rp[1] = v.y; rp[2] = v.z; rp[3] = v.w; }
    }
    __syncthreads();
    for (int i = tid; i < NMS * 64; i += 512) { const int ms = i >> 6, c = i & 63; float s = 0.f;
#pragma unroll
        for (int w = 0; w < 8; ++w) s += red[(w * NMS + ms) * 64 + c];
        if (bias) s += bias[n0 + c];
        out[(size_t)ms * ldo + obase + c] = s; }
    __syncthreads();
}
__device__ __forceinline__ float wave_sum(float v) {
#pragma unroll
    for (int o = 1; o < 64; o <<= 1) v += __shfl_xor(v, o);
    return v;
}

#define XB_TMO      128
#define XB_XCNT(j)  (256  + 64 * (j))
#define XB_XSUB(j)  (1280 + 64 * (j))
#define XB_XGEN(j)  (2304 + 64 * (j))
#define XB_TOP      3328
#define XB_TOPGEN   3392
#define XCD_BAR_WORDS 3456
#define XB_SPIN_CAP (1u << 18)

__device__ __forceinline__ unsigned xb_ld(unsigned* p)              { return __hip_atomic_load(p, __ATOMIC_RELAXED, __HIP_MEMORY_SCOPE_AGENT); }
__device__ __forceinline__ unsigned xb_add(unsigned* p, unsigned v) { return __hip_atomic_fetch_add(p, v, __ATOMIC_RELAXED, __HIP_MEMORY_SCOPE_AGENT); }
__device__ __forceinline__ unsigned xb_xcc_id() { return (unsigned)__builtin_amdgcn_s_getreg((3 << 11) | 20) & 0xFu; }
#define XB_SPIN(cond, bar) do { unsigned _sp = 0; while (cond) { __builtin_amdgcn_s_sleep(1); \
    if ((++_sp & 255u) == 0u) { if (xb_ld(&(bar)[XB_TMO])) break; if (_sp > XB_SPIN_CAP) { atomicAdd(&(bar)[XB_TMO], 1u); break; } } } } while (0)

struct XcdBarrier {
    unsigned* bar; unsigned x;
    volatile LAS unsigned* st;
};

__device__ __forceinline__ XcdBarrier xcd_barrier_post(unsigned* bar, volatile LAS unsigned* st) {
    XcdBarrier b; b.bar = bar; b.x = xb_xcc_id(); b.st = st;
    if (threadIdx.x == 0) (void)xb_add(&bar[XB_XCNT(b.x)], 1u);
    return b;
}
__device__ __forceinline__ void xcd_barrier_complete(unsigned* bar, unsigned x, unsigned& nloc, unsigned& nx) {
    const unsigned G = gridDim.x * gridDim.y * gridDim.z;
    unsigned sum, cnt, mine, sp = 0u;
    for (;;) {
        sum = 0u; cnt = 0u; mine = 0u;
#pragma unroll
        for (unsigned j = 0; j < 16; ++j) { const unsigned c = xb_ld(&bar[XB_XCNT(j)]); sum += c; cnt += (c > 0u) ? 1u : 0u; mine = (j == x) ? c : mine; }
        if (sum == G) break;
        __builtin_amdgcn_s_sleep(1);
        if ((++sp & 255u) == 0u) { if (xb_ld(&bar[XB_TMO])) break; if (sp > XB_SPIN_CAP) { atomicAdd(&bar[XB_TMO], 1u); break; } }
    }
    nloc = mine > 0u ? mine : 1u; nx = cnt > 0u ? cnt : 1u;
}

__device__ __forceinline__ void xcd_barrier(const XcdBarrier& b) {
    asm volatile("s_waitcnt vmcnt(0)" ::: "memory");
    __syncthreads();
    if (threadIdx.x == 0) {
        unsigned* bar = b.bar;
        __builtin_amdgcn_s_waitcnt(0);
        unsigned nloc = b.st[0], nx = b.st[1];
        if (nloc == 0u) { xcd_barrier_complete(bar, b.x, nloc, nx); b.st[0] = nloc; b.st[1] = nx; }
        const unsigned old = xb_add(&bar[XB_XSUB(b.x)], 1u);
        const unsigned gen = old / nloc;
        if (old + 1u == (gen + 1u) * nloc) {
            __builtin_amdgcn_fence(__ATOMIC_RELEASE, "agent");
            asm volatile("s_waitcnt vmcnt(0)" ::: "memory");
            const unsigned og = xb_add(&bar[XB_TOP], 1u);
            const unsigned tg = og / nx;
            if (og + 1u == (tg + 1u) * nx) xb_add(&bar[XB_TOPGEN], 1u);
            else XB_SPIN(xb_ld(&bar[XB_TOPGEN]) == tg, bar);
            __builtin_amdgcn_fence(__ATOMIC_ACQUIRE, "agent");
            xb_add(&bar[XB_XGEN(b.x)], 1u);
            asm volatile("s_waitcnt vmcnt(0)" ::: "memory");
        } else {
            XB_SPIN(xb_ld(&bar[XB_XGEN(b.x)]) == gen, bar);
            __builtin_amdgcn_fence(__ATOMIC_ACQUIRE, "agent");
            asm volatile("s_waitcnt vmcnt(0)" ::: "memory");
        }
    }
    __syncthreads();
}
typedef __attribute__((address_space(1))) unsigned char g_u8;
__device__ __forceinline__ unsigned char* lau(unsigned char* p) { asm volatile("" : "+s"(p)); return (unsigned char*)(g_u8*)p; }
constexpr int NPHASE = 15;
constexpr int LDS_BYTES = 147456;
struct Args { const float* in[27]; float* out; unsigned char* ws; int ph_lo, ph_hi; };
__global__ void __launch_bounds__(512, 2) hybrid_fwd(Args args) {
    extern __shared__ __attribute__((aligned(16))) unsigned char lds_raw[];
    char* lds = (char*)lds_raw;
    LAS unsigned char* ldsl = (LAS unsigned char*)lds_raw;
    const int tid = threadIdx.x, wave = __builtin_amdgcn_readfirstlane(tid >> 6);
#define LANE_LOCAL int lane_ = threadIdx.x; asm volatile("" : "+v"(lane_)); const int lane = lane_ & 63;
    const int G = gridDim.x, bx = blockIdx.x, vcu = (G % 8 == 0) ? (bx % 8) * (G / 8) + bx / 8 : bx;
    unsigned char* ws = args.ws;
    const float* const* in = args.in;
#define mods ((float*)(ws + WS_MODS))
#define shwin ((float*)(ws + WS_SHWIN))
#define shwf ((float*)(ws + WS_SHWF))
#define ropeC ((float*)(ws + WS_ROPE))
#define ropeS ((float*)(ws + WS_ROPE + 4096))
#define c8 ((float*)(ws + WS_C8))
#define lamv ((float*)(ws + WS_LAM))
#define rowss ((float*)(ws + WS_ROWSS))
#define lrus ((float*)(ws + WS_LRUS))
#define xc ((float*)(ws + WS_XC))
#define AP ((bf16_t*)(ws + WS_AP))
#define Pb ((bf16_t*)(ws + WS_P))
#define Yb ((bf16_t*)(ws + WS_Y))
#define HM ((bf16_t*)(ws + WS_HMID))
#define WSP ((bf16_t*)(ws + WS_WSP))
#define WRG ((bf16_t*)(ws + WS_WRG))
    const int lo = args.ph_lo, hi_ = args.ph_hi;
    volatile LAS unsigned* MISC = (volatile LAS unsigned*)(ldsl + LDS_BYTES - 64);
    if (tid < 16) MISC[tid] = 0u;
    __syncthreads();
    XcdBarrier bar; bar.bar = (unsigned*)(ws + WS_CTL); bar.x = 0; bar.st = nullptr;
    if (hi_ - lo > 1) bar = xcd_barrier_post((unsigned*)(ws + WS_CTL), MISC);
#define IN(k) (lo <= (k) && (k) < hi_)
#define SEAM(k) do { if (IN(k) && IN((k) + 1)) { if ((k) == 0) cg::this_grid().sync(); else xcd_barrier(bar); } } while (0)

    if (EN(0) && IN(0)) {
        { LANE_LOCAL LAS float* scr = (LAS float*)(ldsl + wave * 16384);
          const int gw = vcu * 8 + wave, NGW = G * 8;
          constexpr int I_IN = 16 * 80, I_OUT = 16 * 32, I_G = 16 * 88, I_D = 44 * 32, I_L = I_IN + I_OUT + 2 * I_G + I_D;
          for (int it = gw; it < NLAYER * I_L; it += NGW) {
              const int l = it / I_L; int r = it - l * I_L;
              if (r < I_IN) { transpose_item(in[8] + (size_t)l * DM * PW, DM, PW, (bf16_t*)(ws + WS_WIN + l * SZ_WIN), 32 * (r % 80), scr, r / 80, r % 80, lane); continue; } r -= I_IN;
              if (r < I_OUT) { transpose_item(in[22] + (size_t)l * DM * DM, DM, DM, (bf16_t*)(ws + WS_WOUT + l * SZ_WOUT), 32 * (r % 32), scr, r / 32, r % 32, lane); continue; } r -= I_OUT;
              if (r < 2 * I_G) { const int up = r >= I_G; if (up) r -= I_G; const int nb = r % 88, n0 = 32 * nb;
                  transpose_item(in[up ? 24 : 23] + (size_t)l * DM * FH, DM, FH, (bf16_t*)(ws + WS_WFFN + l * SZ_WFFN), (n0 / 128) * 256 + (n0 % 128) + (up ? 128 : 0), scr, r / 88, nb, lane); continue; } r -= 2 * I_G;
              transpose_item(in[25] + (size_t)l * FH * DM, FH, DM, (bf16_t*)(ws + WS_WDN + l * SZ_WDN), 32 * (r % 32), scr, r / 32, r % 32, lane);
          }
        }
        { const int gt = vcu * 512 + tid, NT = G * 512;
          for (int i = gt; i < 131072; i += NT) WSP[i] = f2bf(in[20][i]);
          for (int i = gt; i < 131072; i += NT) { const int ii = i & 63, j = (i >> 6) & 63, h = (i >> 12) & 3, d = (i >> 14) & 1, mat = (i >> 15) & 1, l = i >> 16;
              WRG[i] = f2bf(in[mat ? 16 : 14][((((size_t)l * 2 + d) * 4 + h) * 64 + ii) * 64 + j]); }
          if (gt < 1024) { const int pos = gt >> 4, j = gt & 15; const float inv = powf(10000.f, -(float)j / 16.f); const float ang = (float)pos * inv; ropeC[gt] = cosf(ang); ropeS[gt] = sinf(ang);
              const float lv = in[18][gt]; c8[gt] = 8.f * log1pf(expf(-lv)); }
          if (gt < NLAYER) { float s0 = 0.f, s1 = 0.f; for (int k = 0; k < 64; ++k) { s0 += in[9][(gt * 2 + 0) * 64 + k] * in[10][(gt * 2 + 0) * 64 + k]; s1 += in[9][(gt * 2 + 1) * 64 + k] * in[10][(gt * 2 + 1) * 64 + k]; }
              lamv[gt] = expf(s0) - expf(s1) + (0.8f - 0.6f * expf(-0.3f * (float)gt)); }
        }
        __syncthreads();
        { LAS float* a_lds = (LAS float*)ldsl; LAS float* red = (LAS float*)(ldsl + 36864);
          for (int i = tid; i < NMS * 1024; i += 512) { const int ms = i >> 10, k = i & 1023; const float v = (ms < 8) ? in[1][ms * 1024 + k] : in[3][k]; a_lds[i] = silu_f(v); }
          __syncthreads();
          for (int it = vcu; it < NLAYER * 96; it += G) { const int l = it / 96, n0 = (it % 96) * 64;
              gemv_item(a_lds, red, in[4] + (size_t)l * DM * NMOD, NMOD, n0, mods + (size_t)l * NMS * NMOD, NMOD, n0, in[5] + (size_t)l * NMOD); }
        }
    }
    SEAM(0);
    if (EN(1) && IN(1)) {
        { LAS float* a_lds = (LAS float*)ldsl; LAS float* red = (LAS float*)(ldsl + 36864);
          for (int it = vcu; it < NLAYER * 128; it += G) { const int l = it / 128, r = it % 128; const int soff = (r < 40) ? 0 : 3 * DM;
              __syncthreads();
              for (int i = tid; i < NMS * 1024; i += 512) a_lds[i] = mods[((size_t)l * NMS + (i >> 10)) * NMOD + soff + (i & 1023)];
              __syncthreads();
              if (r < 40) gemv_item(a_lds, red, in[8] + (size_t)l * DM * PW, PW, r * 64, shwin + (size_t)l * NMS * PW, PW, r * 64, nullptr);
              else { const int up = r >= 84, nb = (r - 40) % 44, n0 = nb * 64;
                  gemv_item(a_lds, red, in[up ? 24 : 23] + (size_t)l * DM * FH, FH, n0, shwf + (size_t)l * NMS * NF, NF, (n0 / 128) * 256 + (n0 % 128) + (up ? 128 : 0), nullptr); } }
        }
        { LANE_LOCAL const int gw = vcu * 8 + wave, NGW = G * 8;
          for (int m = gw; m < MROWS; m += NGW) { const int b = m / TB, t = m - b * TB; const bool ctx = t < CTXL; const int ms = ctx ? 8 : b;
              const float* xr = ctx ? in[2] + ((size_t)b * CTXL + t) * DM : in[0] + ((size_t)b * SEQ + (t - CTXL)) * DM;
              f32x4 v[4]; float s = 0.f;
#pragma unroll
              for (int j = 0; j < 4; ++j) { v[j] = ((const f32x4*)xr)[lane + 64 * j]; s += (v[j].x * v[j].x + v[j].y * v[j].y) + (v[j].z * v[j].z + v[j].w * v[j].w); }
              s = wave_sum(s);
#pragma unroll
              for (int j = 0; j < 4; ++j) { const int col = 4 * lane + 256 * j; const f32x4 g = *(const f32x4*)(in[6] + col), sc = *(const f32x4*)(mods + (size_t)ms * NMOD + DM + col);
                  const f32x4 a = v[j] * g * (sc + 1.f); u32x2 w; w.x = cvtpk(a.x, a.y); w.y = cvtpk(a.z, a.w); *(u32x2*)(AP + (size_t)m * DM + col) = w; }
              if (lane < 16) rowss[(size_t)m * 16 + lane] = (lane == 0) ? s : 0.f; }
        }
    }
    SEAM(1);
#pragma unroll 1
    for (int l = 0; l < NLAYER; ++l) {
        const int pb = 2 + 6 * l; const bool last = (l == NLAYER - 1);
        const float* modl = mods + (size_t)l * NMS * NMOD;
        if (EN(2) && IN(pb)) {
            pg8::Gemm g{AP, (const bf16_t*)(ws + WS_WIN + l * SZ_WIN), MROWS, PW, DM}; pg8::Order S; S.init(MROWS / 256, PW, G, bx, 0);
            EpiInProj E{Pb, rowss, shwin + (size_t)l * NMS * PW, ropeC, ropeS};
            pg8::gemm_phase<EpiInProj, pg8::Order, true, true>(ldsl, g, S, E);
        }
        SEAM(pb);
        if (IN(pb + 1)) {
            if (EN(3)) for (int u = vcu; u < NB * NCHUNK; u += G)
                lru::lru_unit<false>(lds, Pb, Yb, u / NCHUNK, u % NCHUNK, in[12] + l * 1024, in[13] + l * 256, WRG + (size_t)l * 65536, in[15] + l * 512, in[17] + l * 512, c8 + l * 512, lrus);
            if (EN(4)) for (int u = G - 1 - vcu; u < NB * NCHUNK; u += G) { const int c = u % NCHUNK; if (last && c < 2) continue;
                sgu::sgu_unit(lds, Pb, Yb, u / NCHUNK, c, WSP + (size_t)l * 65536, in[19] + l * 256, in[21] + l * 512); }
            const float lam = lamv[l], li = 0.8f - 0.6f * __expf(-0.3f * (float)l);
            if (EN(5)) { const int nu = last ? NB * 4 * 16 : NB * 4 * 17;
                for (int u = vcu; u < nu; u += G) { int bh, qb; if (u < NB * 4 * 16) { bh = u >> 4; qb = (u & 15) + 1; } else { bh = u - NB * 4 * 16; qb = 0; }
                    att::attn_unit(lds, Pb, Yb, bh >> 2, bh & 3, qb, lam, in[11] + l * 128, 1.f - li); } }
        }
        SEAM(pb + 1);
        if (EN(6) && IN(pb + 2)) {
            for (int u = vcu; u < NB * NCHUNK; u += G) { const int c = u % NCHUNK; if (last && c < 2) continue;
                lru::lru_unit<true>(lds, Pb, Yb, u / NCHUNK, c, in[12] + l * 1024, in[13] + l * 256, WRG + (size_t)l * 65536, in[15] + l * 512, in[17] + l * 512, c8 + l * 512, lrus); }
        }
        SEAM(pb + 2);
        if (EN(7) && IN(pb + 3)) {
            pg8::Gemm g{Yb, (const bf16_t*)(ws + WS_WOUT + l * SZ_WOUT), MROWS, DM, DM}; pg8::Order S; S.init(last ? 128 : 136, DM, G, bx, last ? 1 : 0);
            EpiRes E{l == 0 ? in[0] : args.out, l == 0 ? in[2] : xc, args.out, xc, modl + 2 * DM, in[7] + l * DM, modl + 4 * DM, AP, rowss, 1};
            pg8::gemm_phase<EpiRes, pg8::Order, true, true>(ldsl, g, S, E);
        }
        SEAM(pb + 3);
        if (EN(8) && IN(pb + 4)) {
            pg8::Gemm g{AP, (const bf16_t*)(ws + WS_WFFN + l * SZ_WFFN), MROWS, NF, DM}; pg8::Order S; S.init(last ? 128 : 136, NF, G, bx, last ? 1 : 0);
            EpiSwiGLU E{HM, rowss, shwf + (size_t)l * NMS * NF};
            pg8::gemm_phase<EpiSwiGLU, pg8::Order, true, true>(ldsl, g, S, E);
        }
        SEAM(pb + 4);
        if (EN(9) && IN(pb + 5)) {
            pg8::Gemm g{HM, (const bf16_t*)(ws + WS_WDN + l * SZ_WDN), MROWS, DM, FH}; pg8::Order S; S.init(last ? 128 : 136, DM, G, bx, last ? 1 : 0);
            const int ln = last ? l : l + 1;
            EpiRes E{args.out, xc, args.out, xc, modl + 5 * DM, in[6] + ln * DM, mods + (size_t)ln * NMS * NMOD + DM, AP, rowss, last ? 0 : 1};
            pg8::gemm_phase<EpiRes, pg8::Order, true, true>(ldsl, g, S, E);
        }
        SEAM(pb + 5);
    }
    if (EN(10) && IN(14)) {
        LANE_LOCAL const int gw = vcu * 8 + wave, NGW = G * 8;
        for (int m = gw; m < NB * SEQ; m += NGW) { const int b = m / SEQ, t = m - b * SEQ; const size_t row = (size_t)b * TB + CTXL + t;
            const float rstd = row_rstd(rowss, row); f32x4* xr = (f32x4*)(args.out + (size_t)m * DM);
#pragma unroll
            for (int j = 0; j < 4; ++j) { const f32x4 g = *(const f32x4*)(in[26] + 4 * lane + 256 * j); xr[lane + 64 * j] = xr[lane + 64 * j] * rstd * g; } }
    }
#undef IN
#undef SEAM
#undef mods
#undef shwin
#undef shwf
#undef ropeC
#undef ropeS
#undef c8
#undef lamv
#undef rowss
#undef lrus
#undef xc
#undef AP
#undef Pb
#undef Yb
#undef HM
#undef WSP
#undef WRG
}

extern "C" void kernel_launch(void* const* d_in, const int* in_sizes, int n_in, void* d_out, int out_size, void* d_ws, size_t ws_size, hipStream_t stream) {
    static int grid = 0;
    if (grid == 0) {
        if (n_in != 27 || out_size != NB * SEQ * DM || ws_size < WS_TOTAL) { fprintf(stderr, "kernel_launch: unexpected shapes (n_in %d out %d ws %zu need %zu)\n", n_in, out_size, ws_size, (size_t)WS_END); grid = -1; return; }
        int dev = 0, cus = 0, per_cu = 0;
        (void)hipGetDevice(&dev); (void)hipDeviceGetAttribute(&cus, hipDeviceAttributeMultiprocessorCount, dev);
        if (hipFuncSetAttribute((const void*)hybrid_fwd, hipFuncAttributeMaxDynamicSharedMemorySize, LDS_BYTES) != hipSuccess) { fprintf(stderr, "kernel_launch: hipFuncSetAttribute failed\n"); grid = -1; return; }
        (void)hipOccupancyMaxActiveBlocksPerMultiprocessor(&per_cu, (const void*)hybrid_fwd, 512, LDS_BYTES);
        if (per_cu < 1) { fprintf(stderr, "kernel_launch: occupancy query says %d blocks per CU\n", per_cu); per_cu = 1; }
        (void)hipGetLastError();
        grid = cus;
    }
    if (grid < 0) return;
    if (hipMemsetAsync((char*)d_ws + WS_CTL, 0, WS_CTL_BYTES, stream) != hipSuccess) { fprintf(stderr, "kernel_launch: memset failed\n"); return; }
    Args a{};
    for (int i = 0; i < 27; ++i) a.in[i] = (const float*)d_in[i];
    a.out = (float*)d_out; a.ws = (unsigned char*)d_ws;
#if MK_SINGLE
    a.ph_lo = 0; a.ph_hi = NPHASE;
    { void* kargs[] = {&a}; hipError_t e = hipLaunchCooperativeKernel((const void*)hybrid_fwd, dim3(grid), dim3(512), kargs, LDS_BYTES, stream);
      if (e != hipSuccess) fprintf(stderr, "cooperative launch failed: %s (grid %d)\n", hipGetErrorString(e), grid); }
#else
    for (int pp = 0; pp < NPHASE + PROBE_NDUP; ++pp) { const int p = pp < NPHASE ? pp : PROBE_DUP0 + (pp - NPHASE) * PROBE_DUPSTEP; a.ph_lo = p; a.ph_hi = p + 1;
        void* kargs[] = {&a}; hipError_t e = hipLaunchCooperativeKernel((const void*)hybrid_fwd, dim3(grid), dim3(512), kargs, LDS_BYTES, stream);
        if (e != hipSuccess) { fprintf(stderr, "cooperative launch %d failed: %s (grid %d)\n", p, hipGetErrorString(e), grid); break; } }
#endif
}
```

```cpp
#include <hip/hip_runtime.h>
#include <hip/hip_cooperative_groups.h>
#include <cstdio>
#include <cstdint>
namespace cg = cooperative_groups;

#ifndef MK_SINGLE
#define MK_SINGLE 1
#endif
#ifndef PH_MASK
#define PH_MASK 0xFFFF
#endif
#define EN(k) (((PH_MASK) >> (k)) & 1)
#ifndef PROBE_NDUP
#define PROBE_NDUP 0
#define PROBE_DUP0 0
#define PROBE_DUPSTEP 6
#endif
#ifndef PROBE_ATTREP
#define PROBE_ATTREP 1
#endif
#ifndef ATT_VAR
#define ATT_VAR 0
#endif

constexpr int NB = 8, SEQ = 4096, CTXL = 256, TB = SEQ + CTXL, MROWS = NB * TB, DM = 1024, PW = 2560, FH = 2816, NF = 2 * FH, NLAYER = 2;
constexpr int Q0c = 0, K0c = 512, V0c = 1024, LX0 = 1536, LG0 = 1792, SU0 = 2048, SV0 = 2304;
constexpr int NMS = 9, NMOD = 6 * DM;
constexpr int NCHUNK = TB / 128;
constexpr size_t SZ_WIN = (size_t)PW * DM * 2, SZ_WOUT = (size_t)DM * DM * 2, SZ_WFFN = (size_t)NF * DM * 2, SZ_WDN = (size_t)DM * FH * 2;
constexpr size_t WS_WIN = 0, WS_WOUT = WS_WIN + 2 * SZ_WIN, WS_WFFN = WS_WOUT + 2 * SZ_WOUT, WS_WDN = WS_WFFN + 2 * SZ_WFFN;
constexpr size_t WS_WSP = WS_WDN + 2 * SZ_WDN;
constexpr size_t WS_WRG = WS_WSP + 262144;
constexpr size_t WS_MODS = WS_WRG + 262144;
constexpr size_t WS_SHWIN = WS_MODS + 442368;
constexpr size_t WS_SHWF = WS_SHWIN + 184320;
constexpr size_t WS_ROPE = WS_SHWF + 405504;
constexpr size_t WS_C8 = WS_ROPE + 8192;
constexpr size_t WS_LAM = WS_C8 + 4096;
constexpr size_t WS_ROWSS = WS_LAM + 256;
constexpr size_t WS_LRUS = WS_ROWSS + (size_t)MROWS * 64;
constexpr size_t WS_XC = WS_LRUS + (size_t)NB * NCHUNK * 2 * 2 * 256 * 4;
constexpr size_t WS_AP = WS_XC + (size_t)NB * CTXL * DM * 4;
constexpr size_t WS_P = WS_AP + (size_t)MROWS * DM * 2;
constexpr size_t WS_Y = WS_P + (size_t)MROWS * PW * 2;
constexpr size_t WS_END = WS_Y + (size_t)MROWS * DM * 2;
constexpr size_t WS_CTL = WS_END, WS_CTL_BYTES = 16384, WS_TOTAL = WS_END + WS_CTL_BYTES;
constexpr size_t WS_HMID = WS_P;
static_assert((size_t)MROWS * FH * 2 <= WS_END - WS_P, "hmid overlay");
static_assert(WS_WSP % 256 == 0 && WS_MODS % 256 == 0 && WS_ROWSS % 256 == 0 && WS_XC % 256 == 0 && WS_AP % 256 == 0 && WS_P % 256 == 0, "align");

#define LAS __attribute__((address_space(3)))
typedef float f32x2 __attribute__((ext_vector_type(2)));
typedef unsigned u32x2 __attribute__((ext_vector_type(2)));
__device__ __forceinline__ unsigned cvtpk(float lo, float hi) { unsigned r; asm("v_cvt_pk_bf16_f32 %0, %1, %2" : "=v"(r) : "v"(lo), "v"(hi)); return r; }
__device__ __forceinline__ float bflo(unsigned w) { return __uint_as_float(w << 16); }
__device__ __forceinline__ float bfhi(unsigned w) { return __uint_as_float(w & 0xffff0000u); }
__device__ __forceinline__ float bf2f(unsigned short h) { return __uint_as_float((unsigned)h << 16); }
__device__ __forceinline__ unsigned short f2bf(float v) { return (unsigned short)(cvtpk(v, v) & 0xffffu); }
__device__ __forceinline__ float fexp(float x) { return __builtin_amdgcn_exp2f(x * 1.4426950408889634f); }
__device__ __forceinline__ float gelu_tanh(float x) { const float u = 1.5957691216f * x * (1.f + 0.044715f * x * x); return x * __builtin_amdgcn_rcpf(1.f + fexp(-u)); }
__device__ __forceinline__ float silu_f(float x) { return x * __builtin_amdgcn_rcpf(1.f + fexp(-x)); }
__device__ __forceinline__ float sigm(float x) { return __builtin_amdgcn_rcpf(1.f + fexp(-x)); }

namespace pg8 {
#define PG8_LAS __attribute__((address_space(3)))
typedef unsigned short bf16_t;
typedef short bf16x8 __attribute__((ext_vector_type(8)));
typedef float f32x4 __attribute__((ext_vector_type(4)));
typedef unsigned u32x4 __attribute__((ext_vector_type(4)));
constexpr int BM = 256, BK = 64, HALF = 128, HTB = HALF * BK * 2  , STAGE_BYTES = 8 * HTB, NXCD = 8, WGM = 8;

__host__ __device__ __forceinline__ int lds_byte(int r, int c) { const int st = (r >> 4) * 2 + (c >> 5), rr = r & 15, cc = c & 31, ob = rr * 64 + cc * 2; return st * 1024 + (ob ^ (((ob >> 9) & 1) << 5)); }
__host__ __device__ __forceinline__ void stage_rc(int b, int& R, int& C) { const int st = b / 1024, sb = b % 1024, swz = sb ^ (((sb >> 9) & 1) << 5); R = (st >> 1) * 16 + swz / 64; C = (st & 1) * 32 + (swz % 64) / 2; }
__host__ __device__ __forceinline__ int perm32(int rho) { const int n = rho >> 4, i = rho & 15; return 8 * (i >> 2) + 4 * n + (i & 3); }

struct Unit { int pm, pn; };
struct Gemm { const bf16_t* A; const bf16_t* Bt; int M, N, K; };

struct StaticOrder {
    int nM, nN, nwg, G, c;
    __host__ __device__ void init(int M, int N, int G_, int c_) { nM = M / BM; nN = N / BM; nwg = nM * nN; G = G_; c = c_; }
    __host__ __device__ bool next(int i, Unit& u) const {
        const long L = (long)i * G + c; if (L >= nwg) return false;
        int wgid = (int)L; { const int q = nwg / NXCD, r = nwg % NXCD, xcd = wgid % NXCD, off = wgid / NXCD; wgid = (xcd < r ? xcd * (q + 1) : r * (q + 1) + (xcd - r) * q) + off; }
        const int nig = WGM * nN, gid = wgid / nig, fm = gid * WGM, gsz = (nM - fm) < WGM ? (nM - fm) : WGM;
        u.pm = fm + ((wgid % nig) % gsz); u.pn = (wgid % nig) / gsz; return true;
    }
    __device__ __forceinline__ void a_ready(const Unit&) const {}
    __device__ __forceinline__ void done(const Unit&) const {}
};

}
namespace pg8 {
template <class Epi, class Sched, bool ALIGN_EPI = false, bool SP2 = false>
__device__ __forceinline__ void gemm_phase(PG8_LAS unsigned char* lds, const Gemm g, const Sched& S, const Epi& E) {
    int tid_ = threadIdx.x; asm volatile("" : "+v"(tid_));
    const int tid = tid_, wid = __builtin_amdgcn_readfirstlane(tid >> 6), lane = tid & 63, wr = wid >> 2, wc = wid & 3, fr = lane & 15, fq = lane >> 4;
    const int K = g.K, nt = K / BK;
    unsigned voffA[2], voffB[2];
#pragma unroll
    for (int i = 0; i < 2; ++i) { int R, C; stage_rc(tid * 16 + i * 8192, R, C); const int Rb = Epi::PERM ? ((R & ~31) + perm32(R & 31)) : R;
        voffA[i] = (unsigned)(R * K + C) * 2u; voffB[i] = (unsigned)(Rb * K + C) * 2u; }
    const size_t kstep = (size_t)(BK * 2);
    const size_t hstep = (size_t)HALF * K * 2;
    const size_t tstep = 2 * hstep;
    const unsigned ldsw = (unsigned)wid * 1024u;
    const int aoff = lds_byte(wr * 64 + fr, fq * 8), boff = lds_byte(wc * 32 + fr, fq * 8);
#define PG8_SA(b, h) (((b) * 2 + (h)) * HTB)
#define PG8_SB(b, h) ((4 + (b) * 2 + (h)) * HTB)
#define PG8_STAGE(bufoff, gbase, voff) do { _Pragma("unroll") for (int _i = 0; _i < 2; ++_i) \
        __builtin_amdgcn_global_load_lds((const unsigned*)((const char*)(gbase) + (voff)[_i]), (PG8_LAS unsigned*)(lds + (bufoff) + ldsw + _i * 8192), 16, 0, 0); } while (0)
#define PG8_LDA(dst, b, h) do { _Pragma("unroll") for (int m = 0; m < 4; ++m) _Pragma("unroll") for (int k = 0; k < 2; ++k) dst[m][k] = *(const PG8_LAS bf16x8*)(lds + PG8_SA(b, h) + aoff + m * 2048 + k * 1024); } while (0)
#define PG8_LDB(dst, b, h) do { _Pragma("unroll") for (int n = 0; n < 2; ++n) _Pragma("unroll") for (int k = 0; k < 2; ++k) dst[n][k] = *(const PG8_LAS bf16x8*)(lds + PG8_SB(b, h) + boff + n * 2048 + k * 1024); } while (0)
#define PG8_MMA(ai, bj, At, Bt) do { __builtin_amdgcn_s_setprio(1); _Pragma("unroll") for (int m = 0; m < 4; ++m) _Pragma("unroll") for (int n = 0; n < 2; ++n) _Pragma("unroll") for (int k = 0; k < 2; ++k) \
        acc[ai][bj][m][n] = __builtin_amdgcn_mfma_f32_16x16x32_bf16(Bt[n][k], At[m][k], acc[ai][bj][m][n], 0, 0, 0); __builtin_amdgcn_s_setprio(0); } while (0)
#define PG8_WAIT_V(n) asm volatile("s_waitcnt vmcnt(" #n ")" ::: "memory")
#define PG8_WAIT_L(n) asm volatile("s_waitcnt lgkmcnt(" #n ")" ::: "memory")
#define PG8_BAR __builtin_amdgcn_s_barrier()
#define PG8_SCHED __builtin_amdgcn_sched_barrier(0)
    Unit cur, nxt; int ui = 0;
    if (!S.next(0, cur)) return;
    f32x4 acc[2][2][4][2];
#pragma unroll
    for (int a = 0; a < 2; ++a)
#pragma unroll
        for (int b = 0; b < 2; ++b)
#pragma unroll
            for (int m = 0; m < 4; ++m)
#pragma unroll
                for (int n = 0; n < 2; ++n) acc[a][b][m][n] = (f32x4){0.f, 0.f, 0.f, 0.f};
    bf16x8 At[4][2], B0[2][2], B1[2][2];
    const char* cA = (const char*)g.A + (size_t)cur.pm * tstep; const char* cB = (const char*)g.Bt + (size_t)cur.pn * tstep;
    S.a_ready(cur);
    if constexpr (SP2) {
        PG8_STAGE(PG8_SB(0, 0), cB, voffB); PG8_STAGE(PG8_SB(0, 1), cB + hstep, voffB); PG8_STAGE(PG8_SA(0, 0), cA, voffA); PG8_STAGE(PG8_SA(0, 1), cA + hstep, voffA);
        if (wr == 1) PG8_BAR;
        PG8_WAIT_V(2); PG8_BAR;
        PG8_STAGE(PG8_SB(1, 0), cB + kstep, voffB); PG8_STAGE(PG8_SA(1, 0), cA + kstep, voffA); PG8_STAGE(PG8_SB(1, 1), cB + hstep + kstep, voffB);
        PG8_WAIT_V(6); PG8_BAR;
    } else {
        PG8_STAGE(PG8_SB(0, 0), cB, voffB); PG8_STAGE(PG8_SA(0, 0), cA, voffA); PG8_STAGE(PG8_SB(0, 1), cB + hstep, voffB); PG8_STAGE(PG8_SA(0, 1), cA + hstep, voffA);
        if (wr == 1) PG8_BAR;
        PG8_WAIT_V(4); PG8_BAR;
        PG8_STAGE(PG8_SB(1, 0), cB + kstep, voffB); PG8_STAGE(PG8_SA(1, 0), cA + kstep, voffA); PG8_STAGE(PG8_SB(1, 1), cB + hstep + kstep, voffB);
        PG8_WAIT_V(6); PG8_BAR;
    }
    for (;;) {
        const bool has_next = S.next(ui + 1, nxt);
        const char* nA = has_next ? (const char*)g.A + (size_t)nxt.pm * tstep : cA; const char* nB = has_next ? (const char*)g.Bt + (size_t)nxt.pn * tstep : cB;
        for (int t = 0; t < nt; t += 2) {
            const bool last = (t == nt - 2);
            const char* a1 = cA + (size_t)(t + 1) * kstep;
            const char* a2 = last ? nA : cA + (size_t)(t + 2) * kstep; const char* b2 = last ? nB : cB + (size_t)(t + 2) * kstep;
            const char* a3 = a2 + kstep; const char* b3 = b2 + kstep;
            if (last && has_next) S.a_ready(nxt);
            if constexpr (SP2) {
            PG8_LDB(B0, 0, 0); PG8_LDB(B1, 0, 1); PG8_SCHED; PG8_LDA(At, 0, 0); PG8_STAGE(PG8_SA(1, 1), a1 + hstep, voffA);
            PG8_WAIT_V(8); PG8_WAIT_L(0); PG8_BAR; PG8_MMA(0, 0, At, B0); PG8_MMA(0, 1, At, B1); PG8_BAR; PG8_SCHED;
            PG8_LDA(At, 0, 1); PG8_STAGE(PG8_SB(0, 0), b2, voffB); PG8_STAGE(PG8_SB(0, 1), b2 + hstep, voffB); PG8_STAGE(PG8_SA(0, 0), a2, voffA);
            PG8_WAIT_V(8); PG8_WAIT_L(0); PG8_BAR; PG8_MMA(1, 0, At, B0); PG8_MMA(1, 1, At, B1); PG8_BAR; PG8_SCHED;
            PG8_LDB(B0, 1, 0); PG8_LDB(B1, 1, 1); PG8_SCHED; PG8_LDA(At, 1, 0); PG8_STAGE(PG8_SA(0, 1), a2 + hstep, voffA);
            PG8_WAIT_V(8); PG8_WAIT_L(0); PG8_BAR; PG8_MMA(0, 0, At, B0); PG8_MMA(0, 1, At, B1); PG8_BAR; PG8_SCHED;
            PG8_LDA(At, 1, 1); PG8_STAGE(PG8_SB(1, 0), b3, voffB); PG8_STAGE(PG8_SB(1, 1), b3 + hstep, voffB); PG8_STAGE(PG8_SA(1, 0), a3, voffA);
            PG8_WAIT_V(8); PG8_WAIT_L(0); PG8_BAR; PG8_MMA(1, 0, At, B0); PG8_MMA(1, 1, At, B1); PG8_BAR; PG8_SCHED;
            } else {
            PG8_LDB(B0, 0, 0); PG8_SCHED; PG8_LDA(At, 0, 0); PG8_STAGE(PG8_SA(1, 1), a1 + hstep, voffA);
            PG8_WAIT_L(8); PG8_BAR; PG8_WAIT_L(0); PG8_MMA(0, 0, At, B0); PG8_BAR; PG8_SCHED;
            PG8_LDB(B1, 0, 1); PG8_STAGE(PG8_SB(0, 0), b2, voffB);
            PG8_BAR; PG8_WAIT_L(0); PG8_MMA(0, 1, At, B1); PG8_BAR;
            PG8_LDA(At, 0, 1); PG8_STAGE(PG8_SA(0, 0), a2, voffA);
            PG8_BAR; PG8_WAIT_L(0); PG8_MMA(1, 0, At, B0); PG8_BAR; PG8_SCHED;
            PG8_STAGE(PG8_SB(0, 1), b2 + hstep, voffB);
            PG8_WAIT_V(6); PG8_BAR; PG8_MMA(1, 1, At, B1); PG8_BAR;
            PG8_LDB(B0, 1, 0); PG8_SCHED; PG8_LDA(At, 1, 0); PG8_STAGE(PG8_SA(0, 1), a2 + hstep, voffA);
            PG8_WAIT_L(8); PG8_BAR; PG8_WAIT_L(0); PG8_MMA(0, 0, At, B0); PG8_BAR; PG8_SCHED;
            PG8_LDB(B1, 1, 1); PG8_STAGE(PG8_SB(1, 0), b3, voffB);
            PG8_BAR; PG8_WAIT_L(0); PG8_MMA(0, 1, At, B1); PG8_BAR;
            PG8_LDA(At, 1, 1); PG8_STAGE(PG8_SA(1, 0), a3, voffA);
            PG8_BAR; PG8_WAIT_L(0); PG8_MMA(1, 0, At, B0); PG8_BAR; PG8_SCHED;
            PG8_STAGE(PG8_SB(1, 1), b3 + hstep, voffB);
            PG8_WAIT_V(6); PG8_BAR; PG8_MMA(1, 1, At, B1); PG8_BAR;
            }
        }
        if constexpr (ALIGN_EPI) { if (wr == 0) PG8_BAR; }
        if constexpr (!Epi::AFTER_DRAIN) { E(acc, cur, wr, wc, fr, fq); S.done(cur); }
        if (!has_next) break;
#pragma unroll
        for (int a = 0; a < 2; ++a)
#pragma unroll
            for (int b = 0; b < 2; ++b)
#pragma unroll
                for (int m = 0; m < 4; ++m)
#pragma unroll
                    for (int n = 0; n < 2; ++n) acc[a][b][m][n] = (f32x4){0.f, 0.f, 0.f, 0.f};
        cur = nxt; cA = nA; cB = nB; ++ui;
        if constexpr (ALIGN_EPI) { if (wr == 1) PG8_BAR; }
    }
    PG8_WAIT_V(0);
    if constexpr (!ALIGN_EPI) { if (wr == 0) PG8_BAR; }
    PG8_BAR;
    if constexpr (Epi::AFTER_DRAIN) { E.fused(acc, cur, wr, wc, fr, fq, lds, wid, lane); S.done(cur); }
#undef PG8_SA
#undef PG8_SB
#undef PG8_STAGE
#undef PG8_LDA
#undef PG8_LDB
#undef PG8_MMA
#undef PG8_WAIT_V
#undef PG8_WAIT_L
#undef PG8_BAR
#undef PG8_SCHED
}
}
namespace pg8 {
struct Order {
    int nM, nN, nwg, G, c, skip;
    __device__ void init(int nM_, int N, int G_, int c_, int skip_) { nM = nM_; nN = N / BM; nwg = nM * nN; G = G_; c = c_; skip = skip_; }
    __device__ bool next(int i, Unit& u) const {
        const long L = (long)i * G + c; if (L >= nwg) return false;
        int wgid = (int)L; { const int q = nwg / NXCD, r = nwg % NXCD, xcd = wgid % NXCD, off = wgid / NXCD; wgid = (xcd < r ? xcd * (q + 1) : r * (q + 1) + (xcd - r) * q) + off; }
        const int nig = WGM * nN, gid = wgid / nig, fm = gid * WGM, gsz = (nM - fm) < WGM ? (nM - fm) : WGM;
        u.pm = fm + ((wgid % nig) % gsz); u.pn = (wgid % nig) / gsz;
        if (skip) u.pm = u.pm + u.pm / 16 + 1;
        return true;
    }
    __device__ __forceinline__ void a_ready(const Unit&) const {}
    __device__ __forceinline__ void done(const Unit&) const {}
};
}

using pg8::f32x4; using pg8::u32x4; using pg8::bf16_t; using pg8::bf16x8;
__device__ __forceinline__ float row_rstd(const float* rowss, size_t row) {
    const f32x4* rs = (const f32x4*)(rowss + row * 16);
    const f32x4 s4 = (rs[0] + rs[1]) + (rs[2] + rs[3]);
    return rsqrtf(((s4.x + s4.y) + (s4.z + s4.w)) * (1.f / 1024.f) + 1e-6f);
}
__device__ __forceinline__ void rows_rstd(const float* rowss, int pm, int wr, int fr, float (&rstd)[2][4]) {
#pragma unroll
    for (int ai = 0; ai < 2; ++ai)
#pragma unroll
      for (int mh = 0; mh < 2; ++mh) { f32x4 t[2][4];
#pragma unroll
        for (int m2 = 0; m2 < 2; ++m2) { const f32x4* rs = (const f32x4*)(rowss + ((size_t)pm * 256 + ai * 128 + wr * 64 + (mh * 2 + m2) * 16 + fr) * 16);
#pragma unroll
            for (int k = 0; k < 4; ++k) t[m2][k] = rs[k]; }
        asm volatile("" ::: "memory");
#pragma unroll
        for (int m2 = 0; m2 < 2; ++m2) { const f32x4 s4 = (t[m2][0] + t[m2][1]) + (t[m2][2] + t[m2][3]); rstd[ai][mh * 2 + m2] = rsqrtf(((s4.x + s4.y) + (s4.z + s4.w)) * (1.f / 1024.f) + 1e-6f); } }
}
struct EpiInProj {
    static constexpr bool PERM = false, AFTER_DRAIN = false;
    bf16_t* P; const float* rowss; const float* sW; const float* ropeC; const float* ropeS;
    __device__ __forceinline__ void operator()(const f32x4 (&acc)[2][2][4][2], const pg8::Unit& u, int wr, int wc, int fr, int fq) const {
        const int b = u.pm / 17, j17 = u.pm - b * 17; const bool ctx = (j17 == 0); const int ms = ctx ? 8 : b;
        const int colb = u.pn * 256 + wc * 32 + 4 * fq;
        const int mode = (u.pn < 4) ? (ctx ? 0 : 1) : (u.pn >= 7 ? 2 : 0);
        f32x4 bv[2][2];
#pragma unroll
        for (int bj = 0; bj < 2; ++bj)
#pragma unroll
            for (int n = 0; n < 2; ++n) bv[bj][n] = *(const f32x4*)(sW + ms * PW + colb + bj * 128 + n * 16);
#pragma unroll
        for (int ai = 0; ai < 2; ++ai) {
#pragma unroll
            for (int m = 0; m < 4; ++m) {
                const int rt = ai * 128 + wr * 64 + m * 16 + fr; const size_t row = (size_t)u.pm * 256 + rt;
                float rstd;
                { const f32x4* rs = (const f32x4*)(rowss + row * 16); const f32x4 t0 = rs[0], t1 = rs[1], t2 = rs[2], t3 = rs[3];
                  const f32x4 s4 = (t0 + t1) + (t2 + t3); rstd = rsqrtf(((s4.x + s4.y) + (s4.z + s4.w)) * (1.f / 1024.f) + 1e-6f); }
                f32x4 v[2][2];
#pragma unroll
                for (int bj = 0; bj < 2; ++bj)
#pragma unroll
                    for (int n = 0; n < 2; ++n) v[bj][n] = acc[ai][bj][m][n] * rstd + bv[bj][n];
                if (mode == 1) {
                    const int tl = (j17 - 1) * 256 + rt; const int pos = (wc & 1) ? (tl & 63) : (tl >> 6);
                    const f32x4 c4 = *(const f32x4*)(ropeC + pos * 16 + 4 * fq), s4 = *(const f32x4*)(ropeS + pos * 16 + 4 * fq);
#pragma unroll
                    for (int bj = 0; bj < 2; ++bj) { const f32x4 x1 = v[bj][0], x2 = v[bj][1]; v[bj][0] = x1 * c4 - x2 * s4; v[bj][1] = x1 * s4 + x2 * c4; }
                } else if (mode == 2) {
#pragma unroll
                    for (int bj = 0; bj < 2; ++bj)
#pragma unroll
                        for (int n = 0; n < 2; ++n) { f32x4 t = v[bj][n]; t.x = gelu_tanh(t.x); t.y = gelu_tanh(t.y); t.z = gelu_tanh(t.z); t.w = gelu_tanh(t.w); v[bj][n] = t; }
                }
                bf16_t* rp = P + row * PW + colb;
#pragma unroll
                for (int bj = 0; bj < 2; ++bj)
#pragma unroll
                    for (int n = 0; n < 2; ++n) { u32x2 w; w.x = cvtpk(v[bj][n].x, v[bj][n].y); w.y = cvtpk(v[bj][n].z, v[bj][n].w); *(u32x2*)(rp + bj * 128 + n * 16) = w; }
            }
        }
    }
};
struct EpiSwiGLU {
    static constexpr bool PERM = true, AFTER_DRAIN = false;
    bf16_t* H; const float* rowss; const float* sW;
    __device__ __forceinline__ void operator()(const f32x4 (&acc)[2][2][4][2], const pg8::Unit& u, int wr, int wc, int fr, int fq) const {
        const int b = u.pm / 17, j17 = u.pm - b * 17; const int ms = (j17 == 0) ? 8 : b;
        const int colb = wc * 32 + 8 * fq;
        f32x4 bg[2], bu[2];
#pragma unroll
        for (int n = 0; n < 2; ++n) { bg[n] = *(const f32x4*)(sW + ms * NF + u.pn * 256 + colb + 4 * n); bu[n] = *(const f32x4*)(sW + ms * NF + u.pn * 256 + 128 + colb + 4 * n); }
        float rstd_[2][4]; rows_rstd(rowss, u.pm, wr, fr, rstd_);
#pragma unroll
        for (int ai = 0; ai < 2; ++ai)
#pragma unroll
            for (int m = 0; m < 4; ++m) {
                const int rt = ai * 128 + wr * 64 + m * 16 + fr; const size_t row = (size_t)u.pm * 256 + rt;
                const float rstd = rstd_[ai][m];
                f32x4 hm[2];
#pragma unroll
                for (int n = 0; n < 2; ++n) { const f32x4 g = acc[ai][0][m][n] * rstd + bg[n], up = acc[ai][1][m][n] * rstd + bu[n];
                    hm[n].x = silu_f(g.x) * up.x; hm[n].y = silu_f(g.y) * up.y; hm[n].z = silu_f(g.z) * up.z; hm[n].w = silu_f(g.w) * up.w; }
                u32x4 w; w.x = cvtpk(hm[0].x, hm[0].y); w.y = cvtpk(hm[0].z, hm[0].w); w.z = cvtpk(hm[1].x, hm[1].y); w.w = cvtpk(hm[1].z, hm[1].w);
                *(u32x4*)(H + row * FH + u.pn * 128 + colb) = w;
            }
    }
};
template <int MODE> struct EpiRes {
    static constexpr bool PERM = true, AFTER_DRAIN = false;
    const float* xin_lat; const float* xin_ctx; float* xo_lat; float* xo_ctx;
    const float* gate; const float* gp; const float* scp;
    const float* gn; const float* scn; bf16_t* A; float* rowss; int write_a;
    __device__ __forceinline__ void operator()(const f32x4 (&acc)[2][2][4][2], const pg8::Unit& u, int wr, int wc, int fr, int fq) const {
        const int b = u.pm / 17, j17 = u.pm - b * 17; const bool ctx = (j17 == 0); const int ms = ctx ? 8 : b;
        const float* xi = ctx ? xin_ctx + (size_t)b * CTXL * DM : xin_lat + ((size_t)b * SEQ + (size_t)(j17 - 1) * 256) * DM;
        float* xo = ctx ? xo_ctx + (size_t)b * CTXL * DM : xo_lat + ((size_t)b * SEQ + (size_t)(j17 - 1) * 256) * DM;
        const int colb = u.pn * 256 + wc * 32 + 8 * fq;
        float ss[2][4];
#pragma unroll
        for (int ai = 0; ai < 2; ++ai)
#pragma unroll
            for (int m = 0; m < 4; ++m) ss[ai][m] = 0.f;
#pragma unroll
        for (int bj = 0; bj < 2; ++bj) {
            const int col = colb + bj * 128;
            f32x4 gv[2], fc[2], rf[2];
#pragma unroll
            for (int n = 0; n < 2; ++n) { gv[n] = *(const f32x4*)(gate + ms * NMOD + col + 4 * n);
                if (write_a) fc[n] = *(const f32x4*)(gn + col + 4 * n) * (*(const f32x4*)(scn + ms * NMOD + col + 4 * n) + 1.f); else fc[n] = (f32x4){0.f, 0.f, 0.f, 0.f};
                if (MODE == 1) { const f32x4 f = *(const f32x4*)(gp + col + 4 * n) * (*(const f32x4*)(scp + ms * NMOD + col + 4 * n) + 1.f);
                    rf[n].x = __builtin_amdgcn_rcpf(f.x); rf[n].y = __builtin_amdgcn_rcpf(f.y); rf[n].z = __builtin_amdgcn_rcpf(f.z); rf[n].w = __builtin_amdgcn_rcpf(f.w); } }
#pragma unroll
            for (int ai = 0; ai < 2; ++ai) {
                f32x4 xl[4][2];
#pragma unroll
                for (int m = 0; m < 4; ++m) { const int rt = ai * 128 + wr * 64 + m * 16 + fr;
                    if (MODE == 0) { const unsigned xo4 = ((unsigned)rt * DM + (unsigned)col) * 4u;
#pragma unroll
                        for (int n = 0; n < 2; ++n) xl[m][n] = *(const f32x4*)((const char*)xi + (xo4 + 16u * n)); }
                    else { const u32x4 w = *(const u32x4*)((const char*)A + (((unsigned)u.pm * 256u + (unsigned)rt) * DM + (unsigned)col) * 2u);
                        xl[m][0] = (f32x4){bflo(w.x), bfhi(w.x), bflo(w.y), bfhi(w.y)} * rf[0]; xl[m][1] = (f32x4){bflo(w.z), bfhi(w.z), bflo(w.w), bfhi(w.w)} * rf[1]; } }
                asm volatile("" ::: "memory");
#pragma unroll
                for (int m = 0; m < 4; ++m) {
                    const int rt = ai * 128 + wr * 64 + m * 16 + fr;
                    const unsigned xo4 = ((unsigned)rt * DM + (unsigned)col) * 4u;
                    f32x4 xv[2];
#pragma unroll
                    for (int n = 0; n < 2; ++n) { xv[n] = xl[m][n] + gv[n] * acc[ai][bj][m][n];
                        if (MODE == 1) *(f32x4*)((char*)xo + (xo4 + 16u * n)) = xv[n];
                        ss[ai][m] += (xv[n].x * xv[n].x + xv[n].y * xv[n].y) + (xv[n].z * xv[n].z + xv[n].w * xv[n].w); }
                    if (write_a) { const f32x4 a0 = xv[0] * fc[0], a1 = xv[1] * fc[1];
                        u32x4 w; w.x = cvtpk(a0.x, a0.y); w.y = cvtpk(a0.z, a0.w); w.z = cvtpk(a1.x, a1.y); w.w = cvtpk(a1.z, a1.w);
                        *(u32x4*)((char*)A + (((unsigned)u.pm * 256u + (unsigned)rt) * DM + (unsigned)col) * 2u) = w; }
                }
            }
        }
#pragma unroll
        for (int ai = 0; ai < 2; ++ai)
#pragma unroll
            for (int m = 0; m < 4; ++m) { float s = ss[ai][m]; s += __shfl_xor(s, 16); s += __shfl_xor(s, 32);
                if (fq == 0) rowss[((size_t)u.pm * 256 + ai * 128 + wr * 64 + m * 16 + fr) * 16 + u.pn * 4 + wc] = s; }
    }
};
namespace att {
using s16x4 = __attribute__((ext_vector_type(4))) short;
using f32x16 = __attribute__((ext_vector_type(16))) float;
constexpr int SHM_V = 16384, SHM_K = 8192, OFF_V = 0, OFF_K = 32768, OFF_WS = 49152, OFF_ST = 51200, LDS_TOTAL = OFF_ST + 65536;
constexpr float SCALE = 0.125f, THR = 8.f;
#define KSWZ(row, colB) ((row) * 128 + ((colB) ^ (((row) & 7) << 4)))
#define SBAR() __builtin_amdgcn_sched_barrier(0)
__device__ __forceinline__ int crow(int r, int hi) { return (r & 3) + 8 * (r >> 2) + 4 * hi; }
__device__ __forceinline__ void partialSM(f32x16& p0, f32x16& p1, float& m_reg, float& mn, float& alpha) {
  constexpr float C = SCALE * 1.4426950408889634f;
  float pmax = p0[0];
#pragma unroll
  for (int r = 1; r < 16; ++r) pmax = fmaxf(pmax, p0[r]);
#pragma unroll
  for (int r = 0; r < 16; ++r) pmax = fmaxf(pmax, p1[r]);
  { auto rr = __builtin_amdgcn_permlane32_swap(__float_as_uint(pmax), __float_as_uint(pmax), false, false);
    pmax = fmaxf(__uint_as_float(rr[0]), __uint_as_float(rr[1])); }
  if (__builtin_expect(__all(pmax - m_reg <= THR / SCALE), 1)) { mn = m_reg; alpha = 1.f; }
  else { mn = fmaxf(m_reg, pmax); alpha = __builtin_amdgcn_exp2f((m_reg - mn) * C); m_reg = mn; }
  const float mnC = -mn * C;
#pragma unroll
  for (int r = 0; r < 16; ++r) p0[r] = fmaf(p0[r], C, mnC);
#pragma unroll
  for (int r = 0; r < 16; ++r) p1[r] = fmaf(p1[r], C, mnC);
#pragma unroll
  for (int r = 0; r < 16; ++r) p0[r] = __builtin_amdgcn_exp2f(p0[r]);
}
__device__ __forceinline__ void finishSM(f32x16& p0, f32x16& p1, float alpha, float& l_reg, bf16x8& pa0, bf16x8& pa1, bf16x8& pa2, bf16x8& pa3) {
#pragma unroll
  for (int r = 0; r < 16; ++r) p1[r] = __builtin_amdgcn_exp2f(p1[r]);
  float ps = 0;
#pragma unroll
  for (int r = 0; r < 16; ++r) ps += p0[r];
#pragma unroll
  for (int r = 0; r < 16; ++r) ps += p1[r];
  { auto rr = __builtin_amdgcn_permlane32_swap(__float_as_uint(ps), __float_as_uint(ps), false, false);
    ps = __uint_as_float(rr[0]) + __uint_as_float(rr[1]); }
  l_reg = l_reg * alpha + ps;
#define PK4(P, BASE, OUT) do { unsigned a0 = cvtpk(P[BASE + 0], P[BASE + 1]), a1 = cvtpk(P[BASE + 2], P[BASE + 3]);   \
    unsigned b0 = cvtpk(P[BASE + 4], P[BASE + 5]), b1 = cvtpk(P[BASE + 6], P[BASE + 7]);                              \
    auto r0 = __builtin_amdgcn_permlane32_swap(a0, b0, false, false); auto r1 = __builtin_amdgcn_permlane32_swap(a1, b1, false, false); \
    u32x4 w = {r0[0], r1[0], r0[1], r1[1]}; OUT = *reinterpret_cast<bf16x8*>(&w); } while (0)
  PK4(p0, 0, pa0); PK4(p0, 8, pa1); PK4(p1, 0, pa2); PK4(p1, 8, pa3);
#undef PK4
}
__device__ __forceinline__ void qkt(f32x16& p0, f32x16& p1, const char* Ks, const bf16x8* qr, int r32, int hi) {
  p0 = f32x16{}; p1 = f32x16{};
#pragma unroll
  for (int d0 = 0; d0 < 4; ++d0) { const int cb = d0 * 32 + hi * 16;
    const bf16x8 b0 = *reinterpret_cast<const bf16x8*>(Ks + KSWZ(r32, cb));
    const bf16x8 b1 = *reinterpret_cast<const bf16x8*>(Ks + KSWZ(32 + r32, cb));
    p0 = __builtin_amdgcn_mfma_f32_32x32x16_bf16(b0, qr[d0], p0, 0, 0, 0);
    p1 = __builtin_amdgcn_mfma_f32_32x32x16_bf16(b1, qr[d0], p1, 0, 0, 0); }
}
__device__ __forceinline__ int v_st(int k, int c) { const int kk = (k & ~0xC) | ((k & 4) << 1) | ((k & 8) >> 1); return ((kk >> 3) * 4 + (c >> 5)) * 512 + ((kk & 7) * 32 + (c & 31)) * 2; }
__device__ __forceinline__ int v_rd_base(int lane) { return ((lane & 3) << 3) | (((lane >> 2) & 3) << 6) | (((lane >> 4) & 1) << 5) | (((lane >> 5) & 1) << 8); }
constexpr int v_rd_off(int d0, int ks, int half) { return d0 * 512 + ks * 4096 + half * 2048; }
template <int OFF> __device__ __forceinline__ s16x4 tr_read(int vb) {
  s16x4 r; asm volatile("ds_read_b64_tr_b16 %0, %1 offset:%2" : "=&v"(r) : "v"(vb), "i"(OFF) : "memory"); return r;
}
template <int D0> __device__ __forceinline__ void pv_one(f32x16& od, int vb, bf16x8 pa0, bf16x8 pa1, bf16x8 pa2, bf16x8 pa3) {
  const s16x4 l0 = tr_read<v_rd_off(D0, 0, 0)>(vb), h0 = tr_read<v_rd_off(D0, 0, 1)>(vb), l1 = tr_read<v_rd_off(D0, 1, 0)>(vb), h1 = tr_read<v_rd_off(D0, 1, 1)>(vb);
  const s16x4 l2 = tr_read<v_rd_off(D0, 2, 0)>(vb), h2 = tr_read<v_rd_off(D0, 2, 1)>(vb), l3 = tr_read<v_rd_off(D0, 3, 0)>(vb), h3 = tr_read<v_rd_off(D0, 3, 1)>(vb);
  asm volatile("s_waitcnt lgkmcnt(0)" ::: "memory"); SBAR();
#define PK(L, H) (bf16x8){L[0], L[1], L[2], L[3], H[0], H[1], H[2], H[3]}
  od = __builtin_amdgcn_mfma_f32_32x32x16_bf16(pa0, PK(l0, h0), od, 0, 0, 0);
  od = __builtin_amdgcn_mfma_f32_32x32x16_bf16(pa1, PK(l1, h1), od, 0, 0, 0);
  od = __builtin_amdgcn_mfma_f32_32x32x16_bf16(pa2, PK(l2, h2), od, 0, 0, 0);
  od = __builtin_amdgcn_mfma_f32_32x32x16_bf16(pa3, PK(l3, h3), od, 0, 0, 0);
#undef PK
}
__device__ __forceinline__ void pv_d0(f32x16* o, int vb, bf16x8 pa0, bf16x8 pa1, bf16x8 pa2, bf16x8 pa3) {
  pv_one<0>(o[0], vb, pa0, pa1, pa2, pa3); pv_one<1>(o[1], vb, pa0, pa1, pa2, pa3); pv_one<2>(o[2], vb, pa0, pa1, pa2, pa3); pv_one<3>(o[3], vb, pa0, pa1, pa2, pa3);
}
__device__ __forceinline__ void attn_unit(char* lds, const bf16_t* __restrict__ P, bf16_t* __restrict__ Y, int b, int h, int qb, float lam, const float* __restrict__ gattn, float oscale) {
  int tid_ = threadIdx.x; asm volatile("" : "+v"(tid_));
  const int tid = tid_, wid = tid >> 6, lane = tid & 63, r32 = lane & 31, hi = lane >> 5;
  const unsigned rowb = (unsigned)b * TB, q0 = rowb + (unsigned)qb * 256;
  const int seq = (qb == 0) ? CTXL : TB, NT = seq / 64;
  char* V_lds = lds + OFF_V; char* K_lds = lds + OFF_K;
  float* ws = (float*)(lds + OFF_WS) + wid * 64; float* li_l = ws; float* al_l = ws + 32;
  unsigned* stash = (unsigned*)(lds + OFF_ST) + wid * 2048;
  const int sr = tid >> 4, sc = (tid & 15) * 8, vst0 = v_st(sr, sc), vst1 = v_st(32 + sr, sc);
  const int kr = tid >> 3, kc = (tid & 7) * 8, kst = KSWZ(kr, kc * 2);
  const int vb0 = (int)(uintptr_t)V_lds + v_rd_base(lane);
  const char* Pc = (const char*)P;
  const unsigned voff = ((rowb + sr) * PW + V0c + h * 128 + sc) * 2u;
#pragma unroll 1
  for (int map = 0; map < 2; ++map) {
    const unsigned qoff = ((q0 + wid * 32 + r32) * PW + Q0c + h * 128 + map * 64 + hi * 8) * 2u;
    const unsigned koff = ((rowb + kr) * PW + K0c + h * 128 + map * 64 + kc) * 2u;
    bf16x8 qr[4];
#pragma unroll
    for (int d0 = 0; d0 < 4; ++d0) qr[d0] = *reinterpret_cast<const bf16x8*>(Pc + (qoff + d0 * 32));
    float m_reg = -1e30f, l_reg = 0; f32x16 o[4] = {};
    struct { bf16x8 vs0, vs1, ks; } sr_[1];
#define SLOAD(i, k0) do { const unsigned ko_ = (unsigned)(k0) * (PW * 2u); sr_[i].vs0 = *reinterpret_cast<const bf16x8*>(Pc + (voff + ko_)); sr_[i].vs1 = *reinterpret_cast<const bf16x8*>(Pc + (voff + ko_ + 32u * PW * 2u)); \
    sr_[i].ks = *reinterpret_cast<const bf16x8*>(Pc + (koff + ko_)); } while (0)
#define SWRITE(bf, i) do { *(bf16x8*)(V_lds + (bf) * SHM_V + vst0) = sr_[i].vs0; *(bf16x8*)(V_lds + (bf) * SHM_V + vst1) = sr_[i].vs1; \
    *(bf16x8*)(K_lds + (bf) * SHM_K + kst) = sr_[i].ks; } while (0)
#define SWAIT() asm volatile("s_waitcnt vmcnt(0)" ::: "memory")
#define RESC(a) do { if (__any((a) < 1.f)) { if (hi == 0) al_l[r32] = (a); asm volatile("s_waitcnt lgkmcnt(0)" ::: "memory"); \
    _Pragma("unroll") for (int d = 0; d < 4; ++d) _Pragma("unroll") for (int r = 0; r < 16; ++r) o[d][r] *= al_l[crow(r, hi)]; } } while (0)
    f32x16 pA0, pA1, pB0, pB1; float mnA, mnB, alA, alB; bf16x8 pa0, pa1, pa2, pa3;
    constexpr int SE = 0, SO = 0;
    SLOAD(SE, 0); asm volatile("s_waitcnt vmcnt(0)" ::: "memory"); SWRITE(0, SE); __syncthreads();
    qkt(pA0, pA1, K_lds, qr, r32, hi); partialSM(pA0, pA1, m_reg, mnA, alA);
    SLOAD(SO, 64);
    SWAIT(); SWRITE(1, SO); __syncthreads();
    for (int j = 1; j + 1 < NT; j += 2) {
      SBAR(); qkt(pB0, pB1, K_lds + SHM_K, qr, r32, hi);
      finishSM(pA0, pA1, alA, l_reg, pa0, pa1, pa2, pa3); SBAR();
      SLOAD(SO, (j + 1) * 64); SBAR();
      pv_d0(o, vb0, pa0, pa1, pa2, pa3); partialSM(pB0, pB1, m_reg, mnB, alB);
      __syncthreads(); SWAIT(); SWRITE(0, SE);
      RESC(alB); __syncthreads();
      SBAR(); qkt(pA0, pA1, K_lds, qr, r32, hi);
      finishSM(pB0, pB1, alB, l_reg, pa0, pa1, pa2, pa3); SBAR();
      SLOAD(SE, (j + 2) * 64); SBAR();
      pv_d0(o, vb0 + SHM_V, pa0, pa1, pa2, pa3); partialSM(pA0, pA1, m_reg, mnA, alA);
      __syncthreads(); SWAIT(); SWRITE(1, SO);
      RESC(alA); __syncthreads();
    }
    SBAR(); qkt(pB0, pB1, K_lds + SHM_K, qr, r32, hi);
    finishSM(pA0, pA1, alA, l_reg, pa0, pa1, pa2, pa3); SBAR();
    pv_d0(o, vb0, pa0, pa1, pa2, pa3); partialSM(pB0, pB1, m_reg, mnB, alB);
    __syncthreads(); RESC(alB);
    finishSM(pB0, pB1, alB, l_reg, pa0, pa1, pa2, pa3); SBAR();
    pv_d0(o, vb0 + SHM_V, pa0, pa1, pa2, pa3);
    if (hi == 0) li_l[r32] = l_reg; asm volatile("s_waitcnt lgkmcnt(0)" ::: "memory");
    if (map == 0) {
#pragma unroll
      for (int r = 0; r < 16; ++r) { const float rl = __builtin_amdgcn_rcpf(li_l[crow(r, hi)]);
        stash[(r * 2 + 0) * 64 + lane] = cvtpk(o[0][r] * rl, o[1][r] * rl); stash[(r * 2 + 1) * 64 + lane] = cvtpk(o[2][r] * rl, o[3][r] * rl); SBAR(); }
    } else if (ATT_VAR != 1) {
      char* Yc = (char*)Y; const unsigned yoff = ((q0 + wid * 32) * DM + h * 128 + r32) * 2u;
      float gv[4];
#pragma unroll
      for (int d0 = 0; d0 < 4; ++d0) gv[d0] = gattn[d0 * 32 + r32] * oscale;
      SBAR();
#pragma unroll
      for (int r = 0; r < 16; ++r) { const float rl = lam * __builtin_amdgcn_rcpf(li_l[crow(r, hi)]);
        const unsigned w0 = stash[(r * 2 + 0) * 64 + lane], w1 = stash[(r * 2 + 1) * 64 + lane];
        const float e0 = bflo(w0) - o[0][r] * rl, e1 = bfhi(w0) - o[1][r] * rl, e2 = bflo(w1) - o[2][r] * rl, e3 = bfhi(w1) - o[3][r] * rl;
        float ssq = (e0 * e0 + e1 * e1) + (e2 * e2 + e3 * e3);
        if (ATT_VAR != 3) { ssq += __shfl_xor(ssq, 1); ssq += __shfl_xor(ssq, 2); ssq += __shfl_xor(ssq, 4); ssq += __shfl_xor(ssq, 8); ssq += __shfl_xor(ssq, 16); }
        const float rs = rsqrtf(ssq * (1.f / 128.f) + 1e-6f);
        bf16_t* yr = (bf16_t*)(Yc + (yoff + (unsigned)crow(r, hi) * (DM * 2u)));
        if (ATT_VAR != 4) { yr[0] = f2bf(e0 * rs * gv[0]); yr[32] = f2bf(e1 * rs * gv[1]); yr[64] = f2bf(e2 * rs * gv[2]); yr[96] = f2bf(e3 * rs * gv[3]); } else { yr[0] = f2bf(e0 * rs + e1 + e2 + e3); } SBAR(); }
    }
    __syncthreads();
#undef SLOAD
#undef SWRITE
#undef SWAIT
#undef RESC
  }
}
#undef KSWZ
}
namespace lru {
using att::f32x16; using att::crow;
constexpr int RS = 528;
constexpr int OFF_CL = 0, OFF_YS = 128 * RS, OFF_CY = 2 * 128 * RS;
template <int CTRL, int RMASK> __device__ __forceinline__ float dppf(float oldv, float src) {
  return __int_as_float(__builtin_amdgcn_update_dpp(__float_as_int(oldv), __float_as_int(src), CTRL, RMASK, 0xF, false));
}
template <bool PASS2>
__device__ __forceinline__ void lru_unit(char* lds, const bf16_t* __restrict__ P, bf16_t* __restrict__ Y, int b, int c, const float* __restrict__ convw, const float* __restrict__ convb,
                                         const bf16_t* __restrict__ wrg, const float* __restrict__ ba, const float* __restrict__ bx, const float* __restrict__ c8, float* lrus) {
  int tid_ = threadIdx.x; asm volatile("" : "+v"(tid_));
  const int tid = tid_, wid = tid >> 6, lane = tid & 63, r32 = lane & 31, hi = lane >> 5;
  const unsigned R0 = (unsigned)b * TB + (unsigned)c * 128;
  const int seg_lo = (c < 2) ? 0 : CTXL, seg_hi = (c < 2) ? CTXL : TB;
  const char* Pc = (const char*)P;
  {
    const int ch8 = (tid & 31) * 8, t0 = (tid >> 5) * 8;
    u32x4 xr[11];
#pragma unroll
    for (int i = 0; i < 11; ++i) { const int tt = c * 128 + t0 - 1 + i;
      if (tt >= seg_lo && tt < seg_hi) xr[i] = *(const u32x4*)(Pc + (((unsigned)b * TB + (unsigned)tt) * PW + LX0 + ch8) * 2u); else xr[i] = (u32x4){0u, 0u, 0u, 0u}; }
    float w[4][8], bb[8];
#pragma unroll
    for (int k = 0; k < 4; ++k) { const f32x4 a = *(const f32x4*)(convw + k * 256 + ch8), d = *(const f32x4*)(convw + k * 256 + ch8 + 4);
      w[k][0] = a.x; w[k][1] = a.y; w[k][2] = a.z; w[k][3] = a.w; w[k][4] = d.x; w[k][5] = d.y; w[k][6] = d.z; w[k][7] = d.w; }
    { const f32x4 a = *(const f32x4*)(convb + ch8), d = *(const f32x4*)(convb + ch8 + 4); bb[0] = a.x; bb[1] = a.y; bb[2] = a.z; bb[3] = a.w; bb[4] = d.x; bb[5] = d.y; bb[6] = d.z; bb[7] = d.w; }
#pragma unroll
    for (int i = 0; i < 8; ++i) { float acc[8];
#pragma unroll
      for (int e = 0; e < 8; ++e) acc[e] = bb[e];
#pragma unroll
      for (int k = 0; k < 4; ++k) { const u32x4 xv = xr[i + k];
        acc[0] += bflo(xv.x) * w[k][0]; acc[1] += bfhi(xv.x) * w[k][1]; acc[2] += bflo(xv.y) * w[k][2]; acc[3] += bfhi(xv.y) * w[k][3];
        acc[4] += bflo(xv.z) * w[k][4]; acc[5] += bfhi(xv.z) * w[k][5]; acc[6] += bflo(xv.w) * w[k][6]; acc[7] += bfhi(xv.w) * w[k][7]; }
      u32x4 o; o.x = cvtpk(acc[0], acc[1]); o.y = cvtpk(acc[2], acc[3]); o.z = cvtpk(acc[4], acc[5]); o.w = cvtpk(acc[6], acc[7]);
      *(u32x4*)(lds + OFF_CL + (t0 + i) * RS + ch8 * 2) = o; }
  }
  if (PASS2) {
    const int d = tid >> 8, ch = tid & 255;
    const int np = d ? (c < 2 ? 1 - c : NCHUNK + 1 - c) : c;
    float cy = 0.f;
    const float* sb = lrus + ((size_t)b * NCHUNK * 4 + (size_t)d * 2) * 256 + ch;
    if (np > 0) { float A[NCHUNK], H[NCHUNK];
#pragma unroll
      for (int i = 0; i < NCHUNK; ++i) { int p = i < np ? i : np - 1;
        const int u = d ? (c < 2 ? 1 - p : (p == 0 ? 1 : (p == 1 ? 0 : NCHUNK + 1 - p))) : p;
        A[i] = sb[(size_t)u * 1024]; H[i] = sb[(size_t)u * 1024 + 256]; }
#pragma unroll
      for (int i = 0; i < NCHUNK; ++i) if (i < np) cy = A[i] * cy + H[i];
    }
    ((float*)(lds + OFF_CY))[tid] = cy;
  }
  __syncthreads();
  const int hh = wid >> 1, jh = wid & 1, chb = hh * 64 + jh * 32;
#pragma unroll 1
  for (int d = 0; d < 2; ++d) {
    const bf16_t* wa = wrg + ((0 * 2 + d) * 4 + hh) * 4096 + (jh * 32 + r32) * 64 + hi * 8;
    const bf16_t* wx = wrg + ((1 * 2 + d) * 4 + hh) * 4096 + (jh * 32 + r32) * 64 + hi * 8;
    bf16x8 fa[4], fx[4];
#pragma unroll
    for (int k = 0; k < 4; ++k) { fa[k] = *reinterpret_cast<const bf16x8*>(wa + k * 16); fx[k] = *reinterpret_cast<const bf16x8*>(wx + k * 16); }
    float carry[16], Pc_[16], bav[16], bxv[16], c8v[16];
#pragma unroll
    for (int q = 0; q < 4; ++q) { const int co = d * 256 + chb + 8 * q + 4 * hi;
      const f32x4 b4 = *(const f32x4*)(ba + co), x4 = *(const f32x4*)(bx + co), c4 = *(const f32x4*)(c8 + co);
      bav[4 * q] = b4.x; bav[4 * q + 1] = b4.y; bav[4 * q + 2] = b4.z; bav[4 * q + 3] = b4.w; bxv[4 * q] = x4.x; bxv[4 * q + 1] = x4.y; bxv[4 * q + 2] = x4.z; bxv[4 * q + 3] = x4.w;
      c8v[4 * q] = c4.x; c8v[4 * q + 1] = c4.y; c8v[4 * q + 2] = c4.z; c8v[4 * q + 3] = c4.w; }
#pragma unroll
    for (int r = 0; r < 16; ++r) { carry[r] = 0.f; Pc_[r] = 1.f; }
    if (PASS2) { const float* cyp = (const float*)(lds + OFF_CY) + d * 256 + chb + 4 * hi;
#pragma unroll
      for (int q = 0; q < 4; ++q) { const f32x4 v = *(const f32x4*)(cyp + 8 * q); carry[4 * q] = v.x; carry[4 * q + 1] = v.y; carry[4 * q + 2] = v.z; carry[4 * q + 3] = v.w; } }
    const int tokl = d ? 31 - r32 : r32;
#pragma unroll 1
    for (int ti = 0; ti < 4; ++ti) {
      const int tt = d ? 3 - ti : ti;
      char* rowp = lds + OFF_CL + (tt * 32 + tokl) * RS;
      f32x16 za = {}, zx = {};
#pragma unroll
      for (int k = 0; k < 4; ++k) { const bf16x8 xb = *reinterpret_cast<const bf16x8*>(rowp + (hh * 64 + k * 16 + hi * 8) * 2);
        za = __builtin_amdgcn_mfma_f32_32x32x16_bf16(fa[k], xb, za, 0, 0, 0); zx = __builtin_amdgcn_mfma_f32_32x32x16_bf16(fx[k], xb, zx, 0, 0, 0); }
      float av[16], bv[16];
#pragma unroll
      for (int q = 0; q < 4; ++q) { const u32x2 cw = *(const u32x2*)(rowp + (chb + 8 * q + 4 * hi) * 2);
        const float clv[4] = {bflo(cw.x), bfhi(cw.x), bflo(cw.y), bfhi(cw.y)};
#pragma unroll
        for (int i = 0; i < 4; ++i) { const int r = 4 * q + i;
          const float rg = sigm(za[r] + bav[r]), ig = sigm(zx[r] + bxv[r]);
          const float a = fexp(-c8v[r] * rg);
          av[r] = a; bv[r] = __builtin_amdgcn_sqrtf(fmaxf(1.f - a * a, 0.f)) * ig * clv[i]; } }
#define LRU_SCAN(CTRL, RM) _Pragma("unroll") for (int r = 0; r < 16; ++r) { const float ap = dppf<CTRL, RM>(1.f, av[r]), bp = dppf<CTRL, RM>(0.f, bv[r]); bv[r] = av[r] * bp + bv[r]; av[r] = av[r] * ap; }
      LRU_SCAN(0x111, 0xF) LRU_SCAN(0x112, 0xF) LRU_SCAN(0x114, 0xF) LRU_SCAN(0x118, 0xF) LRU_SCAN(0x142, 0xA)
#undef LRU_SCAN
#pragma unroll
      for (int q = 0; q < 4; ++q) { float hv[4];
#pragma unroll
        for (int i = 0; i < 4; ++i) { const int r = 4 * q + i; hv[i] = bv[r] + av[r] * carry[r];
          carry[r] = __shfl(hv[i], 31, 32);
          if (!PASS2) Pc_[r] *= __shfl(av[r], 31, 32); }
        if (PASS2) { u32x2* yp = (u32x2*)(lds + OFF_YS + (tt * 32 + tokl) * RS + (chb + 8 * q + 4 * hi) * 2);
          if (d) { const u32x2 o = *yp; hv[0] += bflo(o.x); hv[1] += bfhi(o.x); hv[2] += bflo(o.y); hv[3] += bfhi(o.y); }
          u32x2 w; w.x = cvtpk(hv[0], hv[1]); w.y = cvtpk(hv[2], hv[3]); *yp = w; } }
    }
    if (!PASS2) { if (r32 == 0) { float* sb = lrus + ((((size_t)b * NCHUNK + c) * 2 + d) * 2) * 256 + chb + 4 * hi;
#pragma unroll
        for (int q = 0; q < 4; ++q) { *(f32x4*)(sb + 8 * q) = (f32x4){Pc_[4 * q], Pc_[4 * q + 1], Pc_[4 * q + 2], Pc_[4 * q + 3]};
          *(f32x4*)(sb + 256 + 8 * q) = (f32x4){carry[4 * q], carry[4 * q + 1], carry[4 * q + 2], carry[4 * q + 3]}; } } }
  }
  if (PASS2) {
    __syncthreads();
    const int ch8 = (tid & 31) * 8;
#pragma unroll
    for (int i = 0; i < 8; ++i) { const int t = (tid >> 5) + 16 * i;
      const u32x4 hv = *(const u32x4*)(lds + OFF_YS + t * RS + ch8 * 2), gv = *(const u32x4*)(Pc + ((R0 + t) * PW + LG0 + ch8) * 2u);
      u32x4 o; o.x = cvtpk(bflo(hv.x) * bflo(gv.x), bfhi(hv.x) * bfhi(gv.x)); o.y = cvtpk(bflo(hv.y) * bflo(gv.y), bfhi(hv.y) * bfhi(gv.y));
      o.z = cvtpk(bflo(hv.z) * bflo(gv.z), bfhi(hv.z) * bfhi(gv.z)); o.w = cvtpk(bflo(hv.w) * bflo(gv.w), bfhi(hv.w) * bfhi(gv.w));
      *(u32x4*)((char*)Y + ((R0 + t) * DM + 512 + ch8) * 2u) = o; }
  }
  __syncthreads();
}
}

namespace sgu {
using att::f32x16; using att::crow;
constexpr int VS = 272;
__device__ __forceinline__ void sgu_unit(char* lds, const bf16_t* __restrict__ P, bf16_t* __restrict__ Y, int b, int c, const bf16_t* __restrict__ wsp, const float* __restrict__ gsgu, const float* __restrict__ bsp) {
  int tid_ = threadIdx.x; asm volatile("" : "+v"(tid_));
  const int tid = tid_, wid = tid >> 6, lane = tid & 63, r32 = lane & 31, hi = lane >> 5;
  const size_t R0 = (size_t)b * TB + (size_t)c * 128;
  { const int q = tid & 127, g = tid >> 7;
    const bf16_t* vp = P + (R0 + q) * PW + SV0 + g * 64;
    u32x4 xv[8]; float ss = 0.f;
#pragma unroll
    for (int i = 0; i < 8; ++i) { xv[i] = *(const u32x4*)(vp + i * 8);
      const float a0 = bflo(xv[i].x), a1 = bfhi(xv[i].x), a2 = bflo(xv[i].y), a3 = bfhi(xv[i].y), a4 = bflo(xv[i].z), a5 = bfhi(xv[i].z), a6 = bflo(xv[i].w), a7 = bfhi(xv[i].w);
      ss += (a0 * a0 + a1 * a1) + (a2 * a2 + a3 * a3) + (a4 * a4 + a5 * a5) + (a6 * a6 + a7 * a7); }
    const float rs = rsqrtf(ss * (1.f / 64.f) + 1e-6f);
    char* dst = lds + (g * 64) * VS + q * 2;
#pragma unroll
    for (int i = 0; i < 8; ++i) { const float* gp = gsgu + g * 64 + i * 8; const f32x4 g0 = *(const f32x4*)gp, g1 = *(const f32x4*)(gp + 4);
      *(bf16_t*)(dst + (i * 8 + 0) * VS) = f2bf(bflo(xv[i].x) * rs * g0.x); *(bf16_t*)(dst + (i * 8 + 1) * VS) = f2bf(bfhi(xv[i].x) * rs * g0.y);
      *(bf16_t*)(dst + (i * 8 + 2) * VS) = f2bf(bflo(xv[i].y) * rs * g0.z); *(bf16_t*)(dst + (i * 8 + 3) * VS) = f2bf(bfhi(xv[i].y) * rs * g0.w);
      *(bf16_t*)(dst + (i * 8 + 4) * VS) = f2bf(bflo(xv[i].z) * rs * g1.x); *(bf16_t*)(dst + (i * 8 + 5) * VS) = f2bf(bfhi(xv[i].z) * rs * g1.y);
      *(bf16_t*)(dst + (i * 8 + 6) * VS) = f2bf(bflo(xv[i].w) * rs * g1.z); *(bf16_t*)(dst + (i * 8 + 7) * VS) = f2bf(bfhi(xv[i].w) * rs * g1.w); }
  }
  __syncthreads();
  { const int gg = wid >> 1, chalf = wid & 1, cc = gg * 64 + chalf * 32 + r32;
    bf16x8 vb[8];
#pragma unroll
    for (int k = 0; k < 8; ++k) vb[k] = *reinterpret_cast<const bf16x8*>(lds + cc * VS + (k * 16 + hi * 8) * 2);
#pragma unroll 1
    for (int pt = 0; pt < 4; ++pt) { f32x16 acc = {};
      const bf16_t* ap = wsp + (gg * 128 + pt * 32 + r32) * 128 + hi * 8;
#pragma unroll
      for (int k = 0; k < 8; ++k) { const bf16x8 A = *reinterpret_cast<const bf16x8*>(ap + k * 16); acc = __builtin_amdgcn_mfma_f32_32x32x16_bf16(A, vb[k], acc, 0, 0, 0); }
#pragma unroll
      for (int r = 0; r < 16; ++r) { const int p = pt * 32 + crow(r, hi); const float m = acc[r] + bsp[gg * 128 + p];
        const float uu = bf2f(P[(R0 + p) * PW + SU0 + cc]); Y[(R0 + p) * DM + 768 + cc] = f2bf(uu * m); } }
  }
  __syncthreads();
}
}
__device__ __forceinline__ unsigned pk2(float lo, float hi) { return cvtpk(lo, hi); }
__device__ __forceinline__ void transpose_item(const float* __restrict__ W, int K, int N, bf16_t* __restrict__ WT, int row_base, LAS float* scr, int kb, int nb, int lane) {
    const int k0 = 64 * kb, n0 = 32 * nb;
#pragma unroll 8
    for (int i = 0; i < 32; ++i) { const int kk = 2 * i + (lane >> 5); scr[kk * 33 + (lane & 31)] = W[(size_t)(k0 + kk) * N + n0 + (lane & 31)]; }
    asm volatile("s_waitcnt lgkmcnt(0)" ::: "memory");
    const int c = lane & 7;
#pragma unroll
    for (int j = 0; j < 4; ++j) { const int n = (lane >> 3) + 8 * j; const LAS float* s = scr + (8 * c) * 33 + n;
        u32x4 o; o.x = pk2(s[0 * 33], s[1 * 33]); o.y = pk2(s[2 * 33], s[3 * 33]); o.z = pk2(s[4 * 33], s[5 * 33]); o.w = pk2(s[6 * 33], s[7 * 33]);
        *(u32x4*)(WT + (size_t)(row_base + n) * K + k0 + 8 * c) = o; }
    asm volatile("s_waitcnt lgkmcnt(0)" ::: "memory");
}
__device__ __forceinline__ void gemv_item(const LAS float* a_lds, LAS float* red, const float* __restrict__ W, int N, int n0, float* __restrict__ out, int ldo, int obase, const float* __restrict__ bias) {
    const int tid = threadIdx.x, wid = tid >> 6, lane = tid & 63, c4 = (lane & 15) * 4, ks = lane >> 4;
    f32x4 acc[NMS];
#pragma unroll
    for (int ms = 0; ms < NMS; ++ms) acc[ms] = (f32x4){0.f, 0.f, 0.f, 0.f};
    const float* wp = W + (size_t)(wid * 128 + ks) * N + n0 + c4;
#pragma unroll 8
    for (int st = 0; st < 32; ++st) { const f32x4 wv = *(const f32x4*)(wp + (size_t)st * 4 * N); const int k = wid * 128 + st * 4 + ks;
#pragma unroll
        for (int ms = 0; ms < NMS; ++ms) acc[ms] += wv * a_lds[ms * 1024 + k]; }
#pragma unroll
    for (int ms = 0; ms < NMS; ++ms) {
        f32x4 v = acc[ms];
        v.x += __shfl_xor(v.x, 16); v.y += __shfl_xor(v.y, 16); v.z += __shfl_xor(v.z, 16); v.w += __shfl_xor(v.w, 16);
        v.x += __shfl_xor(v.x, 32); v.y += __shfl_xor(v.y, 32); v.z += __shfl_xor(v.z, 32); v.w += __shfl_xor(v.w, 32);
        if (ks == 0) { LAS float* rp = red + (wid * NMS + ms) * 64 + c4; rp[0] = v.x; rp[1] = v.y; rp[2] = v.z; rp[3] = v.w; }
    }
    __syncthreads();
    for (int i = tid; i < NMS * 64; i += 512) { const int ms = i >> 6, c = i & 63; float s = 0.f;
#pragma unroll
        for (int w = 0; w < 8; ++w) s += red[(w * NMS + ms) * 64 + c];
        if (bias) s += bias[n0 + c];
        out[(size_t)ms * ldo + obase + c] = s; }
    __syncthreads();
}
__device__ __forceinline__ float wave_sum(float v) {
#pragma unroll
    for (int o = 1; o < 64; o <<= 1) v += __shfl_xor(v, o);
    return v;
}

#define XB_TMO      128
#define XB_XCNT(j)  (256  + 64 * (j))
#define XB_XSUB(j)  (1280 + 64 * (j))
#define XB_XGEN(j)  (2304 + 64 * (j))
#define XB_TOP      3328
#define XB_TOPGEN   3392
#define XCD_BAR_WORDS 3456
#define XB_SPIN_CAP (1u << 18)

__device__ __forceinline__ unsigned xb_ld(unsigned* p)              { return __hip_atomic_load(p, __ATOMIC_RELAXED, __HIP_MEMORY_SCOPE_AGENT); }
__device__ __forceinline__ unsigned xb_add(unsigned* p, unsigned v) { return __hip_atomic_fetch_add(p, v, __ATOMIC_RELAXED, __HIP_MEMORY_SCOPE_AGENT); }
__device__ __forceinline__ unsigned xb_xcc_id() { return (unsigned)__builtin_amdgcn_s_getreg((3 << 11) | 20) & 0xFu; }
#define XB_SPIN(cond, bar) do { unsigned _sp = 0; while (cond) { __builtin_amdgcn_s_sleep(1); \
    if ((++_sp & 255u) == 0u) { if (xb_ld(&(bar)[XB_TMO])) break; if (_sp > XB_SPIN_CAP) { atomicAdd(&(bar)[XB_TMO], 1u); break; } } } } while (0)

struct XcdBarrier {
    unsigned* bar; unsigned x;
    volatile LAS unsigned* st;
};

__device__ __forceinline__ XcdBarrier xcd_barrier_post(unsigned* bar, volatile LAS unsigned* st) {
    XcdBarrier b; b.bar = bar; b.x = xb_xcc_id(); b.st = st;
    if (threadIdx.x == 0) (void)xb_add(&bar[XB_XCNT(b.x)], 1u);
    return b;
}
__device__ __forceinline__ void xcd_barrier_complete(unsigned* bar, unsigned x, unsigned& nloc, unsigned& nx) {
    const unsigned G = gridDim.x * gridDim.y * gridDim.z;
    unsigned sum, cnt, mine, sp = 0u;
    for (;;) {
        sum = 0u; cnt = 0u; mine = 0u;
#pragma unroll
        for (unsigned j = 0; j < 16; ++j) { const unsigned c = xb_ld(&bar[XB_XCNT(j)]); sum += c; cnt += (c > 0u) ? 1u : 0u; mine = (j == x) ? c : mine; }
        if (sum == G) break;
        __builtin_amdgcn_s_sleep(1);
        if ((++sp & 255u) == 0u) { if (xb_ld(&bar[XB_TMO])) break; if (sp > XB_SPIN_CAP) { atomicAdd(&bar[XB_TMO], 1u); break; } }
    }
    nloc = mine > 0u ? mine : 1u; nx = cnt > 0u ? cnt : 1u;
}

__device__ __forceinline__ void xcd_barrier(const XcdBarrier& b) {
    asm volatile("s_waitcnt vmcnt(0)" ::: "memory");
    __syncthreads();
    if (threadIdx.x == 0) {
        unsigned* bar = b.bar;
        __builtin_amdgcn_s_waitcnt(0);
        unsigned nloc = b.st[0], nx = b.st[1];
        if (nloc == 0u) { xcd_barrier_complete(bar, b.x, nloc, nx); b.st[0] = nloc; b.st[1] = nx; }
        const unsigned old = xb_add(&bar[XB_XSUB(b.x)], 1u);
        const unsigned gen = old / nloc;
        if (old + 1u == (gen + 1u) * nloc) {
            __builtin_amdgcn_fence(__ATOMIC_RELEASE, "agent");
            asm volatile("s_waitcnt vmcnt(0)" ::: "memory");
            const unsigned og = xb_add(&bar[XB_TOP], 1u);
            const unsigned tg = og / nx;
            if (og + 1u == (tg + 1u) * nx) xb_add(&bar[XB_TOPGEN], 1u);
            else XB_SPIN(xb_ld(&bar[XB_TOPGEN]) == tg, bar);
            __builtin_amdgcn_fence(__ATOMIC_ACQUIRE, "agent");
            xb_add(&bar[XB_XGEN(b.x)], 1u);
            asm volatile("s_waitcnt vmcnt(0)" ::: "memory");
        } else {
            XB_SPIN(xb_ld(&bar[XB_XGEN(b.x)]) == gen, bar);
            __builtin_amdgcn_fence(__ATOMIC_ACQUIRE, "agent");
            asm volatile("s_waitcnt vmcnt(0)" ::: "memory");
        }
    }
    __syncthreads();
}
typedef __attribute__((address_space(1))) unsigned char g_u8;
__device__ __forceinline__ unsigned char* lau(unsigned char* p) { asm volatile("" : "+s"(p)); return (unsigned char*)(g_u8*)p; }
constexpr int NPHASE = 15;
constexpr int LDS_BYTES = 147456;
struct Args { const float* in[27]; float* out; unsigned char* ws; int ph_lo, ph_hi; };
__global__ void __launch_bounds__(512, 2) hybrid_fwd(Args args) {
    extern __shared__ __attribute__((aligned(16))) unsigned char lds_raw[];
    char* lds = (char*)lds_raw;
    LAS unsigned char* ldsl = (LAS unsigned char*)lds_raw;
    const int tid = threadIdx.x, wave = __builtin_amdgcn_readfirstlane(tid >> 6);
#define LANE_LOCAL int lane_ = threadIdx.x; asm volatile("" : "+v"(lane_)); const int lane = lane_ & 63;
    const int G = gridDim.x, bx = blockIdx.x, vcu = (G % 8 == 0) ? (bx % 8) * (G / 8) + bx / 8 : bx;
    unsigned char* ws = args.ws;
    const float* const* in = args.in;
#define mods ((float*)(ws + WS_MODS))
#define shwin ((float*)(ws + WS_SHWIN))
#define shwf ((float*)(ws + WS_SHWF))
#define ropeC ((float*)(ws + WS_ROPE))
#define ropeS ((float*)(ws + WS_ROPE + 4096))
#define c8 ((float*)(ws + WS_C8))
#define lamv ((float*)(ws + WS_LAM))
#define rowss ((float*)(ws + WS_ROWSS))
#define lrus ((float*)(ws + WS_LRUS))
#define xc ((float*)(ws + WS_XC))
#define AP ((bf16_t*)(ws + WS_AP))
#define Pb ((bf16_t*)(ws + WS_P))
#define Yb ((bf16_t*)(ws + WS_Y))
#define HM ((bf16_t*)(ws + WS_HMID))
#define WSP ((bf16_t*)(ws + WS_WSP))
#define WRG ((bf16_t*)(ws + WS_WRG))
    const int lo = args.ph_lo, hi_ = args.ph_hi;
    volatile LAS unsigned* MISC = (volatile LAS unsigned*)(ldsl + LDS_BYTES - 64);
    if (tid < 16) MISC[tid] = 0u;
    __syncthreads();
    XcdBarrier bar; bar.bar = (unsigned*)(ws + WS_CTL); bar.x = 0; bar.st = nullptr;
    if (hi_ - lo > 1) bar = xcd_barrier_post((unsigned*)(ws + WS_CTL), MISC);
#define IN(k) (lo <= (k) && (k) < hi_)
#define SEAM(k) do { if (IN(k) && IN((k) + 1)) { if ((k) == 0) cg::this_grid().sync(); else xcd_barrier(bar); } } while (0)

    if (EN(0) && IN(0)) {
        { LANE_LOCAL LAS float* scr = (LAS float*)(ldsl + wave * 16384);
          const int gw = vcu * 8 + wave, NGW = G * 8;
          constexpr int I_IN = 16 * 80, I_OUT = 16 * 32, I_G = 16 * 88, I_D = 44 * 32, I_L = I_IN + I_OUT + 2 * I_G + I_D;
          for (int it = gw; it < NLAYER * I_L; it += NGW) {
              const int l = it / I_L; int r = it - l * I_L;
              if (r < I_IN) { transpose_item(in[8] + (size_t)l * DM * PW, DM, PW, (bf16_t*)(ws + WS_WIN + l * SZ_WIN), 32 * (r % 80), scr, r / 80, r % 80, lane); continue; } r -= I_IN;
              if (r < I_OUT) { transpose_item(in[22] + (size_t)l * DM * DM, DM, DM, (bf16_t*)(ws + WS_WOUT + l * SZ_WOUT), 32 * (r % 32), scr, r / 32, r % 32, lane); continue; } r -= I_OUT;
              if (r < 2 * I_G) { const int up = r >= I_G; if (up) r -= I_G; const int nb = r % 88, n0 = 32 * nb;
                  transpose_item(in[up ? 24 : 23] + (size_t)l * DM * FH, DM, FH, (bf16_t*)(ws + WS_WFFN + l * SZ_WFFN), (n0 / 128) * 256 + (n0 % 128) + (up ? 128 : 0), scr, r / 88, nb, lane); continue; } r -= 2 * I_G;
              transpose_item(in[25] + (size_t)l * FH * DM, FH, DM, (bf16_t*)(ws + WS_WDN + l * SZ_WDN), 32 * (r % 32), scr, r / 32, r % 32, lane);
          }
        }
        { const int gt = vcu * 512 + tid, NT = G * 512;
          for (int i = gt; i < 131072; i += NT) WSP[i] = f2bf(in[20][i]);
          for (int i = gt; i < 131072; i += NT) { const int ii = i & 63, j = (i >> 6) & 63, h = (i >> 12) & 3, d = (i >> 14) & 1, mat = (i >> 15) & 1, l = i >> 16;
              WRG[i] = f2bf(in[mat ? 16 : 14][((((size_t)l * 2 + d) * 4 + h) * 64 + ii) * 64 + j]); }
          if (gt < 1024) { const int pos = gt >> 4, j = gt & 15; const float inv = powf(10000.f, -(float)j / 16.f); const float ang = (float)pos * inv; ropeC[gt] = cosf(ang); ropeS[gt] = sinf(ang);
              const float lv = in[18][gt]; c8[gt] = 8.f * log1pf(expf(-lv)); }
          if (gt < NLAYER) { float s0 = 0.f, s1 = 0.f; for (int k = 0; k < 64; ++k) { s0 += in[9][(gt * 2 + 0) * 64 + k] * in[10][(gt * 2 + 0) * 64 + k]; s1 += in[9][(gt * 2 + 1) * 64 + k] * in[10][(gt * 2 + 1) * 64 + k]; }
              lamv[gt] = expf(s0) - expf(s1) + (0.8f - 0.6f * expf(-0.3f * (float)gt)); }
        }
        __syncthreads();
        { LAS float* a_lds = (LAS float*)ldsl; LAS float* red = (LAS float*)(ldsl + 36864);
          for (int i = tid; i < NMS * 1024; i += 512) { const int ms = i >> 10, k = i & 1023; const float v = (ms < 8) ? in[1][ms * 1024 + k] : in[3][k]; a_lds[i] = silu_f(v); }
          __syncthreads();
          for (int it = vcu; it < NLAYER * 96; it += G) { const int l = it / 96, n0 = (it % 96) * 64;
              gemv_item(a_lds, red, in[4] + (size_t)l * DM * NMOD, NMOD, n0, mods + (size_t)l * NMS * NMOD, NMOD, n0, in[5] + (size_t)l * NMOD); }
        }
    }
    SEAM(0);
    if (EN(1) && IN(1)) {
        { LAS float* a_lds = (LAS float*)ldsl; LAS float* red = (LAS float*)(ldsl + 36864);
          for (int it = vcu; it < NLAYER * 128; it += G) { const int l = it / 128, r = it % 128; const int soff = (r < 40) ? 0 : 3 * DM;
              __syncthreads();
              for (int i = tid; i < NMS * 1024; i += 512) a_lds[i] = mods[((size_t)l * NMS + (i >> 10)) * NMOD + soff + (i & 1023)];
              __syncthreads();
              if (r < 40) gemv_item(a_lds, red, in[8] + (size_t)l * DM * PW, PW, r * 64, shwin + (size_t)l * NMS * PW, PW, r * 64, nullptr);
              else { const int up = r >= 84, nb = (r - 40) % 44, n0 = nb * 64;
                  gemv_item(a_lds, red, in[up ? 24 : 23] + (size_t)l * DM * FH, FH, n0, shwf + (size_t)l * NMS * NF, NF, (n0 / 128) * 256 + (n0 % 128) + (up ? 128 : 0), nullptr); } }
        }
        { LANE_LOCAL const int gw = vcu * 8 + wave, NGW = G * 8;
          for (int m = gw; m < MROWS; m += NGW) { const int b = m / TB, t = m - b * TB; const bool ctx = t < CTXL; const int ms = ctx ? 8 : b;
              const float* xr = ctx ? in[2] + ((size_t)b * CTXL + t) * DM : in[0] + ((size_t)b * SEQ + (t - CTXL)) * DM;
              f32x4 v[4]; float s = 0.f;
#pragma unroll
              for (int j = 0; j < 4; ++j) { v[j] = ((const f32x4*)xr)[lane + 64 * j]; s += (v[j].x * v[j].x + v[j].y * v[j].y) + (v[j].z * v[j].z + v[j].w * v[j].w); }
              s = wave_sum(s);
#pragma unroll
              for (int j = 0; j < 4; ++j) { const int col = 4 * lane + 256 * j; const f32x4 g = *(const f32x4*)(in[6] + col), sc = *(const f32x4*)(mods + (size_t)ms * NMOD + DM + col);
                  const f32x4 a = v[j] * g * (sc + 1.f); u32x2 w; w.x = cvtpk(a.x, a.y); w.y = cvtpk(a.z, a.w); *(u32x2*)(AP + (size_t)m * DM + col) = w; }
              if (lane < 16) rowss[(size_t)m * 16 + lane] = (lane == 0) ? s : 0.f; }
        }
    }
    SEAM(1);
#pragma unroll 1
    for (int l = 0; l < NLAYER; ++l) {
        const int pb = 2 + 6 * l; const bool last = (l == NLAYER - 1);
        const float* modl = mods + (size_t)l * NMS * NMOD;
        if (EN(2) && IN(pb)) {
            pg8::Gemm g{AP, (const bf16_t*)(ws + WS_WIN + l * SZ_WIN), MROWS, PW, DM}; pg8::Order S; S.init(MROWS / 256, PW, G, bx, 0);
            EpiInProj E{Pb, rowss, shwin + (size_t)l * NMS * PW, ropeC, ropeS};
            pg8::gemm_phase<EpiInProj, pg8::Order, true, true>(ldsl, g, S, E);
        }
        SEAM(pb);
        if (IN(pb + 1)) {
            if (EN(3)) for (int u = vcu; u < NB * NCHUNK; u += G)
                lru::lru_unit<false>(lds, Pb, Yb, u / NCHUNK, u % NCHUNK, in[12] + l * 1024, in[13] + l * 256, WRG + (size_t)l * 65536, in[15] + l * 512, in[17] + l * 512, c8 + l * 512, lrus);
            if (EN(4)) for (int u = G - 1 - vcu; u < NB * NCHUNK; u += G) { const int c = u % NCHUNK; if (last && c < 2) continue;
                sgu::sgu_unit(lds, Pb, Yb, u / NCHUNK, c, WSP + (size_t)l * 65536, in[19] + l * 256, in[21] + l * 512); }
            const float lam = lamv[l], li = 0.8f - 0.6f * __expf(-0.3f * (float)l);
            if (EN(5)) { const int nu = last ? NB * 4 * 16 : NB * 4 * 17;
#pragma unroll 1
                for (int rep_ = 0; rep_ < PROBE_ATTREP; ++rep_)
                for (int u = vcu; u < nu; u += G) { int bh, qb; if (u < NB * 4 * 16) { bh = u >> 4; qb = (u & 15) + 1; } else { bh = u - NB * 4 * 16; qb = 0; }
                    att::attn_unit(lds, Pb, Yb, bh >> 2, bh & 3, qb, lam, in[11] + l * 128, 1.f - li); } }
        }
        SEAM(pb + 1);
        if (EN(6) && IN(pb + 2)) {
            const int nu2 = last ? NB * 32 : NB * NCHUNK;
            for (int u = vcu; u < nu2; u += G) { const int b_ = last ? (u >> 5) : u / NCHUNK, c = last ? 2 + (u & 31) : u % NCHUNK;
                lru::lru_unit<true>(lds, Pb, Yb, b_, c, in[12] + l * 1024, in[13] + l * 256, WRG + (size_t)l * 65536, in[15] + l * 512, in[17] + l * 512, c8 + l * 512, lrus); }
        }
        SEAM(pb + 2);
        if (EN(7) && IN(pb + 3)) {
            pg8::Gemm g{Yb, (const bf16_t*)(ws + WS_WOUT + l * SZ_WOUT), MROWS, DM, DM}; pg8::Order S; S.init(last ? 128 : 136, DM, G, bx, last ? 1 : 0);
            EpiRes<0> E{l == 0 ? in[0] : args.out, l == 0 ? in[2] : xc, args.out, xc, modl + 2 * DM, nullptr, nullptr, in[7] + l * DM, modl + 4 * DM, AP, rowss, 1};
            pg8::gemm_phase<EpiRes<0>, pg8::Order, true, true>(ldsl, g, S, E);
        }
        SEAM(pb + 3);
        if (EN(8) && IN(pb + 4)) {
            pg8::Gemm g{AP, (const bf16_t*)(ws + WS_WFFN + l * SZ_WFFN), MROWS, NF, DM}; pg8::Order S; S.init(last ? 128 : 136, NF, G, bx, last ? 1 : 0);
            EpiSwiGLU E{HM, rowss, shwf + (size_t)l * NMS * NF};
            pg8::gemm_phase<EpiSwiGLU, pg8::Order, true, true>(ldsl, g, S, E);
        }
        SEAM(pb + 4);
        if (EN(9) && IN(pb + 5)) {
            pg8::Gemm g{HM, (const bf16_t*)(ws + WS_WDN + l * SZ_WDN), MROWS, DM, FH}; pg8::Order S; S.init(last ? 128 : 136, DM, G, bx, last ? 1 : 0);
            const int ln = last ? l : l + 1;
            EpiRes<1> E{args.out, xc, args.out, xc, modl + 5 * DM, in[7] + l * DM, modl + 4 * DM, in[6] + ln * DM, mods + (size_t)ln * NMS * NMOD + DM, AP, rowss, last ? 0 : 1};
            pg8::gemm_phase<EpiRes<1>, pg8::Order, true, true>(ldsl, g, S, E);
        }
        SEAM(pb + 5);
    }
    if (EN(10) && IN(14)) {
        LANE_LOCAL const int gw = vcu * 8 + wave, NGW = G * 8;
        for (int m = gw; m < NB * SEQ; m += NGW) { const int b = m / SEQ, t = m - b * SEQ; const size_t row = (size_t)b * TB + CTXL + t;
            const float rstd = row_rstd(rowss, row); f32x4* xr = (f32x4*)(args.out + (size_t)m * DM);
#pragma unroll
            for (int j = 0; j < 4; ++j) { const f32x4 g = *(const f32x4*)(in[26] + 4 * lane + 256 * j); xr[lane + 64 * j] = xr[lane + 64 * j] * rstd * g; } }
    }
#undef IN
#undef SEAM
#undef mods
#undef shwin
#undef shwf
#undef ropeC
#undef ropeS
#undef c8
#undef lamv
#undef rowss
#undef lrus
#undef xc
#undef AP
#undef Pb
#undef Yb
#undef HM
#undef WSP
#undef WRG
}

extern "C" void kernel_launch(void* const* d_in, const int* in_sizes, int n_in, void* d_out, int out_size, void* d_ws, size_t ws_size, hipStream_t stream) {
    static int grid = 0;
    if (grid == 0) {
        if (n_in != 27 || out_size != NB * SEQ * DM || ws_size < WS_TOTAL) { fprintf(stderr, "kernel_launch: unexpected shapes (n_in %d out %d ws %zu need %zu)\n", n_in, out_size, ws_size, (size_t)WS_END); grid = -1; return; }
        int dev = 0, cus = 0, per_cu = 0;
        (void)hipGetDevice(&dev); (void)hipDeviceGetAttribute(&cus, hipDeviceAttributeMultiprocessorCount, dev);
        if (hipFuncSetAttribute((const void*)hybrid_fwd, hipFuncAttributeMaxDynamicSharedMemorySize, LDS_BYTES) != hipSuccess) { fprintf(stderr, "kernel_launch: hipFuncSetAttribute failed\n"); grid = -1; return; }
        (void)hipOccupancyMaxActiveBlocksPerMultiprocessor(&per_cu, (const void*)hybrid_fwd, 512, LDS_BYTES);
        if (per_cu < 1) { fprintf(stderr, "kernel_launch: occupancy query says %d blocks per CU\n", per_cu); per_cu = 1; }
        (void)hipGetLastError();
        grid = cus;
    }
    if (grid < 0) return;
    if (hipMemsetAsync((char*)d_ws + WS_CTL, 0, WS_CTL_BYTES, stream) != hipSuccess) { fprintf(stderr, "kernel_launch: memset failed\n"); return; }
    Args a{};
    for (int i = 0; i < 27; ++i) a.in[i] = (const float*)d_in[i];
    a.out = (float*)d_out; a.ws = (unsigned char*)d_ws;
#if MK_SINGLE
    a.ph_lo = 0; a.ph_hi = NPHASE;
    { void* kargs[] = {&a}; hipError_t e = hipLaunchCooperativeKernel((const void*)hybrid_fwd, dim3(grid), dim3(512), kargs, LDS_BYTES, stream);
      if (e != hipSuccess) fprintf(stderr, "cooperative launch failed: %s (grid %d)\n", hipGetErrorString(e), grid); }
#else
    for (int pp = 0; pp < NPHASE + PROBE_NDUP; ++pp) { const int p = pp < NPHASE ? pp : PROBE_DUP0 + (pp - NPHASE) * PROBE_DUPSTEP; a.ph_lo = p; a.ph_hi = p + 1;
        void* kargs[] = {&a}; hipError_t e = hipLaunchCooperativeKernel((const void*)hybrid_fwd, dim3(grid), dim3(512), kargs, LDS_BYTES, stream);
        if (e != hipSuccess) { fprintf(stderr, "cooperative launch %d failed: %s (grid %d)\n", p, hipGetErrorString(e), grid); break; } }
#endif
}
```

```cpp
#include <hip/hip_runtime.h>
#include <hip/hip_cooperative_groups.h>
#include <cstdio>
#include <cstdint>
namespace cg = cooperative_groups;

#ifndef MK_SINGLE
#define MK_SINGLE 1
#endif
#ifndef PH_MASK
#define PH_MASK 0xFFFF
#endif
#define EN(k) (((PH_MASK) >> (k)) & 1)
#ifndef PROBE_NDUP
#define PROBE_NDUP 0
#define PROBE_DUP0 0
#define PROBE_DUPSTEP 6
#endif
#ifndef PROBE_ATTREP
#define PROBE_ATTREP 1
#endif
#ifndef ATT_VAR
#define ATT_VAR 0
#endif

constexpr int NB = 8, SEQ = 4096, CTXL = 256, TB = SEQ + CTXL, MROWS = NB * TB, DM = 1024, PW = 2560, FH = 2816, NF = 2 * FH, NLAYER = 2;
constexpr int Q0c = 0, K0c = 512, V0c = 1024, LX0 = 1536, LG0 = 1792, SU0 = 2048, SV0 = 2304;
constexpr int NMS = 9, NMOD = 6 * DM;
constexpr int NCHUNK = TB / 128;
constexpr size_t SZ_WIN = (size_t)PW * DM * 2, SZ_WOUT = (size_t)DM * DM * 2, SZ_WFFN = (size_t)NF * DM * 2, SZ_WDN = (size_t)DM * FH * 2;
constexpr size_t WS_WIN = 0, WS_WOUT = WS_WIN + 2 * SZ_WIN, WS_WFFN = WS_WOUT + 2 * SZ_WOUT, WS_WDN = WS_WFFN + 2 * SZ_WFFN;
constexpr size_t WS_WSP = WS_WDN + 2 * SZ_WDN;
constexpr size_t WS_WRG = WS_WSP + 262144;
constexpr size_t WS_MODS = WS_WRG + 262144;
constexpr size_t WS_SHWIN = WS_MODS + 442368;
constexpr size_t WS_SHWF = WS_SHWIN + 184320;
constexpr size_t WS_ROPE = WS_SHWF + 405504;
constexpr size_t WS_C8 = WS_ROPE + 8192;
constexpr size_t WS_LAM = WS_C8 + 4096;
constexpr size_t WS_ROWSS = WS_LAM + 256;
constexpr size_t WS_LRUS = WS_ROWSS + (size_t)MROWS * 64;
constexpr size_t WS_XC = WS_LRUS + (size_t)NB * NCHUNK * 2 * 2 * 256 * 4;
constexpr size_t WS_AP = WS_XC + (size_t)NB * CTXL * DM * 4;
constexpr size_t WS_P = WS_AP + (size_t)MROWS * DM * 2;
constexpr size_t WS_Y = WS_P + (size_t)MROWS * PW * 2;
constexpr size_t WS_END = WS_Y + (size_t)MROWS * DM * 2;
constexpr size_t WS_CTL = WS_END, WS_CTL_BYTES = 16384, WS_TOTAL = WS_END + WS_CTL_BYTES;
constexpr size_t WS_HMID = WS_P;
static_assert((size_t)MROWS * FH * 2 <= WS_END - WS_P, "hmid overlay");
static_assert(WS_WSP % 256 == 0 && WS_MODS % 256 == 0 && WS_ROWSS % 256 == 0 && WS_XC % 256 == 0 && WS_AP % 256 == 0 && WS_P % 256 == 0, "align");

#define LAS __attribute__((address_space(3)))
typedef float f32x2 __attribute__((ext_vector_type(2)));
typedef unsigned u32x2 __attribute__((ext_vector_type(2)));
__device__ __forceinline__ unsigned cvtpk(float lo, float hi) { unsigned r; asm("v_cvt_pk_bf16_f32 %0, %1, %2" : "=v"(r) : "v"(lo), "v"(hi)); return r; }
__device__ __forceinline__ float bflo(unsigned w) { return __uint_as_float(w << 16); }
__device__ __forceinline__ float bfhi(unsigned w) { return __uint_as_float(w & 0xffff0000u); }
__device__ __forceinline__ float bf2f(unsigned short h) { return __uint_as_float((unsigned)h << 16); }
__device__ __forceinline__ unsigned short f2bf(float v) { return (unsigned short)(cvtpk(v, v) & 0xffffu); }
__device__ __forceinline__ float fexp(float x) { return __builtin_amdgcn_exp2f(x * 1.4426950408889634f); }
__device__ __forceinline__ float gelu_tanh(float x) { const float u = 1.5957691216f * x * (1.f + 0.044715f * x * x); return x * __builtin_amdgcn_rcpf(1.f + fexp(-u)); }
__device__ __forceinline__ float silu_f(float x) { return x * __builtin_amdgcn_rcpf(1.f + fexp(-x)); }
__device__ __forceinline__ float sigm(float x) { return __builtin_amdgcn_rcpf(1.f + fexp(-x)); }

namespace pg8 {
#define PG8_LAS __attribute__((address_space(3)))
typedef unsigned short bf16_t;
typedef short bf16x8 __attribute__((ext_vector_type(8)));
typedef float f32x4 __attribute__((ext_vector_type(4)));
typedef unsigned u32x4 __attribute__((ext_vector_type(4)));
constexpr int BM = 256, BK = 64, HALF = 128, HTB = HALF * BK * 2  , STAGE_BYTES = 8 * HTB, NXCD = 8, WGM = 8;

__host__ __device__ __forceinline__ int lds_byte(int r, int c) { const int st = (r >> 4) * 2 + (c >> 5), rr = r & 15, cc = c & 31, ob = rr * 64 + cc * 2; return st * 1024 + (ob ^ (((ob >> 9) & 1) << 5)); }
__host__ __device__ __forceinline__ void stage_rc(int b, int& R, int& C) { const int st = b / 1024, sb = b % 1024, swz = sb ^ (((sb >> 9) & 1) << 5); R = (st >> 1) * 16 + swz / 64; C = (st & 1) * 32 + (swz % 64) / 2; }
__host__ __device__ __forceinline__ int perm32(int rho) { const int n = rho >> 4, i = rho & 15; return 8 * (i >> 2) + 4 * n + (i & 3); }

struct Unit { int pm, pn; };
struct Gemm { const bf16_t* A; const bf16_t* Bt; int M, N, K; };

struct StaticOrder {
    int nM, nN, nwg, G, c;
    __host__ __device__ void init(int M, int N, int G_, int c_) { nM = M / BM; nN = N / BM; nwg = nM * nN; G = G_; c = c_; }
    __host__ __device__ bool next(int i, Unit& u) const {
        const long L = (long)i * G + c; if (L >= nwg) return false;
        int wgid = (int)L; { const int q = nwg / NXCD, r = nwg % NXCD, xcd = wgid % NXCD, off = wgid / NXCD; wgid = (xcd < r ? xcd * (q + 1) : r * (q + 1) + (xcd - r) * q) + off; }
        const int nig = WGM * nN, gid = wgid / nig, fm = gid * WGM, gsz = (nM - fm) < WGM ? (nM - fm) : WGM;
        u.pm = fm + ((wgid % nig) % gsz); u.pn = (wgid % nig) / gsz; return true;
    }
    __device__ __forceinline__ void a_ready(const Unit&) const {}
    __device__ __forceinline__ void done(const Unit&) const {}
};

}
namespace pg8 {
template <class Epi, class Sched, bool ALIGN_EPI = false, bool SP2 = false>
__device__ __forceinline__ void gemm_phase(PG8_LAS unsigned char* lds, const Gemm g, const Sched& S, const Epi& E) {
    int tid_ = threadIdx.x; asm volatile("" : "+v"(tid_));
    const int tid = tid_, wid = __builtin_amdgcn_readfirstlane(tid >> 6), lane = tid & 63, wr = wid >> 2, wc = wid & 3, fr = lane & 15, fq = lane >> 4;
    const int K = g.K, nt = K / BK;
    unsigned voffA[2], voffB[2];
#pragma unroll
    for (int i = 0; i < 2; ++i) { int R, C; stage_rc(tid * 16 + i * 8192, R, C); const int Rb = Epi::PERM ? ((R & ~31) + perm32(R & 31)) : R;
        voffA[i] = (unsigned)(R * K + C) * 2u; voffB[i] = (unsigned)(Rb * K + C) * 2u; }
    const size_t kstep = (size_t)(BK * 2);
    const size_t hstep = (size_t)HALF * K * 2;
    const size_t tstep = 2 * hstep;
    const unsigned ldsw = (unsigned)wid * 1024u;
    const int aoff = lds_byte(wr * 64 + fr, fq * 8), boff = lds_byte(wc * 32 + fr, fq * 8);
#define PG8_SA(b, h) (((b) * 2 + (h)) * HTB)
#define PG8_SB(b, h) ((4 + (b) * 2 + (h)) * HTB)
#define PG8_STAGE(bufoff, gbase, voff) do { _Pragma("unroll") for (int _i = 0; _i < 2; ++_i) \
        __builtin_amdgcn_global_load_lds((const unsigned*)((const char*)(gbase) + (voff)[_i]), (PG8_LAS unsigned*)(lds + (bufoff) + ldsw + _i * 8192), 16, 0, 0); } while (0)
#define PG8_LDA(dst, b, h) do { _Pragma("unroll") for (int m = 0; m < 4; ++m) _Pragma("unroll") for (int k = 0; k < 2; ++k) dst[m][k] = *(const PG8_LAS bf16x8*)(lds + PG8_SA(b, h) + aoff + m * 2048 + k * 1024); } while (0)
#define PG8_LDB(dst, b, h) do { _Pragma("unroll") for (int n = 0; n < 2; ++n) _Pragma("unroll") for (int k = 0; k < 2; ++k) dst[n][k] = *(const PG8_LAS bf16x8*)(lds + PG8_SB(b, h) + boff + n * 2048 + k * 1024); } while (0)
#define PG8_MMA(ai, bj, At, Bt) do { __builtin_amdgcn_s_setprio(1); _Pragma("unroll") for (int m = 0; m < 4; ++m) _Pragma("unroll") for (int n = 0; n < 2; ++n) _Pragma("unroll") for (int k = 0; k < 2; ++k) \
        acc[ai][bj][m][n] = __builtin_amdgcn_mfma_f32_16x16x32_bf16(Bt[n][k], At[m][k], acc[ai][bj][m][n], 0, 0, 0); __builtin_amdgcn_s_setprio(0); } while (0)
#define PG8_WAIT_V(n) asm volatile("s_waitcnt vmcnt(" #n ")" ::: "memory")
#define PG8_WAIT_L(n) asm volatile("s_waitcnt lgkmcnt(" #n ")" ::: "memory")
#define PG8_BAR __builtin_amdgcn_s_barrier()
#define PG8_SCHED __builtin_amdgcn_sched_barrier(0)
    Unit cur, nxt; int ui = 0;
    if (!S.next(0, cur)) return;
    f32x4 acc[2][2][4][2];
#pragma unroll
    for (int a = 0; a < 2; ++a)
#pragma unroll
        for (int b = 0; b < 2; ++b)
#pragma unroll
            for (int m = 0; m < 4; ++m)
#pragma unroll
                for (int n = 0; n < 2; ++n) acc[a][b][m][n] = (f32x4){0.f, 0.f, 0.f, 0.f};
    bf16x8 At[4][2], B0[2][2], B1[2][2];
    const char* cA = (const char*)g.A + (size_t)cur.pm * tstep; const char* cB = (const char*)g.Bt + (size_t)cur.pn * tstep;
    S.a_ready(cur);
    if constexpr (SP2) {
        PG8_STAGE(PG8_SB(0, 0), cB, voffB); PG8_STAGE(PG8_SB(0, 1), cB + hstep, voffB); PG8_STAGE(PG8_SA(0, 0), cA, voffA); PG8_STAGE(PG8_SA(0, 1), cA + hstep, voffA);
        if (wr == 1) PG8_BAR;
        PG8_WAIT_V(2); PG8_BAR;
        PG8_STAGE(PG8_SB(1, 0), cB + kstep, voffB); PG8_STAGE(PG8_SA(1, 0), cA + kstep, voffA); PG8_STAGE(PG8_SB(1, 1), cB + hstep + kstep, voffB);
        PG8_WAIT_V(6); PG8_BAR;
    } else {
        PG8_STAGE(PG8_SB(0, 0), cB, voffB); PG8_STAGE(PG8_SA(0, 0), cA, voffA); PG8_STAGE(PG8_SB(0, 1), cB + hstep, voffB); PG8_STAGE(PG8_SA(0, 1), cA + hstep, voffA);
        if (wr == 1) PG8_BAR;
        PG8_WAIT_V(4); PG8_BAR;
        PG8_STAGE(PG8_SB(1, 0), cB + kstep, voffB); PG8_STAGE(PG8_SA(1, 0), cA + kstep, voffA); PG8_STAGE(PG8_SB(1, 1), cB + hstep + kstep, voffB);
        PG8_WAIT_V(6); PG8_BAR;
    }
    for (;;) {
        const bool has_next = S.next(ui + 1, nxt);
        const char* nA = has_next ? (const char*)g.A + (size_t)nxt.pm * tstep : cA; const char* nB = has_next ? (const char*)g.Bt + (size_t)nxt.pn * tstep : cB;
        for (int t = 0; t < nt; t += 2) {
            const bool last = (t == nt - 2);
            const char* a1 = cA + (size_t)(t + 1) * kstep;
            const char* a2 = last ? nA : cA + (size_t)(t + 2) * kstep; const char* b2 = last ? nB : cB + (size_t)(t + 2) * kstep;
            const char* a3 = a2 + kstep; const char* b3 = b2 + kstep;
            if (last && has_next) S.a_ready(nxt);
            if constexpr (SP2) {
            PG8_LDB(B0, 0, 0); PG8_LDB(B1, 0, 1); PG8_SCHED; PG8_LDA(At, 0, 0); PG8_STAGE(PG8_SA(1, 1), a1 + hstep, voffA);
            PG8_WAIT_V(8); PG8_WAIT_L(0); PG8_BAR; PG8_MMA(0, 0, At, B0); PG8_MMA(0, 1, At, B1); PG8_BAR; PG8_SCHED;
            PG8_LDA(At, 0, 1); PG8_STAGE(PG8_SB(0, 0), b2, voffB); PG8_STAGE(PG8_SB(0, 1), b2 + hstep, voffB); PG8_STAGE(PG8_SA(0, 0), a2, voffA);
            PG8_WAIT_V(8); PG8_WAIT_L(0); PG8_BAR; PG8_MMA(1, 0, At, B0); PG8_MMA(1, 1, At, B1); PG8_BAR; PG8_SCHED;
            PG8_LDB(B0, 1, 0); PG8_LDB(B1, 1, 1); PG8_SCHED; PG8_LDA(At, 1, 0); PG8_STAGE(PG8_SA(0, 1), a2 + hstep, voffA);
            PG8_WAIT_V(8); PG8_WAIT_L(0); PG8_BAR; PG8_MMA(0, 0, At, B0); PG8_MMA(0, 1, At, B1); PG8_BAR; PG8_SCHED;
            PG8_LDA(At, 1, 1); PG8_STAGE(PG8_SB(1, 0), b3, voffB); PG8_STAGE(PG8_SB(1, 1), b3 + hstep, voffB); PG8_STAGE(PG8_SA(1, 0), a3, voffA);
            PG8_WAIT_V(8); PG8_WAIT_L(0); PG8_BAR; PG8_MMA(1, 0, At, B0); PG8_MMA(1, 1, At, B1); PG8_BAR; PG8_SCHED;
            } else {
            PG8_LDB(B0, 0, 0); PG8_SCHED; PG8_LDA(At, 0, 0); PG8_STAGE(PG8_SA(1, 1), a1 + hstep, voffA);
            PG8_WAIT_L(8); PG8_BAR; PG8_WAIT_L(0); PG8_MMA(0, 0, At, B0); PG8_BAR; PG8_SCHED;
            PG8_LDB(B1, 0, 1); PG8_STAGE(PG8_SB(0, 0), b2, voffB);
            PG8_BAR; PG8_WAIT_L(0); PG8_MMA(0, 1, At, B1); PG8_BAR;
            PG8_LDA(At, 0, 1); PG8_STAGE(PG8_SA(0, 0), a2, voffA);
            PG8_BAR; PG8_WAIT_L(0); PG8_MMA(1, 0, At, B0); PG8_BAR; PG8_SCHED;
            PG8_STAGE(PG8_SB(0, 1), b2 + hstep, voffB);
            PG8_WAIT_V(6); PG8_BAR; PG8_MMA(1, 1, At, B1); PG8_BAR;
            PG8_LDB(B0, 1, 0); PG8_SCHED; PG8_LDA(At, 1, 0); PG8_STAGE(PG8_SA(0, 1), a2 + hstep, voffA);
            PG8_WAIT_L(8); PG8_BAR; PG8_WAIT_L(0); PG8_MMA(0, 0, At, B0); PG8_BAR; PG8_SCHED;
            PG8_LDB(B1, 1, 1); PG8_STAGE(PG8_SB(1, 0), b3, voffB);
            PG8_BAR; PG8_WAIT_L(0); PG8_MMA(0, 1, At, B1); PG8_BAR;
            PG8_LDA(At, 1, 1); PG8_STAGE(PG8_SA(1, 0), a3, voffA);
            PG8_BAR; PG8_WAIT_L(0); PG8_MMA(1, 0, At, B0); PG8_BAR; PG8_SCHED;
            PG8_STAGE(PG8_SB(1, 1), b3 + hstep, voffB);
            PG8_WAIT_V(6); PG8_BAR; PG8_MMA(1, 1, At, B1); PG8_BAR;
            }
        }
        if constexpr (ALIGN_EPI) { if (wr == 0) PG8_BAR; }
        if constexpr (!Epi::AFTER_DRAIN) { E(acc, cur, wr, wc, fr, fq); S.done(cur); }
        if (!has_next) break;
#pragma unroll
        for (int a = 0; a < 2; ++a)
#pragma unroll
            for (int b = 0; b < 2; ++b)
#pragma unroll
                for (int m = 0; m < 4; ++m)
#pragma unroll
                    for (int n = 0; n < 2; ++n) acc[a][b][m][n] = (f32x4){0.f, 0.f, 0.f, 0.f};
        cur = nxt; cA = nA; cB = nB; ++ui;
        if constexpr (ALIGN_EPI) { if (wr == 1) PG8_BAR; }
    }
    PG8_WAIT_V(0);
    if constexpr (!ALIGN_EPI) { if (wr == 0) PG8_BAR; }
    PG8_BAR;
    if constexpr (Epi::AFTER_DRAIN) { E.fused(acc, cur, wr, wc, fr, fq, lds, wid, lane); S.done(cur); }
#undef PG8_SA
#undef PG8_SB
#undef PG8_STAGE
#undef PG8_LDA
#undef PG8_LDB
#undef PG8_MMA
#undef PG8_WAIT_V
#undef PG8_WAIT_L
#undef PG8_BAR
#undef PG8_SCHED
}
}
namespace pg8 {
struct Order {
    int nM, nN, nwg, G, c, skip;
    __device__ void init(int nM_, int N, int G_, int c_, int skip_) { nM = nM_; nN = N / BM; nwg = nM * nN; G = G_; c = c_; skip = skip_; }
    __device__ bool next(int i, Unit& u) const {
        const long L = (long)i * G + c; if (L >= nwg) return false;
        int wgid = (int)L; { const int q = nwg / NXCD, r = nwg % NXCD, xcd = wgid % NXCD, off = wgid / NXCD; wgid = (xcd < r ? xcd * (q + 1) : r * (q + 1) + (xcd - r) * q) + off; }
        const int nig = WGM * nN, gid = wgid / nig, fm = gid * WGM, gsz = (nM - fm) < WGM ? (nM - fm) : WGM;
        u.pm = fm + ((wgid % nig) % gsz); u.pn = (wgid % nig) / gsz;
        if (skip) u.pm = u.pm + u.pm / 16 + 1;
        return true;
    }
    __device__ __forceinline__ void a_ready(const Unit&) const {}
    __device__ __forceinline__ void done(const Unit&) const {}
};
}

using pg8::f32x4; using pg8::u32x4; using pg8::bf16_t; using pg8::bf16x8;
__device__ __forceinline__ float row_rstd(const float* rowss, size_t row) {
    const f32x4* rs = (const f32x4*)(rowss + row * 16);
    const f32x4 s4 = (rs[0] + rs[1]) + (rs[2] + rs[3]);
    return rsqrtf(((s4.x + s4.y) + (s4.z + s4.w)) * (1.f / 1024.f) + 1e-6f);
}
__device__ __forceinline__ void rows_rstd(const float* rowss, int pm, int wr, int fr, float (&rstd)[2][4]) {
#pragma unroll
    for (int ai = 0; ai < 2; ++ai)
#pragma unroll
      for (int mh = 0; mh < 2; ++mh) { f32x4 t[2][4];
#pragma unroll
        for (int m2 = 0; m2 < 2; ++m2) { const f32x4* rs = (const f32x4*)(rowss + ((size_t)pm * 256 + ai * 128 + wr * 64 + (mh * 2 + m2) * 16 + fr) * 16);
#pragma unroll
            for (int k = 0; k < 4; ++k) t[m2][k] = rs[k]; }
        asm volatile("" ::: "memory");
#pragma unroll
        for (int m2 = 0; m2 < 2; ++m2) { const f32x4 s4 = (t[m2][0] + t[m2][1]) + (t[m2][2] + t[m2][3]); rstd[ai][mh * 2 + m2] = rsqrtf(((s4.x + s4.y) + (s4.z + s4.w)) * (1.f / 1024.f) + 1e-6f); } }
}
struct EpiInProj {
    static constexpr bool PERM = false, AFTER_DRAIN = false;
    bf16_t* P; const float* rowss; const float* sW; const float* ropeC; const float* ropeS;
    __device__ __forceinline__ void operator()(const f32x4 (&acc)[2][2][4][2], const pg8::Unit& u, int wr, int wc, int fr, int fq) const {
        const int b = u.pm / 17, j17 = u.pm - b * 17; const bool ctx = (j17 == 0); const int ms = ctx ? 8 : b;
        const int colb = u.pn * 256 + wc * 32 + 4 * fq;
        const int mode = (u.pn < 4) ? (ctx ? 0 : 1) : (u.pn >= 7 ? 2 : 0);
        f32x4 bv[2][2];
#pragma unroll
        for (int bj = 0; bj < 2; ++bj)
#pragma unroll
            for (int n = 0; n < 2; ++n) bv[bj][n] = *(const f32x4*)(sW + ms * PW + colb + bj * 128 + n * 16);
#pragma unroll
        for (int ai = 0; ai < 2; ++ai) {
#pragma unroll
            for (int m = 0; m < 4; ++m) {
                const int rt = ai * 128 + wr * 64 + m * 16 + fr; const size_t row = (size_t)u.pm * 256 + rt;
                float rstd;
                { const f32x4* rs = (const f32x4*)(rowss + row * 16); const f32x4 t0 = rs[0], t1 = rs[1], t2 = rs[2], t3 = rs[3];
                  const f32x4 s4 = (t0 + t1) + (t2 + t3); rstd = rsqrtf(((s4.x + s4.y) + (s4.z + s4.w)) * (1.f / 1024.f) + 1e-6f); }
                f32x4 v[2][2];
#pragma unroll
                for (int bj = 0; bj < 2; ++bj)
#pragma unroll
                    for (int n = 0; n < 2; ++n) v[bj][n] = acc[ai][bj][m][n] * rstd + bv[bj][n];
                if (mode == 1) {
                    const int tl = (j17 - 1) * 256 + rt; const int pos = (wc & 1) ? (tl & 63) : (tl >> 6);
                    const f32x4 c4 = *(const f32x4*)(ropeC + pos * 16 + 4 * fq), s4 = *(const f32x4*)(ropeS + pos * 16 + 4 * fq);
#pragma unroll
                    for (int bj = 0; bj < 2; ++bj) { const f32x4 x1 = v[bj][0], x2 = v[bj][1]; v[bj][0] = x1 * c4 - x2 * s4; v[bj][1] = x1 * s4 + x2 * c4; }
                } else if (mode == 2) {
#pragma unroll
                    for (int bj = 0; bj < 2; ++bj)
#pragma unroll
                        for (int n = 0; n < 2; ++n) { f32x4 t = v[bj][n]; t.x = gelu_tanh(t.x); t.y = gelu_tanh(t.y); t.z = gelu_tanh(t.z); t.w = gelu_tanh(t.w); v[bj][n] = t; }
                }
                bf16_t* rp = P + row * PW + colb;
#pragma unroll
                for (int bj = 0; bj < 2; ++bj)
#pragma unroll
                    for (int n = 0; n < 2; ++n) { u32x2 w; w.x = cvtpk(v[bj][n].x, v[bj][n].y); w.y = cvtpk(v[bj][n].z, v[bj][n].w); *(u32x2*)(rp + bj * 128 + n * 16) = w; }
            }
        }
    }
};
struct EpiSwiGLU {
    static constexpr bool PERM = true, AFTER_DRAIN = false;
    bf16_t* H; const float* rowss; const float* sW;
    __device__ __forceinline__ void operator()(const f32x4 (&acc)[2][2][4][2], const pg8::Unit& u, int wr, int wc, int fr, int fq) const {
        const int b = u.pm / 17, j17 = u.pm - b * 17; const int ms = (j17 == 0) ? 8 : b;
        const int colb = wc * 32 + 8 * fq;
        f32x4 bg[2], bu[2];
#pragma unroll
        for (int n = 0; n < 2; ++n) { bg[n] = *(const f32x4*)(sW + ms * NF + u.pn * 256 + colb + 4 * n); bu[n] = *(const f32x4*)(sW + ms * NF + u.pn * 256 + 128 + colb + 4 * n); }
        float rstd_[2][4]; rows_rstd(rowss, u.pm, wr, fr, rstd_);
#pragma unroll
        for (int ai = 0; ai < 2; ++ai)
#pragma unroll
            for (int m = 0; m < 4; ++m) {
                const int rt = ai * 128 + wr * 64 + m * 16 + fr; const size_t row = (size_t)u.pm * 256 + rt;
                const float rstd = rstd_[ai][m];
                f32x4 hm[2];
#pragma unroll
                for (int n = 0; n < 2; ++n) { const f32x4 g = acc[ai][0][m][n] * rstd + bg[n], up = acc[ai][1][m][n] * rstd + bu[n];
                    hm[n].x = silu_f(g.x) * up.x; hm[n].y = silu_f(g.y) * up.y; hm[n].z = silu_f(g.z) * up.z; hm[n].w = silu_f(g.w) * up.w; }
                u32x4 w; w.x = cvtpk(hm[0].x, hm[0].y); w.y = cvtpk(hm[0].z, hm[0].w); w.z = cvtpk(hm[1].x, hm[1].y); w.w = cvtpk(hm[1].z, hm[1].w);
                *(u32x4*)(H + row * FH + u.pn * 128 + colb) = w;
            }
    }
};
template <int MODE> struct EpiRes {
    static constexpr bool PERM = true, AFTER_DRAIN = false;
    const float* xin_lat; const float* xin_ctx; float* xo_lat; float* xo_ctx;
    const float* gate; const float* gp; const float* scp;
    const float* gn; const float* scn; bf16_t* A; float* rowss; int write_a;
    __device__ __forceinline__ void operator()(const f32x4 (&acc)[2][2][4][2], const pg8::Unit& u, int wr, int wc, int fr, int fq) const {
        const int b = u.pm / 17, j17 = u.pm - b * 17; const bool ctx = (j17 == 0); const int ms = ctx ? 8 : b;
        const float* xi = ctx ? xin_ctx + (size_t)b * CTXL * DM : xin_lat + ((size_t)b * SEQ + (size_t)(j17 - 1) * 256) * DM;
        float* xo = ctx ? xo_ctx + (size_t)b * CTXL * DM : xo_lat + ((size_t)b * SEQ + (size_t)(j17 - 1) * 256) * DM;
        const int colb = u.pn * 256 + wc * 32 + 8 * fq;
        float ss[2][4];
#pragma unroll
        for (int ai = 0; ai < 2; ++ai)
#pragma unroll
            for (int m = 0; m < 4; ++m) ss[ai][m] = 0.f;
#pragma unroll
        for (int bj = 0; bj < 2; ++bj) {
            const int col = colb + bj * 128;
            f32x4 gv[2], fc[2], rf[2];
#pragma unroll
            for (int n = 0; n < 2; ++n) { gv[n] = *(const f32x4*)(gate + ms * NMOD + col + 4 * n);
                if (write_a) fc[n] = *(const f32x4*)(gn + col + 4 * n) * (*(const f32x4*)(scn + ms * NMOD + col + 4 * n) + 1.f); else fc[n] = (f32x4){0.f, 0.f, 0.f, 0.f};
                if (MODE == 1) { const f32x4 f = *(const f32x4*)(gp + col + 4 * n) * (*(const f32x4*)(scp + ms * NMOD + col + 4 * n) + 1.f);
                    rf[n].x = __builtin_amdgcn_rcpf(f.x); rf[n].y = __builtin_amdgcn_rcpf(f.y); rf[n].z = __builtin_amdgcn_rcpf(f.z); rf[n].w = __builtin_amdgcn_rcpf(f.w); } }
#pragma unroll
            for (int ai = 0; ai < 2; ++ai) {
                f32x4 xl[4][2];
#pragma unroll
                for (int m = 0; m < 4; ++m) { const int rt = ai * 128 + wr * 64 + m * 16 + fr;
                    if (MODE == 0) { const unsigned xo4 = ((unsigned)rt * DM + (unsigned)col) * 4u;
#pragma unroll
                        for (int n = 0; n < 2; ++n) xl[m][n] = *(const f32x4*)((const char*)xi + (xo4 + 16u * n)); }
                    else { const u32x4 w = *(const u32x4*)((const char*)A + (((unsigned)u.pm * 256u + (unsigned)rt) * DM + (unsigned)col) * 2u);
                        xl[m][0] = (f32x4){bflo(w.x), bfhi(w.x), bflo(w.y), bfhi(w.y)} * rf[0]; xl[m][1] = (f32x4){bflo(w.z), bfhi(w.z), bflo(w.w), bfhi(w.w)} * rf[1]; } }
                asm volatile("" ::: "memory");
#pragma unroll
                for (int m = 0; m < 4; ++m) {
                    const int rt = ai * 128 + wr * 64 + m * 16 + fr;
                    const unsigned xo4 = ((unsigned)rt * DM + (unsigned)col) * 4u;
                    f32x4 xv[2];
#pragma unroll
                    for (int n = 0; n < 2; ++n) { xv[n] = xl[m][n] + gv[n] * acc[ai][bj][m][n];
                        if (MODE == 1) *(f32x4*)((char*)xo + (xo4 + 16u * n)) = xv[n];
                        ss[ai][m] += (xv[n].x * xv[n].x + xv[n].y * xv[n].y) + (xv[n].z * xv[n].z + xv[n].w * xv[n].w); }
                    if (write_a) { const f32x4 a0 = xv[0] * fc[0], a1 = xv[1] * fc[1];
                        u32x4 w; w.x = cvtpk(a0.x, a0.y); w.y = cvtpk(a0.z, a0.w); w.z = cvtpk(a1.x, a1.y); w.w = cvtpk(a1.z, a1.w);
                        *(u32x4*)((char*)A + (((unsigned)u.pm * 256u + (unsigned)rt) * DM + (unsigned)col) * 2u) = w; }
                }
            }
        }
#pragma unroll
        for (int ai = 0; ai < 2; ++ai)
#pragma unroll
            for (int m = 0; m < 4; ++m) { float s = ss[ai][m]; s += __shfl_xor(s, 16); s += __shfl_xor(s, 32);
                if (fq == 0) rowss[((size_t)u.pm * 256 + ai * 128 + wr * 64 + m * 16 + fr) * 16 + u.pn * 4 + wc] = s; }
    }
};
namespace att {
using s16x4 = __attribute__((ext_vector_type(4))) short;
using f32x16 = __attribute__((ext_vector_type(16))) float;
constexpr int SHM_V = 16384, SHM_K = 8192, OFF_V = 0, OFF_K = 32768, OFF_WS = 49152, OFF_ST = 51200, LDS_TOTAL = OFF_ST + 65536;
constexpr float SCALE = 0.125f, THR = 8.f;
#define KSWZ(row, colB) ((row) * 128 + ((colB) ^ (((row) & 7) << 4)))
#define SBAR() __builtin_amdgcn_sched_barrier(0)
__device__ __forceinline__ int crow(int r, int hi) { return (r & 3) + 8 * (r >> 2) + 4 * hi; }
__device__ __forceinline__ void partialSM(f32x16& p0, f32x16& p1, float& m_reg, float& mn, float& alpha) {
  constexpr float C = SCALE * 1.4426950408889634f;
  float pmax = p0[0];
#pragma unroll
  for (int r = 1; r < 16; ++r) pmax = fmaxf(pmax, p0[r]);
#pragma unroll
  for (int r = 0; r < 16; ++r) pmax = fmaxf(pmax, p1[r]);
  { auto rr = __builtin_amdgcn_permlane32_swap(__float_as_uint(pmax), __float_as_uint(pmax), false, false);
    pmax = fmaxf(__uint_as_float(rr[0]), __uint_as_float(rr[1])); }
  if (__builtin_expect(__all(pmax - m_reg <= THR / SCALE), 1)) { mn = m_reg; alpha = 1.f; }
  else { mn = fmaxf(m_reg, pmax); alpha = __builtin_amdgcn_exp2f((m_reg - mn) * C); m_reg = mn; }
  const float mnC = -mn * C;
#pragma unroll
  for (int r = 0; r < 16; ++r) p0[r] = fmaf(p0[r], C, mnC);
#pragma unroll
  for (int r = 0; r < 16; ++r) p1[r] = fmaf(p1[r], C, mnC);
#pragma unroll
  for (int r = 0; r < 16; ++r) p0[r] = __builtin_amdgcn_exp2f(p0[r]);
}
__device__ __forceinline__ void finishSM(f32x16& p0, f32x16& p1, float alpha, float& l_reg, bf16x8& pa0, bf16x8& pa1, bf16x8& pa2, bf16x8& pa3) {
#pragma unroll
  for (int r = 0; r < 16; ++r) p1[r] = __builtin_amdgcn_exp2f(p1[r]);
  float ps = 0;
#pragma unroll
  for (int r = 0; r < 16; ++r) ps += p0[r];
#pragma unroll
  for (int r = 0; r < 16; ++r) ps += p1[r];
  { auto rr = __builtin_amdgcn_permlane32_swap(__float_as_uint(ps), __float_as_uint(ps), false, false);
    ps = __uint_as_float(rr[0]) + __uint_as_float(rr[1]); }
  l_reg = l_reg * alpha + ps;
#define PK4(P, BASE, OUT) do { unsigned a0 = cvtpk(P[BASE + 0], P[BASE + 1]), a1 = cvtpk(P[BASE + 2], P[BASE + 3]);   \
    unsigned b0 = cvtpk(P[BASE + 4], P[BASE + 5]), b1 = cvtpk(P[BASE + 6], P[BASE + 7]);                              \
    auto r0 = __builtin_amdgcn_permlane32_swap(a0, b0, false, false); auto r1 = __builtin_amdgcn_permlane32_swap(a1, b1, false, false); \
    u32x4 w = {r0[0], r1[0], r0[1], r1[1]}; OUT = *reinterpret_cast<bf16x8*>(&w); } while (0)
  PK4(p0, 0, pa0); PK4(p0, 8, pa1); PK4(p1, 0, pa2); PK4(p1, 8, pa3);
#undef PK4
}
__device__ __forceinline__ void qkt(f32x16& p0, f32x16& p1, const char* Ks, const bf16x8* qr, int r32, int hi) {
  p0 = f32x16{}; p1 = f32x16{};
#pragma unroll
  for (int d0 = 0; d0 < 4; ++d0) { const int cb = d0 * 32 + hi * 16;
    const bf16x8 b0 = *reinterpret_cast<const bf16x8*>(Ks + KSWZ(r32, cb));
    const bf16x8 b1 = *reinterpret_cast<const bf16x8*>(Ks + KSWZ(32 + r32, cb));
    p0 = __builtin_amdgcn_mfma_f32_32x32x16_bf16(b0, qr[d0], p0, 0, 0, 0);
    p1 = __builtin_amdgcn_mfma_f32_32x32x16_bf16(b1, qr[d0], p1, 0, 0, 0); }
}
__device__ __forceinline__ int v_st(int k, int c) { const int kk = (k & ~0xC) | ((k & 4) << 1) | ((k & 8) >> 1); return ((kk >> 3) * 4 + (c >> 5)) * 512 + ((kk & 7) * 32 + (c & 31)) * 2; }
__device__ __forceinline__ int v_rd_base(int lane) { return ((lane & 3) << 3) | (((lane >> 2) & 3) << 6) | (((lane >> 4) & 1) << 5) | (((lane >> 5) & 1) << 8); }
constexpr int v_rd_off(int d0, int ks, int half) { return d0 * 512 + ks * 4096 + half * 2048; }
template <int OFF> __device__ __forceinline__ s16x4 tr_read(int vb) {
  s16x4 r; asm volatile("ds_read_b64_tr_b16 %0, %1 offset:%2" : "=&v"(r) : "v"(vb), "i"(OFF) : "memory"); return r;
}
template <int KS> __device__ __forceinline__ void pv_ks(f32x16* o, int vb, bf16x8 pa) {
  const s16x4 l0 = tr_read<v_rd_off(0, KS, 0)>(vb), h0 = tr_read<v_rd_off(0, KS, 1)>(vb), l1 = tr_read<v_rd_off(1, KS, 0)>(vb), h1 = tr_read<v_rd_off(1, KS, 1)>(vb);
  const s16x4 l2 = tr_read<v_rd_off(2, KS, 0)>(vb), h2 = tr_read<v_rd_off(2, KS, 1)>(vb), l3 = tr_read<v_rd_off(3, KS, 0)>(vb), h3 = tr_read<v_rd_off(3, KS, 1)>(vb);
  asm volatile("s_waitcnt lgkmcnt(0)" ::: "memory"); SBAR();
#define PK(L, H) (bf16x8){L[0], L[1], L[2], L[3], H[0], H[1], H[2], H[3]}
  o[0] = __builtin_amdgcn_mfma_f32_32x32x16_bf16(pa, PK(l0, h0), o[0], 0, 0, 0);
  o[1] = __builtin_amdgcn_mfma_f32_32x32x16_bf16(pa, PK(l1, h1), o[1], 0, 0, 0);
  o[2] = __builtin_amdgcn_mfma_f32_32x32x16_bf16(pa, PK(l2, h2), o[2], 0, 0, 0);
  o[3] = __builtin_amdgcn_mfma_f32_32x32x16_bf16(pa, PK(l3, h3), o[3], 0, 0, 0);
#undef PK
}
__device__ __forceinline__ void pv_d0(f32x16* o, int vb, bf16x8 pa0, bf16x8 pa1, bf16x8 pa2, bf16x8 pa3) {
  pv_ks<0>(o, vb, pa0); pv_ks<1>(o, vb, pa1); pv_ks<2>(o, vb, pa2); pv_ks<3>(o, vb, pa3);
}
__device__ __forceinline__ void attn_unit(char* lds, const bf16_t* __restrict__ P, bf16_t* __restrict__ Y, int b, int h, int qb, float lam, const float* __restrict__ gattn, float oscale) {
  int tid_ = threadIdx.x; asm volatile("" : "+v"(tid_));
  const int tid = tid_, wid = tid >> 6, lane = tid & 63, r32 = lane & 31, hi = lane >> 5;
  const unsigned rowb = (unsigned)b * TB, q0 = rowb + (unsigned)qb * 256;
  const int seq = (qb == 0) ? CTXL : TB, NT = seq / 64;
  char* V_lds = lds + OFF_V; char* K_lds = lds + OFF_K;
  float* ws = (float*)(lds + OFF_WS) + wid * 64; float* li_l = ws; float* al_l = ws + 32;
  unsigned* stash = (unsigned*)(lds + OFF_ST) + wid * 2048;
  const int sr = tid >> 4, sc = (tid & 15) * 8, vst0 = v_st(sr, sc), vst1 = v_st(32 + sr, sc);
  const int kr = tid >> 3, kc = (tid & 7) * 8, kst = KSWZ(kr, kc * 2);
  const int vb0 = (int)(uintptr_t)V_lds + v_rd_base(lane);
  const char* Pc = (const char*)P;
  const unsigned voff = ((rowb + sr) * PW + V0c + h * 128 + sc) * 2u;
#pragma unroll 1
  for (int map = 0; map < 2; ++map) {
    const unsigned qoff = ((q0 + wid * 32 + r32) * PW + Q0c + h * 128 + map * 64 + hi * 8) * 2u;
    const unsigned koff = ((rowb + kr) * PW + K0c + h * 128 + map * 64 + kc) * 2u;
    bf16x8 qr[4];
#pragma unroll
    for (int d0 = 0; d0 < 4; ++d0) qr[d0] = *reinterpret_cast<const bf16x8*>(Pc + (qoff + d0 * 32));
    float m_reg = -1e30f, l_reg = 0; f32x16 o[4] = {};
    struct { bf16x8 vs0, vs1, ks; } sr_[1];
#define SLOAD(i, k0) do { const unsigned ko_ = (unsigned)(k0) * (PW * 2u); sr_[i].vs0 = *reinterpret_cast<const bf16x8*>(Pc + (voff + ko_)); sr_[i].vs1 = *reinterpret_cast<const bf16x8*>(Pc + (voff + ko_ + 32u * PW * 2u)); \
    sr_[i].ks = *reinterpret_cast<const bf16x8*>(Pc + (koff + ko_)); } while (0)
#define SWRITE(bf, i) do { *(bf16x8*)(V_lds + (bf) * SHM_V + vst0) = sr_[i].vs0; *(bf16x8*)(V_lds + (bf) * SHM_V + vst1) = sr_[i].vs1; \
    *(bf16x8*)(K_lds + (bf) * SHM_K + kst) = sr_[i].ks; } while (0)
#define SWAIT() asm volatile("s_waitcnt vmcnt(0)" ::: "memory")
#define RESC(a) do { if (__any((a) < 1.f)) { if (hi == 0) al_l[r32] = (a); asm volatile("s_waitcnt lgkmcnt(0)" ::: "memory"); \
    _Pragma("unroll") for (int d = 0; d < 4; ++d) _Pragma("unroll") for (int r = 0; r < 16; ++r) o[d][r] *= al_l[crow(r, hi)]; } } while (0)
    f32x16 pA0, pA1, pB0, pB1; float mnA, mnB, alA, alB; bf16x8 pa0, pa1, pa2, pa3;
    constexpr int SE = 0, SO = 0;
    SLOAD(SE, 0); asm volatile("s_waitcnt vmcnt(0)" ::: "memory"); SWRITE(0, SE); __syncthreads();
    qkt(pA0, pA1, K_lds, qr, r32, hi); partialSM(pA0, pA1, m_reg, mnA, alA);
    SLOAD(SO, 64);
    SWAIT(); SWRITE(1, SO); __syncthreads();
    for (int j = 1; j + 1 < NT; j += 2) {
      SBAR(); qkt(pB0, pB1, K_lds + SHM_K, qr, r32, hi);
      finishSM(pA0, pA1, alA, l_reg, pa0, pa1, pa2, pa3); SBAR();
      SLOAD(SO, (j + 1) * 64); SBAR();
      pv_d0(o, vb0, pa0, pa1, pa2, pa3); partialSM(pB0, pB1, m_reg, mnB, alB);
      __syncthreads(); SWAIT(); SWRITE(0, SE);
      RESC(alB); __syncthreads();
      SBAR(); qkt(pA0, pA1, K_lds, qr, r32, hi);
      finishSM(pB0, pB1, alB, l_reg, pa0, pa1, pa2, pa3); SBAR();
      SLOAD(SE, (j + 2) * 64); SBAR();
      pv_d0(o, vb0 + SHM_V, pa0, pa1, pa2, pa3); partialSM(pA0, pA1, m_reg, mnA, alA);
      __syncthreads(); SWAIT(); SWRITE(1, SO);
      RESC(alA); __syncthreads();
    }
    SBAR(); qkt(pB0, pB1, K_lds + SHM_K, qr, r32, hi);
    finishSM(pA0, pA1, alA, l_reg, pa0, pa1, pa2, pa3); SBAR();
    pv_d0(o, vb0, pa0, pa1, pa2, pa3); partialSM(pB0, pB1, m_reg, mnB, alB);
    __syncthreads(); RESC(alB);
    finishSM(pB0, pB1, alB, l_reg, pa0, pa1, pa2, pa3); SBAR();
    pv_d0(o, vb0 + SHM_V, pa0, pa1, pa2, pa3);
    if (hi == 0) li_l[r32] = l_reg; asm volatile("s_waitcnt lgkmcnt(0)" ::: "memory");
    if (map == 0) {
#pragma unroll
      for (int r = 0; r < 16; ++r) { const float rl = __builtin_amdgcn_rcpf(li_l[crow(r, hi)]);
        stash[(r * 2 + 0) * 64 + lane] = cvtpk(o[0][r] * rl, o[1][r] * rl); stash[(r * 2 + 1) * 64 + lane] = cvtpk(o[2][r] * rl, o[3][r] * rl); SBAR(); }
    } else if (ATT_VAR != 1) {
      char* Yc = (char*)Y; const unsigned yoff = ((q0 + wid * 32) * DM + h * 128 + r32) * 2u;
      float gv[4];
#pragma unroll
      for (int d0 = 0; d0 < 4; ++d0) gv[d0] = gattn[d0 * 32 + r32] * oscale;
      SBAR();
#pragma unroll
      for (int r = 0; r < 16; ++r) { const float rl = lam * __builtin_amdgcn_rcpf(li_l[crow(r, hi)]);
        const unsigned w0 = stash[(r * 2 + 0) * 64 + lane], w1 = stash[(r * 2 + 1) * 64 + lane];
        const float e0 = bflo(w0) - o[0][r] * rl, e1 = bfhi(w0) - o[1][r] * rl, e2 = bflo(w1) - o[2][r] * rl, e3 = bfhi(w1) - o[3][r] * rl;
        float ssq = (e0 * e0 + e1 * e1) + (e2 * e2 + e3 * e3);
        if (ATT_VAR != 3) { ssq += __shfl_xor(ssq, 1); ssq += __shfl_xor(ssq, 2); ssq += __shfl_xor(ssq, 4); ssq += __shfl_xor(ssq, 8); ssq += __shfl_xor(ssq, 16); }
        const float rs = rsqrtf(ssq * (1.f / 128.f) + 1e-6f);
        bf16_t* yr = (bf16_t*)(Yc + (yoff + (unsigned)crow(r, hi) * (DM * 2u)));
        if (ATT_VAR != 4) { yr[0] = f2bf(e0 * rs * gv[0]); yr[32] = f2bf(e1 * rs * gv[1]); yr[64] = f2bf(e2 * rs * gv[2]); yr[96] = f2bf(e3 * rs * gv[3]); } else { yr[0] = f2bf(e0 * rs + e1 + e2 + e3); } SBAR(); }
    }
    __syncthreads();
#undef SLOAD
#undef SWRITE
#undef SWAIT
#undef RESC
  }
}
#undef KSWZ
}
namespace lru {
using att::f32x16; using att::crow;
constexpr int RS = 528;
constexpr int OFF_CL = 0, OFF_YS = 128 * RS, OFF_CY = 2 * 128 * RS;
template <int CTRL, int RMASK> __device__ __forceinline__ float dppf(float oldv, float src) {
  return __int_as_float(__builtin_amdgcn_update_dpp(__float_as_int(oldv), __float_as_int(src), CTRL, RMASK, 0xF, false));
}
template <bool PASS2>
__device__ __forceinline__ void lru_unit(char* lds, const bf16_t* __restrict__ P, bf16_t* __restrict__ Y, int b, int c, const float* __restrict__ convw, const float* __restrict__ convb,
                                         const bf16_t* __restrict__ wrg, const float* __restrict__ ba, const float* __restrict__ bx, const float* __restrict__ c8, float* lrus) {
  int tid_ = threadIdx.x; asm volatile("" : "+v"(tid_));
  const int tid = tid_, wid = tid >> 6, lane = tid & 63, r32 = lane & 31, hi = lane >> 5;
  const unsigned R0 = (unsigned)b * TB + (unsigned)c * 128;
  const int seg_lo = (c < 2) ? 0 : CTXL, seg_hi = (c < 2) ? CTXL : TB;
  const char* Pc = (const char*)P;
  {
    const int ch8 = (tid & 31) * 8, t0 = (tid >> 5) * 8;
    u32x4 xr[11];
#pragma unroll
    for (int i = 0; i < 11; ++i) { const int tt = c * 128 + t0 - 1 + i;
      if (tt >= seg_lo && tt < seg_hi) xr[i] = *(const u32x4*)(Pc + (((unsigned)b * TB + (unsigned)tt) * PW + LX0 + ch8) * 2u); else xr[i] = (u32x4){0u, 0u, 0u, 0u}; }
    float w[4][8], bb[8];
#pragma unroll
    for (int k = 0; k < 4; ++k) { const f32x4 a = *(const f32x4*)(convw + k * 256 + ch8), d = *(const f32x4*)(convw + k * 256 + ch8 + 4);
      w[k][0] = a.x; w[k][1] = a.y; w[k][2] = a.z; w[k][3] = a.w; w[k][4] = d.x; w[k][5] = d.y; w[k][6] = d.z; w[k][7] = d.w; }
    { const f32x4 a = *(const f32x4*)(convb + ch8), d = *(const f32x4*)(convb + ch8 + 4); bb[0] = a.x; bb[1] = a.y; bb[2] = a.z; bb[3] = a.w; bb[4] = d.x; bb[5] = d.y; bb[6] = d.z; bb[7] = d.w; }
#pragma unroll
    for (int i = 0; i < 8; ++i) { float acc[8];
#pragma unroll
      for (int e = 0; e < 8; ++e) acc[e] = bb[e];
#pragma unroll
      for (int k = 0; k < 4; ++k) { const u32x4 xv = xr[i + k];
        acc[0] += bflo(xv.x) * w[k][0]; acc[1] += bfhi(xv.x) * w[k][1]; acc[2] += bflo(xv.y) * w[k][2]; acc[3] += bfhi(xv.y) * w[k][3];
        acc[4] += bflo(xv.z) * w[k][4]; acc[5] += bfhi(xv.z) * w[k][5]; acc[6] += bflo(xv.w) * w[k][6]; acc[7] += bfhi(xv.w) * w[k][7]; }
      u32x4 o; o.x = cvtpk(acc[0], acc[1]); o.y = cvtpk(acc[2], acc[3]); o.z = cvtpk(acc[4], acc[5]); o.w = cvtpk(acc[6], acc[7]);
      *(u32x4*)(lds + OFF_CL + (t0 + i) * RS + ch8 * 2) = o; }
  }
  if (PASS2) {
    const int d = tid >> 8, ch = tid & 255;
    const int np = d ? (c < 2 ? 1 - c : NCHUNK + 1 - c) : c;
    float cy = 0.f;
    const float* sb = lrus + ((size_t)b * NCHUNK * 4 + (size_t)d * 2) * 256 + ch;
    if (np > 0) { float A[NCHUNK], H[NCHUNK];
#pragma unroll
      for (int i = 0; i < NCHUNK; ++i) { int p = i < np ? i : np - 1;
        const int u = d ? (c < 2 ? 1 - p : (p == 0 ? 1 : (p == 1 ? 0 : NCHUNK + 1 - p))) : p;
        A[i] = sb[(size_t)u * 1024]; H[i] = sb[(size_t)u * 1024 + 256]; }
#pragma unroll
      for (int i = 0; i < NCHUNK; ++i) if (i < np) cy = A[i] * cy + H[i];
    }
    ((float*)(lds + OFF_CY))[tid] = cy;
  }
  __syncthreads();
  const int hh = wid >> 1, jh = wid & 1, chb = hh * 64 + jh * 32;
#pragma unroll 1
  for (int d = 0; d < 2; ++d) {
    const bf16_t* wa = wrg + ((0 * 2 + d) * 4 + hh) * 4096 + (jh * 32 + r32) * 64 + hi * 8;
    const bf16_t* wx = wrg + ((1 * 2 + d) * 4 + hh) * 4096 + (jh * 32 + r32) * 64 + hi * 8;
    bf16x8 fa[4], fx[4];
#pragma unroll
    for (int k = 0; k < 4; ++k) { fa[k] = *reinterpret_cast<const bf16x8*>(wa + k * 16); fx[k] = *reinterpret_cast<const bf16x8*>(wx + k * 16); }
    float carry[16], Pc_[16], bav[16], bxv[16], c8v[16];
#pragma unroll
    for (int q = 0; q < 4; ++q) { const int co = d * 256 + chb + 8 * q + 4 * hi;
      const f32x4 b4 = *(const f32x4*)(ba + co), x4 = *(const f32x4*)(bx + co), c4 = *(const f32x4*)(c8 + co);
      bav[4 * q] = b4.x; bav[4 * q + 1] = b4.y; bav[4 * q + 2] = b4.z; bav[4 * q + 3] = b4.w; bxv[4 * q] = x4.x; bxv[4 * q + 1] = x4.y; bxv[4 * q + 2] = x4.z; bxv[4 * q + 3] = x4.w;
      c8v[4 * q] = c4.x; c8v[4 * q + 1] = c4.y; c8v[4 * q + 2] = c4.z; c8v[4 * q + 3] = c4.w; }
#pragma unroll
    for (int r = 0; r < 16; ++r) { carry[r] = 0.f; Pc_[r] = 1.f; }
    if (PASS2) { const float* cyp = (const float*)(lds + OFF_CY) + d * 256 + chb + 4 * hi;
#pragma unroll
      for (int q = 0; q < 4; ++q) { const f32x4 v = *(const f32x4*)(cyp + 8 * q); carry[4 * q] = v.x; carry[4 * q + 1] = v.y; carry[4 * q + 2] = v.z; carry[4 * q + 3] = v.w; } }
    const int tokl = d ? 31 - r32 : r32;
#pragma unroll 1
    for (int ti = 0; ti < 4; ++ti) {
      const int tt = d ? 3 - ti : ti;
      char* rowp = lds + OFF_CL + (tt * 32 + tokl) * RS;
      f32x16 za = {}, zx = {};
#pragma unroll
      for (int k = 0; k < 4; ++k) { const bf16x8 xb = *reinterpret_cast<const bf16x8*>(rowp + (hh * 64 + k * 16 + hi * 8) * 2);
        za = __builtin_amdgcn_mfma_f32_32x32x16_bf16(fa[k], xb, za, 0, 0, 0); zx = __builtin_amdgcn_mfma_f32_32x32x16_bf16(fx[k], xb, zx, 0, 0, 0); }
      float av[16], bv[16];
#pragma unroll
      for (int q = 0; q < 4; ++q) { const u32x2 cw = *(const u32x2*)(rowp + (chb + 8 * q + 4 * hi) * 2);
        const float clv[4] = {bflo(cw.x), bfhi(cw.x), bflo(cw.y), bfhi(cw.y)};
#pragma unroll
        for (int i = 0; i < 4; ++i) { const int r = 4 * q + i;
          const float rg = sigm(za[r] + bav[r]), ig = sigm(zx[r] + bxv[r]);
          const float a = fexp(-c8v[r] * rg);
          av[r] = a; bv[r] = __builtin_amdgcn_sqrtf(fmaxf(1.f - a * a, 0.f)) * ig * clv[i]; } }
#define LRU_SCAN(CTRL, RM) _Pragma("unroll") for (int r = 0; r < 16; ++r) { const float ap = dppf<CTRL, RM>(1.f, av[r]), bp = dppf<CTRL, RM>(0.f, bv[r]); bv[r] = av[r] * bp + bv[r]; av[r] = av[r] * ap; }
      LRU_SCAN(0x111, 0xF) LRU_SCAN(0x112, 0xF) LRU_SCAN(0x114, 0xF) LRU_SCAN(0x118, 0xF) LRU_SCAN(0x142, 0xA)
#undef LRU_SCAN
#pragma unroll
      for (int q = 0; q < 4; ++q) { float hv[4];
#pragma unroll
        for (int i = 0; i < 4; ++i) { const int r = 4 * q + i; hv[i] = bv[r] + av[r] * carry[r];
          carry[r] = __shfl(hv[i], 31, 32);
          if (!PASS2) Pc_[r] *= __shfl(av[r], 31, 32); }
        if (PASS2) { u32x2* yp = (u32x2*)(lds + OFF_YS + (tt * 32 + tokl) * RS + (chb + 8 * q + 4 * hi) * 2);
          if (d) { const u32x2 o = *yp; hv[0] += bflo(o.x); hv[1] += bfhi(o.x); hv[2] += bflo(o.y); hv[3] += bfhi(o.y); }
          u32x2 w; w.x = cvtpk(hv[0], hv[1]); w.y = cvtpk(hv[2], hv[3]); *yp = w; } }
    }
    if (!PASS2) { if (r32 == 0) { float* sb = lrus + ((((size_t)b * NCHUNK + c) * 2 + d) * 2) * 256 + chb + 4 * hi;
#pragma unroll
        for (int q = 0; q < 4; ++q) { *(f32x4*)(sb + 8 * q) = (f32x4){Pc_[4 * q], Pc_[4 * q + 1], Pc_[4 * q + 2], Pc_[4 * q + 3]};
          *(f32x4*)(sb + 256 + 8 * q) = (f32x4){carry[4 * q], carry[4 * q + 1], carry[4 * q + 2], carry[4 * q + 3]}; } } }
  }
  if (PASS2) {
    __syncthreads();
    const int ch8 = (tid & 31) * 8;
#pragma unroll
    for (int i = 0; i < 8; ++i) { const int t = (tid >> 5) + 16 * i;
      const u32x4 hv = *(const u32x4*)(lds + OFF_YS + t * RS + ch8 * 2), gv = *(const u32x4*)(Pc + ((R0 + t) * PW + LG0 + ch8) * 2u);
      u32x4 o; o.x = cvtpk(bflo(hv.x) * bflo(gv.x), bfhi(hv.x) * bfhi(gv.x)); o.y = cvtpk(bflo(hv.y) * bflo(gv.y), bfhi(hv.y) * bfhi(gv.y));
      o.z = cvtpk(bflo(hv.z) * bflo(gv.z), bfhi(hv.z) * bfhi(gv.z)); o.w = cvtpk(bflo(hv.w) * bflo(gv.w), bfhi(hv.w) * bfhi(gv.w));
      *(u32x4*)((char*)Y + ((R0 + t) * DM + 512 + ch8) * 2u) = o; }
  }
  __syncthreads();
}
}

namespace sgu {
using att::f32x16; using att::crow;
constexpr int VS = 272;
__device__ __forceinline__ void sgu_unit(char* lds, const bf16_t* __restrict__ P, bf16_t* __restrict__ Y, int b, int c, const bf16_t* __restrict__ wsp, const float* __restrict__ gsgu, const float* __restrict__ bsp) {
  int tid_ = threadIdx.x; asm volatile("" : "+v"(tid_));
  const int tid = tid_, wid = tid >> 6, lane = tid & 63, r32 = lane & 31, hi = lane >> 5;
  const unsigned R0 = (unsigned)b * TB + (unsigned)c * 128;
  const char* Pc = (const char*)P;
  const int gg = wid >> 1, chalf = wid & 1, cc = gg * 64 + chalf * 32 + r32;
  bf16x8 Af[4][8];
  u32x4 xv[8];
  { const int q = tid & 127, g = tid >> 7;
    const char* vp = Pc + ((R0 + q) * PW + SV0 + g * 64) * 2u;
#pragma unroll
    for (int i = 0; i < 8; ++i) xv[i] = *(const u32x4*)(vp + i * 16); }
#pragma unroll
  for (int pt = 0; pt < 4; ++pt) { const bf16_t* ap = wsp + (gg * 128 + pt * 32 + r32) * 128 + hi * 8;
#pragma unroll
    for (int k = 0; k < 8; ++k) Af[pt][k] = *reinterpret_cast<const bf16x8*>(ap + k * 16); }
  { const int q = tid & 127, g = tid >> 7; float ss = 0.f;
#pragma unroll
    for (int i = 0; i < 8; ++i) {
      const float a0 = bflo(xv[i].x), a1 = bfhi(xv[i].x), a2 = bflo(xv[i].y), a3 = bfhi(xv[i].y), a4 = bflo(xv[i].z), a5 = bfhi(xv[i].z), a6 = bflo(xv[i].w), a7 = bfhi(xv[i].w);
      ss += (a0 * a0 + a1 * a1) + (a2 * a2 + a3 * a3) + (a4 * a4 + a5 * a5) + (a6 * a6 + a7 * a7); }
    const float rs = rsqrtf(ss * (1.f / 64.f) + 1e-6f);
    char* dst = lds + (g * 64) * VS + q * 2;
#pragma unroll
    for (int i = 0; i < 8; ++i) { const float* gp = gsgu + g * 64 + i * 8; const f32x4 g0 = *(const f32x4*)gp, g1 = *(const f32x4*)(gp + 4);
      *(bf16_t*)(dst + (i * 8 + 0) * VS) = f2bf(bflo(xv[i].x) * rs * g0.x); *(bf16_t*)(dst + (i * 8 + 1) * VS) = f2bf(bfhi(xv[i].x) * rs * g0.y);
      *(bf16_t*)(dst + (i * 8 + 2) * VS) = f2bf(bflo(xv[i].y) * rs * g0.z); *(bf16_t*)(dst + (i * 8 + 3) * VS) = f2bf(bfhi(xv[i].y) * rs * g0.w);
      *(bf16_t*)(dst + (i * 8 + 4) * VS) = f2bf(bflo(xv[i].z) * rs * g1.x); *(bf16_t*)(dst + (i * 8 + 5) * VS) = f2bf(bfhi(xv[i].z) * rs * g1.y);
      *(bf16_t*)(dst + (i * 8 + 6) * VS) = f2bf(bflo(xv[i].w) * rs * g1.z); *(bf16_t*)(dst + (i * 8 + 7) * VS) = f2bf(bfhi(xv[i].w) * rs * g1.w); }
  }
  __syncthreads();
  { bf16x8 vb[8];
#pragma unroll
    for (int k = 0; k < 8; ++k) vb[k] = *reinterpret_cast<const bf16x8*>(lds + cc * VS + (k * 16 + hi * 8) * 2);
    unsigned short uu[2][16]; f32x4 bsv[2][4];
#define SGU_LD(pt_, s_) do { _Pragma("unroll") for (int r = 0; r < 16; ++r) uu[s_][r] = *(const unsigned short*)(Pc + ((R0 + (pt_) * 32 + crow(r, hi)) * PW + SU0 + cc) * 2u); \
      _Pragma("unroll") for (int q4 = 0; q4 < 4; ++q4) bsv[s_][q4] = *(const f32x4*)(bsp + gg * 128 + (pt_) * 32 + 8 * q4 + 4 * hi); } while (0)
    SGU_LD(0, 0);
#pragma unroll
    for (int pt = 0; pt < 4; ++pt) { f32x16 acc = {};
      if (pt + 1 < 4) SGU_LD(pt + 1, (pt + 1) & 1);
#pragma unroll
      for (int k = 0; k < 8; ++k) acc = __builtin_amdgcn_mfma_f32_32x32x16_bf16(Af[pt][k], vb[k], acc, 0, 0, 0);
#pragma unroll
      for (int r = 0; r < 16; ++r) { const int p = pt * 32 + crow(r, hi); const float m = acc[r] + bsv[pt & 1][r >> 2][r & 3];
        *(bf16_t*)((char*)Y + ((R0 + p) * DM + 768 + cc) * 2u) = f2bf(bf2f(uu[pt & 1][r]) * m); } }
#undef SGU_LD
  }
  __syncthreads();
}
}
__device__ __forceinline__ unsigned pk2(float lo, float hi) { return cvtpk(lo, hi); }
__device__ __forceinline__ void transpose_item(const float* __restrict__ W, int K, int N, bf16_t* __restrict__ WT, int row_base, LAS float* scr, int kb, int nb, int lane) {
    const int k0 = 64 * kb, n0 = 32 * nb;
#pragma unroll 8
    for (int i = 0; i < 32; ++i) { const int kk = 2 * i + (lane >> 5); scr[kk * 33 + (lane & 31)] = W[(size_t)(k0 + kk) * N + n0 + (lane & 31)]; }
    asm volatile("s_waitcnt lgkmcnt(0)" ::: "memory");
    const int c = lane & 7;
#pragma unroll
    for (int j = 0; j < 4; ++j) { const int n = (lane >> 3) + 8 * j; const LAS float* s = scr + (8 * c) * 33 + n;
        u32x4 o; o.x = pk2(s[0 * 33], s[1 * 33]); o.y = pk2(s[2 * 33], s[3 * 33]); o.z = pk2(s[4 * 33], s[5 * 33]); o.w = pk2(s[6 * 33], s[7 * 33]);
        *(u32x4*)(WT + (size_t)(row_base + n) * K + k0 + 8 * c) = o; }
    asm volatile("s_waitcnt lgkmcnt(0)" ::: "memory");
}
__device__ __forceinline__ void gemv_item(const LAS float* a_lds, LAS float* red, const float* __restrict__ W, int N, int n0, float* __restrict__ out, int ldo, int obase, const float* __restrict__ bias) {
    const int tid = threadIdx.x, wid = tid >> 6, lane = tid & 63, c4 = (lane & 15) * 4, ks = lane >> 4;
    f32x4 acc[NMS];
#pragma unroll
    for (int ms = 0; ms < NMS; ++ms) acc[ms] = (f32x4){0.f, 0.f, 0.f, 0.f};
    const float* wp = W + (size_t)(wid * 128 + ks) * N + n0 + c4;
#pragma unroll 8
    for (int st = 0; st < 32; ++st) { const f32x4 wv = *(const f32x4*)(wp + (size_t)st * 4 * N); const int k = wid * 128 + st * 4 + ks;
#pragma unroll
        for (int ms = 0; ms < NMS; ++ms) acc[ms] += wv * a_lds[ms * 1024 + k]; }
#pragma unroll
    for (int ms = 0; ms < NMS; ++ms) {
        f32x4 v = acc[ms];
        v.x += __shfl_xor(v.x, 16); v.y += __shfl_xor(v.y, 16); v.z += __shfl_xor(v.z, 16); v.w += __shfl_xor(v.w, 16);
        v.x += __shfl_xor(v.x, 32); v.y += __shfl_xor(v.y, 32); v.z += __shfl_xor(v.z, 32); v.w += __shfl_xor(v.w, 32);
        if (ks == 0) { LAS float* rp = red + (wid * NMS + ms) * 64 + c4; rp[0] = v.x; rp[1] = v.y; rp[2] = v.z; rp[3] = v.w; }
    }
    __syncthreads();
    for (int i = tid; i < NMS * 64; i += 512) { const int ms = i >> 6, c = i & 63; float s = 0.f;
#pragma unroll
        for (int w = 0; w < 8; ++w) s += red[(w * NMS + ms) * 64 + c];
        if (bias) s += bias[n0 + c];
        out[(size_t)ms * ldo + obase + c] = s; }
    __syncthreads();
}
__device__ __forceinline__ float wave_sum(float v) {
#pragma unroll
    for (int o = 1; o < 64; o <<= 1) v += __shfl_xor(v, o);
    return v;
}

#define XB_TMO      128
#define XB_XCNT(j)  (256  + 64 * (j))
#define XB_XSUB(j)  (1280 + 64 * (j))
#define XB_XGEN(j)  (2304 + 64 * (j))
#define XB_TOP      3328
#define XB_TOPGEN   3392
#define XCD_BAR_WORDS 3456
#define XB_SPIN_CAP (1u << 18)

__device__ __forceinline__ unsigned xb_ld(unsigned* p)              { return __hip_atomic_load(p, __ATOMIC_RELAXED, __HIP_MEMORY_SCOPE_AGENT); }
__device__ __forceinline__ unsigned xb_add(unsigned* p, unsigned v) { return __hip_atomic_fetch_add(p, v, __ATOMIC_RELAXED, __HIP_MEMORY_SCOPE_AGENT); }
__device__ __forceinline__ unsigned xb_xcc_id() { return (unsigned)__builtin_amdgcn_s_getreg((3 << 11) | 20) & 0xFu; }
#define XB_SPIN(cond, bar) do { unsigned _sp = 0; while (cond) { __builtin_amdgcn_s_sleep(1); \
    if ((++_sp & 255u) == 0u) { if (xb_ld(&(bar)[XB_TMO])) break; if (_sp > XB_SPIN_CAP) { atomicAdd(&(bar)[XB_TMO], 1u); break; } } } } while (0)

struct XcdBarrier {
    unsigned* bar; unsigned x;
    volatile LAS unsigned* st;
};

__device__ __forceinline__ XcdBarrier xcd_barrier_post(unsigned* bar, volatile LAS unsigned* st) {
    XcdBarrier b; b.bar = bar; b.x = xb_xcc_id(); b.st = st;
    if (threadIdx.x == 0) (void)xb_add(&bar[XB_XCNT(b.x)], 1u);
    return b;
}
__device__ __forceinline__ void xcd_barrier_complete(unsigned* bar, unsigned x, unsigned& nloc, unsigned& nx) {
    const unsigned G = gridDim.x * gridDim.y * gridDim.z;
    unsigned sum, cnt, mine, sp = 0u;
    for (;;) {
        sum = 0u; cnt = 0u; mine = 0u;
#pragma unroll
        for (unsigned j = 0; j < 16; ++j) { const unsigned c = xb_ld(&bar[XB_XCNT(j)]); sum += c; cnt += (c > 0u) ? 1u : 0u; mine = (j == x) ? c : mine; }
        if (sum == G) break;
        __builtin_amdgcn_s_sleep(1);
        if ((++sp & 255u) == 0u) { if (xb_ld(&bar[XB_TMO])) break; if (sp > XB_SPIN_CAP) { atomicAdd(&bar[XB_TMO], 1u); break; } }
    }
    nloc = mine > 0u ? mine : 1u; nx = cnt > 0u ? cnt : 1u;
}

__device__ __forceinline__ void xcd_barrier(const XcdBarrier& b) {
    asm volatile("s_waitcnt vmcnt(0)" ::: "memory");
    __syncthreads();
    if (threadIdx.x == 0) {
        unsigned* bar = b.bar;
        __builtin_amdgcn_s_waitcnt(0);
        unsigned nloc = b.st[0], nx = b.st[1];
        if (nloc == 0u) { xcd_barrier_complete(bar, b.x, nloc, nx); b.st[0] = nloc; b.st[1] = nx; }
        const unsigned old = xb_add(&bar[XB_XSUB(b.x)], 1u);
        const unsigned gen = old / nloc;
        if (old + 1u == (gen + 1u) * nloc) {
            __builtin_amdgcn_fence(__ATOMIC_RELEASE, "agent");
            asm volatile("s_waitcnt vmcnt(0)" ::: "memory");
            const unsigned og = xb_add(&bar[XB_TOP], 1u);
            const unsigned tg = og / nx;
            if (og + 1u == (tg + 1u) * nx) xb_add(&bar[XB_TOPGEN], 1u);
            else XB_SPIN(xb_ld(&bar[XB_TOPGEN]) == tg, bar);
            __builtin_amdgcn_fence(__ATOMIC_ACQUIRE, "agent");
            xb_add(&bar[XB_XGEN(b.x)], 1u);
            asm volatile("s_waitcnt vmcnt(0)" ::: "memory");
        } else {
            XB_SPIN(xb_ld(&bar[XB_XGEN(b.x)]) == gen, bar);
            __builtin_amdgcn_fence(__ATOMIC_ACQUIRE, "agent");
            asm volatile("s_waitcnt vmcnt(0)" ::: "memory");
        }
    }
    __syncthreads();
}
typedef __attribute__((address_space(1))) unsigned char g_u8;
__device__ __forceinline__ unsigned char* lau(unsigned char* p) { asm volatile("" : "+s"(p)); return (unsigned char*)(g_u8*)p; }
constexpr int NPHASE = 15;
constexpr int LDS_BYTES = 147456;
struct Args { const float* in[27]; float* out; unsigned char* ws; int ph_lo, ph_hi; };
__global__ void __launch_bounds__(512, 2) hybrid_fwd(Args args) {
    extern __shared__ __attribute__((aligned(16))) unsigned char lds_raw[];
    char* lds = (char*)lds_raw;
    LAS unsigned char* ldsl = (LAS unsigned char*)lds_raw;
    const int tid = threadIdx.x, wave = __builtin_amdgcn_readfirstlane(tid >> 6);
#define LANE_LOCAL int lane_ = threadIdx.x; asm volatile("" : "+v"(lane_)); const int lane = lane_ & 63;
    const int G = gridDim.x, bx = blockIdx.x, vcu = (G % 8 == 0) ? (bx % 8) * (G / 8) + bx / 8 : bx;
    unsigned char* ws = args.ws;
    const float* const* in = args.in;
#define mods ((float*)(ws + WS_MODS))
#define shwin ((float*)(ws + WS_SHWIN))
#define shwf ((float*)(ws + WS_SHWF))
#define ropeC ((float*)(ws + WS_ROPE))
#define ropeS ((float*)(ws + WS_ROPE + 4096))
#define c8 ((float*)(ws + WS_C8))
#define lamv ((float*)(ws + WS_LAM))
#define rowss ((float*)(ws + WS_ROWSS))
#define lrus ((float*)(ws + WS_LRUS))
#define xc ((float*)(ws + WS_XC))
#define AP ((bf16_t*)(ws + WS_AP))
#define Pb ((bf16_t*)(ws + WS_P))
#define Yb ((bf16_t*)(ws + WS_Y))
#define HM ((bf16_t*)(ws + WS_HMID))
#define WSP ((bf16_t*)(ws + WS_WSP))
#define WRG ((bf16_t*)(ws + WS_WRG))
    const int lo = args.ph_lo, hi_ = args.ph_hi;
    volatile LAS unsigned* MISC = (volatile LAS unsigned*)(ldsl + LDS_BYTES - 64);
    if (tid < 16) MISC[tid] = 0u;
    __syncthreads();
    XcdBarrier bar; bar.bar = (unsigned*)(ws + WS_CTL); bar.x = 0; bar.st = nullptr;
    if (hi_ - lo > 1) bar = xcd_barrier_post((unsigned*)(ws + WS_CTL), MISC);
#define IN(k) (lo <= (k) && (k) < hi_)
#define SEAM(k) do { if (IN(k) && IN((k) + 1)) { if ((k) == 0) cg::this_grid().sync(); else xcd_barrier(bar); } } while (0)

    if (EN(0) && IN(0)) {
        { LANE_LOCAL LAS float* scr = (LAS float*)(ldsl + wave * 16384);
          const int gw = vcu * 8 + wave, NGW = G * 8;
          constexpr int I_IN = 16 * 80, I_OUT = 16 * 32, I_G = 16 * 88, I_D = 44 * 32, I_L = I_IN + I_OUT + 2 * I_G + I_D;
          for (int it = gw; it < NLAYER * I_L; it += NGW) {
              const int l = it / I_L; int r = it - l * I_L;
              if (r < I_IN) { transpose_item(in[8] + (size_t)l * DM * PW, DM, PW, (bf16_t*)(ws + WS_WIN + l * SZ_WIN), 32 * (r % 80), scr, r / 80, r % 80, lane); continue; } r -= I_IN;
              if (r < I_OUT) { transpose_item(in[22] + (size_t)l * DM * DM, DM, DM, (bf16_t*)(ws + WS_WOUT + l * SZ_WOUT), 32 * (r % 32), scr, r / 32, r % 32, lane); continue; } r -= I_OUT;
              if (r < 2 * I_G) { const int up = r >= I_G; if (up) r -= I_G; const int nb = r % 88, n0 = 32 * nb;
                  transpose_item(in[up ? 24 : 23] + (size_t)l * DM * FH, DM, FH, (bf16_t*)(ws + WS_WFFN + l * SZ_WFFN), (n0 / 128) * 256 + (n0 % 128) + (up ? 128 : 0), scr, r / 88, nb, lane); continue; } r -= 2 * I_G;
              transpose_item(in[25] + (size_t)l * FH * DM, FH, DM, (bf16_t*)(ws + WS_WDN + l * SZ_WDN), 32 * (r % 32), scr, r / 32, r % 32, lane);
          }
        }
        { const int gt = vcu * 512 + tid, NT = G * 512;
          for (int i = gt; i < 131072; i += NT) WSP[i] = f2bf(in[20][i]);
          for (int i = gt; i < 131072; i += NT) { const int ii = i & 63, j = (i >> 6) & 63, h = (i >> 12) & 3, d = (i >> 14) & 1, mat = (i >> 15) & 1, l = i >> 16;
              WRG[i] = f2bf(in[mat ? 16 : 14][((((size_t)l * 2 + d) * 4 + h) * 64 + ii) * 64 + j]); }
          if (gt < 1024) { const int pos = gt >> 4, j = gt & 15; const float inv = powf(10000.f, -(float)j / 16.f); const float ang = (float)pos * inv; ropeC[gt] = cosf(ang); ropeS[gt] = sinf(ang);
              const float lv = in[18][gt]; c8[gt] = 8.f * log1pf(expf(-lv)); }
          if (gt < NLAYER) { float s0 = 0.f, s1 = 0.f; for (int k = 0; k < 64; ++k) { s0 += in[9][(gt * 2 + 0) * 64 + k] * in[10][(gt * 2 + 0) * 64 + k]; s1 += in[9][(gt * 2 + 1) * 64 + k] * in[10][(gt * 2 + 1) * 64 + k]; }
              lamv[gt] = expf(s0) - expf(s1) + (0.8f - 0.6f * expf(-0.3f * (float)gt)); }
        }
        __syncthreads();
        { LAS float* a_lds = (LAS float*)ldsl; LAS float* red = (LAS float*)(ldsl + 36864);
          for (int i = tid; i < NMS * 1024; i += 512) { const int ms = i >> 10, k = i & 1023; const float v = (ms < 8) ? in[1][ms * 1024 + k] : in[3][k]; a_lds[i] = silu_f(v); }
          __syncthreads();
          for (int it = vcu; it < NLAYER * 96; it += G) { const int l = it / 96, n0 = (it % 96) * 64;
              gemv_item(a_lds, red, in[4] + (size_t)l * DM * NMOD, NMOD, n0, mods + (size_t)l * NMS * NMOD, NMOD, n0, in[5] + (size_t)l * NMOD); }
        }
    }
    SEAM(0);
    if (EN(1) && IN(1)) {
        { LAS float* a_lds = (LAS float*)ldsl; LAS float* red = (LAS float*)(ldsl + 36864);
          for (int it = vcu; it < NLAYER * 128; it += G) { const int l = it / 128, r = it % 128; const int soff = (r < 40) ? 0 : 3 * DM;
              __syncthreads();
              for (int i = tid; i < NMS * 1024; i += 512) a_lds[i] = mods[((size_t)l * NMS + (i >> 10)) * NMOD + soff + (i & 1023)];
              __syncthreads();
              if (r < 40) gemv_item(a_lds, red, in[8] + (size_t)l * DM * PW, PW, r * 64, shwin + (size_t)l * NMS * PW, PW, r * 64, nullptr);
              else { const int up = r >= 84, nb = (r - 40) % 44, n0 = nb * 64;
                  gemv_item(a_lds, red, in[up ? 24 : 23] + (size_t)l * DM * FH, FH, n0, shwf + (size_t)l * NMS * NF, NF, (n0 / 128) * 256 + (n0 % 128) + (up ? 128 : 0), nullptr); } }
        }
        { LANE_LOCAL const int gw = vcu * 8 + wave, NGW = G * 8;
          for (int m = gw; m < MROWS; m += NGW) { const int b = m / TB, t = m - b * TB; const bool ctx = t < CTXL; const int ms = ctx ? 8 : b;
              const float* xr = ctx ? in[2] + ((size_t)b * CTXL + t) * DM : in[0] + ((size_t)b * SEQ + (t - CTXL)) * DM;
              f32x4 v[4]; float s = 0.f;
#pragma unroll
              for (int j = 0; j < 4; ++j) { v[j] = ((const f32x4*)xr)[lane + 64 * j]; s += (v[j].x * v[j].x + v[j].y * v[j].y) + (v[j].z * v[j].z + v[j].w * v[j].w); }
              s = wave_sum(s);
#pragma unroll
              for (int j = 0; j < 4; ++j) { const int col = 4 * lane + 256 * j; const f32x4 g = *(const f32x4*)(in[6] + col), sc = *(const f32x4*)(mods + (size_t)ms * NMOD + DM + col);
                  const f32x4 a = v[j] * g * (sc + 1.f); u32x2 w; w.x = cvtpk(a.x, a.y); w.y = cvtpk(a.z, a.w); *(u32x2*)(AP + (size_t)m * DM + col) = w; }
              if (lane < 16) rowss[(size_t)m * 16 + lane] = (lane == 0) ? s : 0.f; }
        }
    }
    SEAM(1);
#pragma unroll 1
    for (int l = 0; l < NLAYER; ++l) {
        const int pb = 2 + 6 * l; const bool last = (l == NLAYER - 1);
        const float* modl = mods + (size_t)l * NMS * NMOD;
        if (EN(2) && IN(pb)) {
            pg8::Gemm g{AP, (const bf16_t*)(ws + WS_WIN + l * SZ_WIN), MROWS, PW, DM}; pg8::Order S; S.init(MROWS / 256, PW, G, bx, 0);
            EpiInProj E{Pb, rowss, shwin + (size_t)l * NMS * PW, ropeC, ropeS};
            pg8::gemm_phase<EpiInProj, pg8::Order, true, true>(ldsl, g, S, E);
        }
        SEAM(pb);
        if (IN(pb + 1)) {
            if (EN(3)) for (int u = vcu; u < NB * NCHUNK; u += G)
                lru::lru_unit<false>(lds, Pb, Yb, u / NCHUNK, u % NCHUNK, in[12] + l * 1024, in[13] + l * 256, WRG + (size_t)l * 65536, in[15] + l * 512, in[17] + l * 512, c8 + l * 512, lrus);
            if (EN(4)) for (int u = G - 1 - vcu; u < NB * NCHUNK; u += G) { const int c = u % NCHUNK; if (last && c < 2) continue;
                sgu::sgu_unit(lds, Pb, Yb, u / NCHUNK, c, WSP + (size_t)l * 65536, in[19] + l * 256, in[21] + l * 512); }
            const float lam = lamv[l], li = 0.8f - 0.6f * __expf(-0.3f * (float)l);
            if (EN(5)) { const int nu = last ? NB * 4 * 16 : NB * 4 * 17;
#pragma unroll 1
                for (int rep_ = 0; rep_ < PROBE_ATTREP; ++rep_)
                for (int u = vcu; u < nu; u += G) { int bh, qb; if (u < NB * 4 * 16) { bh = u >> 4; qb = (u & 15) + 1; } else { bh = u - NB * 4 * 16; qb = 0; }
                    att::attn_unit(lds, Pb, Yb, bh >> 2, bh & 3, qb, lam, in[11] + l * 128, 1.f - li); } }
        }
        SEAM(pb + 1);
        if (EN(6) && IN(pb + 2)) {
            const int nu2 = last ? NB * 32 : NB * NCHUNK;
            for (int u = vcu; u < nu2; u += G) { const int b_ = last ? (u >> 5) : u / NCHUNK, c = last ? 2 + (u & 31) : u % NCHUNK;
                lru::lru_unit<true>(lds, Pb, Yb, b_, c, in[12] + l * 1024, in[13] + l * 256, WRG + (size_t)l * 65536, in[15] + l * 512, in[17] + l * 512, c8 + l * 512, lrus); }
        }
        SEAM(pb + 2);
        if (EN(7) && IN(pb + 3)) {
            pg8::Gemm g{Yb, (const bf16_t*)(ws + WS_WOUT + l * SZ_WOUT), MROWS, DM, DM}; pg8::Order S; S.init(last ? 128 : 136, DM, G, bx, last ? 1 : 0);
            EpiRes<0> E{l == 0 ? in[0] : args.out, l == 0 ? in[2] : xc, args.out, xc, modl + 2 * DM, nullptr, nullptr, in[7] + l * DM, modl + 4 * DM, AP, rowss, 1};
            pg8::gemm_phase<EpiRes<0>, pg8::Order, true, true>(ldsl, g, S, E);
        }
        SEAM(pb + 3);
        if (EN(8) && IN(pb + 4)) {
            pg8::Gemm g{AP, (const bf16_t*)(ws + WS_WFFN + l * SZ_WFFN), MROWS, NF, DM}; pg8::Order S; S.init(last ? 128 : 136, NF, G, bx, last ? 1 : 0);
            EpiSwiGLU E{HM, rowss, shwf + (size_t)l * NMS * NF};
            pg8::gemm_phase<EpiSwiGLU, pg8::Order, true, true>(ldsl, g, S, E);
        }
        SEAM(pb + 4);
        if (EN(9) && IN(pb + 5)) {
            pg8::Gemm g{HM, (const bf16_t*)(ws + WS_WDN + l * SZ_WDN), MROWS, DM, FH}; pg8::Order S; S.init(last ? 128 : 136, DM, G, bx, last ? 1 : 0);
            const int ln = last ? l : l + 1;
            EpiRes<1> E{args.out, xc, args.out, xc, modl + 5 * DM, in[7] + l * DM, modl + 4 * DM, in[6] + ln * DM, mods + (size_t)ln * NMS * NMOD + DM, AP, rowss, last ? 0 : 1};
            pg8::gemm_phase<EpiRes<1>, pg8::Order, true, true>(ldsl, g, S, E);
        }
        SEAM(pb + 5);
    }
    if (EN(10) && IN(14)) {
        LANE_LOCAL const int gw = vcu * 8 + wave, NGW = G * 8;
        for (int m = gw; m < NB * SEQ; m += NGW) { const int b = m / SEQ, t = m - b * SEQ; const size_t row = (size_t)b * TB + CTXL + t;
            const float rstd = row_rstd(rowss, row); f32x4* xr = (f32x4*)(args.out + (size_t)m * DM);
#pragma unroll
            for (int j = 0; j < 4; ++j) { const f32x4 g = *(const f32x4*)(in[26] + 4 * lane + 256 * j); xr[lane + 64 * j] = xr[lane + 64 * j] * rstd * g; } }
    }
#undef IN
#undef SEAM
#undef mods
#undef shwin
#undef shwf
#undef ropeC
#undef ropeS
#undef c8
#undef lamv
#undef rowss
#undef lrus
#undef xc
#undef AP
#undef Pb
#undef Yb
#undef HM
#undef WSP
#undef WRG
}

extern "C" void kernel_launch(void* const* d_in, const int* in_sizes, int n_in, void* d_out, int out_size, void* d_ws, size_t ws_size, hipStream_t stream) {
    static int grid = 0;
    if (grid == 0) {
        if (n_in != 27 || out_size != NB * SEQ * DM || ws_size < WS_TOTAL) { fprintf(stderr, "kernel_launch: unexpected shapes (n_in %d out %d ws %zu need %zu)\n", n_in, out_size, ws_size, (size_t)WS_END); grid = -1; return; }
        int dev = 0, cus = 0, per_cu = 0;
        (void)hipGetDevice(&dev); (void)hipDeviceGetAttribute(&cus, hipDeviceAttributeMultiprocessorCount, dev);
        if (hipFuncSetAttribute((const void*)hybrid_fwd, hipFuncAttributeMaxDynamicSharedMemorySize, LDS_BYTES) != hipSuccess) { fprintf(stderr, "kernel_launch: hipFuncSetAttribute failed\n"); grid = -1; return; }
        (void)hipOccupancyMaxActiveBlocksPerMultiprocessor(&per_cu, (const void*)hybrid_fwd, 512, LDS_BYTES);
        if (per_cu < 1) { fprintf(stderr, "kernel_launch: occupancy query says %d blocks per CU\n", per_cu); per_cu = 1; }
        (void)hipGetLastError();
        grid = cus;
    }
    if (grid < 0) return;
    if (hipMemsetAsync((char*)d_ws + WS_CTL, 0, WS_CTL_BYTES, stream) != hipSuccess) { fprintf(stderr, "kernel_launch: memset failed\n"); return; }
    Args a{};
    for (int i = 0; i < 27; ++i) a.in[i] = (const float*)d_in[i];
    a.out = (float*)d_out; a.ws = (unsigned char*)d_ws;
#if MK_SINGLE
    a.ph_lo = 0; a.ph_hi = NPHASE;
    { void* kargs[] = {&a}; hipError_t e = hipLaunchCooperativeKernel((const void*)hybrid_fwd, dim3(grid), dim3(512), kargs, LDS_BYTES, stream);
      if (e != hipSuccess) fprintf(stderr, "cooperative launch failed: %s (grid %d)\n", hipGetErrorString(e), grid); }
#else
    for (int pp = 0; pp < NPHASE + PROBE_NDUP; ++pp) { const int p = pp < NPHASE ? pp : PROBE_DUP0 + (pp - NPHASE) * PROBE_DUPSTEP; a.ph_lo = p; a.ph_hi = p + 1;
        void* kargs[] = {&a}; hipError_t e = hipLaunchCooperativeKernel((const void*)hybrid_fwd, dim3(grid), dim3(512), kargs, LDS_BYTES, stream);
        if (e != hipSuccess) { fprintf(stderr, "cooperative launch %d failed: %s (grid %d)\n", p, hipGetErrorString(e), grid); break; } }
#endif
}
```

```cpp
#include <hip/hip_runtime.h>
#include <hip/hip_cooperative_groups.h>
#include <cstdio>
#include <cstdint>
namespace cg = cooperative_groups;

#ifndef MK_SINGLE
#define MK_SINGLE 1
#endif
#ifndef PH_MASK
#define PH_MASK 0xFFFF
#endif
#define EN(k) (((PH_MASK) >> (k)) & 1)
#ifndef PROBE_NDUP
#define PROBE_NDUP 0
#define PROBE_DUP0 0
#define PROBE_DUPSTEP 6
#endif
#ifndef PROBE_ATTREP
#define PROBE_ATTREP 1
#endif
#ifndef ATT_VAR
#define ATT_VAR 0
#endif

constexpr int NB = 8, SEQ = 4096, CTXL = 256, TB = SEQ + CTXL, MROWS = NB * TB, DM = 1024, PW = 2560, FH = 2816, NF = 2 * FH, NLAYER = 2;
constexpr int Q0c = 0, K0c = 512, V0c = 1024, LX0 = 1536, LG0 = 1792, SU0 = 2048, SV0 = 2304;
constexpr int NMS = 9, NMOD = 6 * DM;
constexpr int NCHUNK = TB / 128;
constexpr size_t SZ_WIN = (size_t)PW * DM * 2, SZ_WOUT = (size_t)DM * DM * 2, SZ_WFFN = (size_t)NF * DM * 2, SZ_WDN = (size_t)DM * FH * 2;
constexpr size_t WS_WIN = 0, WS_WOUT = WS_WIN + 2 * SZ_WIN, WS_WFFN = WS_WOUT + 2 * SZ_WOUT, WS_WDN = WS_WFFN + 2 * SZ_WFFN;
constexpr size_t WS_WSP = WS_WDN + 2 * SZ_WDN;
constexpr size_t WS_WRG = WS_WSP + 262144;
constexpr size_t WS_MODS = WS_WRG + 262144;
constexpr size_t WS_SHWIN = WS_MODS + 442368;
constexpr size_t WS_SHWF = WS_SHWIN + 184320;
constexpr size_t WS_ROPE = WS_SHWF + 405504;
constexpr size_t WS_C8 = WS_ROPE + 8192;
constexpr size_t WS_LAM = WS_C8 + 4096;
constexpr size_t WS_ROWSS = WS_LAM + 256;
constexpr size_t WS_LRUS = WS_ROWSS + (size_t)MROWS * 64;
constexpr size_t WS_XC = WS_LRUS + (size_t)NB * NCHUNK * 2 * 2 * 256 * 4;
constexpr size_t WS_AP = WS_XC + (size_t)NB * CTXL * DM * 4;
constexpr size_t WS_P = WS_AP + (size_t)MROWS * DM * 2;
constexpr size_t WS_Y = WS_P + (size_t)MROWS * PW * 2;
constexpr size_t WS_END = WS_Y + (size_t)MROWS * DM * 2;
constexpr size_t WS_CTL = WS_END, WS_CTL_BYTES = 16384, WS_TOTAL = WS_END + WS_CTL_BYTES;
constexpr size_t WS_HMID = WS_P;
static_assert((size_t)MROWS * FH * 2 <= WS_END - WS_P, "hmid overlay");
static_assert(WS_WSP % 256 == 0 && WS_MODS % 256 == 0 && WS_ROWSS % 256 == 0 && WS_XC % 256 == 0 && WS_AP % 256 == 0 && WS_P % 256 == 0, "align");

#define LAS __attribute__((address_space(3)))
typedef float f32x2 __attribute__((ext_vector_type(2)));
typedef unsigned u32x2 __attribute__((ext_vector_type(2)));
__device__ __forceinline__ unsigned cvtpk(float lo, float hi) { unsigned r; asm("v_cvt_pk_bf16_f32 %0, %1, %2" : "=v"(r) : "v"(lo), "v"(hi)); return r; }
__device__ __forceinline__ float bflo(unsigned w) { return __uint_as_float(w << 16); }
__device__ __forceinline__ float bfhi(unsigned w) { return __uint_as_float(w & 0xffff0000u); }
__device__ __forceinline__ float bf2f(unsigned short h) { return __uint_as_float((unsigned)h << 16); }
__device__ __forceinline__ unsigned short f2bf(float v) { return (unsigned short)(cvtpk(v, v) & 0xffffu); }
__device__ __forceinline__ float fexp(float x) { return __builtin_amdgcn_exp2f(x * 1.4426950408889634f); }
__device__ __forceinline__ float gelu_tanh(float x) { const float u = 1.5957691216f * x * (1.f + 0.044715f * x * x); return x * __builtin_amdgcn_rcpf(1.f + fexp(-u)); }
__device__ __forceinline__ float silu_f(float x) { return x * __builtin_amdgcn_rcpf(1.f + fexp(-x)); }
__device__ __forceinline__ float sigm(float x) { return __builtin_amdgcn_rcpf(1.f + fexp(-x)); }

namespace pg8 {
#define PG8_LAS __attribute__((address_space(3)))
typedef unsigned short bf16_t;
typedef short bf16x8 __attribute__((ext_vector_type(8)));
typedef float f32x4 __attribute__((ext_vector_type(4)));
typedef unsigned u32x4 __attribute__((ext_vector_type(4)));
constexpr int BM = 256, BK = 64, HALF = 128, HTB = HALF * BK * 2  , STAGE_BYTES = 8 * HTB, NXCD = 8, WGM = 8;

__host__ __device__ __forceinline__ int lds_byte(int r, int c) { const int st = (r >> 4) * 2 + (c >> 5), rr = r & 15, cc = c & 31, ob = rr * 64 + cc * 2; return st * 1024 + (ob ^ (((ob >> 9) & 1) << 5)); }
__host__ __device__ __forceinline__ void stage_rc(int b, int& R, int& C) { const int st = b / 1024, sb = b % 1024, swz = sb ^ (((sb >> 9) & 1) << 5); R = (st >> 1) * 16 + swz / 64; C = (st & 1) * 32 + (swz % 64) / 2; }
__host__ __device__ __forceinline__ int perm32(int rho) { const int n = rho >> 4, i = rho & 15; return 8 * (i >> 2) + 4 * n + (i & 3); }

struct Unit { int pm, pn; };
struct Gemm { const bf16_t* A; const bf16_t* Bt; int M, N, K; };

struct StaticOrder {
    int nM, nN, nwg, G, c;
    __host__ __device__ void init(int M, int N, int G_, int c_) { nM = M / BM; nN = N / BM; nwg = nM * nN; G = G_; c = c_; }
    __host__ __device__ bool next(int i, Unit& u) const {
        const long L = (long)i * G + c; if (L >= nwg) return false;
        int wgid = (int)L; { const int q = nwg / NXCD, r = nwg % NXCD, xcd = wgid % NXCD, off = wgid / NXCD; wgid = (xcd < r ? xcd * (q + 1) : r * (q + 1) + (xcd - r) * q) + off; }
        const int nig = WGM * nN, gid = wgid / nig, fm = gid * WGM, gsz = (nM - fm) < WGM ? (nM - fm) : WGM;
        u.pm = fm + ((wgid % nig) % gsz); u.pn = (wgid % nig) / gsz; return true;
    }
    __device__ __forceinline__ void a_ready(const Unit&) const {}
    __device__ __forceinline__ void done(const Unit&) const {}
};

}
namespace pg8 {
template <class Epi, class Sched, bool ALIGN_EPI = false, bool SP2 = false>
__device__ __forceinline__ void gemm_phase(PG8_LAS unsigned char* lds, const Gemm g, const Sched& S, const Epi& E) {
    int tid_ = threadIdx.x; asm volatile("" : "+v"(tid_));
    const int tid = tid_, wid = __builtin_amdgcn_readfirstlane(tid >> 6), lane = tid & 63, wr = wid >> 2, wc = wid & 3, fr = lane & 15, fq = lane >> 4;
    const int K = g.K, nt = K / BK;
    unsigned voffA[2], voffB[2];
#pragma unroll
    for (int i = 0; i < 2; ++i) { int R, C; stage_rc(tid * 16 + i * 8192, R, C); const int Rb = Epi::PERM ? ((R & ~31) + perm32(R & 31)) : R;
        voffA[i] = (unsigned)(R * K + C) * 2u; voffB[i] = (unsigned)(Rb * K + C) * 2u; }
    const size_t kstep = (size_t)(BK * 2);
    const size_t hstep = (size_t)HALF * K * 2;
    const size_t tstep = 2 * hstep;
    const unsigned ldsw = (unsigned)wid * 1024u;
    const int aoff = lds_byte(wr * 64 + fr, fq * 8), boff = lds_byte(wc * 32 + fr, fq * 8);
#define PG8_SA(b, h) (((b) * 2 + (h)) * HTB)
#define PG8_SB(b, h) ((4 + (b) * 2 + (h)) * HTB)
#define PG8_STAGE(bufoff, gbase, voff) do { _Pragma("unroll") for (int _i = 0; _i < 2; ++_i) \
        __builtin_amdgcn_global_load_lds((const unsigned*)((const char*)(gbase) + (voff)[_i]), (PG8_LAS unsigned*)(lds + (bufoff) + ldsw + _i * 8192), 16, 0, 0); } while (0)
#define PG8_LDA(dst, b, h) do { _Pragma("unroll") for (int m = 0; m < 4; ++m) _Pragma("unroll") for (int k = 0; k < 2; ++k) dst[m][k] = *(const PG8_LAS bf16x8*)(lds + PG8_SA(b, h) + aoff + m * 2048 + k * 1024); } while (0)
#define PG8_LDB(dst, b, h) do { _Pragma("unroll") for (int n = 0; n < 2; ++n) _Pragma("unroll") for (int k = 0; k < 2; ++k) dst[n][k] = *(const PG8_LAS bf16x8*)(lds + PG8_SB(b, h) + boff + n * 2048 + k * 1024); } while (0)
#define PG8_MMA(ai, bj, At, Bt) do { __builtin_amdgcn_s_setprio(1); _Pragma("unroll") for (int m = 0; m < 4; ++m) _Pragma("unroll") for (int n = 0; n < 2; ++n) _Pragma("unroll") for (int k = 0; k < 2; ++k) \
        acc[ai][bj][m][n] = __builtin_amdgcn_mfma_f32_16x16x32_bf16(Bt[n][k], At[m][k], acc[ai][bj][m][n], 0, 0, 0); __builtin_amdgcn_s_setprio(0); } while (0)
#define PG8_WAIT_V(n) asm volatile("s_waitcnt vmcnt(" #n ")" ::: "memory")
#define PG8_WAIT_L(n) asm volatile("s_waitcnt lgkmcnt(" #n ")" ::: "memory")
#define PG8_BAR __builtin_amdgcn_s_barrier()
#define PG8_SCHED __builtin_amdgcn_sched_barrier(0)
    Unit cur, nxt; int ui = 0;
    if (!S.next(0, cur)) return;
    f32x4 acc[2][2][4][2];
#pragma unroll
    for (int a = 0; a < 2; ++a)
#pragma unroll
        for (int b = 0; b < 2; ++b)
#pragma unroll
            for (int m = 0; m < 4; ++m)
#pragma unroll
                for (int n = 0; n < 2; ++n) acc[a][b][m][n] = (f32x4){0.f, 0.f, 0.f, 0.f};
    bf16x8 At[4][2], B0[2][2], B1[2][2];
    const char* cA = (const char*)g.A + (size_t)cur.pm * tstep; const char* cB = (const char*)g.Bt + (size_t)cur.pn * tstep;
    S.a_ready(cur);
    if constexpr (SP2) {
        PG8_STAGE(PG8_SB(0, 0), cB, voffB); PG8_STAGE(PG8_SB(0, 1), cB + hstep, voffB); PG8_STAGE(PG8_SA(0, 0), cA, voffA); PG8_STAGE(PG8_SA(0, 1), cA + hstep, voffA);
        if (wr == 1) PG8_BAR;
        PG8_WAIT_V(2); PG8_BAR;
        PG8_STAGE(PG8_SB(1, 0), cB + kstep, voffB); PG8_STAGE(PG8_SA(1, 0), cA + kstep, voffA); PG8_STAGE(PG8_SB(1, 1), cB + hstep + kstep, voffB);
        PG8_WAIT_V(6); PG8_BAR;
    } else {
        PG8_STAGE(PG8_SB(0, 0), cB, voffB); PG8_STAGE(PG8_SA(0, 0), cA, voffA); PG8_STAGE(PG8_SB(0, 1), cB + hstep, voffB); PG8_STAGE(PG8_SA(0, 1), cA + hstep, voffA);
        if (wr == 1) PG8_BAR;
        PG8_WAIT_V(4); PG8_BAR;
        PG8_STAGE(PG8_SB(1, 0), cB + kstep, voffB); PG8_STAGE(PG8_SA(1, 0), cA + kstep, voffA); PG8_STAGE(PG8_SB(1, 1), cB + hstep + kstep, voffB);
        PG8_WAIT_V(6); PG8_BAR;
    }
    for (;;) {
        const bool has_next = S.next(ui + 1, nxt);
        const char* nA = has_next ? (const char*)g.A + (size_t)nxt.pm * tstep : cA; const char* nB = has_next ? (const char*)g.Bt + (size_t)nxt.pn * tstep : cB;
        for (int t = 0; t < nt; t += 2) {
            const bool last = (t == nt - 2);
            const char* a1 = cA + (size_t)(t + 1) * kstep;
            const char* a2 = last ? nA : cA + (size_t)(t + 2) * kstep; const char* b2 = last ? nB : cB + (size_t)(t + 2) * kstep;
            const char* a3 = a2 + kstep; const char* b3 = b2 + kstep;
            if (last && has_next) S.a_ready(nxt);
            if constexpr (SP2) {
            PG8_LDB(B0, 0, 0); PG8_LDB(B1, 0, 1); PG8_SCHED; PG8_LDA(At, 0, 0); PG8_STAGE(PG8_SA(1, 1), a1 + hstep, voffA);
            PG8_WAIT_V(8); PG8_WAIT_L(0); PG8_BAR; PG8_MMA(0, 0, At, B0); PG8_MMA(0, 1, At, B1); PG8_BAR; PG8_SCHED;
            PG8_LDA(At, 0, 1); PG8_STAGE(PG8_SB(0, 0), b2, voffB); PG8_STAGE(PG8_SB(0, 1), b2 + hstep, voffB); PG8_STAGE(PG8_SA(0, 0), a2, voffA);
            PG8_WAIT_V(8); PG8_WAIT_L(0); PG8_BAR; PG8_MMA(1, 0, At, B0); PG8_MMA(1, 1, At, B1); PG8_BAR; PG8_SCHED;
            PG8_LDB(B0, 1, 0); PG8_LDB(B1, 1, 1); PG8_SCHED; PG8_LDA(At, 1, 0); PG8_STAGE(PG8_SA(0, 1), a2 + hstep, voffA);
            PG8_WAIT_V(8); PG8_WAIT_L(0); PG8_BAR; PG8_MMA(0, 0, At, B0); PG8_MMA(0, 1, At, B1); PG8_BAR; PG8_SCHED;
            PG8_LDA(At, 1, 1); PG8_STAGE(PG8_SB(1, 0), b3, voffB); PG8_STAGE(PG8_SB(1, 1), b3 + hstep, voffB); PG8_STAGE(PG8_SA(1, 0), a3, voffA);
            PG8_WAIT_V(8); PG8_WAIT_L(0); PG8_BAR; PG8_MMA(1, 0, At, B0); PG8_MMA(1, 1, At, B1); PG8_BAR; PG8_SCHED;
            } else {
            PG8_LDB(B0, 0, 0); PG8_SCHED; PG8_LDA(At, 0, 0); PG8_STAGE(PG8_SA(1, 1), a1 + hstep, voffA);
            PG8_WAIT_L(8); PG8_BAR; PG8_WAIT_L(0); PG8_MMA(0, 0, At, B0); PG8_BAR; PG8_SCHED;
            PG8_LDB(B1, 0, 1); PG8_STAGE(PG8_SB(0, 0), b2, voffB);
            PG8_BAR; PG8_WAIT_L(0); PG8_MMA(0, 1, At, B1); PG8_BAR;
            PG8_LDA(At, 0, 1); PG8_STAGE(PG8_SA(0, 0), a2, voffA);
            PG8_BAR; PG8_WAIT_L(0); PG8_MMA(1, 0, At, B0); PG8_BAR; PG8_SCHED;
            PG8_STAGE(PG8_SB(0, 1), b2 + hstep, voffB);
            PG8_WAIT_V(6); PG8_BAR; PG8_MMA(1, 1, At, B1); PG8_BAR;
            PG8_LDB(B0, 1, 0); PG8_SCHED; PG8_LDA(At, 1, 0); PG8_STAGE(PG8_SA(0, 1), a2 + hstep, voffA);
            PG8_WAIT_L(8); PG8_BAR; PG8_WAIT_L(0); PG8_MMA(0, 0, At, B0); PG8_BAR; PG8_SCHED;
            PG8_LDB(B1, 1, 1); PG8_STAGE(PG8_SB(1, 0), b3, voffB);
            PG8_BAR; PG8_WAIT_L(0); PG8_MMA(0, 1, At, B1); PG8_BAR;
            PG8_LDA(At, 1, 1); PG8_STAGE(PG8_SA(1, 0), a3, voffA);
            PG8_BAR; PG8_WAIT_L(0); PG8_MMA(1, 0, At, B0); PG8_BAR; PG8_SCHED;
            PG8_STAGE(PG8_SB(1, 1), b3 + hstep, voffB);
            PG8_WAIT_V(6); PG8_BAR; PG8_MMA(1, 1, At, B1); PG8_BAR;
            }
        }
        if constexpr (ALIGN_EPI) { if (wr == 0) PG8_BAR; }
        if constexpr (!Epi::AFTER_DRAIN) { E(acc, cur, wr, wc, fr, fq); S.done(cur); }
        if (!has_next) break;
#pragma unroll
        for (int a = 0; a < 2; ++a)
#pragma unroll
            for (int b = 0; b < 2; ++b)
#pragma unroll
                for (int m = 0; m < 4; ++m)
#pragma unroll
                    for (int n = 0; n < 2; ++n) acc[a][b][m][n] = (f32x4){0.f, 0.f, 0.f, 0.f};
        cur = nxt; cA = nA; cB = nB; ++ui;
        if constexpr (ALIGN_EPI) { if (wr == 1) PG8_BAR; }
    }
    PG8_WAIT_V(0);
    if constexpr (!ALIGN_EPI) { if (wr == 0) PG8_BAR; }
    PG8_BAR;
    if constexpr (Epi::AFTER_DRAIN) { E.fused(acc, cur, wr, wc, fr, fq, lds, wid, lane); S.done(cur); }
#undef PG8_SA
#undef PG8_SB
#undef PG8_STAGE
#undef PG8_LDA
#undef PG8_LDB
#undef PG8_MMA
#undef PG8_WAIT_V
#undef PG8_WAIT_L
#undef PG8_BAR
#undef PG8_SCHED
}
}
namespace pg8 {
struct Order {
    int nM, nN, nwg, G, c, skip;
    __device__ void init(int nM_, int N, int G_, int c_, int skip_) { nM = nM_; nN = N / BM; nwg = nM * nN; G = G_; c = c_; skip = skip_; }
    __device__ bool next(int i, Unit& u) const {
        const long L = (long)i * G + c; if (L >= nwg) return false;
        int wgid = (int)L; { const int q = nwg / NXCD, r = nwg % NXCD, xcd = wgid % NXCD, off = wgid / NXCD; wgid = (xcd < r ? xcd * (q + 1) : r * (q + 1) + (xcd - r) * q) + off; }
        const int nig = WGM * nN, gid = wgid / nig, fm = gid * WGM, gsz = (nM - fm) < WGM ? (nM - fm) : WGM;
        u.pm = fm + ((wgid % nig) % gsz); u.pn = (wgid % nig) / gsz;
        if (skip) u.pm = u.pm + u.pm / 16 + 1;
        return true;
    }
    __device__ __forceinline__ void a_ready(const Unit&) const {}
    __device__ __forceinline__ void done(const Unit&) const {}
};
}

using pg8::f32x4; using pg8::u32x4; using pg8::bf16_t; using pg8::bf16x8;
__device__ __forceinline__ float row_rstd(const float* rowss, size_t row) {
    const f32x4* rs = (const f32x4*)(rowss + row * 16);
    const f32x4 s4 = (rs[0] + rs[1]) + (rs[2] + rs[3]);
    return rsqrtf(((s4.x + s4.y) + (s4.z + s4.w)) * (1.f / 1024.f) + 1e-6f);
}
__device__ __forceinline__ void rows_rstd(const float* rowss, int pm, int wr, int fr, float (&rstd)[2][4]) {
#pragma unroll
    for (int ai = 0; ai < 2; ++ai)
#pragma unroll
      for (int mh = 0; mh < 2; ++mh) { f32x4 t[2][4];
#pragma unroll
        for (int m2 = 0; m2 < 2; ++m2) { const f32x4* rs = (const f32x4*)(rowss + ((size_t)pm * 256 + ai * 128 + wr * 64 + (mh * 2 + m2) * 16 + fr) * 16);
#pragma unroll
            for (int k = 0; k < 4; ++k) t[m2][k] = rs[k]; }
        asm volatile("" ::: "memory");
#pragma unroll
        for (int m2 = 0; m2 < 2; ++m2) { const f32x4 s4 = (t[m2][0] + t[m2][1]) + (t[m2][2] + t[m2][3]); rstd[ai][mh * 2 + m2] = rsqrtf(((s4.x + s4.y) + (s4.z + s4.w)) * (1.f / 1024.f) + 1e-6f); } }
}
struct EpiInProj {
    static constexpr bool PERM = false, AFTER_DRAIN = false;
    bf16_t* P; const float* rowss; const float* sW; const float* ropeC; const float* ropeS;
    __device__ __forceinline__ void operator()(const f32x4 (&acc)[2][2][4][2], const pg8::Unit& u, int wr, int wc, int fr, int fq) const {
        const int b = u.pm / 17, j17 = u.pm - b * 17; const bool ctx = (j17 == 0); const int ms = ctx ? 8 : b;
        const int colb = u.pn * 256 + wc * 32 + 4 * fq;
        const int mode = (u.pn < 4) ? (ctx ? 0 : 1) : (u.pn >= 7 ? 2 : 0);
        f32x4 bv[2][2];
#pragma unroll
        for (int bj = 0; bj < 2; ++bj)
#pragma unroll
            for (int n = 0; n < 2; ++n) bv[bj][n] = *(const f32x4*)(sW + ms * PW + colb + bj * 128 + n * 16);
#pragma unroll
        for (int ai = 0; ai < 2; ++ai) {
#pragma unroll
            for (int m = 0; m < 4; ++m) {
                const int rt = ai * 128 + wr * 64 + m * 16 + fr; const size_t row = (size_t)u.pm * 256 + rt;
                float rstd;
                { const f32x4* rs = (const f32x4*)(rowss + row * 16); const f32x4 t0 = rs[0], t1 = rs[1], t2 = rs[2], t3 = rs[3];
                  const f32x4 s4 = (t0 + t1) + (t2 + t3); rstd = rsqrtf(((s4.x + s4.y) + (s4.z + s4.w)) * (1.f / 1024.f) + 1e-6f); }
                f32x4 v[2][2];
#pragma unroll
                for (int bj = 0; bj < 2; ++bj)
#pragma unroll
                    for (int n = 0; n < 2; ++n) v[bj][n] = acc[ai][bj][m][n] * rstd + bv[bj][n];
                if (mode == 1) {
                    const int tl = (j17 - 1) * 256 + rt; const int pos = (wc & 1) ? (tl & 63) : (tl >> 6);
                    const f32x4 c4 = *(const f32x4*)(ropeC + pos * 16 + 4 * fq), s4 = *(const f32x4*)(ropeS + pos * 16 + 4 * fq);
#pragma unroll
                    for (int bj = 0; bj < 2; ++bj) { const f32x4 x1 = v[bj][0], x2 = v[bj][1]; v[bj][0] = x1 * c4 - x2 * s4; v[bj][1] = x1 * s4 + x2 * c4; }
                } else if (mode == 2) {
#pragma unroll
                    for (int bj = 0; bj < 2; ++bj)
#pragma unroll
                        for (int n = 0; n < 2; ++n) { f32x4 t = v[bj][n]; t.x = gelu_tanh(t.x); t.y = gelu_tanh(t.y); t.z = gelu_tanh(t.z); t.w = gelu_tanh(t.w); v[bj][n] = t; }
                }
                bf16_t* rp = P + row * PW + colb;
#pragma unroll
                for (int bj = 0; bj < 2; ++bj)
#pragma unroll
                    for (int n = 0; n < 2; ++n) { u32x2 w; w.x = cvtpk(v[bj][n].x, v[bj][n].y); w.y = cvtpk(v[bj][n].z, v[bj][n].w); *(u32x2*)(rp + bj * 128 + n * 16) = w; }
            }
        }
    }
};
struct EpiSwiGLU {
    static constexpr bool PERM = true, AFTER_DRAIN = false;
    bf16_t* H; const float* rowss; const float* sW;
    __device__ __forceinline__ void operator()(const f32x4 (&acc)[2][2][4][2], const pg8::Unit& u, int wr, int wc, int fr, int fq) const {
        const int b = u.pm / 17, j17 = u.pm - b * 17; const int ms = (j17 == 0) ? 8 : b;
        const int colb = wc * 32 + 8 * fq;
        f32x4 bg[2], bu[2];
#pragma unroll
        for (int n = 0; n < 2; ++n) { bg[n] = *(const f32x4*)(sW + ms * NF + u.pn * 256 + colb + 4 * n); bu[n] = *(const f32x4*)(sW + ms * NF + u.pn * 256 + 128 + colb + 4 * n); }
        float rstd_[2][4]; rows_rstd(rowss, u.pm, wr, fr, rstd_);
#pragma unroll
        for (int ai = 0; ai < 2; ++ai)
#pragma unroll
            for (int m = 0; m < 4; ++m) {
                const int rt = ai * 128 + wr * 64 + m * 16 + fr; const size_t row = (size_t)u.pm * 256 + rt;
                const float rstd = rstd_[ai][m];
                f32x4 hm[2];
#pragma unroll
                for (int n = 0; n < 2; ++n) { const f32x4 g = acc[ai][0][m][n] * rstd + bg[n], up = acc[ai][1][m][n] * rstd + bu[n];
                    hm[n].x = silu_f(g.x) * up.x; hm[n].y = silu_f(g.y) * up.y; hm[n].z = silu_f(g.z) * up.z; hm[n].w = silu_f(g.w) * up.w; }
                u32x4 w; w.x = cvtpk(hm[0].x, hm[0].y); w.y = cvtpk(hm[0].z, hm[0].w); w.z = cvtpk(hm[1].x, hm[1].y); w.w = cvtpk(hm[1].z, hm[1].w);
                *(u32x4*)(H + row * FH + u.pn * 128 + colb) = w;
            }
    }
};
template <int MODE> struct EpiRes {
    static constexpr bool PERM = true, AFTER_DRAIN = false;
    const float* xin_lat; const float* xin_ctx; float* xo_lat; float* xo_ctx;
    const float* gate; const float* gp; const float* scp;
    const float* gn; const float* scn; bf16_t* A; float* rowss; int write_a; int xbf;
    __device__ __forceinline__ void operator()(const f32x4 (&acc)[2][2][4][2], const pg8::Unit& u, int wr, int wc, int fr, int fq) const {
        const int b = u.pm / 17, j17 = u.pm - b * 17; const bool ctx = (j17 == 0); const int ms = ctx ? 8 : b;
        const float* xi = ctx ? xin_ctx + (size_t)b * CTXL * DM : xin_lat + ((size_t)b * SEQ + (size_t)(j17 - 1) * 256) * DM;
        float* xo = ctx ? xo_ctx + (size_t)b * CTXL * DM : xo_lat + ((size_t)b * SEQ + (size_t)(j17 - 1) * 256) * DM;
        const int colb = u.pn * 256 + wc * 32 + 8 * fq;
        float ss[2][4];
#pragma unroll
        for (int ai = 0; ai < 2; ++ai)
#pragma unroll
            for (int m = 0; m < 4; ++m) ss[ai][m] = 0.f;
#pragma unroll
        for (int bj = 0; bj < 2; ++bj) {
            const int col = colb + bj * 128;
            f32x4 gv[2], fc[2], rf[2];
#pragma unroll
            for (int n = 0; n < 2; ++n) { gv[n] = *(const f32x4*)(gate + ms * NMOD + col + 4 * n);
                if (write_a) fc[n] = *(const f32x4*)(gn + col + 4 * n) * (*(const f32x4*)(scn + ms * NMOD + col + 4 * n) + 1.f); else fc[n] = (f32x4){0.f, 0.f, 0.f, 0.f};
                if (MODE == 1) { const f32x4 f = *(const f32x4*)(gp + col + 4 * n) * (*(const f32x4*)(scp + ms * NMOD + col + 4 * n) + 1.f);
                    rf[n].x = __builtin_amdgcn_rcpf(f.x); rf[n].y = __builtin_amdgcn_rcpf(f.y); rf[n].z = __builtin_amdgcn_rcpf(f.z); rf[n].w = __builtin_amdgcn_rcpf(f.w); } }
#pragma unroll
            for (int ai = 0; ai < 2; ++ai) {
                f32x4 xl[4][2];
#pragma unroll
                for (int m = 0; m < 4; ++m) { const int rt = ai * 128 + wr * 64 + m * 16 + fr;
                    if (MODE == 0) { const unsigned xo4 = ((unsigned)rt * DM + (unsigned)col) * 4u;
#pragma unroll
                        for (int n = 0; n < 2; ++n) xl[m][n] = *(const f32x4*)((const char*)xi + (xo4 + 16u * n)); }
                    else { const u32x4 w = *(const u32x4*)((const char*)A + (((unsigned)u.pm * 256u + (unsigned)rt) * DM + (unsigned)col) * 2u);
                        xl[m][0] = (f32x4){bflo(w.x), bfhi(w.x), bflo(w.y), bfhi(w.y)} * rf[0]; xl[m][1] = (f32x4){bflo(w.z), bfhi(w.z), bflo(w.w), bfhi(w.w)} * rf[1]; } }
                asm volatile("" ::: "memory");
#pragma unroll
                for (int m = 0; m < 4; ++m) {
                    const int rt = ai * 128 + wr * 64 + m * 16 + fr;
                    const unsigned xo4 = ((unsigned)rt * DM + (unsigned)col) * 4u;
                    f32x4 xv[2];
#pragma unroll
                    for (int n = 0; n < 2; ++n) { xv[n] = xl[m][n] + gv[n] * acc[ai][bj][m][n];
                        if (MODE == 1 && !xbf) *(f32x4*)((char*)xo + (xo4 + 16u * n)) = xv[n];
                        ss[ai][m] += (xv[n].x * xv[n].x + xv[n].y * xv[n].y) + (xv[n].z * xv[n].z + xv[n].w * xv[n].w); }
                    if (MODE == 1 && xbf) { u32x4 w; w.x = cvtpk(xv[0].x, xv[0].y); w.y = cvtpk(xv[0].z, xv[0].w); w.z = cvtpk(xv[1].x, xv[1].y); w.w = cvtpk(xv[1].z, xv[1].w);
                        *(u32x4*)((char*)xo + ((unsigned)rt * (DM * 4u) + (unsigned)col * 2u)) = w; }
                    if (write_a) { const f32x4 a0 = xv[0] * fc[0], a1 = xv[1] * fc[1];
                        u32x4 w; w.x = cvtpk(a0.x, a0.y); w.y = cvtpk(a0.z, a0.w); w.z = cvtpk(a1.x, a1.y); w.w = cvtpk(a1.z, a1.w);
                        *(u32x4*)((char*)A + (((unsigned)u.pm * 256u + (unsigned)rt) * DM + (unsigned)col) * 2u) = w; }
                }
            }
        }
#pragma unroll
        for (int ai = 0; ai < 2; ++ai)
#pragma unroll
            for (int m = 0; m < 4; ++m) { float s = ss[ai][m]; s += __shfl_xor(s, 16); s += __shfl_xor(s, 32);
                if (fq == 0) rowss[((size_t)u.pm * 256 + ai * 128 + wr * 64 + m * 16 + fr) * 16 + u.pn * 4 + wc] = s; }
    }
};
namespace att {
using s16x4 = __attribute__((ext_vector_type(4))) short;
using f32x16 = __attribute__((ext_vector_type(16))) float;
constexpr int SHM_V = 16384, SHM_K = 8192, OFF_V = 0, OFF_K = 32768, OFF_WS = 49152, OFF_ST = 51200, LDS_TOTAL = OFF_ST + 65536;
constexpr float SCALE = 0.125f, THR = 8.f;
#define KSWZ(row, colB) ((row) * 128 + ((colB) ^ (((row) & 7) << 4)))
#define SBAR() __builtin_amdgcn_sched_barrier(0)
__device__ __forceinline__ int crow(int r, int hi) { return (r & 3) + 8 * (r >> 2) + 4 * hi; }
__device__ __forceinline__ void partialSM(f32x16& p0, f32x16& p1, float& m_reg, float& mn, float& alpha) {
  constexpr float C = SCALE * 1.4426950408889634f;
  float pmax = p0[0];
#pragma unroll
  for (int r = 1; r < 16; ++r) pmax = fmaxf(pmax, p0[r]);
#pragma unroll
  for (int r = 0; r < 16; ++r) pmax = fmaxf(pmax, p1[r]);
  { auto rr = __builtin_amdgcn_permlane32_swap(__float_as_uint(pmax), __float_as_uint(pmax), false, false);
    pmax = fmaxf(__uint_as_float(rr[0]), __uint_as_float(rr[1])); }
  if (__builtin_expect(__all(pmax - m_reg <= THR / SCALE), 1)) { mn = m_reg; alpha = 1.f; }
  else { mn = fmaxf(m_reg, pmax); alpha = __builtin_amdgcn_exp2f((m_reg - mn) * C); m_reg = mn; }
  const float mnC = -mn * C;
#pragma unroll
  for (int r = 0; r < 16; ++r) p0[r] = fmaf(p0[r], C, mnC);
#pragma unroll
  for (int r = 0; r < 16; ++r) p1[r] = fmaf(p1[r], C, mnC);
#pragma unroll
  for (int r = 0; r < 16; ++r) p0[r] = __builtin_amdgcn_exp2f(p0[r]);
}
__device__ __forceinline__ void finishSM(f32x16& p0, f32x16& p1, float alpha, float& l_reg, bf16x8& pa0, bf16x8& pa1, bf16x8& pa2, bf16x8& pa3) {
#pragma unroll
  for (int r = 0; r < 16; ++r) p1[r] = __builtin_amdgcn_exp2f(p1[r]);
  float ps = 0;
#pragma unroll
  for (int r = 0; r < 16; ++r) ps += p0[r];
#pragma unroll
  for (int r = 0; r < 16; ++r) ps += p1[r];
  { auto rr = __builtin_amdgcn_permlane32_swap(__float_as_uint(ps), __float_as_uint(ps), false, false);
    ps = __uint_as_float(rr[0]) + __uint_as_float(rr[1]); }
  l_reg = l_reg * alpha + ps;
#define PK4(P, BASE, OUT) do { unsigned a0 = cvtpk(P[BASE + 0], P[BASE + 1]), a1 = cvtpk(P[BASE + 2], P[BASE + 3]);   \
    unsigned b0 = cvtpk(P[BASE + 4], P[BASE + 5]), b1 = cvtpk(P[BASE + 6], P[BASE + 7]);                              \
    auto r0 = __builtin_amdgcn_permlane32_swap(a0, b0, false, false); auto r1 = __builtin_amdgcn_permlane32_swap(a1, b1, false, false); \
    u32x4 w = {r0[0], r1[0], r0[1], r1[1]}; OUT = *reinterpret_cast<bf16x8*>(&w); } while (0)
  PK4(p0, 0, pa0); PK4(p0, 8, pa1); PK4(p1, 0, pa2); PK4(p1, 8, pa3);
#undef PK4
}
__device__ __forceinline__ void qkt(f32x16& p0, f32x16& p1, const char* Ks, const bf16x8* qr, int r32, int hi) {
  p0 = f32x16{}; p1 = f32x16{};
#pragma unroll
  for (int d0 = 0; d0 < 4; ++d0) { const int cb = d0 * 32 + hi * 16;
    const bf16x8 b0 = *reinterpret_cast<const bf16x8*>(Ks + KSWZ(r32, cb));
    const bf16x8 b1 = *reinterpret_cast<const bf16x8*>(Ks + KSWZ(32 + r32, cb));
    p0 = __builtin_amdgcn_mfma_f32_32x32x16_bf16(b0, qr[d0], p0, 0, 0, 0);
    p1 = __builtin_amdgcn_mfma_f32_32x32x16_bf16(b1, qr[d0], p1, 0, 0, 0); }
}
__device__ __forceinline__ int v_st(int k, int c) { const int kk = (k & ~0xC) | ((k & 4) << 1) | ((k & 8) >> 1); return ((kk >> 3) * 4 + (c >> 5)) * 512 + ((kk & 7) * 32 + (c & 31)) * 2; }
__device__ __forceinline__ int v_rd_base(int lane) { return ((lane & 3) << 3) | (((lane >> 2) & 3) << 6) | (((lane >> 4) & 1) << 5) | (((lane >> 5) & 1) << 8); }
constexpr int v_rd_off(int d0, int ks, int half) { return d0 * 512 + ks * 4096 + half * 2048; }
template <int OFF> __device__ __forceinline__ s16x4 tr_read(int vb) {
  s16x4 r; asm volatile("ds_read_b64_tr_b16 %0, %1 offset:%2" : "=&v"(r) : "v"(vb), "i"(OFF) : "memory"); return r;
}
template <int KS> __device__ __forceinline__ void pv_ks(f32x16* o, int vb, bf16x8 pa) {
  const s16x4 l0 = tr_read<v_rd_off(0, KS, 0)>(vb), h0 = tr_read<v_rd_off(0, KS, 1)>(vb), l1 = tr_read<v_rd_off(1, KS, 0)>(vb), h1 = tr_read<v_rd_off(1, KS, 1)>(vb);
  const s16x4 l2 = tr_read<v_rd_off(2, KS, 0)>(vb), h2 = tr_read<v_rd_off(2, KS, 1)>(vb), l3 = tr_read<v_rd_off(3, KS, 0)>(vb), h3 = tr_read<v_rd_off(3, KS, 1)>(vb);
  asm volatile("s_waitcnt lgkmcnt(0)" ::: "memory"); SBAR();
#define PK(L, H) (bf16x8){L[0], L[1], L[2], L[3], H[0], H[1], H[2], H[3]}
  o[0] = __builtin_amdgcn_mfma_f32_32x32x16_bf16(pa, PK(l0, h0), o[0], 0, 0, 0);
  o[1] = __builtin_amdgcn_mfma_f32_32x32x16_bf16(pa, PK(l1, h1), o[1], 0, 0, 0);
  o[2] = __builtin_amdgcn_mfma_f32_32x32x16_bf16(pa, PK(l2, h2), o[2], 0, 0, 0);
  o[3] = __builtin_amdgcn_mfma_f32_32x32x16_bf16(pa, PK(l3, h3), o[3], 0, 0, 0);
#undef PK
}
__device__ __forceinline__ void pv_d0(f32x16* o, int vb, bf16x8 pa0, bf16x8 pa1, bf16x8 pa2, bf16x8 pa3) {
  pv_ks<0>(o, vb, pa0); pv_ks<1>(o, vb, pa1); pv_ks<2>(o, vb, pa2); pv_ks<3>(o, vb, pa3);
}
__device__ __forceinline__ void attn_unit(char* lds, const bf16_t* __restrict__ P, bf16_t* __restrict__ Y, int b, int h, int qb, float lam, const float* __restrict__ gattn, float oscale) {
  int tid_ = threadIdx.x; asm volatile("" : "+v"(tid_));
  const int tid = tid_, wid = tid >> 6, lane = tid & 63, r32 = lane & 31, hi = lane >> 5;
  const unsigned rowb = (unsigned)b * TB, q0 = rowb + (unsigned)qb * 256;
  const int seq = (qb == 0) ? CTXL : TB, NT = seq / 64;
  char* V_lds = lds + OFF_V; char* K_lds = lds + OFF_K;
  float* ws = (float*)(lds + OFF_WS) + wid * 64; float* li_l = ws; float* al_l = ws + 32;
  unsigned* stash = (unsigned*)(lds + OFF_ST) + wid * 2048;
  const int sr = tid >> 4, sc = (tid & 15) * 8, vst0 = v_st(sr, sc), vst1 = v_st(32 + sr, sc);
  const int kr = tid >> 3, kc = (tid & 7) * 8, kst = KSWZ(kr, kc * 2);
  const int vb0 = (int)(uintptr_t)V_lds + v_rd_base(lane);
  const char* Pc = (const char*)P;
  const unsigned voff = ((rowb + sr) * PW + V0c + h * 128 + sc) * 2u;
#pragma unroll 1
  for (int map = 0; map < 2; ++map) {
    const unsigned qoff = ((q0 + wid * 32 + r32) * PW + Q0c + h * 128 + map * 64 + hi * 8) * 2u;
    const unsigned koff = ((rowb + kr) * PW + K0c + h * 128 + map * 64 + kc) * 2u;
    bf16x8 qr[4];
#pragma unroll
    for (int d0 = 0; d0 < 4; ++d0) qr[d0] = *reinterpret_cast<const bf16x8*>(Pc + (qoff + d0 * 32));
    float m_reg = -1e30f, l_reg = 0; f32x16 o[4] = {};
    struct { bf16x8 vs0, vs1, ks; } sr_[1];
#define SLOAD(i, k0) do { const unsigned ko_ = (unsigned)(k0) * (PW * 2u); sr_[i].vs0 = *reinterpret_cast<const bf16x8*>(Pc + (voff + ko_)); sr_[i].vs1 = *reinterpret_cast<const bf16x8*>(Pc + (voff + ko_ + 32u * PW * 2u)); \
    sr_[i].ks = *reinterpret_cast<const bf16x8*>(Pc + (koff + ko_)); } while (0)
#define SWRITE(bf, i) do { *(bf16x8*)(V_lds + (bf) * SHM_V + vst0) = sr_[i].vs0; *(bf16x8*)(V_lds + (bf) * SHM_V + vst1) = sr_[i].vs1; \
    *(bf16x8*)(K_lds + (bf) * SHM_K + kst) = sr_[i].ks; } while (0)
#define SWAIT() asm volatile("s_waitcnt vmcnt(0)" ::: "memory")
#define RESC(a) do { if (__any((a) < 1.f)) { if (hi == 0) al_l[r32] = (a); asm volatile("s_waitcnt lgkmcnt(0)" ::: "memory"); \
    _Pragma("unroll") for (int d = 0; d < 4; ++d) _Pragma("unroll") for (int r = 0; r < 16; ++r) o[d][r] *= al_l[crow(r, hi)]; } } while (0)
    f32x16 pA0, pA1, pB0, pB1; float mnA, mnB, alA, alB; bf16x8 pa0, pa1, pa2, pa3;
    constexpr int SE = 0, SO = 0;
    SLOAD(SE, 0); asm volatile("s_waitcnt vmcnt(0)" ::: "memory"); SWRITE(0, SE); __syncthreads();
    qkt(pA0, pA1, K_lds, qr, r32, hi); partialSM(pA0, pA1, m_reg, mnA, alA);
    SLOAD(SO, 64);
    SWAIT(); SWRITE(1, SO); __syncthreads();
    for (int j = 1; j + 1 < NT; j += 2) {
      SBAR(); qkt(pB0, pB1, K_lds + SHM_K, qr, r32, hi);
      finishSM(pA0, pA1, alA, l_reg, pa0, pa1, pa2, pa3); SBAR();
      SLOAD(SO, (j + 1) * 64); SBAR();
      pv_d0(o, vb0, pa0, pa1, pa2, pa3); partialSM(pB0, pB1, m_reg, mnB, alB);
      __syncthreads(); SWAIT(); SWRITE(0, SE);
      RESC(alB); __syncthreads();
      SBAR(); qkt(pA0, pA1, K_lds, qr, r32, hi);
      finishSM(pB0, pB1, alB, l_reg, pa0, pa1, pa2, pa3); SBAR();
      SLOAD(SE, (j + 2) * 64); SBAR();
      pv_d0(o, vb0 + SHM_V, pa0, pa1, pa2, pa3); partialSM(pA0, pA1, m_reg, mnA, alA);
      __syncthreads(); SWAIT(); SWRITE(1, SO);
      RESC(alA); __syncthreads();
    }
    SBAR(); qkt(pB0, pB1, K_lds + SHM_K, qr, r32, hi);
    finishSM(pA0, pA1, alA, l_reg, pa0, pa1, pa2, pa3); SBAR();
    pv_d0(o, vb0, pa0, pa1, pa2, pa3); partialSM(pB0, pB1, m_reg, mnB, alB);
    __syncthreads(); RESC(alB);
    finishSM(pB0, pB1, alB, l_reg, pa0, pa1, pa2, pa3); SBAR();
    pv_d0(o, vb0 + SHM_V, pa0, pa1, pa2, pa3);
    if (hi == 0) li_l[r32] = l_reg; asm volatile("s_waitcnt lgkmcnt(0)" ::: "memory");
    if (map == 0) {
#pragma unroll
      for (int r = 0; r < 16; ++r) { const float rl = __builtin_amdgcn_rcpf(li_l[crow(r, hi)]);
        stash[(r * 2 + 0) * 64 + lane] = cvtpk(o[0][r] * rl, o[1][r] * rl); stash[(r * 2 + 1) * 64 + lane] = cvtpk(o[2][r] * rl, o[3][r] * rl); SBAR(); }
    } else if (ATT_VAR != 1) {
      char* Yc = (char*)Y; const unsigned yoff = ((q0 + wid * 32) * DM + h * 128 + r32) * 2u;
      float gv[4];
#pragma unroll
      for (int d0 = 0; d0 < 4; ++d0) gv[d0] = gattn[d0 * 32 + r32] * oscale;
      SBAR();
#pragma unroll
      for (int r = 0; r < 16; ++r) { const float rl = lam * __builtin_amdgcn_rcpf(li_l[crow(r, hi)]);
        const unsigned w0 = stash[(r * 2 + 0) * 64 + lane], w1 = stash[(r * 2 + 1) * 64 + lane];
        const float e0 = bflo(w0) - o[0][r] * rl, e1 = bfhi(w0) - o[1][r] * rl, e2 = bflo(w1) - o[2][r] * rl, e3 = bfhi(w1) - o[3][r] * rl;
        float ssq = (e0 * e0 + e1 * e1) + (e2 * e2 + e3 * e3);
        if (ATT_VAR != 3) { ssq += __shfl_xor(ssq, 1); ssq += __shfl_xor(ssq, 2); ssq += __shfl_xor(ssq, 4); ssq += __shfl_xor(ssq, 8); ssq += __shfl_xor(ssq, 16); }
        const float rs = rsqrtf(ssq * (1.f / 128.f) + 1e-6f);
        bf16_t* yr = (bf16_t*)(Yc + (yoff + (unsigned)crow(r, hi) * (DM * 2u)));
        if (ATT_VAR != 4) { yr[0] = f2bf(e0 * rs * gv[0]); yr[32] = f2bf(e1 * rs * gv[1]); yr[64] = f2bf(e2 * rs * gv[2]); yr[96] = f2bf(e3 * rs * gv[3]); } else { yr[0] = f2bf(e0 * rs + e1 + e2 + e3); } SBAR(); }
    }
    __syncthreads();
#undef SLOAD
#undef SWRITE
#undef SWAIT
#undef RESC
  }
}
#undef KSWZ
}
namespace lru {
using att::f32x16; using att::crow;
constexpr int RS = 528;
constexpr int OFF_CL = 0, OFF_YS = 128 * RS, OFF_CY = 2 * 128 * RS;
template <int CTRL, int RMASK> __device__ __forceinline__ float dppf(float oldv, float src) {
  return __int_as_float(__builtin_amdgcn_update_dpp(__float_as_int(oldv), __float_as_int(src), CTRL, RMASK, 0xF, false));
}
template <bool PASS2>
__device__ __forceinline__ void lru_unit(char* lds, const bf16_t* __restrict__ P, bf16_t* __restrict__ Y, int b, int c, const float* __restrict__ convw, const float* __restrict__ convb,
                                         const bf16_t* __restrict__ wrg, const float* __restrict__ ba, const float* __restrict__ bx, const float* __restrict__ c8, float* lrus) {
  int tid_ = threadIdx.x; asm volatile("" : "+v"(tid_));
  const int tid = tid_, wid = tid >> 6, lane = tid & 63, r32 = lane & 31, hi = lane >> 5;
  const unsigned R0 = (unsigned)b * TB + (unsigned)c * 128;
  const int seg_lo = (c < 2) ? 0 : CTXL, seg_hi = (c < 2) ? CTXL : TB;
  const char* Pc = (const char*)P;
  {
    const int ch8 = (tid & 31) * 8, t0 = (tid >> 5) * 8;
    u32x4 xr[11];
#pragma unroll
    for (int i = 0; i < 11; ++i) { const int tt = c * 128 + t0 - 1 + i;
      if (tt >= seg_lo && tt < seg_hi) xr[i] = *(const u32x4*)(Pc + (((unsigned)b * TB + (unsigned)tt) * PW + LX0 + ch8) * 2u); else xr[i] = (u32x4){0u, 0u, 0u, 0u}; }
    float w[4][8], bb[8];
#pragma unroll
    for (int k = 0; k < 4; ++k) { const f32x4 a = *(const f32x4*)(convw + k * 256 + ch8), d = *(const f32x4*)(convw + k * 256 + ch8 + 4);
      w[k][0] = a.x; w[k][1] = a.y; w[k][2] = a.z; w[k][3] = a.w; w[k][4] = d.x; w[k][5] = d.y; w[k][6] = d.z; w[k][7] = d.w; }
    { const f32x4 a = *(const f32x4*)(convb + ch8), d = *(const f32x4*)(convb + ch8 + 4); bb[0] = a.x; bb[1] = a.y; bb[2] = a.z; bb[3] = a.w; bb[4] = d.x; bb[5] = d.y; bb[6] = d.z; bb[7] = d.w; }
#pragma unroll
    for (int i = 0; i < 8; ++i) { float acc[8];
#pragma unroll
      for (int e = 0; e < 8; ++e) acc[e] = bb[e];
#pragma unroll
      for (int k = 0; k < 4; ++k) { const u32x4 xv = xr[i + k];
        acc[0] += bflo(xv.x) * w[k][0]; acc[1] += bfhi(xv.x) * w[k][1]; acc[2] += bflo(xv.y) * w[k][2]; acc[3] += bfhi(xv.y) * w[k][3];
        acc[4] += bflo(xv.z) * w[k][4]; acc[5] += bfhi(xv.z) * w[k][5]; acc[6] += bflo(xv.w) * w[k][6]; acc[7] += bfhi(xv.w) * w[k][7]; }
      u32x4 o; o.x = cvtpk(acc[0], acc[1]); o.y = cvtpk(acc[2], acc[3]); o.z = cvtpk(acc[4], acc[5]); o.w = cvtpk(acc[6], acc[7]);
      *(u32x4*)(lds + OFF_CL + (t0 + i) * RS + ch8 * 2) = o; }
  }
  if (PASS2) {
    const int d = tid >> 8, ch = tid & 255;
    const int np = d ? (c < 2 ? 1 - c : NCHUNK + 1 - c) : c;
    float cy = 0.f;
    const float* sb = lrus + ((size_t)b * NCHUNK * 4 + (size_t)d * 2) * 256 + ch;
    if (np > 0) { float A[NCHUNK], H[NCHUNK];
#pragma unroll
      for (int i = 0; i < NCHUNK; ++i) { int p = i < np ? i : np - 1;
        const int u = d ? (c < 2 ? 1 - p : (p == 0 ? 1 : (p == 1 ? 0 : NCHUNK + 1 - p))) : p;
        A[i] = sb[(size_t)u * 1024]; H[i] = sb[(size_t)u * 1024 + 256]; }
#pragma unroll
      for (int i = 0; i < NCHUNK; ++i) if (i < np) cy = A[i] * cy + H[i];
    }
    ((float*)(lds + OFF_CY))[tid] = cy;
  }
  __syncthreads();
  const int hh = wid >> 1, jh = wid & 1, chb = hh * 64 + jh * 32;
#pragma unroll 1
  for (int d = 0; d < 2; ++d) {
    const bf16_t* wa = wrg + ((0 * 2 + d) * 4 + hh) * 4096 + (jh * 32 + r32) * 64 + hi * 8;
    const bf16_t* wx = wrg + ((1 * 2 + d) * 4 + hh) * 4096 + (jh * 32 + r32) * 64 + hi * 8;
    bf16x8 fa[4], fx[4];
#pragma unroll
    for (int k = 0; k < 4; ++k) { fa[k] = *reinterpret_cast<const bf16x8*>(wa + k * 16); fx[k] = *reinterpret_cast<const bf16x8*>(wx + k * 16); }
    float carry[16], Pc_[16], bav[16], bxv[16], c8v[16];
#pragma unroll
    for (int q = 0; q < 4; ++q) { const int co = d * 256 + chb + 8 * q + 4 * hi;
      const f32x4 b4 = *(const f32x4*)(ba + co), x4 = *(const f32x4*)(bx + co), c4 = *(const f32x4*)(c8 + co);
      bav[4 * q] = b4.x; bav[4 * q + 1] = b4.y; bav[4 * q + 2] = b4.z; bav[4 * q + 3] = b4.w; bxv[4 * q] = x4.x; bxv[4 * q + 1] = x4.y; bxv[4 * q + 2] = x4.z; bxv[4 * q + 3] = x4.w;
      c8v[4 * q] = c4.x; c8v[4 * q + 1] = c4.y; c8v[4 * q + 2] = c4.z; c8v[4 * q + 3] = c4.w; }
#pragma unroll
    for (int r = 0; r < 16; ++r) { carry[r] = 0.f; Pc_[r] = 1.f; }
    if (PASS2) { const float* cyp = (const float*)(lds + OFF_CY) + d * 256 + chb + 4 * hi;
#pragma unroll
      for (int q = 0; q < 4; ++q) { const f32x4 v = *(const f32x4*)(cyp + 8 * q); carry[4 * q] = v.x; carry[4 * q + 1] = v.y; carry[4 * q + 2] = v.z; carry[4 * q + 3] = v.w; } }
    const int tokl = d ? 31 - r32 : r32;
#pragma unroll 1
    for (int ti = 0; ti < 4; ++ti) {
      const int tt = d ? 3 - ti : ti;
      char* rowp = lds + OFF_CL + (tt * 32 + tokl) * RS;
      f32x16 za = {}, zx = {};
#pragma unroll
      for (int k = 0; k < 4; ++k) { const bf16x8 xb = *reinterpret_cast<const bf16x8*>(rowp + (hh * 64 + k * 16 + hi * 8) * 2);
        za = __builtin_amdgcn_mfma_f32_32x32x16_bf16(fa[k], xb, za, 0, 0, 0); zx = __builtin_amdgcn_mfma_f32_32x32x16_bf16(fx[k], xb, zx, 0, 0, 0); }
      float av[16], bv[16];
#pragma unroll
      for (int q = 0; q < 4; ++q) { const u32x2 cw = *(const u32x2*)(rowp + (chb + 8 * q + 4 * hi) * 2);
        const float clv[4] = {bflo(cw.x), bfhi(cw.x), bflo(cw.y), bfhi(cw.y)};
#pragma unroll
        for (int i = 0; i < 4; ++i) { const int r = 4 * q + i;
          const float rg = sigm(za[r] + bav[r]), ig = sigm(zx[r] + bxv[r]);
          const float a = fexp(-c8v[r] * rg);
          av[r] = a; bv[r] = __builtin_amdgcn_sqrtf(fmaxf(1.f - a * a, 0.f)) * ig * clv[i]; } }
#define LRU_SCAN(CTRL, RM) _Pragma("unroll") for (int r = 0; r < 16; ++r) { const float ap = dppf<CTRL, RM>(1.f, av[r]), bp = dppf<CTRL, RM>(0.f, bv[r]); bv[r] = av[r] * bp + bv[r]; av[r] = av[r] * ap; }
      LRU_SCAN(0x111, 0xF) LRU_SCAN(0x112, 0xF) LRU_SCAN(0x114, 0xF) LRU_SCAN(0x118, 0xF) LRU_SCAN(0x142, 0xA)
#undef LRU_SCAN
#pragma unroll
      for (int q = 0; q < 4; ++q) { float hv[4];
#pragma unroll
        for (int i = 0; i < 4; ++i) { const int r = 4 * q + i; hv[i] = bv[r] + av[r] * carry[r];
          carry[r] = __shfl(hv[i], 31, 32);
          if (!PASS2) Pc_[r] *= __shfl(av[r], 31, 32); }
        if (PASS2) { u32x2* yp = (u32x2*)(lds + OFF_YS + (tt * 32 + tokl) * RS + (chb + 8 * q + 4 * hi) * 2);
          if (d) { const u32x2 o = *yp; hv[0] += bflo(o.x); hv[1] += bfhi(o.x); hv[2] += bflo(o.y); hv[3] += bfhi(o.y); }
          u32x2 w; w.x = cvtpk(hv[0], hv[1]); w.y = cvtpk(hv[2], hv[3]); *yp = w; } }
    }
    if (!PASS2) { if (r32 == 0) { float* sb = lrus + ((((size_t)b * NCHUNK + c) * 2 + d) * 2) * 256 + chb + 4 * hi;
#pragma unroll
        for (int q = 0; q < 4; ++q) { *(f32x4*)(sb + 8 * q) = (f32x4){Pc_[4 * q], Pc_[4 * q + 1], Pc_[4 * q + 2], Pc_[4 * q + 3]};
          *(f32x4*)(sb + 256 + 8 * q) = (f32x4){carry[4 * q], carry[4 * q + 1], carry[4 * q + 2], carry[4 * q + 3]}; } } }
  }
  if (PASS2) {
    __syncthreads();
    const int ch8 = (tid & 31) * 8;
#pragma unroll
    for (int i = 0; i < 8; ++i) { const int t = (tid >> 5) + 16 * i;
      const u32x4 hv = *(const u32x4*)(lds + OFF_YS + t * RS + ch8 * 2), gv = *(const u32x4*)(Pc + ((R0 + t) * PW + LG0 + ch8) * 2u);
      u32x4 o; o.x = cvtpk(bflo(hv.x) * bflo(gv.x), bfhi(hv.x) * bfhi(gv.x)); o.y = cvtpk(bflo(hv.y) * bflo(gv.y), bfhi(hv.y) * bfhi(gv.y));
      o.z = cvtpk(bflo(hv.z) * bflo(gv.z), bfhi(hv.z) * bfhi(gv.z)); o.w = cvtpk(bflo(hv.w) * bflo(gv.w), bfhi(hv.w) * bfhi(gv.w));
      *(u32x4*)((char*)Y + ((R0 + t) * DM + 512 + ch8) * 2u) = o; }
  }
  __syncthreads();
}
}

namespace sgu {
using att::f32x16; using att::crow;
constexpr int VS = 272;
__device__ __forceinline__ void sgu_unit(char* lds, const bf16_t* __restrict__ P, bf16_t* __restrict__ Y, int b, int c, const bf16_t* __restrict__ wsp, const float* __restrict__ gsgu, const float* __restrict__ bsp) {
  int tid_ = threadIdx.x; asm volatile("" : "+v"(tid_));
  const int tid = tid_, wid = tid >> 6, lane = tid & 63, r32 = lane & 31, hi = lane >> 5;
  const unsigned R0 = (unsigned)b * TB + (unsigned)c * 128;
  const char* Pc = (const char*)P;
  const int gg = wid >> 1, chalf = wid & 1, cc = gg * 64 + chalf * 32 + r32;
  bf16x8 Af[4][8];
  u32x4 xv[8];
  { const int q = tid & 127, g = tid >> 7;
    const char* vp = Pc + ((R0 + q) * PW + SV0 + g * 64) * 2u;
#pragma unroll
    for (int i = 0; i < 8; ++i) xv[i] = *(const u32x4*)(vp + i * 16); }
#pragma unroll
  for (int pt = 0; pt < 4; ++pt) { const bf16_t* ap = wsp + (gg * 128 + pt * 32 + r32) * 128 + hi * 8;
#pragma unroll
    for (int k = 0; k < 8; ++k) Af[pt][k] = *reinterpret_cast<const bf16x8*>(ap + k * 16); }
  { const int q = tid & 127, g = tid >> 7; float ss = 0.f;
#pragma unroll
    for (int i = 0; i < 8; ++i) {
      const float a0 = bflo(xv[i].x), a1 = bfhi(xv[i].x), a2 = bflo(xv[i].y), a3 = bfhi(xv[i].y), a4 = bflo(xv[i].z), a5 = bfhi(xv[i].z), a6 = bflo(xv[i].w), a7 = bfhi(xv[i].w);
      ss += (a0 * a0 + a1 * a1) + (a2 * a2 + a3 * a3) + (a4 * a4 + a5 * a5) + (a6 * a6 + a7 * a7); }
    const float rs = rsqrtf(ss * (1.f / 64.f) + 1e-6f);
    char* dst = lds + (g * 64) * VS + q * 2;
#pragma unroll
    for (int i = 0; i < 8; ++i) { const float* gp = gsgu + g * 64 + i * 8; const f32x4 g0 = *(const f32x4*)gp, g1 = *(const f32x4*)(gp + 4);
      *(bf16_t*)(dst + (i * 8 + 0) * VS) = f2bf(bflo(xv[i].x) * rs * g0.x); *(bf16_t*)(dst + (i * 8 + 1) * VS) = f2bf(bfhi(xv[i].x) * rs * g0.y);
      *(bf16_t*)(dst + (i * 8 + 2) * VS) = f2bf(bflo(xv[i].y) * rs * g0.z); *(bf16_t*)(dst + (i * 8 + 3) * VS) = f2bf(bfhi(xv[i].y) * rs * g0.w);
      *(bf16_t*)(dst + (i * 8 + 4) * VS) = f2bf(bflo(xv[i].z) * rs * g1.x); *(bf16_t*)(dst + (i * 8 + 5) * VS) = f2bf(bfhi(xv[i].z) * rs * g1.y);
      *(bf16_t*)(dst + (i * 8 + 6) * VS) = f2bf(bflo(xv[i].w) * rs * g1.z); *(bf16_t*)(dst + (i * 8 + 7) * VS) = f2bf(bfhi(xv[i].w) * rs * g1.w); }
  }
  __syncthreads();
  { bf16x8 vb[8];
#pragma unroll
    for (int k = 0; k < 8; ++k) vb[k] = *reinterpret_cast<const bf16x8*>(lds + cc * VS + (k * 16 + hi * 8) * 2);
    unsigned short uu[2][16]; f32x4 bsv[2][4];
#define SGU_LD(pt_, s_) do { _Pragma("unroll") for (int r = 0; r < 16; ++r) uu[s_][r] = *(const unsigned short*)(Pc + ((R0 + (pt_) * 32 + crow(r, hi)) * PW + SU0 + cc) * 2u); \
      _Pragma("unroll") for (int q4 = 0; q4 < 4; ++q4) bsv[s_][q4] = *(const f32x4*)(bsp + gg * 128 + (pt_) * 32 + 8 * q4 + 4 * hi); } while (0)
    SGU_LD(0, 0);
#pragma unroll
    for (int pt = 0; pt < 4; ++pt) { f32x16 acc = {};
      if (pt + 1 < 4) SGU_LD(pt + 1, (pt + 1) & 1);
#pragma unroll
      for (int k = 0; k < 8; ++k) acc = __builtin_amdgcn_mfma_f32_32x32x16_bf16(Af[pt][k], vb[k], acc, 0, 0, 0);
#pragma unroll
      for (int r = 0; r < 16; ++r) { const int p = pt * 32 + crow(r, hi); const float m = acc[r] + bsv[pt & 1][r >> 2][r & 3];
        *(bf16_t*)((char*)Y + ((R0 + p) * DM + 768 + cc) * 2u) = f2bf(bf2f(uu[pt & 1][r]) * m); } }
#undef SGU_LD
  }
  __syncthreads();
}
}
__device__ __forceinline__ unsigned pk2(float lo, float hi) { return cvtpk(lo, hi); }
__device__ __forceinline__ void transpose_item(const float* __restrict__ W, int K, int N, bf16_t* __restrict__ WT, int row_base, LAS float* scr, int kb, int nb, int lane) {
    const int k0 = 64 * kb, n0 = 32 * nb;
#pragma unroll 8
    for (int i = 0; i < 32; ++i) { const int kk = 2 * i + (lane >> 5); scr[kk * 33 + (lane & 31)] = W[(size_t)(k0 + kk) * N + n0 + (lane & 31)]; }
    asm volatile("s_waitcnt lgkmcnt(0)" ::: "memory");
    const int c = lane & 7;
#pragma unroll
    for (int j = 0; j < 4; ++j) { const int n = (lane >> 3) + 8 * j; const LAS float* s = scr + (8 * c) * 33 + n;
        u32x4 o; o.x = pk2(s[0 * 33], s[1 * 33]); o.y = pk2(s[2 * 33], s[3 * 33]); o.z = pk2(s[4 * 33], s[5 * 33]); o.w = pk2(s[6 * 33], s[7 * 33]);
        *(u32x4*)(WT + (size_t)(row_base + n) * K + k0 + 8 * c) = o; }
    asm volatile("s_waitcnt lgkmcnt(0)" ::: "memory");
}
__device__ __forceinline__ void gemv_item(const LAS float* a_lds, LAS float* red, const float* __restrict__ W, int N, int n0, float* __restrict__ out, int ldo, int obase, const float* __restrict__ bias) {
    const int tid = threadIdx.x, wid = tid >> 6, lane = tid & 63, c4 = (lane & 15) * 4, ks = lane >> 4;
    f32x4 acc[NMS];
#pragma unroll
    for (int ms = 0; ms < NMS; ++ms) acc[ms] = (f32x4){0.f, 0.f, 0.f, 0.f};
    const float* wp = W + (size_t)(wid * 128 + ks) * N + n0 + c4;
#pragma unroll 8
    for (int st = 0; st < 32; ++st) { const f32x4 wv = *(const f32x4*)(wp + (size_t)st * 4 * N); const int k = wid * 128 + st * 4 + ks;
#pragma unroll
        for (int ms = 0; ms < NMS; ++ms) acc[ms] += wv * a_lds[ms * 1024 + k]; }
#pragma unroll
    for (int ms = 0; ms < NMS; ++ms) {
        f32x4 v = acc[ms];
        v.x += __shfl_xor(v.x, 16); v.y += __shfl_xor(v.y, 16); v.z += __shfl_xor(v.z, 16); v.w += __shfl_xor(v.w, 16);
        v.x += __shfl_xor(v.x, 32); v.y += __shfl_xor(v.y, 32); v.z += __shfl_xor(v.z, 32); v.w += __shfl_xor(v.w, 32);
        if (ks == 0) { LAS float* rp = red + (wid * NMS + ms) * 64 + c4; rp[0] = v.x; rp[1] = v.y; rp[2] = v.z; rp[3] = v.w; }
    }
    __syncthreads();
    for (int i = tid; i < NMS * 64; i += 512) { const int ms = i >> 6, c = i & 63; float s = 0.f;
#pragma unroll
        for (int w = 0; w < 8; ++w) s += red[(w * NMS + ms) * 64 + c];
        if (bias) s += bias[n0 + c];
        out[(size_t)ms * ldo + obase + c] = s; }
    __syncthreads();
}
__device__ __forceinline__ float wave_sum(float v) {
#pragma unroll
    for (int o = 1; o < 64; o <<= 1) v += __shfl_xor(v, o);
    return v;
}

#define XB_TMO      128
#define XB_XCNT(j)  (256  + 64 * (j))
#define XB_XSUB(j)  (1280 + 64 * (j))
#define XB_XGEN(j)  (2304 + 64 * (j))
#define XB_TOP      3328
#define XB_TOPGEN   3392
#define XCD_BAR_WORDS 3456
#define XB_SPIN_CAP (1u << 18)

__device__ __forceinline__ unsigned xb_ld(unsigned* p)              { return __hip_atomic_load(p, __ATOMIC_RELAXED, __HIP_MEMORY_SCOPE_AGENT); }
__device__ __forceinline__ unsigned xb_add(unsigned* p, unsigned v) { return __hip_atomic_fetch_add(p, v, __ATOMIC_RELAXED, __HIP_MEMORY_SCOPE_AGENT); }
__device__ __forceinline__ unsigned xb_xcc_id() { return (unsigned)__builtin_amdgcn_s_getreg((3 << 11) | 20) & 0xFu; }
#define XB_SPIN(cond, bar) do { unsigned _sp = 0; while (cond) { __builtin_amdgcn_s_sleep(1); \
    if ((++_sp & 255u) == 0u) { if (xb_ld(&(bar)[XB_TMO])) break; if (_sp > XB_SPIN_CAP) { atomicAdd(&(bar)[XB_TMO], 1u); break; } } } } while (0)

struct XcdBarrier {
    unsigned* bar; unsigned x;
    volatile LAS unsigned* st;
};

__device__ __forceinline__ XcdBarrier xcd_barrier_post(unsigned* bar, volatile LAS unsigned* st) {
    XcdBarrier b; b.bar = bar; b.x = xb_xcc_id(); b.st = st;
    if (threadIdx.x == 0) (void)xb_add(&bar[XB_XCNT(b.x)], 1u);
    return b;
}
__device__ __forceinline__ void xcd_barrier_complete(unsigned* bar, unsigned x, unsigned& nloc, unsigned& nx) {
    const unsigned G = gridDim.x * gridDim.y * gridDim.z;
    unsigned sum, cnt, mine, sp = 0u;
    for (;;) {
        sum = 0u; cnt = 0u; mine = 0u;
#pragma unroll
        for (unsigned j = 0; j < 16; ++j) { const unsigned c = xb_ld(&bar[XB_XCNT(j)]); sum += c; cnt += (c > 0u) ? 1u : 0u; mine = (j == x) ? c : mine; }
        if (sum == G) break;
        __builtin_amdgcn_s_sleep(1);
        if ((++sp & 255u) == 0u) { if (xb_ld(&bar[XB_TMO])) break; if (sp > XB_SPIN_CAP) { atomicAdd(&bar[XB_TMO], 1u); break; } }
    }
    nloc = mine > 0u ? mine : 1u; nx = cnt > 0u ? cnt : 1u;
}

__device__ __forceinline__ void xcd_barrier(const XcdBarrier& b) {
    asm volatile("s_waitcnt vmcnt(0)" ::: "memory");
    __syncthreads();
    if (threadIdx.x == 0) {
        unsigned* bar = b.bar;
        __builtin_amdgcn_s_waitcnt(0);
        unsigned nloc = b.st[0], nx = b.st[1];
        if (nloc == 0u) { xcd_barrier_complete(bar, b.x, nloc, nx); b.st[0] = nloc; b.st[1] = nx; }
        const unsigned old = xb_add(&bar[XB_XSUB(b.x)], 1u);
        const unsigned gen = old / nloc;
        if (old + 1u == (gen + 1u) * nloc) {
            __builtin_amdgcn_fence(__ATOMIC_RELEASE, "agent");
            asm volatile("s_waitcnt vmcnt(0)" ::: "memory");
            const unsigned og = xb_add(&bar[XB_TOP], 1u);
            const unsigned tg = og / nx;
            if (og + 1u == (tg + 1u) * nx) xb_add(&bar[XB_TOPGEN], 1u);
            else XB_SPIN(xb_ld(&bar[XB_TOPGEN]) == tg, bar);
            __builtin_amdgcn_fence(__ATOMIC_ACQUIRE, "agent");
            xb_add(&bar[XB_XGEN(b.x)], 1u);
            asm volatile("s_waitcnt vmcnt(0)" ::: "memory");
        } else {
            XB_SPIN(xb_ld(&bar[XB_XGEN(b.x)]) == gen, bar);
            __builtin_amdgcn_fence(__ATOMIC_ACQUIRE, "agent");
            asm volatile("s_waitcnt vmcnt(0)" ::: "memory");
        }
    }
    __syncthreads();
}
typedef __attribute__((address_space(1))) unsigned char g_u8;
__device__ __forceinline__ unsigned char* lau(unsigned char* p) { asm volatile("" : "+s"(p)); return (unsigned char*)(g_u8*)p; }
constexpr int NPHASE = 15;
constexpr int LDS_BYTES = 147456;
struct Args { const float* in[27]; float* out; unsigned char* ws; int ph_lo, ph_hi; };
__global__ void __launch_bounds__(512, 2) hybrid_fwd(Args args) {
    extern __shared__ __attribute__((aligned(16))) unsigned char lds_raw[];
    char* lds = (char*)lds_raw;
    LAS unsigned char* ldsl = (LAS unsigned char*)lds_raw;
    const int tid = threadIdx.x, wave = __builtin_amdgcn_readfirstlane(tid >> 6);
#define LANE_LOCAL int lane_ = threadIdx.x; asm volatile("" : "+v"(lane_)); const int lane = lane_ & 63;
    const int G = gridDim.x, bx = blockIdx.x, vcu = (G % 8 == 0) ? (bx % 8) * (G / 8) + bx / 8 : bx;
    unsigned char* ws = args.ws;
    const float* const* in = args.in;
#define mods ((float*)(ws + WS_MODS))
#define shwin ((float*)(ws + WS_SHWIN))
#define shwf ((float*)(ws + WS_SHWF))
#define ropeC ((float*)(ws + WS_ROPE))
#define ropeS ((float*)(ws + WS_ROPE + 4096))
#define c8 ((float*)(ws + WS_C8))
#define lamv ((float*)(ws + WS_LAM))
#define rowss ((float*)(ws + WS_ROWSS))
#define lrus ((float*)(ws + WS_LRUS))
#define xc ((float*)(ws + WS_XC))
#define AP ((bf16_t*)(ws + WS_AP))
#define Pb ((bf16_t*)(ws + WS_P))
#define Yb ((bf16_t*)(ws + WS_Y))
#define HM ((bf16_t*)(ws + WS_HMID))
#define WSP ((bf16_t*)(ws + WS_WSP))
#define WRG ((bf16_t*)(ws + WS_WRG))
    const int lo = args.ph_lo, hi_ = args.ph_hi;
    volatile LAS unsigned* MISC = (volatile LAS unsigned*)(ldsl + LDS_BYTES - 64);
    if (tid < 16) MISC[tid] = 0u;
    __syncthreads();
    XcdBarrier bar; bar.bar = (unsigned*)(ws + WS_CTL); bar.x = 0; bar.st = nullptr;
    if (hi_ - lo > 1) bar = xcd_barrier_post((unsigned*)(ws + WS_CTL), MISC);
#define IN(k) (lo <= (k) && (k) < hi_)
#define SEAM(k) do { if (IN(k) && IN((k) + 1)) { if ((k) == 0) cg::this_grid().sync(); else xcd_barrier(bar); } } while (0)

    if (EN(0) && IN(0)) {
        { LANE_LOCAL LAS float* scr = (LAS float*)(ldsl + wave * 16384);
          const int gw = vcu * 8 + wave, NGW = G * 8;
          constexpr int I_IN = 16 * 80, I_OUT = 16 * 32, I_G = 16 * 88, I_D = 44 * 32, I_L = I_IN + I_OUT + 2 * I_G + I_D;
          for (int it = gw; it < NLAYER * I_L; it += NGW) {
              const int l = it / I_L; int r = it - l * I_L;
              if (r < I_IN) { transpose_item(in[8] + (size_t)l * DM * PW, DM, PW, (bf16_t*)(ws + WS_WIN + l * SZ_WIN), 32 * (r % 80), scr, r / 80, r % 80, lane); continue; } r -= I_IN;
              if (r < I_OUT) { transpose_item(in[22] + (size_t)l * DM * DM, DM, DM, (bf16_t*)(ws + WS_WOUT + l * SZ_WOUT), 32 * (r % 32), scr, r / 32, r % 32, lane); continue; } r -= I_OUT;
              if (r < 2 * I_G) { const int up = r >= I_G; if (up) r -= I_G; const int nb = r % 88, n0 = 32 * nb;
                  transpose_item(in[up ? 24 : 23] + (size_t)l * DM * FH, DM, FH, (bf16_t*)(ws + WS_WFFN + l * SZ_WFFN), (n0 / 128) * 256 + (n0 % 128) + (up ? 128 : 0), scr, r / 88, nb, lane); continue; } r -= 2 * I_G;
              transpose_item(in[25] + (size_t)l * FH * DM, FH, DM, (bf16_t*)(ws + WS_WDN + l * SZ_WDN), 32 * (r % 32), scr, r / 32, r % 32, lane);
          }
        }
        { const int gt = vcu * 512 + tid, NT = G * 512;
          for (int i = gt; i < 131072; i += NT) WSP[i] = f2bf(in[20][i]);
          for (int i = gt; i < 131072; i += NT) { const int ii = i & 63, j = (i >> 6) & 63, h = (i >> 12) & 3, d = (i >> 14) & 1, mat = (i >> 15) & 1, l = i >> 16;
              WRG[i] = f2bf(in[mat ? 16 : 14][((((size_t)l * 2 + d) * 4 + h) * 64 + ii) * 64 + j]); }
          if (gt < 1024) { const int pos = gt >> 4, j = gt & 15; const float inv = powf(10000.f, -(float)j / 16.f); const float ang = (float)pos * inv; ropeC[gt] = cosf(ang); ropeS[gt] = sinf(ang);
              const float lv = in[18][gt]; c8[gt] = 8.f * log1pf(expf(-lv)); }
          if (gt < NLAYER) { float s0 = 0.f, s1 = 0.f; for (int k = 0; k < 64; ++k) { s0 += in[9][(gt * 2 + 0) * 64 + k] * in[10][(gt * 2 + 0) * 64 + k]; s1 += in[9][(gt * 2 + 1) * 64 + k] * in[10][(gt * 2 + 1) * 64 + k]; }
              lamv[gt] = expf(s0) - expf(s1) + (0.8f - 0.6f * expf(-0.3f * (float)gt)); }
        }
        __syncthreads();
        { LAS float* a_lds = (LAS float*)ldsl; LAS float* red = (LAS float*)(ldsl + 36864);
          for (int i = tid; i < NMS * 1024; i += 512) { const int ms = i >> 10, k = i & 1023; const float v = (ms < 8) ? in[1][ms * 1024 + k] : in[3][k]; a_lds[i] = silu_f(v); }
          __syncthreads();
          for (int it = vcu; it < NLAYER * 96; it += G) { const int l = it / 96, n0 = (it % 96) * 64;
              gemv_item(a_lds, red, in[4] + (size_t)l * DM * NMOD, NMOD, n0, mods + (size_t)l * NMS * NMOD, NMOD, n0, in[5] + (size_t)l * NMOD); }
        }
    }
    SEAM(0);
    if (EN(1) && IN(1)) {
        { LAS float* a_lds = (LAS float*)ldsl; LAS float* red = (LAS float*)(ldsl + 36864);
          for (int it = vcu; it < NLAYER * 128; it += G) { const int l = it / 128, r = it % 128; const int soff = (r < 40) ? 0 : 3 * DM;
              __syncthreads();
              for (int i = tid; i < NMS * 1024; i += 512) a_lds[i] = mods[((size_t)l * NMS + (i >> 10)) * NMOD + soff + (i & 1023)];
              __syncthreads();
              if (r < 40) gemv_item(a_lds, red, in[8] + (size_t)l * DM * PW, PW, r * 64, shwin + (size_t)l * NMS * PW, PW, r * 64, nullptr);
              else { const int up = r >= 84, nb = (r - 40) % 44, n0 = nb * 64;
                  gemv_item(a_lds, red, in[up ? 24 : 23] + (size_t)l * DM * FH, FH, n0, shwf + (size_t)l * NMS * NF, NF, (n0 / 128) * 256 + (n0 % 128) + (up ? 128 : 0), nullptr); } }
        }
        { LANE_LOCAL const int gw = vcu * 8 + wave, NGW = G * 8;
          for (int m = gw; m < MROWS; m += NGW) { const int b = m / TB, t = m - b * TB; const bool ctx = t < CTXL; const int ms = ctx ? 8 : b;
              const float* xr = ctx ? in[2] + ((size_t)b * CTXL + t) * DM : in[0] + ((size_t)b * SEQ + (t - CTXL)) * DM;
              f32x4 v[4]; float s = 0.f;
#pragma unroll
              for (int j = 0; j < 4; ++j) { v[j] = ((const f32x4*)xr)[lane + 64 * j]; s += (v[j].x * v[j].x + v[j].y * v[j].y) + (v[j].z * v[j].z + v[j].w * v[j].w); }
              s = wave_sum(s);
#pragma unroll
              for (int j = 0; j < 4; ++j) { const int col = 4 * lane + 256 * j; const f32x4 g = *(const f32x4*)(in[6] + col), sc = *(const f32x4*)(mods + (size_t)ms * NMOD + DM + col);
                  const f32x4 a = v[j] * g * (sc + 1.f); u32x2 w; w.x = cvtpk(a.x, a.y); w.y = cvtpk(a.z, a.w); *(u32x2*)(AP + (size_t)m * DM + col) = w; }
              if (lane < 16) rowss[(size_t)m * 16 + lane] = (lane == 0) ? s : 0.f; }
        }
    }
    SEAM(1);
#pragma unroll 1
    for (int l = 0; l < NLAYER; ++l) {
        const int pb = 2 + 6 * l; const bool last = (l == NLAYER - 1);
        const float* modl = mods + (size_t)l * NMS * NMOD;
        if (EN(2) && IN(pb)) {
            pg8::Gemm g{AP, (const bf16_t*)(ws + WS_WIN + l * SZ_WIN), MROWS, PW, DM}; pg8::Order S; S.init(MROWS / 256, PW, G, bx, 0);
            EpiInProj E{Pb, rowss, shwin + (size_t)l * NMS * PW, ropeC, ropeS};
            pg8::gemm_phase<EpiInProj, pg8::Order, true, true>(ldsl, g, S, E);
        }
        SEAM(pb);
        if (IN(pb + 1)) {
            if (EN(3)) for (int u = vcu; u < NB * NCHUNK; u += G)
                lru::lru_unit<false>(lds, Pb, Yb, u / NCHUNK, u % NCHUNK, in[12] + l * 1024, in[13] + l * 256, WRG + (size_t)l * 65536, in[15] + l * 512, in[17] + l * 512, c8 + l * 512, lrus);
            if (EN(4)) for (int u = G - 1 - vcu; u < NB * NCHUNK; u += G) { const int c = u % NCHUNK; if (last && c < 2) continue;
                sgu::sgu_unit(lds, Pb, Yb, u / NCHUNK, c, WSP + (size_t)l * 65536, in[19] + l * 256, in[21] + l * 512); }
            const float lam = lamv[l], li = 0.8f - 0.6f * __expf(-0.3f * (float)l);
            if (EN(5)) { const int nu = last ? NB * 4 * 16 : NB * 4 * 17;
#pragma unroll 1
                for (int rep_ = 0; rep_ < PROBE_ATTREP; ++rep_)
                for (int u = vcu; u < nu; u += G) { int bh, qb; if (u < NB * 4 * 16) { bh = u >> 4; qb = (u & 15) + 1; } else { bh = u - NB * 4 * 16; qb = 0; }
                    att::attn_unit(lds, Pb, Yb, bh >> 2, bh & 3, qb, lam, in[11] + l * 128, 1.f - li); } }
        }
        SEAM(pb + 1);
        if (EN(6) && IN(pb + 2)) {
            const int nu2 = last ? NB * 32 : NB * NCHUNK;
            for (int u = vcu; u < nu2; u += G) { const int b_ = last ? (u >> 5) : u / NCHUNK, c = last ? 2 + (u & 31) : u % NCHUNK;
                lru::lru_unit<true>(lds, Pb, Yb, b_, c, in[12] + l * 1024, in[13] + l * 256, WRG + (size_t)l * 65536, in[15] + l * 512, in[17] + l * 512, c8 + l * 512, lrus); }
        }
        SEAM(pb + 2);
        if (EN(7) && IN(pb + 3)) {
            pg8::Gemm g{Yb, (const bf16_t*)(ws + WS_WOUT + l * SZ_WOUT), MROWS, DM, DM}; pg8::Order S; S.init(last ? 128 : 136, DM, G, bx, last ? 1 : 0);
            EpiRes<0> E{l == 0 ? in[0] : args.out, l == 0 ? in[2] : xc, args.out, xc, modl + 2 * DM, nullptr, nullptr, in[7] + l * DM, modl + 4 * DM, AP, rowss, 1, 0};
            pg8::gemm_phase<EpiRes<0>, pg8::Order, true, true>(ldsl, g, S, E);
        }
        SEAM(pb + 3);
        if (EN(8) && IN(pb + 4)) {
            pg8::Gemm g{AP, (const bf16_t*)(ws + WS_WFFN + l * SZ_WFFN), MROWS, NF, DM}; pg8::Order S; S.init(last ? 128 : 136, NF, G, bx, last ? 1 : 0);
            EpiSwiGLU E{HM, rowss, shwf + (size_t)l * NMS * NF};
            pg8::gemm_phase<EpiSwiGLU, pg8::Order, true, true>(ldsl, g, S, E);
        }
        SEAM(pb + 4);
        if (EN(9) && IN(pb + 5)) {
            pg8::Gemm g{HM, (const bf16_t*)(ws + WS_WDN + l * SZ_WDN), MROWS, DM, FH}; pg8::Order S; S.init(last ? 128 : 136, DM, G, bx, last ? 1 : 0);
            const int ln = last ? l : l + 1;
            EpiRes<1> E{args.out, xc, args.out, xc, modl + 5 * DM, in[7] + l * DM, modl + 4 * DM, in[6] + ln * DM, mods + (size_t)ln * NMS * NMOD + DM, AP, rowss, last ? 0 : 1, last ? 1 : 0};
            pg8::gemm_phase<EpiRes<1>, pg8::Order, true, true>(ldsl, g, S, E);
        }
        SEAM(pb + 5);
    }
    if (EN(10) && IN(14)) {
        LANE_LOCAL const int gw = vcu * 8 + wave, NGW = G * 8;
        for (int m = gw; m < NB * SEQ; m += NGW) { const int b = m / SEQ, t = m - b * SEQ; const size_t row = (size_t)b * TB + CTXL + t;
            const float rstd = row_rstd(rowss, row); f32x4* xr = (f32x4*)(args.out + (size_t)m * DM);
            u32x2 w[4];
#pragma unroll
            for (int j = 0; j < 4; ++j) w[j] = ((const u32x2*)xr)[lane + 64 * j];
            asm volatile("s_waitcnt vmcnt(0)" ::: "memory");
#pragma unroll
            for (int j = 0; j < 4; ++j) { const f32x4 g = *(const f32x4*)(in[26] + 4 * lane + 256 * j);
                const f32x4 xv = (f32x4){bflo(w[j].x), bfhi(w[j].x), bflo(w[j].y), bfhi(w[j].y)}; xr[lane + 64 * j] = xv * rstd * g; } }
    }
#undef IN
#undef SEAM
#undef mods
#undef shwin
#undef shwf
#undef ropeC
#undef ropeS
#undef c8
#undef lamv
#undef rowss
#undef lrus
#undef xc
#undef AP
#undef Pb
#undef Yb
#undef HM
#undef WSP
#undef WRG
}

extern "C" void kernel_launch(void* const* d_in, const int* in_sizes, int n_in, void* d_out, int out_size, void* d_ws, size_t ws_size, hipStream_t stream) {
    static int grid = 0;
    if (grid == 0) {
        if (n_in != 27 || out_size != NB * SEQ * DM || ws_size < WS_TOTAL) { fprintf(stderr, "kernel_launch: unexpected shapes (n_in %d out %d ws %zu need %zu)\n", n_in, out_size, ws_size, (size_t)WS_END); grid = -1; return; }
        int dev = 0, cus = 0, per_cu = 0;
        (void)hipGetDevice(&dev); (void)hipDeviceGetAttribute(&cus, hipDeviceAttributeMultiprocessorCount, dev);
        if (hipFuncSetAttribute((const void*)hybrid_fwd, hipFuncAttributeMaxDynamicSharedMemorySize, LDS_BYTES) != hipSuccess) { fprintf(stderr, "kernel_launch: hipFuncSetAttribute failed\n"); grid = -1; return; }
        (void)hipOccupancyMaxActiveBlocksPerMultiprocessor(&per_cu, (const void*)hybrid_fwd, 512, LDS_BYTES);
        if (per_cu < 1) { fprintf(stderr, "kernel_launch: occupancy query says %d blocks per CU\n", per_cu); per_cu = 1; }
        (void)hipGetLastError();
        grid = cus;
    }
    if (grid < 0) return;
    if (hipMemsetAsync((char*)d_ws + WS_CTL, 0, WS_CTL_BYTES, stream) != hipSuccess) { fprintf(stderr, "kernel_launch: memset failed\n"); return; }
    Args a{};
    for (int i = 0; i < 27; ++i) a.in[i] = (const float*)d_in[i];
    a.out = (float*)d_out; a.ws = (unsigned char*)d_ws;
#if MK_SINGLE
    a.ph_lo = 0; a.ph_hi = NPHASE;
    { void* kargs[] = {&a}; hipError_t e = hipLaunchCooperativeKernel((const void*)hybrid_fwd, dim3(grid), dim3(512), kargs, LDS_BYTES, stream);
      if (e != hipSuccess) fprintf(stderr, "cooperative launch failed: %s (grid %d)\n", hipGetErrorString(e), grid); }
#else
    for (int pp = 0; pp < NPHASE + PROBE_NDUP; ++pp) { const int p = pp < NPHASE ? pp : PROBE_DUP0 + (pp - NPHASE) * PROBE_DUPSTEP; a.ph_lo = p; a.ph_hi = p + 1;
        void* kargs[] = {&a}; hipError_t e = hipLaunchCooperativeKernel((const void*)hybrid_fwd, dim3(grid), dim3(512), kargs, LDS_BYTES, stream);
        if (e != hipSuccess) { fprintf(stderr, "cooperative launch %d failed: %s (grid %d)\n", p, hipGetErrorString(e), grid); break; } }
#endif
}
```

```cpp
#include <hip/hip_runtime.h>
#include <hip/hip_cooperative_groups.h>
#include <cstdio>
#include <cstdint>
namespace cg = cooperative_groups;

#ifndef MK_SINGLE
#define MK_SINGLE 1
#endif
#ifndef PH_MASK
#define PH_MASK 0xFFFF
#endif
#define EN(k) (((PH_MASK) >> (k)) & 1)
#ifndef PROBE_NDUP
#define PROBE_NDUP 0
#define PROBE_DUP0 0
#define PROBE_DUPSTEP 6
#endif
#ifndef PROBE_ATTREP
#define PROBE_ATTREP 1
#endif
#ifndef ATT_VAR
#define ATT_VAR 0
#endif

constexpr int NB = 8, SEQ = 4096, CTXL = 256, TB = SEQ + CTXL, MROWS = NB * TB, DM = 1024, PW = 2560, FH = 2816, NF = 2 * FH, NLAYER = 2;
constexpr int Q0c = 0, K0c = 512, V0c = 1024, LX0 = 1536, LG0 = 1792, SU0 = 2048, SV0 = 2304;
constexpr int NMS = 9, NMOD = 6 * DM;
constexpr int NCHUNK = TB / 128;
constexpr size_t SZ_WIN = (size_t)PW * DM * 2, SZ_WOUT = (size_t)DM * DM * 2, SZ_WFFN = (size_t)NF * DM * 2, SZ_WDN = (size_t)DM * FH * 2;
constexpr size_t WS_WIN = 0, WS_WOUT = WS_WIN + 2 * SZ_WIN, WS_WFFN = WS_WOUT + 2 * SZ_WOUT, WS_WDN = WS_WFFN + 2 * SZ_WFFN;
constexpr size_t WS_WSP = WS_WDN + 2 * SZ_WDN;
constexpr size_t WS_WRG = WS_WSP + 262144;
constexpr size_t WS_MODS = WS_WRG + 262144;
constexpr size_t WS_SHWIN = WS_MODS + 442368;
constexpr size_t WS_SHWF = WS_SHWIN + 184320;
constexpr size_t WS_ROPE = WS_SHWF + 405504;
constexpr size_t WS_C8 = WS_ROPE + 8192;
constexpr size_t WS_LAM = WS_C8 + 4096;
constexpr size_t WS_ROWSS = WS_LAM + 256;
constexpr size_t WS_LRUS = WS_ROWSS + (size_t)MROWS * 64;
constexpr size_t WS_XC = WS_LRUS + (size_t)NB * NCHUNK * 2 * 2 * 256 * 4;
constexpr size_t WS_AP = WS_XC + (size_t)NB * CTXL * DM * 4;
constexpr size_t WS_P = WS_AP + (size_t)MROWS * DM * 2;
constexpr size_t WS_Y = WS_P + (size_t)MROWS * PW * 2;
constexpr size_t WS_END = WS_Y + (size_t)MROWS * DM * 2;
constexpr size_t WS_CTL = WS_END, WS_CTL_BYTES = 16384, WS_TOTAL = WS_END + WS_CTL_BYTES;
constexpr size_t WS_HMID = WS_P;
static_assert((size_t)MROWS * FH * 2 <= WS_END - WS_P, "hmid overlay");
static_assert(WS_WSP % 256 == 0 && WS_MODS % 256 == 0 && WS_ROWSS % 256 == 0 && WS_XC % 256 == 0 && WS_AP % 256 == 0 && WS_P % 256 == 0, "align");

#define LAS __attribute__((address_space(3)))
typedef float f32x2 __attribute__((ext_vector_type(2)));
typedef unsigned u32x2 __attribute__((ext_vector_type(2)));
__device__ __forceinline__ unsigned cvtpk(float lo, float hi) { unsigned r; asm("v_cvt_pk_bf16_f32 %0, %1, %2" : "=v"(r) : "v"(lo), "v"(hi)); return r; }
__device__ __forceinline__ float bflo(unsigned w) { return __uint_as_float(w << 16); }
__device__ __forceinline__ float bfhi(unsigned w) { return __uint_as_float(w & 0xffff0000u); }
__device__ __forceinline__ float bf2f(unsigned short h) { return __uint_as_float((unsigned)h << 16); }
__device__ __forceinline__ unsigned short f2bf(float v) { return (unsigned short)(cvtpk(v, v) & 0xffffu); }
__device__ __forceinline__ float fexp(float x) { return __builtin_amdgcn_exp2f(x * 1.4426950408889634f); }
__device__ __forceinline__ float gelu_tanh(float x) { const float u = 1.5957691216f * x * (1.f + 0.044715f * x * x); return x * __builtin_amdgcn_rcpf(1.f + fexp(-u)); }
__device__ __forceinline__ float silu_f(float x) { return x * __builtin_amdgcn_rcpf(1.f + fexp(-x)); }
__device__ __forceinline__ float sigm(float x) { return __builtin_amdgcn_rcpf(1.f + fexp(-x)); }

namespace pg8 {
#define PG8_LAS __attribute__((address_space(3)))
typedef unsigned short bf16_t;
typedef short bf16x8 __attribute__((ext_vector_type(8)));
typedef float f32x4 __attribute__((ext_vector_type(4)));
typedef unsigned u32x4 __attribute__((ext_vector_type(4)));
constexpr int BM = 256, BK = 64, HALF = 128, HTB = HALF * BK * 2  , STAGE_BYTES = 8 * HTB, NXCD = 8, WGM = 8;

__host__ __device__ __forceinline__ int lds_byte(int r, int c) { const int st = (r >> 4) * 2 + (c >> 5), rr = r & 15, cc = c & 31, ob = rr * 64 + cc * 2; return st * 1024 + (ob ^ (((ob >> 9) & 1) << 5)); }
__host__ __device__ __forceinline__ void stage_rc(int b, int& R, int& C) { const int st = b / 1024, sb = b % 1024, swz = sb ^ (((sb >> 9) & 1) << 5); R = (st >> 1) * 16 + swz / 64; C = (st & 1) * 32 + (swz % 64) / 2; }
__host__ __device__ __forceinline__ int perm32(int rho) { const int n = rho >> 4, i = rho & 15; return 8 * (i >> 2) + 4 * n + (i & 3); }

struct Unit { int pm, pn; };
struct Gemm { const bf16_t* A; const bf16_t* Bt; int M, N, K; };

struct StaticOrder {
    int nM, nN, nwg, G, c;
    __host__ __device__ void init(int M, int N, int G_, int c_) { nM = M / BM; nN = N / BM; nwg = nM * nN; G = G_; c = c_; }
    __host__ __device__ bool next(int i, Unit& u) const {
        const long L = (long)i * G + c; if (L >= nwg) return false;
        int wgid = (int)L; { const int q = nwg / NXCD, r = nwg % NXCD, xcd = wgid % NXCD, off = wgid / NXCD; wgid = (xcd < r ? xcd * (q + 1) : r * (q + 1) + (xcd - r) * q) + off; }
        const int nig = WGM * nN, gid = wgid / nig, fm = gid * WGM, gsz = (nM - fm) < WGM ? (nM - fm) : WGM;
        u.pm = fm + ((wgid % nig) % gsz); u.pn = (wgid % nig) / gsz; return true;
    }
    __device__ __forceinline__ void a_ready(const Unit&) const {}
    __device__ __forceinline__ void done(const Unit&) const {}
};

}
namespace pg8 {
template <class Epi, class Sched, bool ALIGN_EPI = false, bool SP2 = false>
__device__ __forceinline__ void gemm_phase(PG8_LAS unsigned char* lds, const Gemm g, const Sched& S, const Epi& E) {
    int tid_ = threadIdx.x; asm volatile("" : "+v"(tid_));
    const int tid = tid_, wid = __builtin_amdgcn_readfirstlane(tid >> 6), lane = tid & 63, wr = wid >> 2, wc = wid & 3, fr = lane & 15, fq = lane >> 4;
    const int K = g.K, nt = K / BK;
    unsigned voffA[2], voffB[2];
#pragma unroll
    for (int i = 0; i < 2; ++i) { int R, C; stage_rc(tid * 16 + i * 8192, R, C); const int Rb = Epi::PERM ? ((R & ~31) + perm32(R & 31)) : R;
        voffA[i] = (unsigned)(R * K + C) * 2u; voffB[i] = (unsigned)(Rb * K + C) * 2u; }
    const size_t kstep = (size_t)(BK * 2);
    const size_t hstep = (size_t)HALF * K * 2;
    const size_t tstep = 2 * hstep;
    const unsigned ldsw = (unsigned)wid * 1024u;
    const int aoff = lds_byte(wr * 64 + fr, fq * 8), boff = lds_byte(wc * 32 + fr, fq * 8);
#define PG8_SA(b, h) (((b) * 2 + (h)) * HTB)
#define PG8_SB(b, h) ((4 + (b) * 2 + (h)) * HTB)
#define PG8_STAGE(bufoff, gbase, voff) do { _Pragma("unroll") for (int _i = 0; _i < 2; ++_i) \
        __builtin_amdgcn_global_load_lds((const unsigned*)((const char*)(gbase) + (voff)[_i]), (PG8_LAS unsigned*)(lds + (bufoff) + ldsw + _i * 8192), 16, 0, 0); } while (0)
#define PG8_LDA(dst, b, h) do { _Pragma("unroll") for (int m = 0; m < 4; ++m) _Pragma("unroll") for (int k = 0; k < 2; ++k) dst[m][k] = *(const PG8_LAS bf16x8*)(lds + PG8_SA(b, h) + aoff + m * 2048 + k * 1024); } while (0)
#define PG8_LDB(dst, b, h) do { _Pragma("unroll") for (int n = 0; n < 2; ++n) _Pragma("unroll") for (int k = 0; k < 2; ++k) dst[n][k] = *(const PG8_LAS bf16x8*)(lds + PG8_SB(b, h) + boff + n * 2048 + k * 1024); } while (0)
#define PG8_MMA(ai, bj, At, Bt) do { __builtin_amdgcn_s_setprio(1); _Pragma("unroll") for (int m = 0; m < 4; ++m) _Pragma("unroll") for (int n = 0; n < 2; ++n) _Pragma("unroll") for (int k = 0; k < 2; ++k) \
        acc[ai][bj][m][n] = __builtin_amdgcn_mfma_f32_16x16x32_bf16(Bt[n][k], At[m][k], acc[ai][bj][m][n], 0, 0, 0); __builtin_amdgcn_s_setprio(0); } while (0)
#define PG8_WAIT_V(n) asm volatile("s_waitcnt vmcnt(" #n ")" ::: "memory")
#define PG8_WAIT_L(n) asm volatile("s_waitcnt lgkmcnt(" #n ")" ::: "memory")
#define PG8_BAR __builtin_amdgcn_s_barrier()
#define PG8_SCHED __builtin_amdgcn_sched_barrier(0)
    Unit cur, nxt; int ui = 0;
    if (!S.next(0, cur)) return;
    f32x4 acc[2][2][4][2];
#pragma unroll
    for (int a = 0; a < 2; ++a)
#pragma unroll
        for (int b = 0; b < 2; ++b)
#pragma unroll
            for (int m = 0; m < 4; ++m)
#pragma unroll
                for (int n = 0; n < 2; ++n) acc[a][b][m][n] = (f32x4){0.f, 0.f, 0.f, 0.f};
    bf16x8 At[4][2], B0[2][2], B1[2][2];
    const char* cA = (const char*)g.A + (size_t)cur.pm * tstep; const char* cB = (const char*)g.Bt + (size_t)cur.pn * tstep;
    S.a_ready(cur);
    if constexpr (SP2) {
        PG8_STAGE(PG8_SB(0, 0), cB, voffB); PG8_STAGE(PG8_SB(0, 1), cB + hstep, voffB); PG8_STAGE(PG8_SA(0, 0), cA, voffA); PG8_STAGE(PG8_SA(0, 1), cA + hstep, voffA);
        if (wr == 1) PG8_BAR;
        PG8_WAIT_V(2); PG8_BAR;
        PG8_STAGE(PG8_SB(1, 0), cB + kstep, voffB); PG8_STAGE(PG8_SA(1, 0), cA + kstep, voffA); PG8_STAGE(PG8_SB(1, 1), cB + hstep + kstep, voffB);
        PG8_WAIT_V(6); PG8_BAR;
    } else {
        PG8_STAGE(PG8_SB(0, 0), cB, voffB); PG8_STAGE(PG8_SA(0, 0), cA, voffA); PG8_STAGE(PG8_SB(0, 1), cB + hstep, voffB); PG8_STAGE(PG8_SA(0, 1), cA + hstep, voffA);
        if (wr == 1) PG8_BAR;
        PG8_WAIT_V(4); PG8_BAR;
        PG8_STAGE(PG8_SB(1, 0), cB + kstep, voffB); PG8_STAGE(PG8_SA(1, 0), cA + kstep, voffA); PG8_STAGE(PG8_SB(1, 1), cB + hstep + kstep, voffB);
        PG8_WAIT_V(6); PG8_BAR;
    }
    for (;;) {
        const bool has_next = S.next(ui + 1, nxt);
        const char* nA = has_next ? (const char*)g.A + (size_t)nxt.pm * tstep : cA; const char* nB = has_next ? (const char*)g.Bt + (size_t)nxt.pn * tstep : cB;
        for (int t = 0; t < nt; t += 2) {
            const bool last = (t == nt - 2);
            const char* a1 = cA + (size_t)(t + 1) * kstep;
            const char* a2 = last ? nA : cA + (size_t)(t + 2) * kstep; const char* b2 = last ? nB : cB + (size_t)(t + 2) * kstep;
            const char* a3 = a2 + kstep; const char* b3 = b2 + kstep;
            if (last && has_next) S.a_ready(nxt);
            if constexpr (SP2) {
            PG8_LDB(B0, 0, 0); PG8_LDB(B1, 0, 1); PG8_SCHED; PG8_LDA(At, 0, 0); PG8_STAGE(PG8_SA(1, 1), a1 + hstep, voffA);
            PG8_WAIT_V(8); PG8_WAIT_L(0); PG8_BAR; PG8_MMA(0, 0, At, B0); PG8_MMA(0, 1, At, B1); PG8_BAR; PG8_SCHED;
            PG8_LDA(At, 0, 1); PG8_STAGE(PG8_SB(0, 0), b2, voffB); PG8_STAGE(PG8_SB(0, 1), b2 + hstep, voffB); PG8_STAGE(PG8_SA(0, 0), a2, voffA);
            PG8_WAIT_V(8); PG8_WAIT_L(0); PG8_BAR; PG8_MMA(1, 0, At, B0); PG8_MMA(1, 1, At, B1); PG8_BAR; PG8_SCHED;
            PG8_LDB(B0, 1, 0); PG8_LDB(B1, 1, 1); PG8_SCHED; PG8_LDA(At, 1, 0); PG8_STAGE(PG8_SA(0, 1), a2 + hstep, voffA);
            PG8_WAIT_V(8); PG8_WAIT_L(0); PG8_BAR; PG8_MMA(0, 0, At, B0); PG8_MMA(0, 1, At, B1); PG8_BAR; PG8_SCHED;
            PG8_LDA(At, 1, 1); PG8_STAGE(PG8_SB(1, 0), b3, voffB); PG8_STAGE(PG8_SB(1, 1), b3 + hstep, voffB); PG8_STAGE(PG8_SA(1, 0), a3, voffA);
            PG8_WAIT_V(8); PG8_WAIT_L(0); PG8_BAR; PG8_MMA(1, 0, At, B0); PG8_MMA(1, 1, At, B1); PG8_BAR; PG8_SCHED;
            } else {
            PG8_LDB(B0, 0, 0); PG8_SCHED; PG8_LDA(At, 0, 0); PG8_STAGE(PG8_SA(1, 1), a1 + hstep, voffA);
            PG8_WAIT_L(8); PG8_BAR; PG8_WAIT_L(0); PG8_MMA(0, 0, At, B0); PG8_BAR; PG8_SCHED;
            PG8_LDB(B1, 0, 1); PG8_STAGE(PG8_SB(0, 0), b2, voffB);
            PG8_BAR; PG8_WAIT_L(0); PG8_MMA(0, 1, At, B1); PG8_BAR;
            PG8_LDA(At, 0, 1); PG8_STAGE(PG8_SA(0, 0), a2, voffA);
            PG8_BAR; PG8_WAIT_L(0); PG8_MMA(1, 0, At, B0); PG8_BAR; PG8_SCHED;
            PG8_STAGE(PG8_SB(0, 1), b2 + hstep, voffB);
            PG8_WAIT_V(6); PG8_BAR; PG8_MMA(1, 1, At, B1); PG8_BAR;
            PG8_LDB(B0, 1, 0); PG8_SCHED; PG8_LDA(At, 1, 0); PG8_STAGE(PG8_SA(0, 1), a2 + hstep, voffA);
            PG8_WAIT_L(8); PG8_BAR; PG8_WAIT_L(0); PG8_MMA(0, 0, At, B0); PG8_BAR; PG8_SCHED;
            PG8_LDB(B1, 1, 1); PG8_STAGE(PG8_SB(1, 0), b3, voffB);
            PG8_BAR; PG8_WAIT_L(0); PG8_MMA(0, 1, At, B1); PG8_BAR;
            PG8_LDA(At, 1, 1); PG8_STAGE(PG8_SA(1, 0), a3, voffA);
            PG8_BAR; PG8_WAIT_L(0); PG8_MMA(1, 0, At, B0); PG8_BAR; PG8_SCHED;
            PG8_STAGE(PG8_SB(1, 1), b3 + hstep, voffB);
            PG8_WAIT_V(6); PG8_BAR; PG8_MMA(1, 1, At, B1); PG8_BAR;
            }
        }
        if constexpr (ALIGN_EPI) { if (wr == 0) PG8_BAR; }
        if constexpr (!Epi::AFTER_DRAIN) { E(acc, cur, wr, wc, fr, fq); S.done(cur); }
        if (!has_next) break;
#pragma unroll
        for (int a = 0; a < 2; ++a)
#pragma unroll
            for (int b = 0; b < 2; ++b)
#pragma unroll
                for (int m = 0; m < 4; ++m)
#pragma unroll
                    for (int n = 0; n < 2; ++n) acc[a][b][m][n] = (f32x4){0.f, 0.f, 0.f, 0.f};
        cur = nxt; cA = nA; cB = nB; ++ui;
        if constexpr (ALIGN_EPI) { if (wr == 1) PG8_BAR; }
    }
    PG8_WAIT_V(0);
    if constexpr (!ALIGN_EPI) { if (wr == 0) PG8_BAR; }
    PG8_BAR;
    if constexpr (Epi::AFTER_DRAIN) { E.fused(acc, cur, wr, wc, fr, fq, lds, wid, lane); S.done(cur); }
#undef PG8_SA
#undef PG8_SB
#undef PG8_STAGE
#undef PG8_LDA
#undef PG8_LDB
#undef PG8_MMA
#undef PG8_WAIT_V
#undef PG8_WAIT_L
#undef PG8_BAR
#undef PG8_SCHED
}
}
namespace pg8 {
struct Order {
    int nM, nN, nwg, G, c, skip;
    __device__ void init(int nM_, int N, int G_, int c_, int skip_) { nM = nM_; nN = N / BM; nwg = nM * nN; G = G_; c = c_; skip = skip_; }
    __device__ bool next(int i, Unit& u) const {
        const long L = (long)i * G + c; if (L >= nwg) return false;
        int wgid = (int)L; { const int q = nwg / NXCD, r = nwg % NXCD, xcd = wgid % NXCD, off = wgid / NXCD; wgid = (xcd < r ? xcd * (q + 1) : r * (q + 1) + (xcd - r) * q) + off; }
        const int nig = WGM * nN, gid = wgid / nig, fm = gid * WGM, gsz = (nM - fm) < WGM ? (nM - fm) : WGM;
        u.pm = fm + ((wgid % nig) % gsz); u.pn = (wgid % nig) / gsz;
        if (skip) u.pm = u.pm + u.pm / 16 + 1;
        return true;
    }
    __device__ __forceinline__ void a_ready(const Unit&) const {}
    __device__ __forceinline__ void done(const Unit&) const {}
};
}

using pg8::f32x4; using pg8::u32x4; using pg8::bf16_t; using pg8::bf16x8;
__device__ __forceinline__ float row_rstd(const float* rowss, size_t row) {
    const f32x4* rs = (const f32x4*)(rowss + row * 16);
    const f32x4 s4 = (rs[0] + rs[1]) + (rs[2] + rs[3]);
    return rsqrtf(((s4.x + s4.y) + (s4.z + s4.w)) * (1.f / 1024.f) + 1e-6f);
}
__device__ __forceinline__ void rows_rstd(const float* rowss, int pm, int wr, int fr, float (&rstd)[2][4]) {
#pragma unroll
    for (int ai = 0; ai < 2; ++ai)
#pragma unroll
      for (int mh = 0; mh < 2; ++mh) { f32x4 t[2][4];
#pragma unroll
        for (int m2 = 0; m2 < 2; ++m2) { const f32x4* rs = (const f32x4*)(rowss + ((size_t)pm * 256 + ai * 128 + wr * 64 + (mh * 2 + m2) * 16 + fr) * 16);
#pragma unroll
            for (int k = 0; k < 4; ++k) t[m2][k] = rs[k]; }
        asm volatile("" ::: "memory");
#pragma unroll
        for (int m2 = 0; m2 < 2; ++m2) { const f32x4 s4 = (t[m2][0] + t[m2][1]) + (t[m2][2] + t[m2][3]); rstd[ai][mh * 2 + m2] = rsqrtf(((s4.x + s4.y) + (s4.z + s4.w)) * (1.f / 1024.f) + 1e-6f); } }
}
struct EpiInProj {
    static constexpr bool PERM = false, AFTER_DRAIN = false;
    bf16_t* P; const float* rowss; const float* sW; const float* ropeC; const float* ropeS;
    __device__ __forceinline__ void operator()(const f32x4 (&acc)[2][2][4][2], const pg8::Unit& u, int wr, int wc, int fr, int fq) const {
        const int b = u.pm / 17, j17 = u.pm - b * 17; const bool ctx = (j17 == 0); const int ms = ctx ? 8 : b;
        const int colb = u.pn * 256 + wc * 32 + 4 * fq;
        const int mode = (u.pn < 4) ? (ctx ? 0 : 1) : (u.pn >= 7 ? 2 : 0);
        f32x4 bv[2][2];
#pragma unroll
        for (int bj = 0; bj < 2; ++bj)
#pragma unroll
            for (int n = 0; n < 2; ++n) bv[bj][n] = *(const f32x4*)(sW + ms * PW + colb + bj * 128 + n * 16);
#pragma unroll
        for (int ai = 0; ai < 2; ++ai) {
#pragma unroll
            for (int m = 0; m < 4; ++m) {
                const int rt = ai * 128 + wr * 64 + m * 16 + fr; const size_t row = (size_t)u.pm * 256 + rt;
                float rstd;
                { const f32x4* rs = (const f32x4*)(rowss + row * 16); const f32x4 t0 = rs[0], t1 = rs[1], t2 = rs[2], t3 = rs[3];
                  const f32x4 s4 = (t0 + t1) + (t2 + t3); rstd = rsqrtf(((s4.x + s4.y) + (s4.z + s4.w)) * (1.f / 1024.f) + 1e-6f); }
                f32x4 v[2][2];
#pragma unroll
                for (int bj = 0; bj < 2; ++bj)
#pragma unroll
                    for (int n = 0; n < 2; ++n) v[bj][n] = acc[ai][bj][m][n] * rstd + bv[bj][n];
                if (mode == 1) {
                    const int tl = (j17 - 1) * 256 + rt; const int pos = (wc & 1) ? (tl & 63) : (tl >> 6);
                    const f32x4 c4 = *(const f32x4*)(ropeC + pos * 16 + 4 * fq), s4 = *(const f32x4*)(ropeS + pos * 16 + 4 * fq);
#pragma unroll
                    for (int bj = 0; bj < 2; ++bj) { const f32x4 x1 = v[bj][0], x2 = v[bj][1]; v[bj][0] = x1 * c4 - x2 * s4; v[bj][1] = x1 * s4 + x2 * c4; }
                } else if (mode == 2) {
#pragma unroll
                    for (int bj = 0; bj < 2; ++bj)
#pragma unroll
                        for (int n = 0; n < 2; ++n) { f32x4 t = v[bj][n]; t.x = gelu_tanh(t.x); t.y = gelu_tanh(t.y); t.z = gelu_tanh(t.z); t.w = gelu_tanh(t.w); v[bj][n] = t; }
                }
                bf16_t* rp = P + row * PW + colb;
#pragma unroll
                for (int bj = 0; bj < 2; ++bj)
#pragma unroll
                    for (int n = 0; n < 2; ++n) { u32x2 w; w.x = cvtpk(v[bj][n].x, v[bj][n].y); w.y = cvtpk(v[bj][n].z, v[bj][n].w); *(u32x2*)(rp + bj * 128 + n * 16) = w; }
            }
        }
    }
};
struct EpiSwiGLU {
    static constexpr bool PERM = true, AFTER_DRAIN = false;
    bf16_t* H; const float* rowss; const float* sW;
    __device__ __forceinline__ void operator()(const f32x4 (&acc)[2][2][4][2], const pg8::Unit& u, int wr, int wc, int fr, int fq) const {
        const int b = u.pm / 17, j17 = u.pm - b * 17; const int ms = (j17 == 0) ? 8 : b;
        const int colb = wc * 32 + 8 * fq;
        f32x4 bg[2], bu[2];
#pragma unroll
        for (int n = 0; n < 2; ++n) { bg[n] = *(const f32x4*)(sW + ms * NF + u.pn * 256 + colb + 4 * n); bu[n] = *(const f32x4*)(sW + ms * NF + u.pn * 256 + 128 + colb + 4 * n); }
        float rstd_[2][4]; rows_rstd(rowss, u.pm, wr, fr, rstd_);
#pragma unroll
        for (int ai = 0; ai < 2; ++ai)
#pragma unroll
            for (int m = 0; m < 4; ++m) {
                const int rt = ai * 128 + wr * 64 + m * 16 + fr; const size_t row = (size_t)u.pm * 256 + rt;
                const float rstd = rstd_[ai][m];
                f32x4 hm[2];
#pragma unroll
                for (int n = 0; n < 2; ++n) { const f32x4 g = acc[ai][0][m][n] * rstd + bg[n], up = acc[ai][1][m][n] * rstd + bu[n];
                    hm[n].x = silu_f(g.x) * up.x; hm[n].y = silu_f(g.y) * up.y; hm[n].z = silu_f(g.z) * up.z; hm[n].w = silu_f(g.w) * up.w; }
                u32x4 w; w.x = cvtpk(hm[0].x, hm[0].y); w.y = cvtpk(hm[0].z, hm[0].w); w.z = cvtpk(hm[1].x, hm[1].y); w.w = cvtpk(hm[1].z, hm[1].w);
                *(u32x4*)(H + row * FH + u.pn * 128 + colb) = w;
            }
    }
};
struct EpiRes {
    static constexpr bool PERM = true, AFTER_DRAIN = false;
    const float* xin_lat; const float* xin_ctx; float* xo_lat; int xsrc;
    const float* gate; const float* gp; const float* scp;
    const float* gn; const float* scn; bf16_t* A; float* rowss; int write_a; int xbf;
    __device__ __forceinline__ void operator()(const f32x4 (&acc)[2][2][4][2], const pg8::Unit& u, int wr, int wc, int fr, int fq) const {
        const int b = u.pm / 17, j17 = u.pm - b * 17; const bool ctx = (j17 == 0); const int ms = ctx ? 8 : b;
        const float* xi = ctx ? xin_ctx + (size_t)b * CTXL * DM : xin_lat + ((size_t)b * SEQ + (size_t)(j17 - 1) * 256) * DM;
        float* xo = xo_lat + ((size_t)b * SEQ + (size_t)(j17 - 1) * 256) * DM;
        const int colb = u.pn * 256 + wc * 32 + 8 * fq;
        float ss[2][4];
#pragma unroll
        for (int ai = 0; ai < 2; ++ai)
#pragma unroll
            for (int m = 0; m < 4; ++m) ss[ai][m] = 0.f;
#pragma unroll
        for (int bj = 0; bj < 2; ++bj) {
            const int col = colb + bj * 128;
            f32x4 gv[2], fc[2], rf[2];
#pragma unroll
            for (int n = 0; n < 2; ++n) { gv[n] = *(const f32x4*)(gate + ms * NMOD + col + 4 * n);
                if (write_a) fc[n] = *(const f32x4*)(gn + col + 4 * n) * (*(const f32x4*)(scn + ms * NMOD + col + 4 * n) + 1.f); else fc[n] = (f32x4){0.f, 0.f, 0.f, 0.f};
                if (xsrc) { const f32x4 f = *(const f32x4*)(gp + col + 4 * n) * (*(const f32x4*)(scp + ms * NMOD + col + 4 * n) + 1.f);
                    rf[n].x = __builtin_amdgcn_rcpf(f.x); rf[n].y = __builtin_amdgcn_rcpf(f.y); rf[n].z = __builtin_amdgcn_rcpf(f.z); rf[n].w = __builtin_amdgcn_rcpf(f.w); }
                else rf[n] = (f32x4){0.f, 0.f, 0.f, 0.f}; }
#pragma unroll
            for (int ai = 0; ai < 2; ++ai) {
                f32x4 xl[4][2];
                if (!xsrc) {
#pragma unroll
                    for (int m = 0; m < 4; ++m) { const unsigned xo4 = ((unsigned)(ai * 128 + wr * 64 + m * 16 + fr) * DM + (unsigned)col) * 4u;
#pragma unroll
                        for (int n = 0; n < 2; ++n) xl[m][n] = *(const f32x4*)((const char*)xi + (xo4 + 16u * n)); }
                } else {
                    u32x4 w[4];
#pragma unroll
                    for (int m = 0; m < 4; ++m) w[m] = *(const u32x4*)((const char*)A + (((unsigned)u.pm * 256u + (unsigned)(ai * 128 + wr * 64 + m * 16 + fr)) * DM + (unsigned)col) * 2u);
#pragma unroll
                    for (int m = 0; m < 4; ++m) { xl[m][0] = (f32x4){bflo(w[m].x), bfhi(w[m].x), bflo(w[m].y), bfhi(w[m].y)} * rf[0]; xl[m][1] = (f32x4){bflo(w[m].z), bfhi(w[m].z), bflo(w[m].w), bfhi(w[m].w)} * rf[1]; }
                }
                asm volatile("" ::: "memory");
#pragma unroll
                for (int m = 0; m < 4; ++m) {
                    const int rt = ai * 128 + wr * 64 + m * 16 + fr;
                    f32x4 xv[2];
#pragma unroll
                    for (int n = 0; n < 2; ++n) { xv[n] = xl[m][n] + gv[n] * acc[ai][bj][m][n];
                        ss[ai][m] += (xv[n].x * xv[n].x + xv[n].y * xv[n].y) + (xv[n].z * xv[n].z + xv[n].w * xv[n].w); }
                    if (xbf) { u32x4 w; w.x = cvtpk(xv[0].x, xv[0].y); w.y = cvtpk(xv[0].z, xv[0].w); w.z = cvtpk(xv[1].x, xv[1].y); w.w = cvtpk(xv[1].z, xv[1].w);
                        *(u32x4*)((char*)xo + ((unsigned)rt * (DM * 4u) + (unsigned)col * 2u)) = w; }
                    if (write_a) { const f32x4 a0 = xv[0] * fc[0], a1 = xv[1] * fc[1];
                        u32x4 w; w.x = cvtpk(a0.x, a0.y); w.y = cvtpk(a0.z, a0.w); w.z = cvtpk(a1.x, a1.y); w.w = cvtpk(a1.z, a1.w);
                        *(u32x4*)((char*)A + (((unsigned)u.pm * 256u + (unsigned)rt) * DM + (unsigned)col) * 2u) = w; }
                }
            }
        }
#pragma unroll
        for (int ai = 0; ai < 2; ++ai)
#pragma unroll
            for (int m = 0; m < 4; ++m) { float s = ss[ai][m]; s += __shfl_xor(s, 16); s += __shfl_xor(s, 32);
                if (fq == 0) rowss[((size_t)u.pm * 256 + ai * 128 + wr * 64 + m * 16 + fr) * 16 + u.pn * 4 + wc] = s; }
    }
};
namespace att {
using s16x4 = __attribute__((ext_vector_type(4))) short;
using f32x16 = __attribute__((ext_vector_type(16))) float;
constexpr int SHM_V = 16384, SHM_K = 8192, OFF_V = 0, OFF_K = 32768, OFF_WS = 49152, OFF_ST = 51200, LDS_TOTAL = OFF_ST + 65536;
constexpr float SCALE = 0.125f, THR = 8.f;
#define KSWZ(row, colB) ((row) * 128 + ((colB) ^ (((row) & 7) << 4)))
#define SBAR() __builtin_amdgcn_sched_barrier(0)
__device__ __forceinline__ int crow(int r, int hi) { return (r & 3) + 8 * (r >> 2) + 4 * hi; }
__device__ __forceinline__ void partialSM(f32x16& p0, f32x16& p1, float& m_reg, float& mn, float& alpha) {
  constexpr float C = SCALE * 1.4426950408889634f;
  float pmax = p0[0];
#pragma unroll
  for (int r = 1; r < 16; ++r) pmax = fmaxf(pmax, p0[r]);
#pragma unroll
  for (int r = 0; r < 16; ++r) pmax = fmaxf(pmax, p1[r]);
  { auto rr = __builtin_amdgcn_permlane32_swap(__float_as_uint(pmax), __float_as_uint(pmax), false, false);
    pmax = fmaxf(__uint_as_float(rr[0]), __uint_as_float(rr[1])); }
  if (__builtin_expect(__all(pmax - m_reg <= THR / SCALE), 1)) { mn = m_reg; alpha = 1.f; }
  else { mn = fmaxf(m_reg, pmax); alpha = __builtin_amdgcn_exp2f((m_reg - mn) * C); m_reg = mn; }
  const float mnC = -mn * C;
#pragma unroll
  for (int r = 0; r < 16; ++r) p0[r] = fmaf(p0[r], C, mnC);
#pragma unroll
  for (int r = 0; r < 16; ++r) p1[r] = fmaf(p1[r], C, mnC);
#pragma unroll
  for (int r = 0; r < 16; ++r) p0[r] = __builtin_amdgcn_exp2f(p0[r]);
}
__device__ __forceinline__ void finishSM(f32x16& p0, f32x16& p1, float alpha, float& l_reg, bf16x8& pa0, bf16x8& pa1, bf16x8& pa2, bf16x8& pa3) {
#pragma unroll
  for (int r = 0; r < 16; ++r) p1[r] = __builtin_amdgcn_exp2f(p1[r]);
  float ps = 0;
#pragma unroll
  for (int r = 0; r < 16; ++r) ps += p0[r];
#pragma unroll
  for (int r = 0; r < 16; ++r) ps += p1[r];
  { auto rr = __builtin_amdgcn_permlane32_swap(__float_as_uint(ps), __float_as_uint(ps), false, false);
    ps = __uint_as_float(rr[0]) + __uint_as_float(rr[1]); }
  l_reg = l_reg * alpha + ps;
#define PK4(P, BASE, OUT) do { unsigned a0 = cvtpk(P[BASE + 0], P[BASE + 1]), a1 = cvtpk(P[BASE + 2], P[BASE + 3]);   \
    unsigned b0 = cvtpk(P[BASE + 4], P[BASE + 5]), b1 = cvtpk(P[BASE + 6], P[BASE + 7]);                              \
    auto r0 = __builtin_amdgcn_permlane32_swap(a0, b0, false, false); auto r1 = __builtin_amdgcn_permlane32_swap(a1, b1, false, false); \
    u32x4 w = {r0[0], r1[0], r0[1], r1[1]}; OUT = *reinterpret_cast<bf16x8*>(&w); } while (0)
  PK4(p0, 0, pa0); PK4(p0, 8, pa1); PK4(p1, 0, pa2); PK4(p1, 8, pa3);
#undef PK4
}
__device__ __forceinline__ void qkt(f32x16& p0, f32x16& p1, const char* Ks, const bf16x8* qr, int r32, int hi) {
  p0 = f32x16{}; p1 = f32x16{};
#pragma unroll
  for (int d0 = 0; d0 < 4; ++d0) { const int cb = d0 * 32 + hi * 16;
    const bf16x8 b0 = *reinterpret_cast<const bf16x8*>(Ks + KSWZ(r32, cb));
    const bf16x8 b1 = *reinterpret_cast<const bf16x8*>(Ks + KSWZ(32 + r32, cb));
    p0 = __builtin_amdgcn_mfma_f32_32x32x16_bf16(b0, qr[d0], p0, 0, 0, 0);
    p1 = __builtin_amdgcn_mfma_f32_32x32x16_bf16(b1, qr[d0], p1, 0, 0, 0); }
}
__device__ __forceinline__ int v_st(int k, int c) { const int kk = (k & ~0xC) | ((k & 4) << 1) | ((k & 8) >> 1); return ((kk >> 3) * 4 + (c >> 5)) * 512 + ((kk & 7) * 32 + (c & 31)) * 2; }
__device__ __forceinline__ int v_rd_base(int lane) { return ((lane & 3) << 3) | (((lane >> 2) & 3) << 6) | (((lane >> 4) & 1) << 5) | (((lane >> 5) & 1) << 8); }
constexpr int v_rd_off(int d0, int ks, int half) { return d0 * 512 + ks * 4096 + half * 2048; }
template <int OFF> __device__ __forceinline__ s16x4 tr_read(int vb) {
  s16x4 r; asm volatile("ds_read_b64_tr_b16 %0, %1 offset:%2" : "=&v"(r) : "v"(vb), "i"(OFF) : "memory"); return r;
}
template <int KS> __device__ __forceinline__ void pv_ks(f32x16* o, int vb, bf16x8 pa) {
  const s16x4 l0 = tr_read<v_rd_off(0, KS, 0)>(vb), h0 = tr_read<v_rd_off(0, KS, 1)>(vb), l1 = tr_read<v_rd_off(1, KS, 0)>(vb), h1 = tr_read<v_rd_off(1, KS, 1)>(vb);
  const s16x4 l2 = tr_read<v_rd_off(2, KS, 0)>(vb), h2 = tr_read<v_rd_off(2, KS, 1)>(vb), l3 = tr_read<v_rd_off(3, KS, 0)>(vb), h3 = tr_read<v_rd_off(3, KS, 1)>(vb);
  asm volatile("s_waitcnt lgkmcnt(0)" ::: "memory"); SBAR();
#define PK(L, H) (bf16x8){L[0], L[1], L[2], L[3], H[0], H[1], H[2], H[3]}
  o[0] = __builtin_amdgcn_mfma_f32_32x32x16_bf16(pa, PK(l0, h0), o[0], 0, 0, 0);
  o[1] = __builtin_amdgcn_mfma_f32_32x32x16_bf16(pa, PK(l1, h1), o[1], 0, 0, 0);
  o[2] = __builtin_amdgcn_mfma_f32_32x32x16_bf16(pa, PK(l2, h2), o[2], 0, 0, 0);
  o[3] = __builtin_amdgcn_mfma_f32_32x32x16_bf16(pa, PK(l3, h3), o[3], 0, 0, 0);
#undef PK
}
__device__ __forceinline__ void pv_d0(f32x16* o, int vb, bf16x8 pa0, bf16x8 pa1, bf16x8 pa2, bf16x8 pa3) {
  pv_ks<0>(o, vb, pa0); pv_ks<1>(o, vb, pa1); pv_ks<2>(o, vb, pa2); pv_ks<3>(o, vb, pa3);
}
__device__ __forceinline__ void attn_unit(char* lds, const bf16_t* __restrict__ P, bf16_t* __restrict__ Y, int b, int h, int qb, float lam, const float* __restrict__ gattn, float oscale) {
  int tid_ = threadIdx.x; asm volatile("" : "+v"(tid_));
  const int tid = tid_, wid = tid >> 6, lane = tid & 63, r32 = lane & 31, hi = lane >> 5;
  const unsigned rowb = (unsigned)b * TB, q0 = rowb + (unsigned)qb * 256;
  const int seq = (qb == 0) ? CTXL : TB, NT = seq / 64;
  char* V_lds = lds + OFF_V; char* K_lds = lds + OFF_K;
  float* ws = (float*)(lds + OFF_WS) + wid * 64; float* li_l = ws; float* al_l = ws + 32;
  unsigned* stash = (unsigned*)(lds + OFF_ST) + wid * 2048;
  const int sr = tid >> 4, sc = (tid & 15) * 8, vst0 = v_st(sr, sc), vst1 = v_st(32 + sr, sc);
  const int kr = tid >> 3, kc = (tid & 7) * 8, kst = KSWZ(kr, kc * 2);
  const int vb0 = (int)(uintptr_t)V_lds + v_rd_base(lane);
  const char* Pc = (const char*)P;
  const unsigned voff = ((rowb + sr) * PW + V0c + h * 128 + sc) * 2u;
#pragma unroll 1
  for (int map = 0; map < 2; ++map) {
    const unsigned qoff = ((q0 + wid * 32 + r32) * PW + Q0c + h * 128 + map * 64 + hi * 8) * 2u;
    const unsigned koff = ((rowb + kr) * PW + K0c + h * 128 + map * 64 + kc) * 2u;
    bf16x8 qr[4];
#pragma unroll
    for (int d0 = 0; d0 < 4; ++d0) qr[d0] = *reinterpret_cast<const bf16x8*>(Pc + (qoff + d0 * 32));
    float m_reg = -1e30f, l_reg = 0; f32x16 o[4] = {};
    struct { bf16x8 vs0, vs1, ks; } sr_[1];
#define SLOAD(i, k0) do { const unsigned ko_ = (unsigned)(k0) * (PW * 2u); sr_[i].vs0 = *reinterpret_cast<const bf16x8*>(Pc + (voff + ko_)); sr_[i].vs1 = *reinterpret_cast<const bf16x8*>(Pc + (voff + ko_ + 32u * PW * 2u)); \
    sr_[i].ks = *reinterpret_cast<const bf16x8*>(Pc + (koff + ko_)); } while (0)
#define SWRITE(bf, i) do { *(bf16x8*)(V_lds + (bf) * SHM_V + vst0) = sr_[i].vs0; *(bf16x8*)(V_lds + (bf) * SHM_V + vst1) = sr_[i].vs1; \
    *(bf16x8*)(K_lds + (bf) * SHM_K + kst) = sr_[i].ks; } while (0)
#define SWAIT() asm volatile("s_waitcnt vmcnt(0)" ::: "memory")
#define RESC(a) do { if (__any((a) < 1.f)) { if (hi == 0) al_l[r32] = (a); asm volatile("s_waitcnt lgkmcnt(0)" ::: "memory"); \
    _Pragma("unroll") for (int d = 0; d < 4; ++d) _Pragma("unroll") for (int r = 0; r < 16; ++r) o[d][r] *= al_l[crow(r, hi)]; } } while (0)
    f32x16 pA0, pA1, pB0, pB1; float mnA, mnB, alA, alB; bf16x8 pa0, pa1, pa2, pa3;
    constexpr int SE = 0, SO = 0;
    SLOAD(SE, 0); asm volatile("s_waitcnt vmcnt(0)" ::: "memory"); SWRITE(0, SE); __syncthreads();
    qkt(pA0, pA1, K_lds, qr, r32, hi); partialSM(pA0, pA1, m_reg, mnA, alA);
    SLOAD(SO, 64);
    SWAIT(); SWRITE(1, SO); __syncthreads();
    for (int j = 1; j + 1 < NT; j += 2) {
      SBAR(); qkt(pB0, pB1, K_lds + SHM_K, qr, r32, hi);
      finishSM(pA0, pA1, alA, l_reg, pa0, pa1, pa2, pa3); SBAR();
      SLOAD(SO, (j + 1) * 64); SBAR();
      pv_d0(o, vb0, pa0, pa1, pa2, pa3); partialSM(pB0, pB1, m_reg, mnB, alB);
      __syncthreads(); SWAIT(); SWRITE(0, SE);
      RESC(alB); __syncthreads();
      SBAR(); qkt(pA0, pA1, K_lds, qr, r32, hi);
      finishSM(pB0, pB1, alB, l_reg, pa0, pa1, pa2, pa3); SBAR();
      SLOAD(SE, (j + 2) * 64); SBAR();
      pv_d0(o, vb0 + SHM_V, pa0, pa1, pa2, pa3); partialSM(pA0, pA1, m_reg, mnA, alA);
      __syncthreads(); SWAIT(); SWRITE(1, SO);
      RESC(alA); __syncthreads();
    }
    SBAR(); qkt(pB0, pB1, K_lds + SHM_K, qr, r32, hi);
    finishSM(pA0, pA1, alA, l_reg, pa0, pa1, pa2, pa3); SBAR();
    pv_d0(o, vb0, pa0, pa1, pa2, pa3); partialSM(pB0, pB1, m_reg, mnB, alB);
    __syncthreads(); RESC(alB);
    finishSM(pB0, pB1, alB, l_reg, pa0, pa1, pa2, pa3); SBAR();
    pv_d0(o, vb0 + SHM_V, pa0, pa1, pa2, pa3);
    if (hi == 0) li_l[r32] = l_reg; asm volatile("s_waitcnt lgkmcnt(0)" ::: "memory");
    if (map == 0) {
#pragma unroll
      for (int r = 0; r < 16; ++r) { const float rl = __builtin_amdgcn_rcpf(li_l[crow(r, hi)]);
        stash[(r * 2 + 0) * 64 + lane] = cvtpk(o[0][r] * rl, o[1][r] * rl); stash[(r * 2 + 1) * 64 + lane] = cvtpk(o[2][r] * rl, o[3][r] * rl); SBAR(); }
    } else if (ATT_VAR != 1) {
      char* Yc = (char*)Y; const unsigned yoff = ((q0 + wid * 32) * DM + h * 128 + r32) * 2u;
      float gv[4];
#pragma unroll
      for (int d0 = 0; d0 < 4; ++d0) gv[d0] = gattn[d0 * 32 + r32] * oscale;
      SBAR();
#pragma unroll
      for (int r = 0; r < 16; ++r) { const float rl = lam * __builtin_amdgcn_rcpf(li_l[crow(r, hi)]);
        const unsigned w0 = stash[(r * 2 + 0) * 64 + lane], w1 = stash[(r * 2 + 1) * 64 + lane];
        const float e0 = bflo(w0) - o[0][r] * rl, e1 = bfhi(w0) - o[1][r] * rl, e2 = bflo(w1) - o[2][r] * rl, e3 = bfhi(w1) - o[3][r] * rl;
        float ssq = (e0 * e0 + e1 * e1) + (e2 * e2 + e3 * e3);
        if (ATT_VAR != 3) { ssq += __shfl_xor(ssq, 1); ssq += __shfl_xor(ssq, 2); ssq += __shfl_xor(ssq, 4); ssq += __shfl_xor(ssq, 8); ssq += __shfl_xor(ssq, 16); }
        const float rs = rsqrtf(ssq * (1.f / 128.f) + 1e-6f);
        bf16_t* yr = (bf16_t*)(Yc + (yoff + (unsigned)crow(r, hi) * (DM * 2u)));
        if (ATT_VAR != 4) { yr[0] = f2bf(e0 * rs * gv[0]); yr[32] = f2bf(e1 * rs * gv[1]); yr[64] = f2bf(e2 * rs * gv[2]); yr[96] = f2bf(e3 * rs * gv[3]); } else { yr[0] = f2bf(e0 * rs + e1 + e2 + e3); } SBAR(); }
    }
    __syncthreads();
#undef SLOAD
#undef SWRITE
#undef SWAIT
#undef RESC
  }
}
#undef KSWZ
}
namespace lru {
using att::f32x16; using att::crow;
constexpr int RS = 528;
constexpr int OFF_CL = 0, OFF_YS = 128 * RS, OFF_CY = 2 * 128 * RS;
template <int CTRL, int RMASK> __device__ __forceinline__ float dppf(float oldv, float src) {
  return __int_as_float(__builtin_amdgcn_update_dpp(__float_as_int(oldv), __float_as_int(src), CTRL, RMASK, 0xF, false));
}
template <bool PASS2>
__device__ __forceinline__ void lru_unit(char* lds, const bf16_t* __restrict__ P, bf16_t* __restrict__ Y, int b, int c, const float* __restrict__ convw, const float* __restrict__ convb,
                                         const bf16_t* __restrict__ wrg, const float* __restrict__ ba, const float* __restrict__ bx, const float* __restrict__ c8, float* lrus) {
  int tid_ = threadIdx.x; asm volatile("" : "+v"(tid_));
  const int tid = tid_, wid = tid >> 6, lane = tid & 63, r32 = lane & 31, hi = lane >> 5;
  const unsigned R0 = (unsigned)b * TB + (unsigned)c * 128;
  const int seg_lo = (c < 2) ? 0 : CTXL, seg_hi = (c < 2) ? CTXL : TB;
  const char* Pc = (const char*)P;
  {
    const int ch8 = (tid & 31) * 8, t0 = (tid >> 5) * 8;
    u32x4 xr[11];
#pragma unroll
    for (int i = 0; i < 11; ++i) { const int tt = c * 128 + t0 - 1 + i;
      if (tt >= seg_lo && tt < seg_hi) xr[i] = *(const u32x4*)(Pc + (((unsigned)b * TB + (unsigned)tt) * PW + LX0 + ch8) * 2u); else xr[i] = (u32x4){0u, 0u, 0u, 0u}; }
    float w[4][8], bb[8];
#pragma unroll
    for (int k = 0; k < 4; ++k) { const f32x4 a = *(const f32x4*)(convw + k * 256 + ch8), d = *(const f32x4*)(convw + k * 256 + ch8 + 4);
      w[k][0] = a.x; w[k][1] = a.y; w[k][2] = a.z; w[k][3] = a.w; w[k][4] = d.x; w[k][5] = d.y; w[k][6] = d.z; w[k][7] = d.w; }
    { const f32x4 a = *(const f32x4*)(convb + ch8), d = *(const f32x4*)(convb + ch8 + 4); bb[0] = a.x; bb[1] = a.y; bb[2] = a.z; bb[3] = a.w; bb[4] = d.x; bb[5] = d.y; bb[6] = d.z; bb[7] = d.w; }
#pragma unroll
    for (int i = 0; i < 8; ++i) { float acc[8];
#pragma unroll
      for (int e = 0; e < 8; ++e) acc[e] = bb[e];
#pragma unroll
      for (int k = 0; k < 4; ++k) { const u32x4 xv = xr[i + k];
        acc[0] += bflo(xv.x) * w[k][0]; acc[1] += bfhi(xv.x) * w[k][1]; acc[2] += bflo(xv.y) * w[k][2]; acc[3] += bfhi(xv.y) * w[k][3];
        acc[4] += bflo(xv.z) * w[k][4]; acc[5] += bfhi(xv.z) * w[k][5]; acc[6] += bflo(xv.w) * w[k][6]; acc[7] += bfhi(xv.w) * w[k][7]; }
      u32x4 o; o.x = cvtpk(acc[0], acc[1]); o.y = cvtpk(acc[2], acc[3]); o.z = cvtpk(acc[4], acc[5]); o.w = cvtpk(acc[6], acc[7]);
      *(u32x4*)(lds + OFF_CL + (t0 + i) * RS + ch8 * 2) = o; }
  }
  if (PASS2) {
    const int d = tid >> 8, ch = tid & 255;
    const int np = d ? (c < 2 ? 1 - c : NCHUNK + 1 - c) : c;
    float cy = 0.f;
    const float* sb = lrus + ((size_t)b * NCHUNK * 4 + (size_t)d * 2) * 256 + ch;
    if (np > 0) { float A[NCHUNK], H[NCHUNK];
#pragma unroll
      for (int i = 0; i < NCHUNK; ++i) { int p = i < np ? i : np - 1;
        const int u = d ? (c < 2 ? 1 - p : (p == 0 ? 1 : (p == 1 ? 0 : NCHUNK + 1 - p))) : p;
        A[i] = sb[(size_t)u * 1024]; H[i] = sb[(size_t)u * 1024 + 256]; }
#pragma unroll
      for (int i = 0; i < NCHUNK; ++i) if (i < np) cy = A[i] * cy + H[i];
    }
    ((float*)(lds + OFF_CY))[tid] = cy;
  }
  __syncthreads();
  const int hh = wid >> 1, jh = wid & 1, chb = hh * 64 + jh * 32;
#pragma unroll 1
  for (int d = 0; d < 2; ++d) {
    const bf16_t* wa = wrg + ((0 * 2 + d) * 4 + hh) * 4096 + (jh * 32 + r32) * 64 + hi * 8;
    const bf16_t* wx = wrg + ((1 * 2 + d) * 4 + hh) * 4096 + (jh * 32 + r32) * 64 + hi * 8;
    bf16x8 fa[4], fx[4];
#pragma unroll
    for (int k = 0; k < 4; ++k) { fa[k] = *reinterpret_cast<const bf16x8*>(wa + k * 16); fx[k] = *reinterpret_cast<const bf16x8*>(wx + k * 16); }
    float carry[16], Pc_[16], bav[16], bxv[16], c8v[16];
#pragma unroll
    for (int q = 0; q < 4; ++q) { const int co = d * 256 + chb + 8 * q + 4 * hi;
      const f32x4 b4 = *(const f32x4*)(ba + co), x4 = *(const f32x4*)(bx + co), c4 = *(const f32x4*)(c8 + co);
      bav[4 * q] = b4.x; bav[4 * q + 1] = b4.y; bav[4 * q + 2] = b4.z; bav[4 * q + 3] = b4.w; bxv[4 * q] = x4.x; bxv[4 * q + 1] = x4.y; bxv[4 * q + 2] = x4.z; bxv[4 * q + 3] = x4.w;
      c8v[4 * q] = c4.x; c8v[4 * q + 1] = c4.y; c8v[4 * q + 2] = c4.z; c8v[4 * q + 3] = c4.w; }
#pragma unroll
    for (int r = 0; r < 16; ++r) { carry[r] = 0.f; Pc_[r] = 1.f; }
    if (PASS2) { const float* cyp = (const float*)(lds + OFF_CY) + d * 256 + chb + 4 * hi;
#pragma unroll
      for (int q = 0; q < 4; ++q) { const f32x4 v = *(const f32x4*)(cyp + 8 * q); carry[4 * q] = v.x; carry[4 * q + 1] = v.y; carry[4 * q + 2] = v.z; carry[4 * q + 3] = v.w; } }
    const int tokl = d ? 31 - r32 : r32;
#pragma unroll 1
    for (int ti = 0; ti < 4; ++ti) {
      const int tt = d ? 3 - ti : ti;
      char* rowp = lds + OFF_CL + (tt * 32 + tokl) * RS;
      f32x16 za = {}, zx = {};
#pragma unroll
      for (int k = 0; k < 4; ++k) { const bf16x8 xb = *reinterpret_cast<const bf16x8*>(rowp + (hh * 64 + k * 16 + hi * 8) * 2);
        za = __builtin_amdgcn_mfma_f32_32x32x16_bf16(fa[k], xb, za, 0, 0, 0); zx = __builtin_amdgcn_mfma_f32_32x32x16_bf16(fx[k], xb, zx, 0, 0, 0); }
      float av[16], bv[16];
#pragma unroll
      for (int q = 0; q < 4; ++q) { const u32x2 cw = *(const u32x2*)(rowp + (chb + 8 * q + 4 * hi) * 2);
        const float clv[4] = {bflo(cw.x), bfhi(cw.x), bflo(cw.y), bfhi(cw.y)};
#pragma unroll
        for (int i = 0; i < 4; ++i) { const int r = 4 * q + i;
          const float rg = sigm(za[r] + bav[r]), ig = sigm(zx[r] + bxv[r]);
          const float a = fexp(-c8v[r] * rg);
          av[r] = a; bv[r] = __builtin_amdgcn_sqrtf(fmaxf(1.f - a * a, 0.f)) * ig * clv[i]; } }
#define LRU_SCAN(CTRL, RM) _Pragma("unroll") for (int r = 0; r < 16; ++r) { const float ap = dppf<CTRL, RM>(1.f, av[r]), bp = dppf<CTRL, RM>(0.f, bv[r]); bv[r] = av[r] * bp + bv[r]; av[r] = av[r] * ap; }
      LRU_SCAN(0x111, 0xF) LRU_SCAN(0x112, 0xF) LRU_SCAN(0x114, 0xF) LRU_SCAN(0x118, 0xF) LRU_SCAN(0x142, 0xA)
#undef LRU_SCAN
#pragma unroll
      for (int q = 0; q < 4; ++q) { float hv[4];
#pragma unroll
        for (int i = 0; i < 4; ++i) { const int r = 4 * q + i; hv[i] = bv[r] + av[r] * carry[r];
          carry[r] = __shfl(hv[i], 31, 32);
          if (!PASS2) Pc_[r] *= __shfl(av[r], 31, 32); }
        if (PASS2) { u32x2* yp = (u32x2*)(lds + OFF_YS + (tt * 32 + tokl) * RS + (chb + 8 * q + 4 * hi) * 2);
          if (d) { const u32x2 o = *yp; hv[0] += bflo(o.x); hv[1] += bfhi(o.x); hv[2] += bflo(o.y); hv[3] += bfhi(o.y); }
          u32x2 w; w.x = cvtpk(hv[0], hv[1]); w.y = cvtpk(hv[2], hv[3]); *yp = w; } }
    }
    if (!PASS2) { if (r32 == 0) { float* sb = lrus + ((((size_t)b * NCHUNK + c) * 2 + d) * 2) * 256 + chb + 4 * hi;
#pragma unroll
        for (int q = 0; q < 4; ++q) { *(f32x4*)(sb + 8 * q) = (f32x4){Pc_[4 * q], Pc_[4 * q + 1], Pc_[4 * q + 2], Pc_[4 * q + 3]};
          *(f32x4*)(sb + 256 + 8 * q) = (f32x4){carry[4 * q], carry[4 * q + 1], carry[4 * q + 2], carry[4 * q + 3]}; } } }
  }
  if (PASS2) {
    __syncthreads();
    const int ch8 = (tid & 31) * 8;
#pragma unroll
    for (int i = 0; i < 8; ++i) { const int t = (tid >> 5) + 16 * i;
      const u32x4 hv = *(const u32x4*)(lds + OFF_YS + t * RS + ch8 * 2), gv = *(const u32x4*)(Pc + ((R0 + t) * PW + LG0 + ch8) * 2u);
      u32x4 o; o.x = cvtpk(bflo(hv.x) * bflo(gv.x), bfhi(hv.x) * bfhi(gv.x)); o.y = cvtpk(bflo(hv.y) * bflo(gv.y), bfhi(hv.y) * bfhi(gv.y));
      o.z = cvtpk(bflo(hv.z) * bflo(gv.z), bfhi(hv.z) * bfhi(gv.z)); o.w = cvtpk(bflo(hv.w) * bflo(gv.w), bfhi(hv.w) * bfhi(gv.w));
      *(u32x4*)((char*)Y + ((R0 + t) * DM + 512 + ch8) * 2u) = o; }
  }
  __syncthreads();
}
}

namespace sgu {
using att::f32x16; using att::crow;
constexpr int VS = 272;
__device__ __forceinline__ void sgu_unit(char* lds, const bf16_t* __restrict__ P, bf16_t* __restrict__ Y, int b, int c, const bf16_t* __restrict__ wsp, const float* __restrict__ gsgu, const float* __restrict__ bsp) {
  int tid_ = threadIdx.x; asm volatile("" : "+v"(tid_));
  const int tid = tid_, wid = tid >> 6, lane = tid & 63, r32 = lane & 31, hi = lane >> 5;
  const unsigned R0 = (unsigned)b * TB + (unsigned)c * 128;
  const char* Pc = (const char*)P;
  const int gg = wid >> 1, chalf = wid & 1, cc = gg * 64 + chalf * 32 + r32;
  bf16x8 Af[4][8];
  u32x4 xv[8];
  { const int q = tid & 127, g = tid >> 7;
    const char* vp = Pc + ((R0 + q) * PW + SV0 + g * 64) * 2u;
#pragma unroll
    for (int i = 0; i < 8; ++i) xv[i] = *(const u32x4*)(vp + i * 16); }
#pragma unroll
  for (int pt = 0; pt < 4; ++pt) { const bf16_t* ap = wsp + (gg * 128 + pt * 32 + r32) * 128 + hi * 8;
#pragma unroll
    for (int k = 0; k < 8; ++k) Af[pt][k] = *reinterpret_cast<const bf16x8*>(ap + k * 16); }
  { const int q = tid & 127, g = tid >> 7; float ss = 0.f;
#pragma unroll
    for (int i = 0; i < 8; ++i) {
      const float a0 = bflo(xv[i].x), a1 = bfhi(xv[i].x), a2 = bflo(xv[i].y), a3 = bfhi(xv[i].y), a4 = bflo(xv[i].z), a5 = bfhi(xv[i].z), a6 = bflo(xv[i].w), a7 = bfhi(xv[i].w);
      ss += (a0 * a0 + a1 * a1) + (a2 * a2 + a3 * a3) + (a4 * a4 + a5 * a5) + (a6 * a6 + a7 * a7); }
    const float rs = rsqrtf(ss * (1.f / 64.f) + 1e-6f);
    char* dst = lds + (g * 64) * VS + q * 2;
#pragma unroll
    for (int i = 0; i < 8; ++i) { const float* gp = gsgu + g * 64 + i * 8; const f32x4 g0 = *(const f32x4*)gp, g1 = *(const f32x4*)(gp + 4);
      *(bf16_t*)(dst + (i * 8 + 0) * VS) = f2bf(bflo(xv[i].x) * rs * g0.x); *(bf16_t*)(dst + (i * 8 + 1) * VS) = f2bf(bfhi(xv[i].x) * rs * g0.y);
      *(bf16_t*)(dst + (i * 8 + 2) * VS) = f2bf(bflo(xv[i].y) * rs * g0.z); *(bf16_t*)(dst + (i * 8 + 3) * VS) = f2bf(bfhi(xv[i].y) * rs * g0.w);
      *(bf16_t*)(dst + (i * 8 + 4) * VS) = f2bf(bflo(xv[i].z) * rs * g1.x); *(bf16_t*)(dst + (i * 8 + 5) * VS) = f2bf(bfhi(xv[i].z) * rs * g1.y);
      *(bf16_t*)(dst + (i * 8 + 6) * VS) = f2bf(bflo(xv[i].w) * rs * g1.z); *(bf16_t*)(dst + (i * 8 + 7) * VS) = f2bf(bfhi(xv[i].w) * rs * g1.w); }
  }
  __syncthreads();
  { bf16x8 vb[8];
#pragma unroll
    for (int k = 0; k < 8; ++k) vb[k] = *reinterpret_cast<const bf16x8*>(lds + cc * VS + (k * 16 + hi * 8) * 2);
    unsigned short uu[2][16]; f32x4 bsv[2][4];
#define SGU_LD(pt_, s_) do { _Pragma("unroll") for (int r = 0; r < 16; ++r) uu[s_][r] = *(const unsigned short*)(Pc + ((R0 + (pt_) * 32 + crow(r, hi)) * PW + SU0 + cc) * 2u); \
      _Pragma("unroll") for (int q4 = 0; q4 < 4; ++q4) bsv[s_][q4] = *(const f32x4*)(bsp + gg * 128 + (pt_) * 32 + 8 * q4 + 4 * hi); } while (0)
    SGU_LD(0, 0);
#pragma unroll
    for (int pt = 0; pt < 4; ++pt) { f32x16 acc = {};
      if (pt + 1 < 4) SGU_LD(pt + 1, (pt + 1) & 1);
#pragma unroll
      for (int k = 0; k < 8; ++k) acc = __builtin_amdgcn_mfma_f32_32x32x16_bf16(Af[pt][k], vb[k], acc, 0, 0, 0);
#pragma unroll
      for (int r = 0; r < 16; ++r) { const int p = pt * 32 + crow(r, hi); const float m = acc[r] + bsv[pt & 1][r >> 2][r & 3];
        *(bf16_t*)((char*)Y + ((R0 + p) * DM + 768 + cc) * 2u) = f2bf(bf2f(uu[pt & 1][r]) * m); } }
#undef SGU_LD
  }
  __syncthreads();
}
}
__device__ __forceinline__ unsigned pk2(float lo, float hi) { return cvtpk(lo, hi); }
__device__ __forceinline__ void transpose_item(const float* __restrict__ W, int K, int N, bf16_t* __restrict__ WT, int row_base, LAS float* scr, int kb, int nb, int lane) {
    const int k0 = 64 * kb, n0 = 32 * nb;
#pragma unroll 8
    for (int i = 0; i < 32; ++i) { const int kk = 2 * i + (lane >> 5); scr[kk * 33 + (lane & 31)] = W[(size_t)(k0 + kk) * N + n0 + (lane & 31)]; }
    asm volatile("s_waitcnt lgkmcnt(0)" ::: "memory");
    const int c = lane & 7;
#pragma unroll
    for (int j = 0; j < 4; ++j) { const int n = (lane >> 3) + 8 * j; const LAS float* s = scr + (8 * c) * 33 + n;
        u32x4 o; o.x = pk2(s[0 * 33], s[1 * 33]); o.y = pk2(s[2 * 33], s[3 * 33]); o.z = pk2(s[4 * 33], s[5 * 33]); o.w = pk2(s[6 * 33], s[7 * 33]);
        *(u32x4*)(WT + (size_t)(row_base + n) * K + k0 + 8 * c) = o; }
    asm volatile("s_waitcnt lgkmcnt(0)" ::: "memory");
}
__device__ __forceinline__ void gemv_item(const LAS float* a_lds, LAS float* red, const float* __restrict__ W, int N, int n0, float* __restrict__ out, int ldo, int obase, const float* __restrict__ bias) {
    const int tid = threadIdx.x, wid = tid >> 6, lane = tid & 63, c4 = (lane & 15) * 4, ks = lane >> 4;
    f32x4 acc[NMS];
#pragma unroll
    for (int ms = 0; ms < NMS; ++ms) acc[ms] = (f32x4){0.f, 0.f, 0.f, 0.f};
    const float* wp = W + (size_t)(wid * 128 + ks) * N + n0 + c4;
#pragma unroll 8
    for (int st = 0; st < 32; ++st) { const f32x4 wv = *(const f32x4*)(wp + (size_t)st * 4 * N); const int k = wid * 128 + st * 4 + ks;
#pragma unroll
        for (int ms = 0; ms < NMS; ++ms) acc[ms] += wv * a_lds[ms * 1024 + k]; }
#pragma unroll
    for (int ms = 0; ms < NMS; ++ms) {
        f32x4 v = acc[ms];
        v.x += __shfl_xor(v.x, 16); v.y += __shfl_xor(v.y, 16); v.z += __shfl_xor(v.z, 16); v.w += __shfl_xor(v.w, 16);
        v.x += __shfl_xor(v.x, 32); v.y += __shfl_xor(v.y, 32); v.z += __shfl_xor(v.z, 32); v.w += __shfl_xor(v.w, 32);
        if (ks == 0) { LAS float* rp = red + (wid * NMS + ms) * 64 + c4; rp[0] = v.x; rp[1] = v.y; rp[2] = v.z; rp[3] = v.w; }
    }
    __syncthreads();
    for (int i = tid; i < NMS * 64; i += 512) { const int ms = i >> 6, c = i & 63; float s = 0.f;
#pragma unroll
        for (int w = 0; w < 8; ++w) s += red[(w * NMS + ms) * 64 + c];
        if (bias) s += bias[n0 + c];
        out[(size_t)ms * ldo + obase + c] = s; }
    __syncthreads();
}
__device__ __forceinline__ float wave_sum(float v) {
#pragma unroll
    for (int o = 1; o < 64; o <<= 1) v += __shfl_xor(v, o);
    return v;
}

#define XB_TMO      128
#define XB_XCNT(j)  (256  + 64 * (j))
#define XB_XSUB(j)  (1280 + 64 * (j))
#define XB_XGEN(j)  (2304 + 64 * (j))
#define XB_TOP      3328
#define XB_TOPGEN   3392
#define XCD_BAR_WORDS 3456
#define XB_SPIN_CAP (1u << 18)

__device__ __forceinline__ unsigned xb_ld(unsigned* p)              { return __hip_atomic_load(p, __ATOMIC_RELAXED, __HIP_MEMORY_SCOPE_AGENT); }
__device__ __forceinline__ unsigned xb_add(unsigned* p, unsigned v) { return __hip_atomic_fetch_add(p, v, __ATOMIC_RELAXED, __HIP_MEMORY_SCOPE_AGENT); }
__device__ __forceinline__ unsigned xb_xcc_id() { return (unsigned)__builtin_amdgcn_s_getreg((3 << 11) | 20) & 0xFu; }
#define XB_SPIN(cond, bar) do { unsigned _sp = 0; while (cond) { __builtin_amdgcn_s_sleep(1); \
    if ((++_sp & 255u) == 0u) { if (xb_ld(&(bar)[XB_TMO])) break; if (_sp > XB_SPIN_CAP) { atomicAdd(&(bar)[XB_TMO], 1u); break; } } } } while (0)

struct XcdBarrier {
    unsigned* bar; unsigned x;
    volatile LAS unsigned* st;
};

__device__ __forceinline__ XcdBarrier xcd_barrier_post(unsigned* bar, volatile LAS unsigned* st) {
    XcdBarrier b; b.bar = bar; b.x = xb_xcc_id(); b.st = st;
    if (threadIdx.x == 0) (void)xb_add(&bar[XB_XCNT(b.x)], 1u);
    return b;
}
__device__ __forceinline__ void xcd_barrier_complete(unsigned* bar, unsigned x, unsigned& nloc, unsigned& nx) {
    const unsigned G = gridDim.x * gridDim.y * gridDim.z;
    unsigned sum, cnt, mine, sp = 0u;
    for (;;) {
        sum = 0u; cnt = 0u; mine = 0u;
#pragma unroll
        for (unsigned j = 0; j < 16; ++j) { const unsigned c = xb_ld(&bar[XB_XCNT(j)]); sum += c; cnt += (c > 0u) ? 1u : 0u; mine = (j == x) ? c : mine; }
        if (sum == G) break;
        __builtin_amdgcn_s_sleep(1);
        if ((++sp & 255u) == 0u) { if (xb_ld(&bar[XB_TMO])) break; if (sp > XB_SPIN_CAP) { atomicAdd(&bar[XB_TMO], 1u); break; } }
    }
    nloc = mine > 0u ? mine : 1u; nx = cnt > 0u ? cnt : 1u;
}

__device__ __forceinline__ void xcd_barrier(const XcdBarrier& b) {
    asm volatile("s_waitcnt vmcnt(0)" ::: "memory");
    __syncthreads();
    if (threadIdx.x == 0) {
        unsigned* bar = b.bar;
        __builtin_amdgcn_s_waitcnt(0);
        unsigned nloc = b.st[0], nx = b.st[1];
        if (nloc == 0u) { xcd_barrier_complete(bar, b.x, nloc, nx); b.st[0] = nloc; b.st[1] = nx; }
        const unsigned old = xb_add(&bar[XB_XSUB(b.x)], 1u);
        const unsigned gen = old / nloc;
        if (old + 1u == (gen + 1u) * nloc) {
            __builtin_amdgcn_fence(__ATOMIC_RELEASE, "agent");
            asm volatile("s_waitcnt vmcnt(0)" ::: "memory");
            const unsigned og = xb_add(&bar[XB_TOP], 1u);
            const unsigned tg = og / nx;
            if (og + 1u == (tg + 1u) * nx) xb_add(&bar[XB_TOPGEN], 1u);
            else XB_SPIN(xb_ld(&bar[XB_TOPGEN]) == tg, bar);
            __builtin_amdgcn_fence(__ATOMIC_ACQUIRE, "agent");
            xb_add(&bar[XB_XGEN(b.x)], 1u);
            asm volatile("s_waitcnt vmcnt(0)" ::: "memory");
        } else {
            XB_SPIN(xb_ld(&bar[XB_XGEN(b.x)]) == gen, bar);
            __builtin_amdgcn_fence(__ATOMIC_ACQUIRE, "agent");
            asm volatile("s_waitcnt vmcnt(0)" ::: "memory");
        }
    }
    __syncthreads();
}
typedef __attribute__((address_space(1))) unsigned char g_u8;
__device__ __forceinline__ unsigned char* lau(unsigned char* p) { asm volatile("" : "+s"(p)); return (unsigned char*)(g_u8*)p; }
constexpr int NPHASE = 15;
constexpr int LDS_BYTES = 147456;
struct Args { const float* in[27]; float* out; unsigned char* ws; int ph_lo, ph_hi; };
__global__ void __launch_bounds__(512, 2) hybrid_fwd(Args args) {
    extern __shared__ __attribute__((aligned(16))) unsigned char lds_raw[];
    char* lds = (char*)lds_raw;
    LAS unsigned char* ldsl = (LAS unsigned char*)lds_raw;
    const int tid = threadIdx.x, wave = __builtin_amdgcn_readfirstlane(tid >> 6);
#define LANE_LOCAL int lane_ = threadIdx.x; asm volatile("" : "+v"(lane_)); const int lane = lane_ & 63;
    const int G = gridDim.x, bx = blockIdx.x, vcu = (G % 8 == 0) ? (bx % 8) * (G / 8) + bx / 8 : bx;
    unsigned char* ws = args.ws;
    const float* const* in = args.in;
#define mods ((float*)(ws + WS_MODS))
#define shwin ((float*)(ws + WS_SHWIN))
#define shwf ((float*)(ws + WS_SHWF))
#define ropeC ((float*)(ws + WS_ROPE))
#define ropeS ((float*)(ws + WS_ROPE + 4096))
#define c8 ((float*)(ws + WS_C8))
#define lamv ((float*)(ws + WS_LAM))
#define rowss ((float*)(ws + WS_ROWSS))
#define lrus ((float*)(ws + WS_LRUS))
#define xc ((float*)(ws + WS_XC))
#define AP ((bf16_t*)(ws + WS_AP))
#define Pb ((bf16_t*)(ws + WS_P))
#define Yb ((bf16_t*)(ws + WS_Y))
#define HM ((bf16_t*)(ws + WS_HMID))
#define WSP ((bf16_t*)(ws + WS_WSP))
#define WRG ((bf16_t*)(ws + WS_WRG))
    const int lo = args.ph_lo, hi_ = args.ph_hi;
    volatile LAS unsigned* MISC = (volatile LAS unsigned*)(ldsl + LDS_BYTES - 64);
    if (tid < 16) MISC[tid] = 0u;
    __syncthreads();
    XcdBarrier bar; bar.bar = (unsigned*)(ws + WS_CTL); bar.x = 0; bar.st = nullptr;
    if (hi_ - lo > 1) bar = xcd_barrier_post((unsigned*)(ws + WS_CTL), MISC);
#define IN(k) (lo <= (k) && (k) < hi_)
#define SEAM(k) do { if (IN(k) && IN((k) + 1)) { if ((k) == 0) cg::this_grid().sync(); else xcd_barrier(bar); } } while (0)

    if (EN(0) && IN(0)) {
        { LANE_LOCAL LAS float* scr = (LAS float*)(ldsl + wave * 16384);
          const int gw = vcu * 8 + wave, NGW = G * 8;
          constexpr int I_IN = 16 * 80, I_OUT = 16 * 32, I_G = 16 * 88, I_D = 44 * 32, I_L = I_IN + I_OUT + 2 * I_G + I_D;
          for (int it = gw; it < NLAYER * I_L; it += NGW) {
              const int l = it / I_L; int r = it - l * I_L;
              if (r < I_IN) { transpose_item(in[8] + (size_t)l * DM * PW, DM, PW, (bf16_t*)(ws + WS_WIN + l * SZ_WIN), 32 * (r % 80), scr, r / 80, r % 80, lane); continue; } r -= I_IN;
              if (r < I_OUT) { transpose_item(in[22] + (size_t)l * DM * DM, DM, DM, (bf16_t*)(ws + WS_WOUT + l * SZ_WOUT), 32 * (r % 32), scr, r / 32, r % 32, lane); continue; } r -= I_OUT;
              if (r < 2 * I_G) { const int up = r >= I_G; if (up) r -= I_G; const int nb = r % 88, n0 = 32 * nb;
                  transpose_item(in[up ? 24 : 23] + (size_t)l * DM * FH, DM, FH, (bf16_t*)(ws + WS_WFFN + l * SZ_WFFN), (n0 / 128) * 256 + (n0 % 128) + (up ? 128 : 0), scr, r / 88, nb, lane); continue; } r -= 2 * I_G;
              transpose_item(in[25] + (size_t)l * FH * DM, FH, DM, (bf16_t*)(ws + WS_WDN + l * SZ_WDN), 32 * (r % 32), scr, r / 32, r % 32, lane);
          }
        }
        { const int gt = vcu * 512 + tid, NT = G * 512;
          for (int i = gt; i < 131072; i += NT) WSP[i] = f2bf(in[20][i]);
          for (int i = gt; i < 131072; i += NT) { const int ii = i & 63, j = (i >> 6) & 63, h = (i >> 12) & 3, d = (i >> 14) & 1, mat = (i >> 15) & 1, l = i >> 16;
              WRG[i] = f2bf(in[mat ? 16 : 14][((((size_t)l * 2 + d) * 4 + h) * 64 + ii) * 64 + j]); }
          if (gt < 1024) { const int pos = gt >> 4, j = gt & 15; const float inv = powf(10000.f, -(float)j / 16.f); const float ang = (float)pos * inv; ropeC[gt] = cosf(ang); ropeS[gt] = sinf(ang);
              const float lv = in[18][gt]; c8[gt] = 8.f * log1pf(expf(-lv)); }
          if (gt < NLAYER) { float s0 = 0.f, s1 = 0.f; for (int k = 0; k < 64; ++k) { s0 += in[9][(gt * 2 + 0) * 64 + k] * in[10][(gt * 2 + 0) * 64 + k]; s1 += in[9][(gt * 2 + 1) * 64 + k] * in[10][(gt * 2 + 1) * 64 + k]; }
              lamv[gt] = expf(s0) - expf(s1) + (0.8f - 0.6f * expf(-0.3f * (float)gt)); }
        }
        __syncthreads();
        { LAS float* a_lds = (LAS float*)ldsl; LAS float* red = (LAS float*)(ldsl + 36864);
          for (int i = tid; i < NMS * 1024; i += 512) { const int ms = i >> 10, k = i & 1023; const float v = (ms < 8) ? in[1][ms * 1024 + k] : in[3][k]; a_lds[i] = silu_f(v); }
          __syncthreads();
          for (int it = vcu; it < NLAYER * 96; it += G) { const int l = it / 96, n0 = (it % 96) * 64;
              gemv_item(a_lds, red, in[4] + (size_t)l * DM * NMOD, NMOD, n0, mods + (size_t)l * NMS * NMOD, NMOD, n0, in[5] + (size_t)l * NMOD); }
        }
    }
    SEAM(0);
    if (EN(1) && IN(1)) {
        { LAS float* a_lds = (LAS float*)ldsl; LAS float* red = (LAS float*)(ldsl + 36864);
          for (int it = vcu; it < NLAYER * 128; it += G) { const int l = it / 128, r = it % 128; const int soff = (r < 40) ? 0 : 3 * DM;
              __syncthreads();
              for (int i = tid; i < NMS * 1024; i += 512) a_lds[i] = mods[((size_t)l * NMS + (i >> 10)) * NMOD + soff + (i & 1023)];
              __syncthreads();
              if (r < 40) gemv_item(a_lds, red, in[8] + (size_t)l * DM * PW, PW, r * 64, shwin + (size_t)l * NMS * PW, PW, r * 64, nullptr);
              else { const int up = r >= 84, nb = (r - 40) % 44, n0 = nb * 64;
                  gemv_item(a_lds, red, in[up ? 24 : 23] + (size_t)l * DM * FH, FH, n0, shwf + (size_t)l * NMS * NF, NF, (n0 / 128) * 256 + (n0 % 128) + (up ? 128 : 0), nullptr); } }
        }
        { LANE_LOCAL const int gw = vcu * 8 + wave, NGW = G * 8;
          for (int m = gw; m < MROWS; m += NGW) { const int b = m / TB, t = m - b * TB; const bool ctx = t < CTXL; const int ms = ctx ? 8 : b;
              const float* xr = ctx ? in[2] + ((size_t)b * CTXL + t) * DM : in[0] + ((size_t)b * SEQ + (t - CTXL)) * DM;
              f32x4 v[4]; float s = 0.f;
#pragma unroll
              for (int j = 0; j < 4; ++j) { v[j] = ((const f32x4*)xr)[lane + 64 * j]; s += (v[j].x * v[j].x + v[j].y * v[j].y) + (v[j].z * v[j].z + v[j].w * v[j].w); }
              s = wave_sum(s);
#pragma unroll
              for (int j = 0; j < 4; ++j) { const int col = 4 * lane + 256 * j; const f32x4 g = *(const f32x4*)(in[6] + col), sc = *(const f32x4*)(mods + (size_t)ms * NMOD + DM + col);
                  const f32x4 a = v[j] * g * (sc + 1.f); u32x2 w; w.x = cvtpk(a.x, a.y); w.y = cvtpk(a.z, a.w); *(u32x2*)(AP + (size_t)m * DM + col) = w; }
              if (lane < 16) rowss[(size_t)m * 16 + lane] = (lane == 0) ? s : 0.f; }
        }
    }
    SEAM(1);
#pragma unroll 1
    for (int l = 0; l < NLAYER; ++l) {
        const int pb = 2 + 6 * l; const bool last = (l == NLAYER - 1);
        const float* modl = mods + (size_t)l * NMS * NMOD;
        if (EN(2) && IN(pb)) {
            pg8::Gemm g{AP, (const bf16_t*)(ws + WS_WIN + l * SZ_WIN), MROWS, PW, DM}; pg8::Order S; S.init(MROWS / 256, PW, G, bx, 0);
            EpiInProj E{Pb, rowss, shwin + (size_t)l * NMS * PW, ropeC, ropeS};
            pg8::gemm_phase<EpiInProj, pg8::Order, true, true>(ldsl, g, S, E);
        }
        SEAM(pb);
        if (IN(pb + 1)) {
            if (EN(3)) for (int u = vcu; u < NB * NCHUNK; u += G)
                lru::lru_unit<false>(lds, Pb, Yb, u / NCHUNK, u % NCHUNK, in[12] + l * 1024, in[13] + l * 256, WRG + (size_t)l * 65536, in[15] + l * 512, in[17] + l * 512, c8 + l * 512, lrus);
            if (EN(4)) for (int u = G - 1 - vcu; u < NB * NCHUNK; u += G) { const int c = u % NCHUNK; if (last && c < 2) continue;
                sgu::sgu_unit(lds, Pb, Yb, u / NCHUNK, c, WSP + (size_t)l * 65536, in[19] + l * 256, in[21] + l * 512); }
            const float lam = lamv[l], li = 0.8f - 0.6f * __expf(-0.3f * (float)l);
            if (EN(5)) { const int nu = last ? NB * 4 * 16 : NB * 4 * 17;
#pragma unroll 1
                for (int rep_ = 0; rep_ < PROBE_ATTREP; ++rep_)
                for (int u = vcu; u < nu; u += G) { int bh, qb; if (u < NB * 4 * 16) { bh = u >> 4; qb = (u & 15) + 1; } else { bh = u - NB * 4 * 16; qb = 0; }
                    att::attn_unit(lds, Pb, Yb, bh >> 2, bh & 3, qb, lam, in[11] + l * 128, 1.f - li); } }
        }
        SEAM(pb + 1);
        if (EN(6) && IN(pb + 2)) {
            const int nu2 = last ? NB * 32 : NB * NCHUNK;
            for (int u = vcu; u < nu2; u += G) { const int b_ = last ? (u >> 5) : u / NCHUNK, c = last ? 2 + (u & 31) : u % NCHUNK;
                lru::lru_unit<true>(lds, Pb, Yb, b_, c, in[12] + l * 1024, in[13] + l * 256, WRG + (size_t)l * 65536, in[15] + l * 512, in[17] + l * 512, c8 + l * 512, lrus); }
        }
        SEAM(pb + 2);
        if (EN(7) && IN(pb + 3)) {
            pg8::Gemm g{Yb, (const bf16_t*)(ws + WS_WOUT + l * SZ_WOUT), MROWS, DM, DM}; pg8::Order S; S.init(last ? 128 : 136, DM, G, bx, last ? 1 : 0);
            EpiRes E{in[0], in[2], args.out, l == 0 ? 0 : 1, modl + 2 * DM, in[6] + l * DM, modl + DM, in[7] + l * DM, modl + 4 * DM, AP, rowss, 1, 0};
            pg8::gemm_phase<EpiRes, pg8::Order, true, true>(ldsl, g, S, E);
        }
        SEAM(pb + 3);
        if (EN(8) && IN(pb + 4)) {
            pg8::Gemm g{AP, (const bf16_t*)(ws + WS_WFFN + l * SZ_WFFN), MROWS, NF, DM}; pg8::Order S; S.init(last ? 128 : 136, NF, G, bx, last ? 1 : 0);
            EpiSwiGLU E{HM, rowss, shwf + (size_t)l * NMS * NF};
            pg8::gemm_phase<EpiSwiGLU, pg8::Order, true, true>(ldsl, g, S, E);
        }
        SEAM(pb + 4);
        if (EN(9) && IN(pb + 5)) {
            pg8::Gemm g{HM, (const bf16_t*)(ws + WS_WDN + l * SZ_WDN), MROWS, DM, FH}; pg8::Order S; S.init(last ? 128 : 136, DM, G, bx, last ? 1 : 0);
            const int ln = last ? l : l + 1;
            EpiRes E{in[0], in[2], args.out, 1, modl + 5 * DM, in[7] + l * DM, modl + 4 * DM, in[6] + ln * DM, mods + (size_t)ln * NMS * NMOD + DM, AP, rowss, last ? 0 : 1, last ? 1 : 0};
            pg8::gemm_phase<EpiRes, pg8::Order, true, true>(ldsl, g, S, E);
        }
        SEAM(pb + 5);
    }
    if (EN(10) && IN(14)) {
        LANE_LOCAL const int gw = vcu * 8 + wave, NGW = G * 8;
        for (int m = gw; m < NB * SEQ; m += NGW) { const int b = m / SEQ, t = m - b * SEQ; const size_t row = (size_t)b * TB + CTXL + t;
            const float rstd = row_rstd(rowss, row); f32x4* xr = (f32x4*)(args.out + (size_t)m * DM);
            u32x2 w[4];
#pragma unroll
            for (int j = 0; j < 4; ++j) w[j] = ((const u32x2*)xr)[lane + 64 * j];
            asm volatile("s_waitcnt vmcnt(0)" ::: "memory");
#pragma unroll
            for (int j = 0; j < 4; ++j) { const f32x4 g = *(const f32x4*)(in[26] + 4 * lane + 256 * j);
                const f32x4 xv = (f32x4){bflo(w[j].x), bfhi(w[j].x), bflo(w[j].y), bfhi(w[j].y)}; xr[lane + 64 * j] = xv * rstd * g; } }
    }
#undef IN
#undef SEAM
#undef mods
#undef shwin
#undef shwf
#undef ropeC
#undef ropeS
#undef c8
#undef lamv
#undef rowss
#undef lrus
#undef xc
#undef AP
#undef Pb
#undef Yb
#undef HM
#undef WSP
#undef WRG
}

extern "C" void kernel_launch(void* const* d_in, const int* in_sizes, int n_in, void* d_out, int out_size, void* d_ws, size_t ws_size, hipStream_t stream) {
    static int grid = 0;
    if (grid == 0) {
        if (n_in != 27 || out_size != NB * SEQ * DM || ws_size < WS_TOTAL) { fprintf(stderr, "kernel_launch: unexpected shapes (n_in %d out %d ws %zu need %zu)\n", n_in, out_size, ws_size, (size_t)WS_END); grid = -1; return; }
        int dev = 0, cus = 0, per_cu = 0;
        (void)hipGetDevice(&dev); (void)hipDeviceGetAttribute(&cus, hipDeviceAttributeMultiprocessorCount, dev);
        if (hipFuncSetAttribute((const void*)hybrid_fwd, hipFuncAttributeMaxDynamicSharedMemorySize, LDS_BYTES) != hipSuccess) { fprintf(stderr, "kernel_launch: hipFuncSetAttribute failed\n"); grid = -1; return; }
        (void)hipOccupancyMaxActiveBlocksPerMultiprocessor(&per_cu, (const void*)hybrid_fwd, 512, LDS_BYTES);
        if (per_cu < 1) { fprintf(stderr, "kernel_launch: occupancy query says %d blocks per CU\n", per_cu); per_cu = 1; }
        (void)hipGetLastError();
        grid = cus;
    }
    if (grid < 0) return;
    if (hipMemsetAsync((char*)d_ws + WS_CTL, 0, WS_CTL_BYTES, stream) != hipSuccess) { fprintf(stderr, "kernel_launch: memset failed\n"); return; }
    Args a{};
    for (int i = 0; i < 27; ++i) a.in[i] = (const float*)d_in[i];
    a.out = (float*)d_out; a.ws = (unsigned char*)d_ws;
#if MK_SINGLE
    a.ph_lo = 0; a.ph_hi = NPHASE;
    { void* kargs[] = {&a}; hipError_t e = hipLaunchCooperativeKernel((const void*)hybrid_fwd, dim3(grid), dim3(512), kargs, LDS_BYTES, stream);
      if (e != hipSuccess) fprintf(stderr, "cooperative launch failed: %s (grid %d)\n", hipGetErrorString(e), grid); }
#else
    for (int pp = 0; pp < NPHASE + PROBE_NDUP; ++pp) { const int p = pp < NPHASE ? pp : PROBE_DUP0 + (pp - NPHASE) * PROBE_DUPSTEP; a.ph_lo = p; a.ph_hi = p + 1;
        void* kargs[] = {&a}; hipError_t e = hipLaunchCooperativeKernel((const void*)hybrid_fwd, dim3(grid), dim3(512), kargs, LDS_BYTES, stream);
        if (e != hipSuccess) { fprintf(stderr, "cooperative launch %d failed: %s (grid %d)\n", p, hipGetErrorString(e), grid); break; } }
#endif
}
```

```cpp
#include <hip/hip_runtime.h>
#include <hip/hip_cooperative_groups.h>
#include <cstdio>
#include <cstdint>
namespace cg = cooperative_groups;

#ifndef MK_SINGLE
#define MK_SINGLE 1
#endif
#ifndef PH_MASK
#define PH_MASK 0xFFFF
#endif
#define EN(k) (((PH_MASK) >> (k)) & 1)
#ifndef PROBE_NDUP
#define PROBE_NDUP 0
#define PROBE_DUP0 0
#define PROBE_DUPSTEP 6
#endif
#ifndef PROBE_ATTREP
#define PROBE_ATTREP 1
#endif
#ifndef ATT_VAR
#define ATT_VAR 0
#endif

constexpr int NB = 8, SEQ = 4096, CTXL = 256, TB = SEQ + CTXL, MROWS = NB * TB, DM = 1024, PW = 2560, FH = 2816, NF = 2 * FH, NLAYER = 2;
constexpr int Q0c = 0, K0c = 512, V0c = 1024, LX0 = 1536, LG0 = 1792, SU0 = 2048, SV0 = 2304;
constexpr int NMS = 9, NMOD = 6 * DM;
constexpr int NCHUNK = TB / 128;
constexpr size_t SZ_WIN = (size_t)PW * DM * 2, SZ_WOUT = (size_t)DM * DM * 2, SZ_WFFN = (size_t)NF * DM * 2, SZ_WDN = (size_t)DM * FH * 2;
constexpr size_t WS_WIN = 0, WS_WOUT = WS_WIN + 2 * SZ_WIN, WS_WFFN = WS_WOUT + 2 * SZ_WOUT, WS_WDN = WS_WFFN + 2 * SZ_WFFN;
constexpr size_t WS_WSP = WS_WDN + 2 * SZ_WDN;
constexpr size_t WS_WRG = WS_WSP + 262144;
constexpr size_t WS_MODS = WS_WRG + 262144;
constexpr size_t WS_SHWIN = WS_MODS + 442368;
constexpr size_t WS_SHWF = WS_SHWIN + 184320;
constexpr size_t WS_ROPE = WS_SHWF + 405504;
constexpr size_t WS_C8 = WS_ROPE + 8192;
constexpr size_t WS_LAM = WS_C8 + 4096;
constexpr size_t WS_ROWSS = WS_LAM + 256;
constexpr size_t WS_LRUS = WS_ROWSS + (size_t)MROWS * 64;
constexpr size_t WS_XC = WS_LRUS + (size_t)NB * NCHUNK * 2 * 2 * 256 * 4;
constexpr size_t WS_AP = WS_XC + (size_t)NB * CTXL * DM * 4;
constexpr size_t WS_P = WS_AP + (size_t)MROWS * DM * 2;
constexpr size_t WS_Y = WS_P + (size_t)MROWS * PW * 2;
constexpr size_t WS_END = WS_Y + (size_t)MROWS * DM * 2;
constexpr size_t WS_CTL = WS_END, WS_CTL_BYTES = 16384, WS_TOTAL = WS_END + WS_CTL_BYTES;
constexpr size_t WS_HMID = WS_P;
static_assert((size_t)MROWS * FH * 2 <= WS_END - WS_P, "hmid overlay");
static_assert(WS_WSP % 256 == 0 && WS_MODS % 256 == 0 && WS_ROWSS % 256 == 0 && WS_XC % 256 == 0 && WS_AP % 256 == 0 && WS_P % 256 == 0, "align");

#define LAS __attribute__((address_space(3)))
typedef float f32x2 __attribute__((ext_vector_type(2)));
typedef unsigned u32x2 __attribute__((ext_vector_type(2)));
__device__ __forceinline__ unsigned cvtpk(float lo, float hi) { unsigned r; asm("v_cvt_pk_bf16_f32 %0, %1, %2" : "=v"(r) : "v"(lo), "v"(hi)); return r; }
__device__ __forceinline__ float bflo(unsigned w) { return __uint_as_float(w << 16); }
__device__ __forceinline__ float bfhi(unsigned w) { return __uint_as_float(w & 0xffff0000u); }
__device__ __forceinline__ float bf2f(unsigned short h) { return __uint_as_float((unsigned)h << 16); }
__device__ __forceinline__ unsigned short f2bf(float v) { return (unsigned short)(cvtpk(v, v) & 0xffffu); }
__device__ __forceinline__ float fexp(float x) { return __builtin_amdgcn_exp2f(x * 1.4426950408889634f); }
__device__ __forceinline__ float gelu_tanh(float x) { const float u = 1.5957691216f * x * (1.f + 0.044715f * x * x); return x * __builtin_amdgcn_rcpf(1.f + fexp(-u)); }
__device__ __forceinline__ float silu_f(float x) { return x * __builtin_amdgcn_rcpf(1.f + fexp(-x)); }
__device__ __forceinline__ float sigm(float x) { return __builtin_amdgcn_rcpf(1.f + fexp(-x)); }

namespace pg8 {
#define PG8_LAS __attribute__((address_space(3)))
typedef unsigned short bf16_t;
typedef short bf16x8 __attribute__((ext_vector_type(8)));
typedef float f32x4 __attribute__((ext_vector_type(4)));
typedef unsigned u32x4 __attribute__((ext_vector_type(4)));
constexpr int BM = 256, BK = 64, HALF = 128, HTB = HALF * BK * 2  , STAGE_BYTES = 8 * HTB, NXCD = 8, WGM = 8;

__host__ __device__ __forceinline__ int lds_byte(int r, int c) { const int st = (r >> 4) * 2 + (c >> 5), rr = r & 15, cc = c & 31, ob = rr * 64 + cc * 2; return st * 1024 + (ob ^ (((ob >> 9) & 1) << 5)); }
__host__ __device__ __forceinline__ void stage_rc(int b, int& R, int& C) { const int st = b / 1024, sb = b % 1024, swz = sb ^ (((sb >> 9) & 1) << 5); R = (st >> 1) * 16 + swz / 64; C = (st & 1) * 32 + (swz % 64) / 2; }
__host__ __device__ __forceinline__ int perm32(int rho) { const int n = rho >> 4, i = rho & 15; return 8 * (i >> 2) + 4 * n + (i & 3); }

struct Unit { int pm, pn; };
struct Gemm { const bf16_t* A; const bf16_t* Bt; int M, N, K; };

struct StaticOrder {
    int nM, nN, nwg, G, c;
    __host__ __device__ void init(int M, int N, int G_, int c_) { nM = M / BM; nN = N / BM; nwg = nM * nN; G = G_; c = c_; }
    __host__ __device__ bool next(int i, Unit& u) const {
        const long L = (long)i * G + c; if (L >= nwg) return false;
        int wgid = (int)L; { const int q = nwg / NXCD, r = nwg % NXCD, xcd = wgid % NXCD, off = wgid / NXCD; wgid = (xcd < r ? xcd * (q + 1) : r * (q + 1) + (xcd - r) * q) + off; }
        const int nig = WGM * nN, gid = wgid / nig, fm = gid * WGM, gsz = (nM - fm) < WGM ? (nM - fm) : WGM;
        u.pm = fm + ((wgid % nig) % gsz); u.pn = (wgid % nig) / gsz; return true;
    }
    __device__ __forceinline__ void a_ready(const Unit&) const {}
    __device__ __forceinline__ void done(const Unit&) const {}
};

}
namespace pg8 {
template <class Epi, class Sched, bool ALIGN_EPI = false, bool SP2 = false>
__device__ __forceinline__ void gemm_phase(PG8_LAS unsigned char* lds, const Gemm g, const Sched& S, const Epi& E) {
    int tid_ = threadIdx.x; asm volatile("" : "+v"(tid_));
    const int tid = tid_, wid = __builtin_amdgcn_readfirstlane(tid >> 6), lane = tid & 63, wr = wid >> 2, wc = wid & 3, fr = lane & 15, fq = lane >> 4;
    const int K = g.K, nt = K / BK;
    unsigned voffA[2], voffB[2];
#pragma unroll
    for (int i = 0; i < 2; ++i) { int R, C; stage_rc(tid * 16 + i * 8192, R, C); const int Rb = Epi::PERM ? ((R & ~31) + perm32(R & 31)) : R;
        voffA[i] = (unsigned)(R * K + C) * 2u; voffB[i] = (unsigned)(Rb * K + C) * 2u; }
    const size_t kstep = (size_t)(BK * 2);
    const size_t hstep = (size_t)HALF * K * 2;
    const size_t tstep = 2 * hstep;
    const unsigned ldsw = (unsigned)wid * 1024u;
    const int aoff = lds_byte(wr * 64 + fr, fq * 8), boff = lds_byte(wc * 32 + fr, fq * 8);
#define PG8_SA(b, h) (((b) * 2 + (h)) * HTB)
#define PG8_SB(b, h) ((4 + (b) * 2 + (h)) * HTB)
#define PG8_STAGE(bufoff, gbase, voff) do { _Pragma("unroll") for (int _i = 0; _i < 2; ++_i) \
        __builtin_amdgcn_global_load_lds((const unsigned*)((const char*)(gbase) + (voff)[_i]), (PG8_LAS unsigned*)(lds + (bufoff) + ldsw + _i * 8192), 16, 0, 0); } while (0)
#define PG8_LDA(dst, b, h) do { _Pragma("unroll") for (int m = 0; m < 4; ++m) _Pragma("unroll") for (int k = 0; k < 2; ++k) dst[m][k] = *(const PG8_LAS bf16x8*)(lds + PG8_SA(b, h) + aoff + m * 2048 + k * 1024); } while (0)
#define PG8_LDB(dst, b, h) do { _Pragma("unroll") for (int n = 0; n < 2; ++n) _Pragma("unroll") for (int k = 0; k < 2; ++k) dst[n][k] = *(const PG8_LAS bf16x8*)(lds + PG8_SB(b, h) + boff + n * 2048 + k * 1024); } while (0)
#define PG8_MMA(ai, bj, At, Bt) do { __builtin_amdgcn_s_setprio(1); _Pragma("unroll") for (int m = 0; m < 4; ++m) _Pragma("unroll") for (int n = 0; n < 2; ++n) _Pragma("unroll") for (int k = 0; k < 2; ++k) \
        acc[ai][bj][m][n] = __builtin_amdgcn_mfma_f32_16x16x32_bf16(Bt[n][k], At[m][k], acc[ai][bj][m][n], 0, 0, 0); __builtin_amdgcn_s_setprio(0); } while (0)
#define PG8_WAIT_V(n) asm volatile("s_waitcnt vmcnt(" #n ")" ::: "memory")
#define PG8_WAIT_L(n) asm volatile("s_waitcnt lgkmcnt(" #n ")" ::: "memory")
#define PG8_BAR __builtin_amdgcn_s_barrier()
#define PG8_SCHED __builtin_amdgcn_sched_barrier(0)
    Unit cur, nxt; int ui = 0;
    if (!S.next(0, cur)) return;
    f32x4 acc[2][2][4][2];
#pragma unroll
    for (int a = 0; a < 2; ++a)
#pragma unroll
        for (int b = 0; b < 2; ++b)
#pragma unroll
            for (int m = 0; m < 4; ++m)
#pragma unroll
                for (int n = 0; n < 2; ++n) acc[a][b][m][n] = (f32x4){0.f, 0.f, 0.f, 0.f};
    bf16x8 At[4][2], B0[2][2], B1[2][2];
    const char* cA = (const char*)g.A + (size_t)cur.pm * tstep; const char* cB = (const char*)g.Bt + (size_t)cur.pn * tstep;
    S.a_ready(cur);
    if constexpr (SP2) {
        PG8_STAGE(PG8_SB(0, 0), cB, voffB); PG8_STAGE(PG8_SB(0, 1), cB + hstep, voffB); PG8_STAGE(PG8_SA(0, 0), cA, voffA); PG8_STAGE(PG8_SA(0, 1), cA + hstep, voffA);
        if (wr == 1) PG8_BAR;
        PG8_WAIT_V(2); PG8_BAR;
        PG8_STAGE(PG8_SB(1, 0), cB + kstep, voffB); PG8_STAGE(PG8_SA(1, 0), cA + kstep, voffA); PG8_STAGE(PG8_SB(1, 1), cB + hstep + kstep, voffB);
        PG8_WAIT_V(6); PG8_BAR;
    } else {
        PG8_STAGE(PG8_SB(0, 0), cB, voffB); PG8_STAGE(PG8_SA(0, 0), cA, voffA); PG8_STAGE(PG8_SB(0, 1), cB + hstep, voffB); PG8_STAGE(PG8_SA(0, 1), cA + hstep, voffA);
        if (wr == 1) PG8_BAR;
        PG8_WAIT_V(4); PG8_BAR;
        PG8_STAGE(PG8_SB(1, 0), cB + kstep, voffB); PG8_STAGE(PG8_SA(1, 0), cA + kstep, voffA); PG8_STAGE(PG8_SB(1, 1), cB + hstep + kstep, voffB);
        PG8_WAIT_V(6); PG8_BAR;
    }
    for (;;) {
        const bool has_next = S.next(ui + 1, nxt);
        const char* nA = has_next ? (const char*)g.A + (size_t)nxt.pm * tstep : cA; const char* nB = has_next ? (const char*)g.Bt + (size_t)nxt.pn * tstep : cB;
        for (int t = 0; t < nt; t += 2) {
            const bool last = (t == nt - 2);
            const char* a1 = cA + (size_t)(t + 1) * kstep;
            const char* a2 = last ? nA : cA + (size_t)(t + 2) * kstep; const char* b2 = last ? nB : cB + (size_t)(t + 2) * kstep;
            const char* a3 = a2 + kstep; const char* b3 = b2 + kstep;
            if (last && has_next) S.a_ready(nxt);
            if constexpr (SP2) {
            PG8_LDB(B0, 0, 0); PG8_LDB(B1, 0, 1); PG8_SCHED; PG8_LDA(At, 0, 0); PG8_STAGE(PG8_SA(1, 1), a1 + hstep, voffA);
            PG8_WAIT_V(8); PG8_WAIT_L(0); PG8_BAR; PG8_MMA(0, 0, At, B0); PG8_MMA(0, 1, At, B1); PG8_BAR; PG8_SCHED;
            PG8_LDA(At, 0, 1); PG8_STAGE(PG8_SB(0, 0), b2, voffB); PG8_STAGE(PG8_SB(0, 1), b2 + hstep, voffB); PG8_STAGE(PG8_SA(0, 0), a2, voffA);
            PG8_WAIT_V(8); PG8_WAIT_L(0); PG8_BAR; PG8_MMA(1, 0, At, B0); PG8_MMA(1, 1, At, B1); PG8_BAR; PG8_SCHED;
            PG8_LDB(B0, 1, 0); PG8_LDB(B1, 1, 1); PG8_SCHED; PG8_LDA(At, 1, 0); PG8_STAGE(PG8_SA(0, 1), a2 + hstep, voffA);
            PG8_WAIT_V(8); PG8_WAIT_L(0); PG8_BAR; PG8_MMA(0, 0, At, B0); PG8_MMA(0, 1, At, B1); PG8_BAR; PG8_SCHED;
            PG8_LDA(At, 1, 1); PG8_STAGE(PG8_SB(1, 0), b3, voffB); PG8_STAGE(PG8_SB(1, 1), b3 + hstep, voffB); PG8_STAGE(PG8_SA(1, 0), a3, voffA);
            PG8_WAIT_V(8); PG8_WAIT_L(0); PG8_BAR; PG8_MMA(1, 0, At, B0); PG8_MMA(1, 1, At, B1); PG8_BAR; PG8_SCHED;
            } else {
            PG8_LDB(B0, 0, 0); PG8_SCHED; PG8_LDA(At, 0, 0); PG8_STAGE(PG8_SA(1, 1), a1 + hstep, voffA);
            PG8_WAIT_L(8); PG8_BAR; PG8_WAIT_L(0); PG8_MMA(0, 0, At, B0); PG8_BAR; PG8_SCHED;
            PG8_LDB(B1, 0, 1); PG8_STAGE(PG8_SB(0, 0), b2, voffB);
            PG8_BAR; PG8_WAIT_L(0); PG8_MMA(0, 1, At, B1); PG8_BAR;
            PG8_LDA(At, 0, 1); PG8_STAGE(PG8_SA(0, 0), a2, voffA);
            PG8_BAR; PG8_WAIT_L(0); PG8_MMA(1, 0, At, B0); PG8_BAR; PG8_SCHED;
            PG8_STAGE(PG8_SB(0, 1), b2 + hstep, voffB);
            PG8_WAIT_V(6); PG8_BAR; PG8_MMA(1, 1, At, B1); PG8_BAR;
            PG8_LDB(B0, 1, 0); PG8_SCHED; PG8_LDA(At, 1, 0); PG8_STAGE(PG8_SA(0, 1), a2 + hstep, voffA);
            PG8_WAIT_L(8); PG8_BAR; PG8_WAIT_L(0); PG8_MMA(0, 0, At, B0); PG8_BAR; PG8_SCHED;
            PG8_LDB(B1, 1, 1); PG8_STAGE(PG8_SB(1, 0), b3, voffB);
            PG8_BAR; PG8_WAIT_L(0); PG8_MMA(0, 1, At, B1); PG8_BAR;
            PG8_LDA(At, 1, 1); PG8_STAGE(PG8_SA(1, 0), a3, voffA);
            PG8_BAR; PG8_WAIT_L(0); PG8_MMA(1, 0, At, B0); PG8_BAR; PG8_SCHED;
            PG8_STAGE(PG8_SB(1, 1), b3 + hstep, voffB);
            PG8_WAIT_V(6); PG8_BAR; PG8_MMA(1, 1, At, B1); PG8_BAR;
            }
        }
        if constexpr (ALIGN_EPI) { if (wr == 0) PG8_BAR; }
        if constexpr (!Epi::AFTER_DRAIN) { E(acc, cur, wr, wc, fr, fq); S.done(cur); }
        if (!has_next) break;
#pragma unroll
        for (int a = 0; a < 2; ++a)
#pragma unroll
            for (int b = 0; b < 2; ++b)
#pragma unroll
                for (int m = 0; m < 4; ++m)
#pragma unroll
                    for (int n = 0; n < 2; ++n) acc[a][b][m][n] = (f32x4){0.f, 0.f, 0.f, 0.f};
        cur = nxt; cA = nA; cB = nB; ++ui;
        if constexpr (ALIGN_EPI) { if (wr == 1) PG8_BAR; }
    }
    PG8_WAIT_V(0);
    if constexpr (!ALIGN_EPI) { if (wr == 0) PG8_BAR; }
    PG8_BAR;
    if constexpr (Epi::AFTER_DRAIN) { E.fused(acc, cur, wr, wc, fr, fq, lds, wid, lane); S.done(cur); }
#undef PG8_SA
#undef PG8_SB
#undef PG8_STAGE
#undef PG8_LDA
#undef PG8_LDB
#undef PG8_MMA
#undef PG8_WAIT_V
#undef PG8_WAIT_L
#undef PG8_BAR
#undef PG8_SCHED
}
}
namespace pg8 {
struct Order {
    int nM, nN, nwg, G, c, skip;
    __device__ void init(int nM_, int N, int G_, int c_, int skip_) { nM = nM_; nN = N / BM; nwg = nM * nN; G = G_; c = c_; skip = skip_; }
    __device__ bool next(int i, Unit& u) const {
        const long L = (long)i * G + c; if (L >= nwg) return false;
        int wgid = (int)L; { const int q = nwg / NXCD, r = nwg % NXCD, xcd = wgid % NXCD, off = wgid / NXCD; wgid = (xcd < r ? xcd * (q + 1) : r * (q + 1) + (xcd - r) * q) + off; }
        const int nig = WGM * nN, gid = wgid / nig, fm = gid * WGM, gsz = (nM - fm) < WGM ? (nM - fm) : WGM;
        u.pm = fm + ((wgid % nig) % gsz); u.pn = (wgid % nig) / gsz;
        if (skip) u.pm = u.pm + u.pm / 16 + 1;
        return true;
    }
    __device__ __forceinline__ void a_ready(const Unit&) const {}
    __device__ __forceinline__ void done(const Unit&) const {}
};
}

using pg8::f32x4; using pg8::u32x4; using pg8::bf16_t; using pg8::bf16x8;
__device__ __forceinline__ float row_rstd(const float* rowss, size_t row) {
    const f32x4* rs = (const f32x4*)(rowss + row * 16);
    const f32x4 s4 = (rs[0] + rs[1]) + (rs[2] + rs[3]);
    return rsqrtf(((s4.x + s4.y) + (s4.z + s4.w)) * (1.f / 1024.f) + 1e-6f);
}
__device__ __forceinline__ void rows_rstd(const float* rowss, int pm, int wr, int fr, float (&rstd)[2][4]) {
#pragma unroll
    for (int ai = 0; ai < 2; ++ai)
#pragma unroll
      for (int mh = 0; mh < 2; ++mh) { f32x4 t[2][4];
#pragma unroll
        for (int m2 = 0; m2 < 2; ++m2) { const f32x4* rs = (const f32x4*)(rowss + ((size_t)pm * 256 + ai * 128 + wr * 64 + (mh * 2 + m2) * 16 + fr) * 16);
#pragma unroll
            for (int k = 0; k < 4; ++k) t[m2][k] = rs[k]; }
        asm volatile("" ::: "memory");
#pragma unroll
        for (int m2 = 0; m2 < 2; ++m2) { const f32x4 s4 = (t[m2][0] + t[m2][1]) + (t[m2][2] + t[m2][3]); rstd[ai][mh * 2 + m2] = rsqrtf(((s4.x + s4.y) + (s4.z + s4.w)) * (1.f / 1024.f) + 1e-6f); } }
}
struct EpiInProj {
    static constexpr bool PERM = false, AFTER_DRAIN = false;
    bf16_t* P; const float* rowss; const float* sW; const float* ropeC; const float* ropeS;
    __device__ __forceinline__ void operator()(const f32x4 (&acc)[2][2][4][2], const pg8::Unit& u, int wr, int wc, int fr, int fq) const {
        const int b = u.pm / 17, j17 = u.pm - b * 17; const bool ctx = (j17 == 0); const int ms = ctx ? 8 : b;
        const int colb = u.pn * 256 + wc * 32 + 4 * fq;
        const int mode = (u.pn < 4) ? (ctx ? 0 : 1) : (u.pn >= 7 ? 2 : 0);
        f32x4 bv[2][2];
#pragma unroll
        for (int bj = 0; bj < 2; ++bj)
#pragma unroll
            for (int n = 0; n < 2; ++n) bv[bj][n] = *(const f32x4*)(sW + ms * PW + colb + bj * 128 + n * 16);
#pragma unroll
        for (int ai = 0; ai < 2; ++ai) {
#pragma unroll
            for (int m = 0; m < 4; ++m) {
                const int rt = ai * 128 + wr * 64 + m * 16 + fr; const size_t row = (size_t)u.pm * 256 + rt;
                float rstd;
                { const f32x4* rs = (const f32x4*)(rowss + row * 16); const f32x4 t0 = rs[0], t1 = rs[1], t2 = rs[2], t3 = rs[3];
                  const f32x4 s4 = (t0 + t1) + (t2 + t3); rstd = rsqrtf(((s4.x + s4.y) + (s4.z + s4.w)) * (1.f / 1024.f) + 1e-6f); }
                f32x4 v[2][2];
#pragma unroll
                for (int bj = 0; bj < 2; ++bj)
#pragma unroll
                    for (int n = 0; n < 2; ++n) v[bj][n] = acc[ai][bj][m][n] * rstd + bv[bj][n];
                if (mode == 1) {
                    const int tl = (j17 - 1) * 256 + rt; const int pos = (wc & 1) ? (tl & 63) : (tl >> 6);
                    const f32x4 c4 = *(const f32x4*)(ropeC + pos * 16 + 4 * fq), s4 = *(const f32x4*)(ropeS + pos * 16 + 4 * fq);
#pragma unroll
                    for (int bj = 0; bj < 2; ++bj) { const f32x4 x1 = v[bj][0], x2 = v[bj][1]; v[bj][0] = x1 * c4 - x2 * s4; v[bj][1] = x1 * s4 + x2 * c4; }
                } else if (mode == 2) {
#pragma unroll
                    for (int bj = 0; bj < 2; ++bj)
#pragma unroll
                        for (int n = 0; n < 2; ++n) { f32x4 t = v[bj][n]; t.x = gelu_tanh(t.x); t.y = gelu_tanh(t.y); t.z = gelu_tanh(t.z); t.w = gelu_tanh(t.w); v[bj][n] = t; }
                }
                bf16_t* rp = P + row * PW + colb;
#pragma unroll
                for (int bj = 0; bj < 2; ++bj)
#pragma unroll
                    for (int n = 0; n < 2; ++n) { u32x2 w; w.x = cvtpk(v[bj][n].x, v[bj][n].y); w.y = cvtpk(v[bj][n].z, v[bj][n].w); *(u32x2*)(rp + bj * 128 + n * 16) = w; }
            }
        }
    }
};
struct EpiSwiGLU {
    static constexpr bool PERM = true, AFTER_DRAIN = false;
    bf16_t* H; const float* rowss; const float* sW;
    __device__ __forceinline__ void operator()(const f32x4 (&acc)[2][2][4][2], const pg8::Unit& u, int wr, int wc, int fr, int fq) const {
        const int b = u.pm / 17, j17 = u.pm - b * 17; const int ms = (j17 == 0) ? 8 : b;
        const int colb = wc * 32 + 8 * fq;
        f32x4 bg[2], bu[2];
#pragma unroll
        for (int n = 0; n < 2; ++n) { bg[n] = *(const f32x4*)(sW + ms * NF + u.pn * 256 + colb + 4 * n); bu[n] = *(const f32x4*)(sW + ms * NF + u.pn * 256 + 128 + colb + 4 * n); }
        float rstd_[2][4]; rows_rstd(rowss, u.pm, wr, fr, rstd_);
#pragma unroll
        for (int ai = 0; ai < 2; ++ai)
#pragma unroll
            for (int m = 0; m < 4; ++m) {
                const int rt = ai * 128 + wr * 64 + m * 16 + fr; const size_t row = (size_t)u.pm * 256 + rt;
                const float rstd = rstd_[ai][m];
                f32x4 hm[2];
#pragma unroll
                for (int n = 0; n < 2; ++n) { const f32x4 g = acc[ai][0][m][n] * rstd + bg[n], up = acc[ai][1][m][n] * rstd + bu[n];
                    hm[n].x = silu_f(g.x) * up.x; hm[n].y = silu_f(g.y) * up.y; hm[n].z = silu_f(g.z) * up.z; hm[n].w = silu_f(g.w) * up.w; }
                u32x4 w; w.x = cvtpk(hm[0].x, hm[0].y); w.y = cvtpk(hm[0].z, hm[0].w); w.z = cvtpk(hm[1].x, hm[1].y); w.w = cvtpk(hm[1].z, hm[1].w);
                *(u32x4*)(H + row * FH + u.pn * 128 + colb) = w;
            }
    }
};
struct EpiRes {
    static constexpr bool PERM = true, AFTER_DRAIN = false;
    const float* xin_lat; const float* xin_ctx; float* xo_lat; int xsrc;
    const float* gate; const float* gp; const float* scp;
    const float* gn; const float* scn; bf16_t* A; float* rowss; int write_a; int xbf;
    __device__ __forceinline__ void operator()(const f32x4 (&acc)[2][2][4][2], const pg8::Unit& u, int wr, int wc, int fr, int fq) const {
        const int b = u.pm / 17, j17 = u.pm - b * 17; const bool ctx = (j17 == 0); const int ms = ctx ? 8 : b;
        const float* xi = ctx ? xin_ctx + (size_t)b * CTXL * DM : xin_lat + ((size_t)b * SEQ + (size_t)(j17 - 1) * 256) * DM;
        float* xo = xo_lat + ((size_t)b * SEQ + (size_t)(j17 - 1) * 256) * DM;
        const int colb = u.pn * 256 + wc * 32 + 8 * fq;
        float ss[2][4];
#pragma unroll
        for (int ai = 0; ai < 2; ++ai)
#pragma unroll
            for (int m = 0; m < 4; ++m) ss[ai][m] = 0.f;
#pragma unroll
        for (int bj = 0; bj < 2; ++bj) {
            const int col = colb + bj * 128;
            f32x4 gv[2], fc[2], rf[2];
#pragma unroll
            for (int n = 0; n < 2; ++n) { gv[n] = *(const f32x4*)(gate + ms * NMOD + col + 4 * n);
                if (write_a) fc[n] = *(const f32x4*)(gn + col + 4 * n) * (*(const f32x4*)(scn + ms * NMOD + col + 4 * n) + 1.f); else fc[n] = (f32x4){0.f, 0.f, 0.f, 0.f};
                if (xsrc) { const f32x4 f = *(const f32x4*)(gp + col + 4 * n) * (*(const f32x4*)(scp + ms * NMOD + col + 4 * n) + 1.f);
                    rf[n].x = __builtin_amdgcn_rcpf(f.x); rf[n].y = __builtin_amdgcn_rcpf(f.y); rf[n].z = __builtin_amdgcn_rcpf(f.z); rf[n].w = __builtin_amdgcn_rcpf(f.w); }
                else rf[n] = (f32x4){0.f, 0.f, 0.f, 0.f}; }
#pragma unroll
            for (int ai = 0; ai < 2; ++ai) {
                f32x4 xl[4][2];
                if (!xsrc) {
#pragma unroll
                    for (int m = 0; m < 4; ++m) { const unsigned xo4 = ((unsigned)(ai * 128 + wr * 64 + m * 16 + fr) * DM + (unsigned)col) * 4u;
#pragma unroll
                        for (int n = 0; n < 2; ++n) xl[m][n] = *(const f32x4*)((const char*)xi + (xo4 + 16u * n)); }
                } else {
                    u32x4 w[4];
#pragma unroll
                    for (int m = 0; m < 4; ++m) w[m] = *(const u32x4*)((const char*)A + (((unsigned)u.pm * 256u + (unsigned)(ai * 128 + wr * 64 + m * 16 + fr)) * DM + (unsigned)col) * 2u);
#pragma unroll
                    for (int m = 0; m < 4; ++m) { xl[m][0] = (f32x4){bflo(w[m].x), bfhi(w[m].x), bflo(w[m].y), bfhi(w[m].y)} * rf[0]; xl[m][1] = (f32x4){bflo(w[m].z), bfhi(w[m].z), bflo(w[m].w), bfhi(w[m].w)} * rf[1]; }
                }
                asm volatile("" ::: "memory");
#pragma unroll
                for (int m = 0; m < 4; ++m) {
                    const int rt = ai * 128 + wr * 64 + m * 16 + fr;
                    f32x4 xv[2];
#pragma unroll
                    for (int n = 0; n < 2; ++n) { xv[n] = xl[m][n] + gv[n] * acc[ai][bj][m][n];
                        ss[ai][m] += (xv[n].x * xv[n].x + xv[n].y * xv[n].y) + (xv[n].z * xv[n].z + xv[n].w * xv[n].w); }
                    if (xbf) { u32x4 w; w.x = cvtpk(xv[0].x, xv[0].y); w.y = cvtpk(xv[0].z, xv[0].w); w.z = cvtpk(xv[1].x, xv[1].y); w.w = cvtpk(xv[1].z, xv[1].w);
                        *(u32x4*)((char*)xo + ((unsigned)rt * (DM * 4u) + (unsigned)col * 2u)) = w; }
                    if (write_a) { const f32x4 a0 = xv[0] * fc[0], a1 = xv[1] * fc[1];
                        u32x4 w; w.x = cvtpk(a0.x, a0.y); w.y = cvtpk(a0.z, a0.w); w.z = cvtpk(a1.x, a1.y); w.w = cvtpk(a1.z, a1.w);
                        *(u32x4*)((char*)A + (((unsigned)u.pm * 256u + (unsigned)rt) * DM + (unsigned)col) * 2u) = w; }
                }
            }
        }
#pragma unroll
        for (int ai = 0; ai < 2; ++ai)
#pragma unroll
            for (int m = 0; m < 4; ++m) { float s = ss[ai][m]; s += __shfl_xor(s, 16); s += __shfl_xor(s, 32);
                if (fq == 0) rowss[((size_t)u.pm * 256 + ai * 128 + wr * 64 + m * 16 + fr) * 16 + u.pn * 4 + wc] = s; }
    }
};
namespace att {
using s16x4 = __attribute__((ext_vector_type(4))) short;
using f32x16 = __attribute__((ext_vector_type(16))) float;
constexpr int SHM_V = 16384, SHM_K = 8192, OFF_V = 0, OFF_K = 32768, OFF_WS = 49152, OFF_ST = 51200, LDS_TOTAL = OFF_ST + 65536;
constexpr float SCALE = 0.125f, THR = 8.f;
#define KSWZ(row, colB) ((row) * 128 + ((colB) ^ (((row) & 7) << 4)))
#define SBAR() __builtin_amdgcn_sched_barrier(0)
__device__ __forceinline__ int crow(int r, int hi) { return (r & 3) + 8 * (r >> 2) + 4 * hi; }
__device__ __forceinline__ void partialSM(f32x16& p0, f32x16& p1, float& m_reg, float& mn, float& alpha) {
  constexpr float C = SCALE * 1.4426950408889634f;
  float pmax = p0[0];
#pragma unroll
  for (int r = 1; r < 16; ++r) pmax = fmaxf(pmax, p0[r]);
#pragma unroll
  for (int r = 0; r < 16; ++r) pmax = fmaxf(pmax, p1[r]);
  { auto rr = __builtin_amdgcn_permlane32_swap(__float_as_uint(pmax), __float_as_uint(pmax), false, false);
    pmax = fmaxf(__uint_as_float(rr[0]), __uint_as_float(rr[1])); }
  if (__builtin_expect(__all(pmax - m_reg <= THR / SCALE), 1)) { mn = m_reg; alpha = 1.f; }
  else { mn = fmaxf(m_reg, pmax); alpha = __builtin_amdgcn_exp2f((m_reg - mn) * C); m_reg = mn; }
  const float mnC = -mn * C;
#pragma unroll
  for (int r = 0; r < 16; ++r) p0[r] = fmaf(p0[r], C, mnC);
#pragma unroll
  for (int r = 0; r < 16; ++r) p1[r] = fmaf(p1[r], C, mnC);
#pragma unroll
  for (int r = 0; r < 16; ++r) p0[r] = __builtin_amdgcn_exp2f(p0[r]);
}
__device__ __forceinline__ void finishSM(f32x16& p0, f32x16& p1, float alpha, float& l_reg, bf16x8& pa0, bf16x8& pa1, bf16x8& pa2, bf16x8& pa3) {
#pragma unroll
  for (int r = 0; r < 16; ++r) p1[r] = __builtin_amdgcn_exp2f(p1[r]);
  float ps = 0;
#pragma unroll
  for (int r = 0; r < 16; ++r) ps += p0[r];
#pragma unroll
  for (int r = 0; r < 16; ++r) ps += p1[r];
  { auto rr = __builtin_amdgcn_permlane32_swap(__float_as_uint(ps), __float_as_uint(ps), false, false);
    ps = __uint_as_float(rr[0]) + __uint_as_float(rr[1]); }
  l_reg = l_reg * alpha + ps;
#define PK4(P, BASE, OUT) do { unsigned a0 = cvtpk(P[BASE + 0], P[BASE + 1]), a1 = cvtpk(P[BASE + 2], P[BASE + 3]);   \
    unsigned b0 = cvtpk(P[BASE + 4], P[BASE + 5]), b1 = cvtpk(P[BASE + 6], P[BASE + 7]);                              \
    auto r0 = __builtin_amdgcn_permlane32_swap(a0, b0, false, false); auto r1 = __builtin_amdgcn_permlane32_swap(a1, b1, false, false); \
    u32x4 w = {r0[0], r1[0], r0[1], r1[1]}; OUT = *reinterpret_cast<bf16x8*>(&w); } while (0)
  PK4(p0, 0, pa0); PK4(p0, 8, pa1); PK4(p1, 0, pa2); PK4(p1, 8, pa3);
#undef PK4
}
__device__ __forceinline__ void qkt(f32x16& p0, f32x16& p1, const char* Ks, const bf16x8* qr, int r32, int hi) {
  p0 = f32x16{}; p1 = f32x16{};
#pragma unroll
  for (int d0 = 0; d0 < 4; ++d0) { const int cb = d0 * 32 + hi * 16;
    const bf16x8 b0 = *reinterpret_cast<const bf16x8*>(Ks + KSWZ(r32, cb));
    const bf16x8 b1 = *reinterpret_cast<const bf16x8*>(Ks + KSWZ(32 + r32, cb));
    p0 = __builtin_amdgcn_mfma_f32_32x32x16_bf16(b0, qr[d0], p0, 0, 0, 0);
    p1 = __builtin_amdgcn_mfma_f32_32x32x16_bf16(b1, qr[d0], p1, 0, 0, 0); }
}
__device__ __forceinline__ int v_st(int k, int c) { const int kk = (k & ~0xC) | ((k & 4) << 1) | ((k & 8) >> 1); return ((kk >> 3) * 4 + (c >> 5)) * 512 + ((kk & 7) * 32 + (c & 31)) * 2; }
__device__ __forceinline__ int v_rd_base(int lane) { return ((lane & 3) << 3) | (((lane >> 2) & 3) << 6) | (((lane >> 4) & 1) << 5) | (((lane >> 5) & 1) << 8); }
constexpr int v_rd_off(int d0, int ks, int half) { return d0 * 512 + ks * 4096 + half * 2048; }
template <int OFF> __device__ __forceinline__ s16x4 tr_read(int vb) {
  s16x4 r; asm volatile("ds_read_b64_tr_b16 %0, %1 offset:%2" : "=&v"(r) : "v"(vb), "i"(OFF) : "memory"); return r;
}
template <int KS> __device__ __forceinline__ void pv_ks(f32x16* o, int vb, bf16x8 pa) {
  const s16x4 l0 = tr_read<v_rd_off(0, KS, 0)>(vb), h0 = tr_read<v_rd_off(0, KS, 1)>(vb), l1 = tr_read<v_rd_off(1, KS, 0)>(vb), h1 = tr_read<v_rd_off(1, KS, 1)>(vb);
  const s16x4 l2 = tr_read<v_rd_off(2, KS, 0)>(vb), h2 = tr_read<v_rd_off(2, KS, 1)>(vb), l3 = tr_read<v_rd_off(3, KS, 0)>(vb), h3 = tr_read<v_rd_off(3, KS, 1)>(vb);
  asm volatile("s_waitcnt lgkmcnt(0)" ::: "memory"); SBAR();
#define PK(L, H) (bf16x8){L[0], L[1], L[2], L[3], H[0], H[1], H[2], H[3]}
  o[0] = __builtin_amdgcn_mfma_f32_32x32x16_bf16(pa, PK(l0, h0), o[0], 0, 0, 0);
  o[1] = __builtin_amdgcn_mfma_f32_32x32x16_bf16(pa, PK(l1, h1), o[1], 0, 0, 0);
  o[2] = __builtin_amdgcn_mfma_f32_32x32x16_bf16(pa, PK(l2, h2), o[2], 0, 0, 0);
  o[3] = __builtin_amdgcn_mfma_f32_32x32x16_bf16(pa, PK(l3, h3), o[3], 0, 0, 0);
#undef PK
}
__device__ __forceinline__ void pv_d0(f32x16* o, int vb, bf16x8 pa0, bf16x8 pa1, bf16x8 pa2, bf16x8 pa3) {
  pv_ks<0>(o, vb, pa0); pv_ks<1>(o, vb, pa1); pv_ks<2>(o, vb, pa2); pv_ks<3>(o, vb, pa3);
}
__device__ __forceinline__ void attn_unit(char* lds, const bf16_t* __restrict__ P, bf16_t* __restrict__ Y, int b, int h, int qb, float lam, const float* __restrict__ gattn, float oscale) {
  int tid_ = threadIdx.x; asm volatile("" : "+v"(tid_));
  const int tid = tid_, wid = tid >> 6, lane = tid & 63, r32 = lane & 31, hi = lane >> 5;
  const unsigned rowb = (unsigned)b * TB, q0 = rowb + (unsigned)qb * 256;
  const int seq = (qb == 0) ? CTXL : TB, NT = seq / 64;
  char* V_lds = lds + OFF_V; char* K_lds = lds + OFF_K;
  float* ws = (float*)(lds + OFF_WS) + wid * 64; float* li_l = ws; float* al_l = ws + 32;
  unsigned* stash = (unsigned*)(lds + OFF_ST) + wid * 2048;
  const int sr = tid >> 4, sc = (tid & 15) * 8, vst0 = v_st(sr, sc), vst1 = v_st(32 + sr, sc);
  const int kr = tid >> 3, kc = (tid & 7) * 8, kst = KSWZ(kr, kc * 2);
  const int vb0 = (int)(uintptr_t)V_lds + v_rd_base(lane);
  const char* Pc = (const char*)P;
  const unsigned voff = ((rowb + sr) * PW + V0c + h * 128 + sc) * 2u;
#pragma unroll 1
  for (int map = 0; map < 2; ++map) {
    const unsigned qoff = ((q0 + wid * 32 + r32) * PW + Q0c + h * 128 + map * 64 + hi * 8) * 2u;
    const unsigned koff = ((rowb + kr) * PW + K0c + h * 128 + map * 64 + kc) * 2u;
    bf16x8 qr[4];
#pragma unroll
    for (int d0 = 0; d0 < 4; ++d0) qr[d0] = *reinterpret_cast<const bf16x8*>(Pc + (qoff + d0 * 32));
    float m_reg = -1e30f, l_reg = 0; f32x16 o[4] = {};
    struct { bf16x8 vs0, vs1, ks; } sr_[1];
#define SLOAD(i, k0) do { const unsigned ko_ = (unsigned)(k0) * (PW * 2u); sr_[i].vs0 = *reinterpret_cast<const bf16x8*>(Pc + (voff + ko_)); sr_[i].vs1 = *reinterpret_cast<const bf16x8*>(Pc + (voff + ko_ + 32u * PW * 2u)); \
    sr_[i].ks = *reinterpret_cast<const bf16x8*>(Pc + (koff + ko_)); } while (0)
#define SWRITE(bf, i) do { *(bf16x8*)(V_lds + (bf) * SHM_V + vst0) = sr_[i].vs0; *(bf16x8*)(V_lds + (bf) * SHM_V + vst1) = sr_[i].vs1; \
    *(bf16x8*)(K_lds + (bf) * SHM_K + kst) = sr_[i].ks; } while (0)
#define SWAIT() asm volatile("s_waitcnt vmcnt(0)" ::: "memory")
#define RESC(a) do { if (__any((a) < 1.f)) { if (hi == 0) al_l[r32] = (a); asm volatile("s_waitcnt lgkmcnt(0)" ::: "memory"); \
    _Pragma("unroll") for (int d = 0; d < 4; ++d) _Pragma("unroll") for (int r = 0; r < 16; ++r) o[d][r] *= al_l[crow(r, hi)]; } } while (0)
    f32x16 pA0, pA1, pB0, pB1; float mnA, mnB, alA, alB; bf16x8 pa0, pa1, pa2, pa3;
    constexpr int SE = 0, SO = 0;
    SLOAD(SE, 0); asm volatile("s_waitcnt vmcnt(0)" ::: "memory"); SWRITE(0, SE); __syncthreads();
    qkt(pA0, pA1, K_lds, qr, r32, hi); partialSM(pA0, pA1, m_reg, mnA, alA);
    SLOAD(SO, 64);
    SWAIT(); SWRITE(1, SO); __syncthreads();
    for (int j = 1; j + 1 < NT; j += 2) {
      SBAR(); qkt(pB0, pB1, K_lds + SHM_K, qr, r32, hi);
      finishSM(pA0, pA1, alA, l_reg, pa0, pa1, pa2, pa3); SBAR();
      SLOAD(SO, (j + 1) * 64); SBAR();
      pv_d0(o, vb0, pa0, pa1, pa2, pa3); partialSM(pB0, pB1, m_reg, mnB, alB);
      __syncthreads(); SWAIT(); SWRITE(0, SE);
      RESC(alB); __syncthreads();
      SBAR(); qkt(pA0, pA1, K_lds, qr, r32, hi);
      finishSM(pB0, pB1, alB, l_reg, pa0, pa1, pa2, pa3); SBAR();
      SLOAD(SE, (j + 2) * 64); SBAR();
      pv_d0(o, vb0 + SHM_V, pa0, pa1, pa2, pa3); partialSM(pA0, pA1, m_reg, mnA, alA);
      __syncthreads(); SWAIT(); SWRITE(1, SO);
      RESC(alA); __syncthreads();
    }
    SBAR(); qkt(pB0, pB1, K_lds + SHM_K, qr, r32, hi);
    finishSM(pA0, pA1, alA, l_reg, pa0, pa1, pa2, pa3); SBAR();
    pv_d0(o, vb0, pa0, pa1, pa2, pa3); partialSM(pB0, pB1, m_reg, mnB, alB);
    __syncthreads(); RESC(alB);
    finishSM(pB0, pB1, alB, l_reg, pa0, pa1, pa2, pa3); SBAR();
    pv_d0(o, vb0 + SHM_V, pa0, pa1, pa2, pa3);
    if (hi == 0) li_l[r32] = l_reg; asm volatile("s_waitcnt lgkmcnt(0)" ::: "memory");
    if (map == 0) {
#pragma unroll
      for (int r = 0; r < 16; ++r) { const float rl = __builtin_amdgcn_rcpf(li_l[crow(r, hi)]);
        stash[(r * 2 + 0) * 64 + lane] = cvtpk(o[0][r] * rl, o[1][r] * rl); stash[(r * 2 + 1) * 64 + lane] = cvtpk(o[2][r] * rl, o[3][r] * rl); SBAR(); }
    } else if (ATT_VAR != 1) {
      char* Yc = (char*)Y; const unsigned yoff = ((q0 + wid * 32) * DM + h * 128 + r32) * 2u;
      float gv[4];
#pragma unroll
      for (int d0 = 0; d0 < 4; ++d0) gv[d0] = gattn[d0 * 32 + r32] * oscale;
      SBAR();
#pragma unroll
      for (int r = 0; r < 16; ++r) { const float rl = lam * __builtin_amdgcn_rcpf(li_l[crow(r, hi)]);
        const unsigned w0 = stash[(r * 2 + 0) * 64 + lane], w1 = stash[(r * 2 + 1) * 64 + lane];
        const float e0 = bflo(w0) - o[0][r] * rl, e1 = bfhi(w0) - o[1][r] * rl, e2 = bflo(w1) - o[2][r] * rl, e3 = bfhi(w1) - o[3][r] * rl;
        float ssq = (e0 * e0 + e1 * e1) + (e2 * e2 + e3 * e3);
        if (ATT_VAR != 3) { ssq += __shfl_xor(ssq, 1); ssq += __shfl_xor(ssq, 2); ssq += __shfl_xor(ssq, 4); ssq += __shfl_xor(ssq, 8); ssq += __shfl_xor(ssq, 16); }
        const float rs = rsqrtf(ssq * (1.f / 128.f) + 1e-6f);
        bf16_t* yr = (bf16_t*)(Yc + (yoff + (unsigned)crow(r, hi) * (DM * 2u)));
        if (ATT_VAR != 4) { yr[0] = f2bf(e0 * rs * gv[0]); yr[32] = f2bf(e1 * rs * gv[1]); yr[64] = f2bf(e2 * rs * gv[2]); yr[96] = f2bf(e3 * rs * gv[3]); } else { yr[0] = f2bf(e0 * rs + e1 + e2 + e3); } SBAR(); }
    }
    __syncthreads();
#undef SLOAD
#undef SWRITE
#undef SWAIT
#undef RESC
  }
}
#undef KSWZ
}
namespace lru {
using att::f32x16; using att::crow;
constexpr int RS = 528;
constexpr int OFF_CL = 0, OFF_YS = 128 * RS, OFF_CY = 2 * 128 * RS;
template <int CTRL, int RMASK> __device__ __forceinline__ float dppf(float oldv, float src) {
  return __int_as_float(__builtin_amdgcn_update_dpp(__float_as_int(oldv), __float_as_int(src), CTRL, RMASK, 0xF, false));
}
template <bool PASS2>
__device__ __forceinline__ void lru_unit(char* lds, const bf16_t* __restrict__ P, bf16_t* __restrict__ Y, int b, int c, const float* __restrict__ convw, const float* __restrict__ convb,
                                         const bf16_t* __restrict__ wrg, const float* __restrict__ ba, const float* __restrict__ bx, const float* __restrict__ c8, float* lrus) {
  int tid_ = threadIdx.x; asm volatile("" : "+v"(tid_));
  const int tid = tid_, wid = tid >> 6, lane = tid & 63, r32 = lane & 31, hi = lane >> 5;
  const unsigned R0 = (unsigned)b * TB + (unsigned)c * 128;
  const int seg_lo = (c < 2) ? 0 : CTXL, seg_hi = (c < 2) ? CTXL : TB;
  const char* Pc = (const char*)P;
  {
    const int ch8 = (tid & 31) * 8, t0 = (tid >> 5) * 8;
    u32x4 xr[11];
#pragma unroll
    for (int i = 0; i < 11; ++i) { const int tt = c * 128 + t0 - 1 + i;
      if (tt >= seg_lo && tt < seg_hi) xr[i] = *(const u32x4*)(Pc + (((unsigned)b * TB + (unsigned)tt) * PW + LX0 + ch8) * 2u); else xr[i] = (u32x4){0u, 0u, 0u, 0u}; }
    float w[4][8], bb[8];
#pragma unroll
    for (int k = 0; k < 4; ++k) { const f32x4 a = *(const f32x4*)(convw + k * 256 + ch8), d = *(const f32x4*)(convw + k * 256 + ch8 + 4);
      w[k][0] = a.x; w[k][1] = a.y; w[k][2] = a.z; w[k][3] = a.w; w[k][4] = d.x; w[k][5] = d.y; w[k][6] = d.z; w[k][7] = d.w; }
    { const f32x4 a = *(const f32x4*)(convb + ch8), d = *(const f32x4*)(convb + ch8 + 4); bb[0] = a.x; bb[1] = a.y; bb[2] = a.z; bb[3] = a.w; bb[4] = d.x; bb[5] = d.y; bb[6] = d.z; bb[7] = d.w; }
#pragma unroll
    for (int i = 0; i < 8; ++i) { float acc[8];
#pragma unroll
      for (int e = 0; e < 8; ++e) acc[e] = bb[e];
#pragma unroll
      for (int k = 0; k < 4; ++k) { const u32x4 xv = xr[i + k];
        acc[0] += bflo(xv.x) * w[k][0]; acc[1] += bfhi(xv.x) * w[k][1]; acc[2] += bflo(xv.y) * w[k][2]; acc[3] += bfhi(xv.y) * w[k][3];
        acc[4] += bflo(xv.z) * w[k][4]; acc[5] += bfhi(xv.z) * w[k][5]; acc[6] += bflo(xv.w) * w[k][6]; acc[7] += bfhi(xv.w) * w[k][7]; }
      u32x4 o; o.x = cvtpk(acc[0], acc[1]); o.y = cvtpk(acc[2], acc[3]); o.z = cvtpk(acc[4], acc[5]); o.w = cvtpk(acc[6], acc[7]);
      *(u32x4*)(lds + OFF_CL + (t0 + i) * RS + ch8 * 2) = o; }
  }
  if (PASS2) {
    const int d = tid >> 8, ch = tid & 255;
    const int np = d ? (c < 2 ? 1 - c : NCHUNK + 1 - c) : c;
    float cy = 0.f;
    const float* sb = lrus + ((size_t)b * NCHUNK * 4 + (size_t)d * 2) * 256 + ch;
    if (np > 0) { float A[NCHUNK], H[NCHUNK];
#pragma unroll
      for (int i = 0; i < NCHUNK; ++i) { int p = i < np ? i : np - 1;
        const int u = d ? (c < 2 ? 1 - p : (p == 0 ? 1 : (p == 1 ? 0 : NCHUNK + 1 - p))) : p;
        A[i] = sb[(size_t)u * 1024]; H[i] = sb[(size_t)u * 1024 + 256]; }
#pragma unroll
      for (int i = 0; i < NCHUNK; ++i) if (i < np) cy = A[i] * cy + H[i];
    }
    ((float*)(lds + OFF_CY))[tid] = cy;
  }
  __syncthreads();
  const int hh = wid >> 1, jh = wid & 1, chb = hh * 64 + jh * 32;
#pragma unroll 1
  for (int d = 0; d < 2; ++d) {
    const bf16_t* wa = wrg + ((0 * 2 + d) * 4 + hh) * 4096 + (jh * 32 + r32) * 64 + hi * 8;
    const bf16_t* wx = wrg + ((1 * 2 + d) * 4 + hh) * 4096 + (jh * 32 + r32) * 64 + hi * 8;
    bf16x8 fa[4], fx[4];
#pragma unroll
    for (int k = 0; k < 4; ++k) { fa[k] = *reinterpret_cast<const bf16x8*>(wa + k * 16); fx[k] = *reinterpret_cast<const bf16x8*>(wx + k * 16); }
    float carry[16], Pc_[16], bav[16], bxv[16], c8v[16];
#pragma unroll
    for (int q = 0; q < 4; ++q) { const int co = d * 256 + chb + 8 * q + 4 * hi;
      const f32x4 b4 = *(const f32x4*)(ba + co), x4 = *(const f32x4*)(bx + co), c4 = *(const f32x4*)(c8 + co);
      bav[4 * q] = b4.x; bav[4 * q + 1] = b4.y; bav[4 * q + 2] = b4.z; bav[4 * q + 3] = b4.w; bxv[4 * q] = x4.x; bxv[4 * q + 1] = x4.y; bxv[4 * q + 2] = x4.z; bxv[4 * q + 3] = x4.w;
      c8v[4 * q] = c4.x; c8v[4 * q + 1] = c4.y; c8v[4 * q + 2] = c4.z; c8v[4 * q + 3] = c4.w; }
#pragma unroll
    for (int r = 0; r < 16; ++r) { carry[r] = 0.f; Pc_[r] = 1.f; }
    if (PASS2) { const float* cyp = (const float*)(lds + OFF_CY) + d * 256 + chb + 4 * hi;
#pragma unroll
      for (int q = 0; q < 4; ++q) { const f32x4 v = *(const f32x4*)(cyp + 8 * q); carry[4 * q] = v.x; carry[4 * q + 1] = v.y; carry[4 * q + 2] = v.z; carry[4 * q + 3] = v.w; } }
    const int tokl = d ? 31 - r32 : r32;
#pragma unroll 1
    for (int ti = 0; ti < 4; ++ti) {
      const int tt = d ? 3 - ti : ti;
      char* rowp = lds + OFF_CL + (tt * 32 + tokl) * RS;
      f32x16 za = {}, zx = {};
#pragma unroll
      for (int k = 0; k < 4; ++k) { const bf16x8 xb = *reinterpret_cast<const bf16x8*>(rowp + (hh * 64 + k * 16 + hi * 8) * 2);
        za = __builtin_amdgcn_mfma_f32_32x32x16_bf16(fa[k], xb, za, 0, 0, 0); zx = __builtin_amdgcn_mfma_f32_32x32x16_bf16(fx[k], xb, zx, 0, 0, 0); }
      float av[16], bv[16];
#pragma unroll
      for (int q = 0; q < 4; ++q) { const u32x2 cw = *(const u32x2*)(rowp + (chb + 8 * q + 4 * hi) * 2);
        const float clv[4] = {bflo(cw.x), bfhi(cw.x), bflo(cw.y), bfhi(cw.y)};
#pragma unroll
        for (int i = 0; i < 4; ++i) { const int r = 4 * q + i;
          const float rg = sigm(za[r] + bav[r]), ig = sigm(zx[r] + bxv[r]);
          const float a = fexp(-c8v[r] * rg);
          av[r] = a; bv[r] = __builtin_amdgcn_sqrtf(fmaxf(1.f - a * a, 0.f)) * ig * clv[i]; } }
#define LRU_SCAN(CTRL, RM) _Pragma("unroll") for (int r = 0; r < 16; ++r) { const float ap = dppf<CTRL, RM>(1.f, av[r]), bp = dppf<CTRL, RM>(0.f, bv[r]); bv[r] = av[r] * bp + bv[r]; av[r] = av[r] * ap; }
      LRU_SCAN(0x111, 0xF) LRU_SCAN(0x112, 0xF) LRU_SCAN(0x114, 0xF) LRU_SCAN(0x118, 0xF) LRU_SCAN(0x142, 0xA)
#undef LRU_SCAN
#pragma unroll
      for (int q = 0; q < 4; ++q) { float hv[4];
#pragma unroll
        for (int i = 0; i < 4; ++i) { const int r = 4 * q + i; hv[i] = bv[r] + av[r] * carry[r];
          carry[r] = __shfl(hv[i], 31, 32);
          if (!PASS2) Pc_[r] *= __shfl(av[r], 31, 32); }
        if (PASS2) { u32x2* yp = (u32x2*)(lds + OFF_YS + (tt * 32 + tokl) * RS + (chb + 8 * q + 4 * hi) * 2);
          if (d) { const u32x2 o = *yp; hv[0] += bflo(o.x); hv[1] += bfhi(o.x); hv[2] += bflo(o.y); hv[3] += bfhi(o.y); }
          u32x2 w; w.x = cvtpk(hv[0], hv[1]); w.y = cvtpk(hv[2], hv[3]); *yp = w; } }
    }
    if (!PASS2) { if (r32 == 0) { float* sb = lrus + ((((size_t)b * NCHUNK + c) * 2 + d) * 2) * 256 + chb + 4 * hi;
#pragma unroll
        for (int q = 0; q < 4; ++q) { *(f32x4*)(sb + 8 * q) = (f32x4){Pc_[4 * q], Pc_[4 * q + 1], Pc_[4 * q + 2], Pc_[4 * q + 3]};
          *(f32x4*)(sb + 256 + 8 * q) = (f32x4){carry[4 * q], carry[4 * q + 1], carry[4 * q + 2], carry[4 * q + 3]}; } } }
  }
  if (PASS2) {
    __syncthreads();
    const int ch8 = (tid & 31) * 8;
#pragma unroll
    for (int i = 0; i < 8; ++i) { const int t = (tid >> 5) + 16 * i;
      const u32x4 hv = *(const u32x4*)(lds + OFF_YS + t * RS + ch8 * 2), gv = *(const u32x4*)(Pc + ((R0 + t) * PW + LG0 + ch8) * 2u);
      u32x4 o; o.x = cvtpk(bflo(hv.x) * bflo(gv.x), bfhi(hv.x) * bfhi(gv.x)); o.y = cvtpk(bflo(hv.y) * bflo(gv.y), bfhi(hv.y) * bfhi(gv.y));
      o.z = cvtpk(bflo(hv.z) * bflo(gv.z), bfhi(hv.z) * bfhi(gv.z)); o.w = cvtpk(bflo(hv.w) * bflo(gv.w), bfhi(hv.w) * bfhi(gv.w));
      *(u32x4*)((char*)Y + ((R0 + t) * DM + 512 + ch8) * 2u) = o; }
  }
  __syncthreads();
}
}

namespace sgu {
using att::f32x16; using att::crow;
constexpr int VS = 272;
__device__ __forceinline__ void sgu_unit(char* lds, const bf16_t* __restrict__ P, bf16_t* __restrict__ Y, int b, int c, const bf16_t* __restrict__ wsp, const float* __restrict__ gsgu, const float* __restrict__ bsp) {
  int tid_ = threadIdx.x; asm volatile("" : "+v"(tid_));
  const int tid = tid_, wid = tid >> 6, lane = tid & 63, r32 = lane & 31, hi = lane >> 5;
  const unsigned R0 = (unsigned)b * TB + (unsigned)c * 128;
  const char* Pc = (const char*)P;
  const int gg = wid >> 1, chalf = wid & 1, cc = gg * 64 + chalf * 32 + r32;
  bf16x8 Af[4][8];
  u32x4 xv[8];
  { const int q = tid & 127, g = tid >> 7;
    const char* vp = Pc + ((R0 + q) * PW + SV0 + g * 64) * 2u;
#pragma unroll
    for (int i = 0; i < 8; ++i) xv[i] = *(const u32x4*)(vp + i * 16); }
#pragma unroll
  for (int pt = 0; pt < 4; ++pt) { const bf16_t* ap = wsp + (gg * 128 + pt * 32 + r32) * 128 + hi * 8;
#pragma unroll
    for (int k = 0; k < 8; ++k) Af[pt][k] = *reinterpret_cast<const bf16x8*>(ap + k * 16); }
  { const int q = tid & 127, g = tid >> 7; float ss = 0.f;
#pragma unroll
    for (int i = 0; i < 8; ++i) {
      const float a0 = bflo(xv[i].x), a1 = bfhi(xv[i].x), a2 = bflo(xv[i].y), a3 = bfhi(xv[i].y), a4 = bflo(xv[i].z), a5 = bfhi(xv[i].z), a6 = bflo(xv[i].w), a7 = bfhi(xv[i].w);
      ss += (a0 * a0 + a1 * a1) + (a2 * a2 + a3 * a3) + (a4 * a4 + a5 * a5) + (a6 * a6 + a7 * a7); }
    const float rs = rsqrtf(ss * (1.f / 64.f) + 1e-6f);
    char* dst = lds + (g * 64) * VS + q * 2;
#pragma unroll
    for (int i = 0; i < 8; ++i) { const float* gp = gsgu + g * 64 + i * 8; const f32x4 g0 = *(const f32x4*)gp, g1 = *(const f32x4*)(gp + 4);
      *(bf16_t*)(dst + (i * 8 + 0) * VS) = f2bf(bflo(xv[i].x) * rs * g0.x); *(bf16_t*)(dst + (i * 8 + 1) * VS) = f2bf(bfhi(xv[i].x) * rs * g0.y);
      *(bf16_t*)(dst + (i * 8 + 2) * VS) = f2bf(bflo(xv[i].y) * rs * g0.z); *(bf16_t*)(dst + (i * 8 + 3) * VS) = f2bf(bfhi(xv[i].y) * rs * g0.w);
      *(bf16_t*)(dst + (i * 8 + 4) * VS) = f2bf(bflo(xv[i].z) * rs * g1.x); *(bf16_t*)(dst + (i * 8 + 5) * VS) = f2bf(bfhi(xv[i].z) * rs * g1.y);
      *(bf16_t*)(dst + (i * 8 + 6) * VS) = f2bf(bflo(xv[i].w) * rs * g1.z); *(bf16_t*)(dst + (i * 8 + 7) * VS) = f2bf(bfhi(xv[i].w) * rs * g1.w); }
  }
  __syncthreads();
  { bf16x8 vb[8];
#pragma unroll
    for (int k = 0; k < 8; ++k) vb[k] = *reinterpret_cast<const bf16x8*>(lds + cc * VS + (k * 16 + hi * 8) * 2);
    unsigned short uu[2][16]; f32x4 bsv[2][4];
#define SGU_LD(pt_, s_) do { _Pragma("unroll") for (int r = 0; r < 16; ++r) uu[s_][r] = *(const unsigned short*)(Pc + ((R0 + (pt_) * 32 + crow(r, hi)) * PW + SU0 + cc) * 2u); \
      _Pragma("unroll") for (int q4 = 0; q4 < 4; ++q4) bsv[s_][q4] = *(const f32x4*)(bsp + gg * 128 + (pt_) * 32 + 8 * q4 + 4 * hi); } while (0)
    SGU_LD(0, 0);
#pragma unroll
    for (int pt = 0; pt < 4; ++pt) { f32x16 acc = {};
      if (pt + 1 < 4) SGU_LD(pt + 1, (pt + 1) & 1);
#pragma unroll
      for (int k = 0; k < 8; ++k) acc = __builtin_amdgcn_mfma_f32_32x32x16_bf16(Af[pt][k], vb[k], acc, 0, 0, 0);
#pragma unroll
      for (int r = 0; r < 16; ++r) { const int p = pt * 32 + crow(r, hi); const float m = acc[r] + bsv[pt & 1][r >> 2][r & 3];
        *(bf16_t*)((char*)Y + ((R0 + p) * DM + 768 + cc) * 2u) = f2bf(bf2f(uu[pt & 1][r]) * m); } }
#undef SGU_LD
  }
  __syncthreads();
}
}
__device__ __forceinline__ unsigned pk2(float lo, float hi) { return cvtpk(lo, hi); }
__device__ __forceinline__ void transpose_item(const float* __restrict__ W, int K, int N, bf16_t* __restrict__ WT, int row_base, LAS float* scr, int kb, int nb, int lane) {
    const int k0 = 64 * kb, n0 = 32 * nb;
#pragma unroll 8
    for (int i = 0; i < 32; ++i) { const int kk = 2 * i + (lane >> 5); scr[kk * 33 + (lane & 31)] = W[(size_t)(k0 + kk) * N + n0 + (lane & 31)]; }
    asm volatile("s_waitcnt lgkmcnt(0)" ::: "memory");
    const int c = lane & 7;
#pragma unroll
    for (int j = 0; j < 4; ++j) { const int n = (lane >> 3) + 8 * j; const LAS float* s = scr + (8 * c) * 33 + n;
        u32x4 o; o.x = pk2(s[0 * 33], s[1 * 33]); o.y = pk2(s[2 * 33], s[3 * 33]); o.z = pk2(s[4 * 33], s[5 * 33]); o.w = pk2(s[6 * 33], s[7 * 33]);
        *(u32x4*)(WT + (size_t)(row_base + n) * K + k0 + 8 * c) = o; }
    asm volatile("s_waitcnt lgkmcnt(0)" ::: "memory");
}
__device__ __forceinline__ void gemv_item(const LAS float* a_lds, LAS float* red, const float* __restrict__ W, int N, int n0, float* __restrict__ out, int ldo, int obase, const float* __restrict__ bias) {
    const int tid = threadIdx.x, wid = tid >> 6, lane = tid & 63, c4 = (lane & 15) * 4, ks = lane >> 4;
    f32x4 acc[NMS];
#pragma unroll
    for (int ms = 0; ms < NMS; ++ms) acc[ms] = (f32x4){0.f, 0.f, 0.f, 0.f};
    const float* wp = W + (size_t)(wid * 128 + ks) * N + n0 + c4;
#pragma unroll 8
    for (int st = 0; st < 32; ++st) { const f32x4 wv = *(const f32x4*)(wp + (size_t)st * 4 * N); const int k = wid * 128 + st * 4 + ks;
#pragma unroll
        for (int ms = 0; ms < NMS; ++ms) acc[ms] += wv * a_lds[ms * 1024 + k]; }
#pragma unroll
    for (int ms = 0; ms < NMS; ++ms) {
        f32x4 v = acc[ms];
        v.x += __shfl_xor(v.x, 16); v.y += __shfl_xor(v.y, 16); v.z += __shfl_xor(v.z, 16); v.w += __shfl_xor(v.w, 16);
        v.x += __shfl_xor(v.x, 32); v.y += __shfl_xor(v.y, 32); v.z += __shfl_xor(v.z, 32); v.w += __shfl_xor(v.w, 32);
        if (ks == 0) { LAS float* rp = red + (wid * NMS + ms) * 64 + c4; rp[0] = v.x; rp[1] = v.y; rp[2] = v.z; rp[3] = v.w; }
    }
    __syncthreads();
    for (int i = tid; i < NMS * 64; i += 512) { const int ms = i >> 6, c = i & 63; float s = 0.f;
#pragma unroll
        for (int w = 0; w < 8; ++w) s += red[(w * NMS + ms) * 64 + c];
        if (bias) s += bias[n0 + c];
        out[(size_t)ms * ldo + obase + c] = s; }
    __syncthreads();
}
__device__ __forceinline__ float wave_sum(float v) {
#pragma unroll
    for (int o = 1; o < 64; o <<= 1) v += __shfl_xor(v, o);
    return v;
}

#define XB_TMO      128
#define XB_XCNT(j)  (256  + 64 * (j))
#define XB_XSUB(j)  (1280 + 64 * (j))
#define XB_XGEN(j)  (2304 + 64 * (j))
#define XB_TOP      3328
#define XB_TOPGEN   3392
#define XCD_BAR_WORDS 3456
#define XB_SPIN_CAP (1u << 18)

__device__ __forceinline__ unsigned xb_ld(unsigned* p)              { return __hip_atomic_load(p, __ATOMIC_RELAXED, __HIP_MEMORY_SCOPE_AGENT); }
__device__ __forceinline__ unsigned xb_add(unsigned* p, unsigned v) { return __hip_atomic_fetch_add(p, v, __ATOMIC_RELAXED, __HIP_MEMORY_SCOPE_AGENT); }
__device__ __forceinline__ unsigned xb_xcc_id() { return (unsigned)__builtin_amdgcn_s_getreg((3 << 11) | 20) & 0xFu; }
#define XB_SPIN(cond, bar) do { unsigned _sp = 0; while (cond) { __builtin_amdgcn_s_sleep(1); \
    if ((++_sp & 255u) == 0u) { if (xb_ld(&(bar)[XB_TMO])) break; if (_sp > XB_SPIN_CAP) { atomicAdd(&(bar)[XB_TMO], 1u); break; } } } } while (0)

struct XcdBarrier {
    unsigned* bar; unsigned x;
    volatile LAS unsigned* st;
};

__device__ __forceinline__ XcdBarrier xcd_barrier_post(unsigned* bar, volatile LAS unsigned* st) {
    XcdBarrier b; b.bar = bar; b.x = xb_xcc_id(); b.st = st;
    if (threadIdx.x == 0) (void)xb_add(&bar[XB_XCNT(b.x)], 1u);
    return b;
}
__device__ __forceinline__ void xcd_barrier_complete(unsigned* bar, unsigned x, unsigned& nloc, unsigned& nx) {
    const unsigned G = gridDim.x * gridDim.y * gridDim.z;
    unsigned sum, cnt, mine, sp = 0u;
    for (;;) {
        sum = 0u; cnt = 0u; mine = 0u;
#pragma unroll
        for (unsigned j = 0; j < 16; ++j) { const unsigned c = xb_ld(&bar[XB_XCNT(j)]); sum += c; cnt += (c > 0u) ? 1u : 0u; mine = (j == x) ? c : mine; }
        if (sum == G) break;
        __builtin_amdgcn_s_sleep(1);
        if ((++sp & 255u) == 0u) { if (xb_ld(&bar[XB_TMO])) break; if (sp > XB_SPIN_CAP) { atomicAdd(&bar[XB_TMO], 1u); break; } }
    }
    nloc = mine > 0u ? mine : 1u; nx = cnt > 0u ? cnt : 1u;
}

__device__ __forceinline__ void xcd_barrier(const XcdBarrier& b) {
    asm volatile("s_waitcnt vmcnt(0)" ::: "memory");
    __syncthreads();
    if (threadIdx.x == 0) {
        unsigned* bar = b.bar;
        __builtin_amdgcn_s_waitcnt(0);
        unsigned nloc = b.st[0], nx = b.st[1];
        if (nloc == 0u) { xcd_barrier_complete(bar, b.x, nloc, nx); b.st[0] = nloc; b.st[1] = nx; }
        const unsigned old = xb_add(&bar[XB_XSUB(b.x)], 1u);
        const unsigned gen = old / nloc;
        if (old + 1u == (gen + 1u) * nloc) {
            __builtin_amdgcn_fence(__ATOMIC_RELEASE, "agent");
            asm volatile("s_waitcnt vmcnt(0)" ::: "memory");
            const unsigned og = xb_add(&bar[XB_TOP], 1u);
            const unsigned tg = og / nx;
            if (og + 1u == (tg + 1u) * nx) xb_add(&bar[XB_TOPGEN], 1u);
            else XB_SPIN(xb_ld(&bar[XB_TOPGEN]) == tg, bar);
            __builtin_amdgcn_fence(__ATOMIC_ACQUIRE, "agent");
            xb_add(&bar[XB_XGEN(b.x)], 1u);
            asm volatile("s_waitcnt vmcnt(0)" ::: "memory");
        } else {
            XB_SPIN(xb_ld(&bar[XB_XGEN(b.x)]) == gen, bar);
            __builtin_amdgcn_fence(__ATOMIC_ACQUIRE, "agent");
            asm volatile("s_waitcnt vmcnt(0)" ::: "memory");
        }
    }
    __syncthreads();
}
typedef __attribute__((address_space(1))) unsigned char g_u8;
__device__ __forceinline__ unsigned char* lau(unsigned char* p) { asm volatile("" : "+s"(p)); return (unsigned char*)(g_u8*)p; }
constexpr int NPHASE = 15;
constexpr int LDS_BYTES = 147456;
struct Args { const float* in[27]; float* out; unsigned char* ws; int ph_lo, ph_hi; };
__global__ void __launch_bounds__(512, 2) hybrid_fwd(Args args) {
    extern __shared__ __attribute__((aligned(16))) unsigned char lds_raw[];
    char* lds = (char*)lds_raw;
    LAS unsigned char* ldsl = (LAS unsigned char*)lds_raw;
    const int tid = threadIdx.x, wave = __builtin_amdgcn_readfirstlane(tid >> 6);
#define LANE_LOCAL int lane_ = threadIdx.x; asm volatile("" : "+v"(lane_)); const int lane = lane_ & 63;
    const int G = gridDim.x, bx = blockIdx.x, vcu = (G % 8 == 0) ? (bx % 8) * (G / 8) + bx / 8 : bx;
    unsigned char* ws = args.ws;
    const float* const* in = args.in;
#define mods ((float*)(ws + WS_MODS))
#define shwin ((float*)(ws + WS_SHWIN))
#define shwf ((float*)(ws + WS_SHWF))
#define ropeC ((float*)(ws + WS_ROPE))
#define ropeS ((float*)(ws + WS_ROPE + 4096))
#define c8 ((float*)(ws + WS_C8))
#define lamv ((float*)(ws + WS_LAM))
#define rowss ((float*)(ws + WS_ROWSS))
#define lrus ((float*)(ws + WS_LRUS))
#define xc ((float*)(ws + WS_XC))
#define AP ((bf16_t*)(ws + WS_AP))
#define Pb ((bf16_t*)(ws + WS_P))
#define Yb ((bf16_t*)(ws + WS_Y))
#define HM ((bf16_t*)(ws + WS_HMID))
#define WSP ((bf16_t*)(ws + WS_WSP))
#define WRG ((bf16_t*)(ws + WS_WRG))
    const int lo = args.ph_lo, hi_ = args.ph_hi;
    volatile LAS unsigned* MISC = (volatile LAS unsigned*)(ldsl + LDS_BYTES - 64);
    if (tid < 16) MISC[tid] = 0u;
    __syncthreads();
    XcdBarrier bar; bar.bar = (unsigned*)(ws + WS_CTL); bar.x = 0; bar.st = nullptr;
    if (hi_ - lo > 1) bar = xcd_barrier_post((unsigned*)(ws + WS_CTL), MISC);
#define IN(k) (lo <= (k) && (k) < hi_)
#define SEAM(k) do { if (IN(k) && IN((k) + 1)) { if ((k) == 0) cg::this_grid().sync(); else xcd_barrier(bar); } } while (0)

    if (EN(0) && IN(0)) {
        { LANE_LOCAL LAS float* scr = (LAS float*)(ldsl + wave * 16384);
          const int gw = vcu * 8 + wave, NGW = G * 8;
          constexpr int I_IN = 16 * 80, I_OUT = 16 * 32, I_G = 16 * 88, I_D = 44 * 32, I_L = I_IN + I_OUT + 2 * I_G + I_D;
          for (int it = gw; it < NLAYER * I_L; it += NGW) {
              const int l = it / I_L; int r = it - l * I_L;
              if (r < I_IN) { transpose_item(in[8] + (size_t)l * DM * PW, DM, PW, (bf16_t*)(ws + WS_WIN + l * SZ_WIN), 32 * (r % 80), scr, r / 80, r % 80, lane); continue; } r -= I_IN;
              if (r < I_OUT) { transpose_item(in[22] + (size_t)l * DM * DM, DM, DM, (bf16_t*)(ws + WS_WOUT + l * SZ_WOUT), 32 * (r % 32), scr, r / 32, r % 32, lane); continue; } r -= I_OUT;
              if (r < 2 * I_G) { const int up = r >= I_G; if (up) r -= I_G; const int nb = r % 88, n0 = 32 * nb;
                  transpose_item(in[up ? 24 : 23] + (size_t)l * DM * FH, DM, FH, (bf16_t*)(ws + WS_WFFN + l * SZ_WFFN), (n0 / 128) * 256 + (n0 % 128) + (up ? 128 : 0), scr, r / 88, nb, lane); continue; } r -= 2 * I_G;
              transpose_item(in[25] + (size_t)l * FH * DM, FH, DM, (bf16_t*)(ws + WS_WDN + l * SZ_WDN), 32 * (r % 32), scr, r / 32, r % 32, lane);
          }
        }
        { const int gt = vcu * 512 + tid, NT = G * 512;
          for (int i = gt; i < 131072; i += NT) WSP[i] = f2bf(in[20][i]);
          for (int i = gt; i < 131072; i += NT) { const int ii = i & 63, j = (i >> 6) & 63, h = (i >> 12) & 3, d = (i >> 14) & 1, mat = (i >> 15) & 1, l = i >> 16;
              WRG[i] = f2bf(in[mat ? 16 : 14][((((size_t)l * 2 + d) * 4 + h) * 64 + ii) * 64 + j]); }
          if (gt < 1024) { const int pos = gt >> 4, j = gt & 15; const float inv = powf(10000.f, -(float)j / 16.f); const float ang = (float)pos * inv; ropeC[gt] = cosf(ang); ropeS[gt] = sinf(ang);
              const float lv = in[18][gt]; c8[gt] = 8.f * log1pf(expf(-lv)); }
          if (gt < NLAYER) { float s0 = 0.f, s1 = 0.f; for (int k = 0; k < 64; ++k) { s0 += in[9][(gt * 2 + 0) * 64 + k] * in[10][(gt * 2 + 0) * 64 + k]; s1 += in[9][(gt * 2 + 1) * 64 + k] * in[10][(gt * 2 + 1) * 64 + k]; }
              lamv[gt] = expf(s0) - expf(s1) + (0.8f - 0.6f * expf(-0.3f * (float)gt)); }
        }
        __syncthreads();
        { LAS float* a_lds = (LAS float*)ldsl; LAS float* red = (LAS float*)(ldsl + 36864);
          for (int i = tid; i < NMS * 1024; i += 512) { const int ms = i >> 10, k = i & 1023; const float v = (ms < 8) ? in[1][ms * 1024 + k] : in[3][k]; a_lds[i] = silu_f(v); }
          __syncthreads();
          for (int it = vcu; it < NLAYER * 96; it += G) { const int l = it / 96, n0 = (it % 96) * 64;
              gemv_item(a_lds, red, in[4] + (size_t)l * DM * NMOD, NMOD, n0, mods + (size_t)l * NMS * NMOD, NMOD, n0, in[5] + (size_t)l * NMOD); }
        }
    }
    SEAM(0);
    if (EN(1) && IN(1)) {
        { LAS float* a_lds = (LAS float*)ldsl; LAS float* red = (LAS float*)(ldsl + 36864);
          for (int it = vcu; it < NLAYER * 128; it += G) { const int l = it / 128, r = it % 128; const int soff = (r < 40) ? 0 : 3 * DM;
              __syncthreads();
              for (int i = tid; i < NMS * 1024; i += 512) a_lds[i] = mods[((size_t)l * NMS + (i >> 10)) * NMOD + soff + (i & 1023)];
              __syncthreads();
              if (r < 40) gemv_item(a_lds, red, in[8] + (size_t)l * DM * PW, PW, r * 64, shwin + (size_t)l * NMS * PW, PW, r * 64, nullptr);
              else { const int up = r >= 84, nb = (r - 40) % 44, n0 = nb * 64;
                  gemv_item(a_lds, red, in[up ? 24 : 23] + (size_t)l * DM * FH, FH, n0, shwf + (size_t)l * NMS * NF, NF, (n0 / 128) * 256 + (n0 % 128) + (up ? 128 : 0), nullptr); } }
        }
        { LANE_LOCAL const int gw = vcu * 8 + wave, NGW = G * 8;
          for (int m = gw; m < MROWS; m += NGW) { const int b = m / TB, t = m - b * TB; const bool ctx = t < CTXL; const int ms = ctx ? 8 : b;
              const float* xr = ctx ? in[2] + ((size_t)b * CTXL + t) * DM : in[0] + ((size_t)b * SEQ + (t - CTXL)) * DM;
              f32x4 v[4]; float s = 0.f;
#pragma unroll
              for (int j = 0; j < 4; ++j) { v[j] = ((const f32x4*)xr)[lane + 64 * j]; s += (v[j].x * v[j].x + v[j].y * v[j].y) + (v[j].z * v[j].z + v[j].w * v[j].w); }
              s = wave_sum(s);
#pragma unroll
              for (int j = 0; j < 4; ++j) { const int col = 4 * lane + 256 * j; const f32x4 g = *(const f32x4*)(in[6] + col), sc = *(const f32x4*)(mods + (size_t)ms * NMOD + DM + col);
                  const f32x4 a = v[j] * g * (sc + 1.f); u32x2 w; w.x = cvtpk(a.x, a.y); w.y = cvtpk(a.z, a.w); *(u32x2*)(AP + (size_t)m * DM + col) = w; }
              if (lane < 16) rowss[(size_t)m * 16 + lane] = (lane == 0) ? s : 0.f; }
        }
    }
    SEAM(1);
#pragma unroll 1
    for (int l = 0; l < NLAYER; ++l) {
        const int pb = 2 + 6 * l; const bool last = (l == NLAYER - 1);
        const float* modl = mods + (size_t)l * NMS * NMOD;
        if (EN(2) && IN(pb)) {
            pg8::Gemm g{AP, (const bf16_t*)(ws + WS_WIN + l * SZ_WIN), MROWS, PW, DM}; pg8::Order S; S.init(MROWS / 256, PW, G, bx, 0);
            EpiInProj E{Pb, rowss, shwin + (size_t)l * NMS * PW, ropeC, ropeS};
            pg8::gemm_phase<EpiInProj, pg8::Order, true, true>(ldsl, g, S, E);
        }
        SEAM(pb);
        if (IN(pb + 1)) {
            if (EN(3)) for (int u = vcu; u < NB * NCHUNK; u += G)
                lru::lru_unit<false>(lds, Pb, Yb, u / NCHUNK, u % NCHUNK, in[12] + l * 1024, in[13] + l * 256, WRG + (size_t)l * 65536, in[15] + l * 512, in[17] + l * 512, c8 + l * 512, lrus);
            if (EN(4)) for (int u = G - 1 - vcu; u < NB * NCHUNK; u += G) { const int c = u % NCHUNK; if (last && c < 2) continue;
                sgu::sgu_unit(lds, Pb, Yb, u / NCHUNK, c, WSP + (size_t)l * 65536, in[19] + l * 256, in[21] + l * 512); }
            const float lam = lamv[l], li = 0.8f - 0.6f * __expf(-0.3f * (float)l);
            if (EN(5)) { const int nu = last ? NB * 4 * 16 : NB * 4 * 17;
#pragma unroll 1
                for (int rep_ = 0; rep_ < PROBE_ATTREP; ++rep_)
                for (int u = vcu; u < nu; u += G) { int bh, qb; if (u < NB * 4 * 16) { bh = u >> 4; qb = (u & 15) + 1; } else { bh = u - NB * 4 * 16; qb = 0; }
                    att::attn_unit(lds, Pb, Yb, bh >> 2, bh & 3, qb, lam, in[11] + l * 128, 1.f - li); } }
        }
        SEAM(pb + 1);
        if (EN(6) && IN(pb + 2)) {
            const int nu2 = last ? NB * 32 : NB * NCHUNK;
            for (int u = vcu; u < nu2; u += G) { const int b_ = last ? (u >> 5) : u / NCHUNK, c = last ? 2 + (u & 31) : u % NCHUNK;
                lru::lru_unit<true>(lds, Pb, Yb, b_, c, in[12] + l * 1024, in[13] + l * 256, WRG + (size_t)l * 65536, in[15] + l * 512, in[17] + l * 512, c8 + l * 512, lrus); }
        }
        SEAM(pb + 2);
        if (EN(7) && IN(pb + 3)) {
            pg8::Gemm g{Yb, (const bf16_t*)(ws + WS_WOUT + l * SZ_WOUT), MROWS, DM, DM}; pg8::Order S; S.init(last ? 128 : 136, DM, G, bx, last ? 1 : 0);
            EpiRes E{in[0], in[2], args.out, 1, modl + 2 * DM, in[6] + l * DM, modl + DM, in[7] + l * DM, modl + 4 * DM, AP, rowss, 1, 0};
            pg8::gemm_phase<EpiRes, pg8::Order, true, true>(ldsl, g, S, E);
        }
        SEAM(pb + 3);
        if (EN(8) && IN(pb + 4)) {
            pg8::Gemm g{AP, (const bf16_t*)(ws + WS_WFFN + l * SZ_WFFN), MROWS, NF, DM}; pg8::Order S; S.init(last ? 128 : 136, NF, G, bx, last ? 1 : 0);
            EpiSwiGLU E{HM, rowss, shwf + (size_t)l * NMS * NF};
            pg8::gemm_phase<EpiSwiGLU, pg8::Order, true, true>(ldsl, g, S, E);
        }
        SEAM(pb + 4);
        if (EN(9) && IN(pb + 5)) {
            pg8::Gemm g{HM, (const bf16_t*)(ws + WS_WDN + l * SZ_WDN), MROWS, DM, FH}; pg8::Order S; S.init(last ? 128 : 136, DM, G, bx, last ? 1 : 0);
            const int ln = last ? l : l + 1;
            EpiRes E{in[0], in[2], args.out, 1, modl + 5 * DM, in[7] + l * DM, modl + 4 * DM, in[6] + ln * DM, mods + (size_t)ln * NMS * NMOD + DM, AP, rowss, last ? 0 : 1, last ? 1 : 0};
            pg8::gemm_phase<EpiRes, pg8::Order, true, true>(ldsl, g, S, E);
        }
        SEAM(pb + 5);
    }
    if (EN(10) && IN(14)) {
        LANE_LOCAL const int gw = vcu * 8 + wave, NGW = G * 8;
        for (int m = gw; m < NB * SEQ; m += NGW) { const int b = m / SEQ, t = m - b * SEQ; const size_t row = (size_t)b * TB + CTXL + t;
            const float rstd = row_rstd(rowss, row); f32x4* xr = (f32x4*)(args.out + (size_t)m * DM);
            u32x2 w[4];
#pragma unroll
            for (int j = 0; j < 4; ++j) w[j] = ((const u32x2*)xr)[lane + 64 * j];
            asm volatile("s_waitcnt vmcnt(0)" ::: "memory");
#pragma unroll
            for (int j = 0; j < 4; ++j) { const f32x4 g = *(const f32x4*)(in[26] + 4 * lane + 256 * j);
                const f32x4 xv = (f32x4){bflo(w[j].x), bfhi(w[j].x), bflo(w[j].y), bfhi(w[j].y)}; xr[lane + 64 * j] = xv * rstd * g; } }
    }
#undef IN
#undef SEAM
#undef mods
#undef shwin
#undef shwf
#undef ropeC
#undef ropeS
#undef c8
#undef lamv
#undef rowss
#undef lrus
#undef xc
#undef AP
#undef Pb
#undef Yb
#undef HM
#undef WSP
#undef WRG
}

extern "C" void kernel_launch(void* const* d_in, const int* in_sizes, int n_in, void* d_out, int out_size, void* d_ws, size_t ws_size, hipStream_t stream) {
    static int grid = 0;
    if (grid == 0) {
        if (n_in != 27 || out_size != NB * SEQ * DM || ws_size < WS_TOTAL) { fprintf(stderr, "kernel_launch: unexpected shapes (n_in %d out %d ws %zu need %zu)\n", n_in, out_size, ws_size, (size_t)WS_END); grid = -1; return; }
        int dev = 0, cus = 0, per_cu = 0;
        (void)hipGetDevice(&dev); (void)hipDeviceGetAttribute(&cus, hipDeviceAttributeMultiprocessorCount, dev);
        if (hipFuncSetAttribute((const void*)hybrid_fwd, hipFuncAttributeMaxDynamicSharedMemorySize, LDS_BYTES) != hipSuccess) { fprintf(stderr, "kernel_launch: hipFuncSetAttribute failed\n"); grid = -1; return; }
        (void)hipOccupancyMaxActiveBlocksPerMultiprocessor(&per_cu, (const void*)hybrid_fwd, 512, LDS_BYTES);
        if (per_cu < 1) { fprintf(stderr, "kernel_launch: occupancy query says %d blocks per CU\n", per_cu); per_cu = 1; }
        (void)hipGetLastError();
        grid = cus;
    }
    if (grid < 0) return;
    if (hipMemsetAsync((char*)d_ws + WS_CTL, 0, WS_CTL_BYTES, stream) != hipSuccess) { fprintf(stderr, "kernel_launch: memset failed\n"); return; }
    Args a{};
    for (int i = 0; i < 27; ++i) a.in[i] = (const float*)d_in[i];
    a.out = (float*)d_out; a.ws = (unsigned char*)d_ws;
#if MK_SINGLE
    a.ph_lo = 0; a.ph_hi = NPHASE;
    { void* kargs[] = {&a}; hipError_t e = hipLaunchCooperativeKernel((const void*)hybrid_fwd, dim3(grid), dim3(512), kargs, LDS_BYTES, stream);
      if (e != hipSuccess) fprintf(stderr, "cooperative launch failed: %s (grid %d)\n", hipGetErrorString(e), grid); }
#else
    for (int pp = 0; pp < NPHASE + PROBE_NDUP; ++pp) { const int p = pp < NPHASE ? pp : PROBE_DUP0 + (pp - NPHASE) * PROBE_DUPSTEP; a.ph_lo = p; a.ph_hi = p + 1;
        void* kargs[] = {&a}; hipError_t e = hipLaunchCooperativeKernel((const void*)hybrid_fwd, dim3(grid), dim3(512), kargs, LDS_BYTES, stream);
        if (e != hipSuccess) { fprintf(stderr, "cooperative launch %d failed: %s (grid %d)\n", p, hipGetErrorString(e), grid); break; } }
#endif
}
```

```cpp
#include <hip/hip_runtime.h>
#include <hip/hip_cooperative_groups.h>
#include <cstdio>
#include <cstdint>
namespace cg = cooperative_groups;

#ifndef MK_SINGLE
#define MK_SINGLE 1
#endif
#ifndef PH_MASK
#define PH_MASK 0xFFFF
#endif
#define EN(k) (((PH_MASK) >> (k)) & 1)
#ifndef PROBE_NDUP
#define PROBE_NDUP 0
#define PROBE_DUP0 0
#define PROBE_DUPSTEP 6
#endif
#ifndef PROBE_ATTREP
#define PROBE_ATTREP 1
#endif
#ifndef ATT_VAR
#define ATT_VAR 0
#endif

constexpr int NB = 8, SEQ = 4096, CTXL = 256, TB = SEQ + CTXL, MROWS = NB * TB, DM = 1024, PW = 2560, FH = 2816, NF = 2 * FH, NLAYER = 2;
constexpr int Q0c = 0, K0c = 512, V0c = 1024, LX0 = 1536, LG0 = 1792, SU0 = 2048, SV0 = 2304;
constexpr int NMS = 9, NMOD = 6 * DM;
constexpr int NCHUNK = TB / 128;
constexpr size_t SZ_WIN = (size_t)PW * DM * 2, SZ_WOUT = (size_t)DM * DM * 2, SZ_WFFN = (size_t)NF * DM * 2, SZ_WDN = (size_t)DM * FH * 2;
constexpr size_t WS_WIN = 0, WS_WOUT = WS_WIN + 2 * SZ_WIN, WS_WFFN = WS_WOUT + 2 * SZ_WOUT, WS_WDN = WS_WFFN + 2 * SZ_WFFN;
constexpr size_t WS_WSP = WS_WDN + 2 * SZ_WDN;
constexpr size_t WS_WRG = WS_WSP + 262144;
constexpr size_t WS_MODS = WS_WRG + 262144;
constexpr size_t WS_SHWIN = WS_MODS + 442368;
constexpr size_t WS_SHWF = WS_SHWIN + 184320;
constexpr size_t WS_ROPE = WS_SHWF + 405504;
constexpr size_t WS_C8 = WS_ROPE + 8192;
constexpr size_t WS_LAM = WS_C8 + 4096;
constexpr size_t WS_ROWSS = WS_LAM + 256;
constexpr size_t WS_LRUS = WS_ROWSS + (size_t)MROWS * 64;
constexpr size_t WS_XC = WS_LRUS + (size_t)NB * NCHUNK * 2 * 2 * 256 * 4;
constexpr size_t WS_AP = WS_XC + (size_t)NB * CTXL * DM * 4;
constexpr size_t WS_P = WS_AP + (size_t)MROWS * DM * 2;
constexpr size_t WS_Y = WS_P + (size_t)MROWS * PW * 2;
constexpr size_t WS_END = WS_Y + (size_t)MROWS * DM * 2;
constexpr size_t WS_CTL = WS_END, WS_CTL_BYTES = 16384, WS_TOTAL = WS_END + WS_CTL_BYTES;
constexpr size_t WS_HMID = WS_P;
static_assert((size_t)MROWS * FH * 2 <= WS_END - WS_P, "hmid overlay");
static_assert(WS_WSP % 256 == 0 && WS_MODS % 256 == 0 && WS_ROWSS % 256 == 0 && WS_XC % 256 == 0 && WS_AP % 256 == 0 && WS_P % 256 == 0, "align");

#define LAS __attribute__((address_space(3)))
typedef float f32x2 __attribute__((ext_vector_type(2)));
typedef unsigned u32x2 __attribute__((ext_vector_type(2)));
__device__ __forceinline__ unsigned cvtpk(float lo, float hi) { unsigned r; asm("v_cvt_pk_bf16_f32 %0, %1, %2" : "=v"(r) : "v"(lo), "v"(hi)); return r; }
__device__ __forceinline__ float bflo(unsigned w) { return __uint_as_float(w << 16); }
__device__ __forceinline__ float bfhi(unsigned w) { return __uint_as_float(w & 0xffff0000u); }
__device__ __forceinline__ float bf2f(unsigned short h) { return __uint_as_float((unsigned)h << 16); }
__device__ __forceinline__ unsigned short f2bf(float v) { return (unsigned short)(cvtpk(v, v) & 0xffffu); }
__device__ __forceinline__ float fexp(float x) { return __builtin_amdgcn_exp2f(x * 1.4426950408889634f); }
__device__ __forceinline__ float gelu_tanh(float x) { const float u = 1.5957691216f * x * (1.f + 0.044715f * x * x); return x * __builtin_amdgcn_rcpf(1.f + fexp(-u)); }
__device__ __forceinline__ float silu_f(float x) { return x * __builtin_amdgcn_rcpf(1.f + fexp(-x)); }
__device__ __forceinline__ float sigm(float x) { return __builtin_amdgcn_rcpf(1.f + fexp(-x)); }

namespace pg8 {
#define PG8_LAS __attribute__((address_space(3)))
typedef unsigned short bf16_t;
typedef short bf16x8 __attribute__((ext_vector_type(8)));
typedef float f32x4 __attribute__((ext_vector_type(4)));
typedef unsigned u32x4 __attribute__((ext_vector_type(4)));
constexpr int BM = 256, BK = 64, HALF = 128, HTB = HALF * BK * 2  , STAGE_BYTES = 8 * HTB, NXCD = 8, WGM = 8;

__host__ __device__ __forceinline__ int lds_byte(int r, int c) { const int st = (r >> 4) * 2 + (c >> 5), rr = r & 15, cc = c & 31, ob = rr * 64 + cc * 2; return st * 1024 + (ob ^ (((ob >> 9) & 1) << 5)); }
__host__ __device__ __forceinline__ void stage_rc(int b, int& R, int& C) { const int st = b / 1024, sb = b % 1024, swz = sb ^ (((sb >> 9) & 1) << 5); R = (st >> 1) * 16 + swz / 64; C = (st & 1) * 32 + (swz % 64) / 2; }
__host__ __device__ __forceinline__ int perm32(int rho) { const int n = rho >> 4, i = rho & 15; return 8 * (i >> 2) + 4 * n + (i & 3); }

struct Unit { int pm, pn; };
struct Gemm { const bf16_t* A; const bf16_t* Bt; int M, N, K; };

struct StaticOrder {
    int nM, nN, nwg, G, c;
    __host__ __device__ void init(int M, int N, int G_, int c_) { nM = M / BM; nN = N / BM; nwg = nM * nN; G = G_; c = c_; }
    __host__ __device__ bool next(int i, Unit& u) const {
        const long L = (long)i * G + c; if (L >= nwg) return false;
        int wgid = (int)L; { const int q = nwg / NXCD, r = nwg % NXCD, xcd = wgid % NXCD, off = wgid / NXCD; wgid = (xcd < r ? xcd * (q + 1) : r * (q + 1) + (xcd - r) * q) + off; }
        const int nig = WGM * nN, gid = wgid / nig, fm = gid * WGM, gsz = (nM - fm) < WGM ? (nM - fm) : WGM;
        u.pm = fm + ((wgid % nig) % gsz); u.pn = (wgid % nig) / gsz; return true;
    }
    __device__ __forceinline__ void a_ready(const Unit&) const {}
    __device__ __forceinline__ void done(const Unit&) const {}
};

}
namespace pg8 {
template <class Epi, class Sched, bool ALIGN_EPI = false, bool SP2 = false>
__device__ __forceinline__ void gemm_phase(PG8_LAS unsigned char* lds, const Gemm g, const Sched& S, const Epi& E) {
    int tid_ = threadIdx.x; asm volatile("" : "+v"(tid_));
    const int tid = tid_, wid = __builtin_amdgcn_readfirstlane(tid >> 6), lane = tid & 63, wr = wid >> 2, wc = wid & 3, fr = lane & 15, fq = lane >> 4;
    const int K = g.K, nt = K / BK;
    unsigned voffA[2], voffB[2];
#pragma unroll
    for (int i = 0; i < 2; ++i) { int R, C; stage_rc(tid * 16 + i * 8192, R, C); const int Rb = Epi::PERM ? ((R & ~31) + perm32(R & 31)) : R;
        voffA[i] = (unsigned)(R * K + C) * 2u; voffB[i] = (unsigned)(Rb * K + C) * 2u; }
    const size_t kstep = (size_t)(BK * 2);
    const size_t hstep = (size_t)HALF * K * 2;
    const size_t tstep = 2 * hstep;
    const unsigned ldsw = (unsigned)wid * 1024u;
    const int aoff = lds_byte(wr * 64 + fr, fq * 8), boff = lds_byte(wc * 32 + fr, fq * 8);
#define PG8_SA(b, h) (((b) * 2 + (h)) * HTB)
#define PG8_SB(b, h) ((4 + (b) * 2 + (h)) * HTB)
#define PG8_STAGE(bufoff, gbase, voff) do { _Pragma("unroll") for (int _i = 0; _i < 2; ++_i) \
        __builtin_amdgcn_global_load_lds((const unsigned*)((const char*)(gbase) + (voff)[_i]), (PG8_LAS unsigned*)(lds + (bufoff) + ldsw + _i * 8192), 16, 0, 0); } while (0)
#define PG8_LDA(dst, b, h) do { _Pragma("unroll") for (int m = 0; m < 4; ++m) _Pragma("unroll") for (int k = 0; k < 2; ++k) dst[m][k] = *(const PG8_LAS bf16x8*)(lds + PG8_SA(b, h) + aoff + m * 2048 + k * 1024); } while (0)
#define PG8_LDB(dst, b, h) do { _Pragma("unroll") for (int n = 0; n < 2; ++n) _Pragma("unroll") for (int k = 0; k < 2; ++k) dst[n][k] = *(const PG8_LAS bf16x8*)(lds + PG8_SB(b, h) + boff + n * 2048 + k * 1024); } while (0)
#define PG8_MMA(ai, bj, At, Bt) do { __builtin_amdgcn_s_setprio(1); _Pragma("unroll") for (int m = 0; m < 4; ++m) _Pragma("unroll") for (int n = 0; n < 2; ++n) _Pragma("unroll") for (int k = 0; k < 2; ++k) \
        acc[ai][bj][m][n] = __builtin_amdgcn_mfma_f32_16x16x32_bf16(Bt[n][k], At[m][k], acc[ai][bj][m][n], 0, 0, 0); __builtin_amdgcn_s_setprio(0); } while (0)
#define PG8_WAIT_V(n) asm volatile("s_waitcnt vmcnt(" #n ")" ::: "memory")
#define PG8_WAIT_L(n) asm volatile("s_waitcnt lgkmcnt(" #n ")" ::: "memory")
#define PG8_BAR __builtin_amdgcn_s_barrier()
#define PG8_SCHED __builtin_amdgcn_sched_barrier(0)
    Unit cur, nxt; int ui = 0;
    if (!S.next(0, cur)) return;
    f32x4 acc[2][2][4][2];
#pragma unroll
    for (int a = 0; a < 2; ++a)
#pragma unroll
        for (int b = 0; b < 2; ++b)
#pragma unroll
            for (int m = 0; m < 4; ++m)
#pragma unroll
                for (int n = 0; n < 2; ++n) acc[a][b][m][n] = (f32x4){0.f, 0.f, 0.f, 0.f};
    bf16x8 At[4][2], B0[2][2], B1[2][2];
    const char* cA = (const char*)g.A + (size_t)cur.pm * tstep; const char* cB = (const char*)g.Bt + (size_t)cur.pn * tstep;
    S.a_ready(cur);
    if constexpr (SP2) {
        PG8_STAGE(PG8_SB(0, 0), cB, voffB); PG8_STAGE(PG8_SB(0, 1), cB + hstep, voffB); PG8_STAGE(PG8_SA(0, 0), cA, voffA); PG8_STAGE(PG8_SA(0, 1), cA + hstep, voffA);
        if (wr == 1) PG8_BAR;
        PG8_WAIT_V(2); PG8_BAR;
        PG8_STAGE(PG8_SB(1, 0), cB + kstep, voffB); PG8_STAGE(PG8_SA(1, 0), cA + kstep, voffA); PG8_STAGE(PG8_SB(1, 1), cB + hstep + kstep, voffB);
        PG8_WAIT_V(6); PG8_BAR;
    } else {
        PG8_STAGE(PG8_SB(0, 0), cB, voffB); PG8_STAGE(PG8_SA(0, 0), cA, voffA); PG8_STAGE(PG8_SB(0, 1), cB + hstep, voffB); PG8_STAGE(PG8_SA(0, 1), cA + hstep, voffA);
        if (wr == 1) PG8_BAR;
        PG8_WAIT_V(4); PG8_BAR;
        PG8_STAGE(PG8_SB(1, 0), cB + kstep, voffB); PG8_STAGE(PG8_SA(1, 0), cA + kstep, voffA); PG8_STAGE(PG8_SB(1, 1), cB + hstep + kstep, voffB);
        PG8_WAIT_V(6); PG8_BAR;
    }
    for (;;) {
        const bool has_next = S.next(ui + 1, nxt);
        const char* nA = has_next ? (const char*)g.A + (size_t)nxt.pm * tstep : cA; const char* nB = has_next ? (const char*)g.Bt + (size_t)nxt.pn * tstep : cB;
        for (int t = 0; t < nt; t += 2) {
            const bool last = (t == nt - 2);
            const char* a1 = cA + (size_t)(t + 1) * kstep;
            const char* a2 = last ? nA : cA + (size_t)(t + 2) * kstep; const char* b2 = last ? nB : cB + (size_t)(t + 2) * kstep;
            const char* a3 = a2 + kstep; const char* b3 = b2 + kstep;
            if (last && has_next) S.a_ready(nxt);
            if constexpr (SP2) {
            PG8_LDB(B0, 0, 0); PG8_LDB(B1, 0, 1); PG8_SCHED; PG8_LDA(At, 0, 0); PG8_STAGE(PG8_SA(1, 1), a1 + hstep, voffA);
            PG8_WAIT_V(8); PG8_WAIT_L(0); PG8_BAR; PG8_MMA(0, 0, At, B0); PG8_MMA(0, 1, At, B1); PG8_BAR; PG8_SCHED;
            PG8_LDA(At, 0, 1); PG8_STAGE(PG8_SB(0, 0), b2, voffB); PG8_STAGE(PG8_SB(0, 1), b2 + hstep, voffB); PG8_STAGE(PG8_SA(0, 0), a2, voffA);
            PG8_WAIT_V(8); PG8_WAIT_L(0); PG8_BAR; PG8_MMA(1, 0, At, B0); PG8_MMA(1, 1, At, B1); PG8_BAR; PG8_SCHED;
            PG8_LDB(B0, 1, 0); PG8_LDB(B1, 1, 1); PG8_SCHED; PG8_LDA(At, 1, 0); PG8_STAGE(PG8_SA(0, 1), a2 + hstep, voffA);
            PG8_WAIT_V(8); PG8_WAIT_L(0); PG8_BAR; PG8_MMA(0, 0, At, B0); PG8_MMA(0, 1, At, B1); PG8_BAR; PG8_SCHED;
            PG8_LDA(At, 1, 1); PG8_STAGE(PG8_SB(1, 0), b3, voffB); PG8_STAGE(PG8_SB(1, 1), b3 + hstep, voffB); PG8_STAGE(PG8_SA(1, 0), a3, voffA);
            PG8_WAIT_V(8); PG8_WAIT_L(0); PG8_BAR; PG8_MMA(1, 0, At, B0); PG8_MMA(1, 1, At, B1); PG8_BAR; PG8_SCHED;
            } else {
            PG8_LDB(B0, 0, 0); PG8_SCHED; PG8_LDA(At, 0, 0); PG8_STAGE(PG8_SA(1, 1), a1 + hstep, voffA);
            PG8_WAIT_L(8); PG8_BAR; PG8_WAIT_L(0); PG8_MMA(0, 0, At, B0); PG8_BAR; PG8_SCHED;
            PG8_LDB(B1, 0, 1); PG8_STAGE(PG8_SB(0, 0), b2, voffB);
            PG8_BAR; PG8_WAIT_L(0); PG8_MMA(0, 1, At, B1); PG8_BAR;
            PG8_LDA(At, 0, 1); PG8_STAGE(PG8_SA(0, 0), a2, voffA);
            PG8_BAR; PG8_WAIT_L(0); PG8_MMA(1, 0, At, B0); PG8_BAR; PG8_SCHED;
            PG8_STAGE(PG8_SB(0, 1), b2 + hstep, voffB);
            PG8_WAIT_V(6); PG8_BAR; PG8_MMA(1, 1, At, B1); PG8_BAR;
            PG8_LDB(B0, 1, 0); PG8_SCHED; PG8_LDA(At, 1, 0); PG8_STAGE(PG8_SA(0, 1), a2 + hstep, voffA);
            PG8_WAIT_L(8); PG8_BAR; PG8_WAIT_L(0); PG8_MMA(0, 0, At, B0); PG8_BAR; PG8_SCHED;
            PG8_LDB(B1, 1, 1); PG8_STAGE(PG8_SB(1, 0), b3, voffB);
            PG8_BAR; PG8_WAIT_L(0); PG8_MMA(0, 1, At, B1); PG8_BAR;
            PG8_LDA(At, 1, 1); PG8_STAGE(PG8_SA(1, 0), a3, voffA);
            PG8_BAR; PG8_WAIT_L(0); PG8_MMA(1, 0, At, B0); PG8_BAR; PG8_SCHED;
            PG8_STAGE(PG8_SB(1, 1), b3 + hstep, voffB);
            PG8_WAIT_V(6); PG8_BAR; PG8_MMA(1, 1, At, B1); PG8_BAR;
            }
        }
        if constexpr (ALIGN_EPI) { if (wr == 0) PG8_BAR; }
        if constexpr (!Epi::AFTER_DRAIN) { E(acc, cur, wr, wc, fr, fq); S.done(cur); }
        if (!has_next) break;
#pragma unroll
        for (int a = 0; a < 2; ++a)
#pragma unroll
            for (int b = 0; b < 2; ++b)
#pragma unroll
                for (int m = 0; m < 4; ++m)
#pragma unroll
                    for (int n = 0; n < 2; ++n) acc[a][b][m][n] = (f32x4){0.f, 0.f, 0.f, 0.f};
        cur = nxt; cA = nA; cB = nB; ++ui;
        if constexpr (ALIGN_EPI) { if (wr == 1) PG8_BAR; }
    }
    PG8_WAIT_V(0);
    if constexpr (!ALIGN_EPI) { if (wr == 0) PG8_BAR; }
    PG8_BAR;
    if constexpr (Epi::AFTER_DRAIN) { E.fused(acc, cur, wr, wc, fr, fq, lds, wid, lane); S.done(cur); }
#undef PG8_SA
#undef PG8_SB
#undef PG8_STAGE
#undef PG8_LDA
#undef PG8_LDB
#undef PG8_MMA
#undef PG8_WAIT_V
#undef PG8_WAIT_L
#undef PG8_BAR
#undef PG8_SCHED
}
}
namespace pg8 {
struct Order {
    int nM, nN, nwg, G, c, skip;
    __device__ void init(int nM_, int N, int G_, int c_, int skip_) { nM = nM_; nN = N / BM; nwg = nM * nN; G = G_; c = c_; skip = skip_; }
    __device__ bool next(int i, Unit& u) const {
        const long L = (long)i * G + c; if (L >= nwg) return false;
        int wgid = (int)L; { const int q = nwg / NXCD, r = nwg % NXCD, xcd = wgid % NXCD, off = wgid / NXCD; wgid = (xcd < r ? xcd * (q + 1) : r * (q + 1) + (xcd - r) * q) + off; }
        const int nig = WGM * nN, gid = wgid / nig, fm = gid * WGM, gsz = (nM - fm) < WGM ? (nM - fm) : WGM;
        u.pm = fm + ((wgid % nig) % gsz); u.pn = (wgid % nig) / gsz;
        if (skip) u.pm = u.pm + u.pm / 16 + 1;
        return true;
    }
    __device__ __forceinline__ void a_ready(const Unit&) const {}
    __device__ __forceinline__ void done(const Unit&) const {}
};
}

using pg8::f32x4; using pg8::u32x4; using pg8::bf16_t; using pg8::bf16x8;
__device__ __forceinline__ float row_rstd(const float* rowss, size_t row) {
    const f32x4* rs = (const f32x4*)(rowss + row * 16);
    const f32x4 s4 = (rs[0] + rs[1]) + (rs[2] + rs[3]);
    return rsqrtf(((s4.x + s4.y) + (s4.z + s4.w)) * (1.f / 1024.f) + 1e-6f);
}
__device__ __forceinline__ void rows_rstd(const float* rowss, int pm, int wr, int fr, float (&rstd)[2][4]) {
#pragma unroll
    for (int ai = 0; ai < 2; ++ai)
#pragma unroll
      for (int mh = 0; mh < 2; ++mh) { f32x4 t[2][4];
#pragma unroll
        for (int m2 = 0; m2 < 2; ++m2) { const f32x4* rs = (const f32x4*)(rowss + ((size_t)pm * 256 + ai * 128 + wr * 64 + (mh * 2 + m2) * 16 + fr) * 16);
#pragma unroll
            for (int k = 0; k < 4; ++k) t[m2][k] = rs[k]; }
        asm volatile("" ::: "memory");
#pragma unroll
        for (int m2 = 0; m2 < 2; ++m2) { const f32x4 s4 = (t[m2][0] + t[m2][1]) + (t[m2][2] + t[m2][3]); rstd[ai][mh * 2 + m2] = rsqrtf(((s4.x + s4.y) + (s4.z + s4.w)) * (1.f / 1024.f) + 1e-6f); } }
}
struct EpiInProj {
    static constexpr bool PERM = false, AFTER_DRAIN = false;
    bf16_t* P; const float* rowss; const float* sW; const float* ropeC; const float* ropeS;
    __device__ __forceinline__ void operator()(const f32x4 (&acc)[2][2][4][2], const pg8::Unit& u, int wr, int wc, int fr, int fq) const {
        const int b = u.pm / 17, j17 = u.pm - b * 17; const bool ctx = (j17 == 0); const int ms = ctx ? 8 : b;
        const int colb = u.pn * 256 + wc * 32 + 4 * fq;
        const int mode = (u.pn < 4) ? (ctx ? 0 : 1) : (u.pn >= 7 ? 2 : 0);
        f32x4 bv[2][2];
#pragma unroll
        for (int bj = 0; bj < 2; ++bj)
#pragma unroll
            for (int n = 0; n < 2; ++n) bv[bj][n] = *(const f32x4*)(sW + ms * PW + colb + bj * 128 + n * 16);
#pragma unroll
        for (int ai = 0; ai < 2; ++ai) {
#pragma unroll
            for (int m = 0; m < 4; ++m) {
                const int rt = ai * 128 + wr * 64 + m * 16 + fr; const size_t row = (size_t)u.pm * 256 + rt;
                float rstd;
                { const f32x4* rs = (const f32x4*)(rowss + row * 16); const f32x4 t0 = rs[0], t1 = rs[1], t2 = rs[2], t3 = rs[3];
                  const f32x4 s4 = (t0 + t1) + (t2 + t3); rstd = rsqrtf(((s4.x + s4.y) + (s4.z + s4.w)) * (1.f / 1024.f) + 1e-6f); }
                f32x4 v[2][2];
#pragma unroll
                for (int bj = 0; bj < 2; ++bj)
#pragma unroll
                    for (int n = 0; n < 2; ++n) v[bj][n] = acc[ai][bj][m][n] * rstd + bv[bj][n];
                if (mode == 1) {
                    const int tl = (j17 - 1) * 256 + rt; const int pos = (wc & 1) ? (tl & 63) : (tl >> 6);
                    const f32x4 c4 = *(const f32x4*)(ropeC + pos * 16 + 4 * fq), s4 = *(const f32x4*)(ropeS + pos * 16 + 4 * fq);
#pragma unroll
                    for (int bj = 0; bj < 2; ++bj) { const f32x4 x1 = v[bj][0], x2 = v[bj][1]; v[bj][0] = x1 * c4 - x2 * s4; v[bj][1] = x1 * s4 + x2 * c4; }
                } else if (mode == 2) {
#pragma unroll
                    for (int bj = 0; bj < 2; ++bj)
#pragma unroll
                        for (int n = 0; n < 2; ++n) { f32x4 t = v[bj][n]; t.x = gelu_tanh(t.x); t.y = gelu_tanh(t.y); t.z = gelu_tanh(t.z); t.w = gelu_tanh(t.w); v[bj][n] = t; }
                }
                bf16_t* rp = P + row * PW + colb;
#pragma unroll
                for (int bj = 0; bj < 2; ++bj)
#pragma unroll
                    for (int n = 0; n < 2; ++n) { u32x2 w; w.x = cvtpk(v[bj][n].x, v[bj][n].y); w.y = cvtpk(v[bj][n].z, v[bj][n].w); *(u32x2*)(rp + bj * 128 + n * 16) = w; }
            }
        }
    }
};
struct EpiSwiGLU {
    static constexpr bool PERM = true, AFTER_DRAIN = false;
    bf16_t* H; const float* rowss; const float* sW;
    __device__ __forceinline__ void operator()(const f32x4 (&acc)[2][2][4][2], const pg8::Unit& u, int wr, int wc, int fr, int fq) const {
        const int b = u.pm / 17, j17 = u.pm - b * 17; const int ms = (j17 == 0) ? 8 : b;
        const int colb = wc * 32 + 8 * fq;
        f32x4 bg[2], bu[2];
#pragma unroll
        for (int n = 0; n < 2; ++n) { bg[n] = *(const f32x4*)(sW + ms * NF + u.pn * 256 + colb + 4 * n); bu[n] = *(const f32x4*)(sW + ms * NF + u.pn * 256 + 128 + colb + 4 * n); }
        float rstd_[2][4]; rows_rstd(rowss, u.pm, wr, fr, rstd_);
#pragma unroll
        for (int ai = 0; ai < 2; ++ai)
#pragma unroll
            for (int m = 0; m < 4; ++m) {
                const int rt = ai * 128 + wr * 64 + m * 16 + fr; const size_t row = (size_t)u.pm * 256 + rt;
                const float rstd = rstd_[ai][m];
                f32x4 hm[2];
#pragma unroll
                for (int n = 0; n < 2; ++n) { const f32x4 g = acc[ai][0][m][n] * rstd + bg[n], up = acc[ai][1][m][n] * rstd + bu[n];
                    hm[n].x = silu_f(g.x) * up.x; hm[n].y = silu_f(g.y) * up.y; hm[n].z = silu_f(g.z) * up.z; hm[n].w = silu_f(g.w) * up.w; }
                u32x4 w; w.x = cvtpk(hm[0].x, hm[0].y); w.y = cvtpk(hm[0].z, hm[0].w); w.z = cvtpk(hm[1].x, hm[1].y); w.w = cvtpk(hm[1].z, hm[1].w);
                *(u32x4*)(H + row * FH + u.pn * 128 + colb) = w;
            }
    }
};
struct EpiRes {
    static constexpr bool PERM = true, AFTER_DRAIN = false;
    const float* xin_lat; const float* xin_ctx; float* xo_lat; int xsrc;
    const float* gate; const float* gp; const float* scp;
    const float* gn; const float* scn; bf16_t* A; float* rowss; int write_a; int xbf;
    __device__ __forceinline__ void operator()(const f32x4 (&acc)[2][2][4][2], const pg8::Unit& u, int wr, int wc, int fr, int fq) const {
        const int b = u.pm / 17, j17 = u.pm - b * 17; const bool ctx = (j17 == 0); const int ms = ctx ? 8 : b;
        const float* xi = ctx ? xin_ctx + (size_t)b * CTXL * DM : xin_lat + ((size_t)b * SEQ + (size_t)(j17 - 1) * 256) * DM;
        float* xo = xo_lat + ((size_t)b * SEQ + (size_t)(j17 - 1) * 256) * DM;
        const int colb = u.pn * 256 + wc * 32 + 8 * fq;
        float ss[2][4];
#pragma unroll
        for (int ai = 0; ai < 2; ++ai)
#pragma unroll
            for (int m = 0; m < 4; ++m) ss[ai][m] = 0.f;
#pragma unroll
        for (int bj = 0; bj < 2; ++bj) {
            const int col = colb + bj * 128;
            f32x4 gv[2], fc[2], rf[2];
#pragma unroll
            for (int n = 0; n < 2; ++n) { gv[n] = *(const f32x4*)(gate + ms * NMOD + col + 4 * n);
                if (write_a) fc[n] = *(const f32x4*)(gn + col + 4 * n) * (*(const f32x4*)(scn + ms * NMOD + col + 4 * n) + 1.f); else fc[n] = (f32x4){0.f, 0.f, 0.f, 0.f};
                if (xsrc) { const f32x4 f = *(const f32x4*)(gp + col + 4 * n) * (*(const f32x4*)(scp + ms * NMOD + col + 4 * n) + 1.f);
                    rf[n].x = __builtin_amdgcn_rcpf(f.x); rf[n].y = __builtin_amdgcn_rcpf(f.y); rf[n].z = __builtin_amdgcn_rcpf(f.z); rf[n].w = __builtin_amdgcn_rcpf(f.w); }
                else rf[n] = (f32x4){0.f, 0.f, 0.f, 0.f}; }
#pragma unroll
            for (int ai = 0; ai < 2; ++ai) {
                f32x4 xl[4][2];
                if (!xsrc) {
#pragma unroll
                    for (int m = 0; m < 4; ++m) { const unsigned xo4 = ((unsigned)(ai * 128 + wr * 64 + m * 16 + fr) * DM + (unsigned)col) * 4u;
#pragma unroll
                        for (int n = 0; n < 2; ++n) xl[m][n] = *(const f32x4*)((const char*)xi + (xo4 + 16u * n)); }
                } else {
                    u32x4 w[4];
#pragma unroll
                    for (int m = 0; m < 4; ++m) w[m] = *(const u32x4*)((const char*)A + (((unsigned)u.pm * 256u + (unsigned)(ai * 128 + wr * 64 + m * 16 + fr)) * DM + (unsigned)col) * 2u);
#pragma unroll
                    for (int m = 0; m < 4; ++m) { xl[m][0] = (f32x4){bflo(w[m].x), bfhi(w[m].x), bflo(w[m].y), bfhi(w[m].y)} * rf[0]; xl[m][1] = (f32x4){bflo(w[m].z), bfhi(w[m].z), bflo(w[m].w), bfhi(w[m].w)} * rf[1]; }
                }
                asm volatile("" ::: "memory");
#pragma unroll
                for (int m = 0; m < 4; ++m) {
                    const int rt = ai * 128 + wr * 64 + m * 16 + fr;
                    f32x4 xv[2];
#pragma unroll
                    for (int n = 0; n < 2; ++n) { xv[n] = xl[m][n] + gv[n] * acc[ai][bj][m][n];
                        ss[ai][m] += (xv[n].x * xv[n].x + xv[n].y * xv[n].y) + (xv[n].z * xv[n].z + xv[n].w * xv[n].w); }
                    if (xbf) { u32x4 w; w.x = cvtpk(xv[0].x, xv[0].y); w.y = cvtpk(xv[0].z, xv[0].w); w.z = cvtpk(xv[1].x, xv[1].y); w.w = cvtpk(xv[1].z, xv[1].w);
                        *(u32x4*)((char*)xo + ((unsigned)rt * (DM * 4u) + (unsigned)col * 2u)) = w; }
                    if (write_a) { const f32x4 a0 = xv[0] * fc[0], a1 = xv[1] * fc[1];
                        u32x4 w; w.x = cvtpk(a0.x, a0.y); w.y = cvtpk(a0.z, a0.w); w.z = cvtpk(a1.x, a1.y); w.w = cvtpk(a1.z, a1.w);
                        *(u32x4*)((char*)A + (((unsigned)u.pm * 256u + (unsigned)rt) * DM + (unsigned)col) * 2u) = w; }
                }
            }
        }
#pragma unroll
        for (int ai = 0; ai < 2; ++ai)
#pragma unroll
            for (int m = 0; m < 4; ++m) { float s = ss[ai][m]; s += __shfl_xor(s, 16); s += __shfl_xor(s, 32);
                if (fq == 0) rowss[((size_t)u.pm * 256 + ai * 128 + wr * 64 + m * 16 + fr) * 16 + u.pn * 4 + wc] = s; }
    }
};
namespace att {
using s16x4 = __attribute__((ext_vector_type(4))) short;
using f32x16 = __attribute__((ext_vector_type(16))) float;
constexpr int SHM_V = 16384, SHM_K = 8192, OFF_V = 0, OFF_K = 32768, OFF_WS = 49152, OFF_ST = 51200, LDS_TOTAL = OFF_ST + 65536;
constexpr float SCALE = 0.125f, THR = 8.f;
#define KSWZ(row, colB) ((row) * 128 + ((colB) ^ (((row) & 7) << 4)))
#define SBAR() __builtin_amdgcn_sched_barrier(0)
__device__ __forceinline__ int crow(int r, int hi) { return (r & 3) + 8 * (r >> 2) + 4 * hi; }
__device__ __forceinline__ void partialSM(f32x16& p0, f32x16& p1, float& m_reg, float& mn, float& alpha) {
  constexpr float C = SCALE * 1.4426950408889634f;
  float pmax = p0[0];
#pragma unroll
  for (int r = 1; r < 16; ++r) pmax = fmaxf(pmax, p0[r]);
#pragma unroll
  for (int r = 0; r < 16; ++r) pmax = fmaxf(pmax, p1[r]);
  { auto rr = __builtin_amdgcn_permlane32_swap(__float_as_uint(pmax), __float_as_uint(pmax), false, false);
    pmax = fmaxf(__uint_as_float(rr[0]), __uint_as_float(rr[1])); }
  if (__builtin_expect(__all(pmax - m_reg <= THR / SCALE), 1)) { mn = m_reg; alpha = 1.f; }
  else { mn = fmaxf(m_reg, pmax); alpha = __builtin_amdgcn_exp2f((m_reg - mn) * C); m_reg = mn; }
  const float mnC = -mn * C;
#pragma unroll
  for (int r = 0; r < 16; ++r) p0[r] = fmaf(p0[r], C, mnC);
#pragma unroll
  for (int r = 0; r < 16; ++r) p1[r] = fmaf(p1[r], C, mnC);
#pragma unroll
  for (int r = 0; r < 16; ++r) p0[r] = __builtin_amdgcn_exp2f(p0[r]);
}
__device__ __forceinline__ void finishSM(f32x16& p0, f32x16& p1, float alpha, float& l_reg, bf16x8& pa0, bf16x8& pa1, bf16x8& pa2, bf16x8& pa3) {
#pragma unroll
  for (int r = 0; r < 16; ++r) p1[r] = __builtin_amdgcn_exp2f(p1[r]);
  float ps = 0;
#pragma unroll
  for (int r = 0; r < 16; ++r) ps += p0[r];
#pragma unroll
  for (int r = 0; r < 16; ++r) ps += p1[r];
  { auto rr = __builtin_amdgcn_permlane32_swap(__float_as_uint(ps), __float_as_uint(ps), false, false);
    ps = __uint_as_float(rr[0]) + __uint_as_float(rr[1]); }
  l_reg = l_reg * alpha + ps;
#define PK4(P, BASE, OUT) do { unsigned a0 = cvtpk(P[BASE + 0], P[BASE + 1]), a1 = cvtpk(P[BASE + 2], P[BASE + 3]);   \
    unsigned b0 = cvtpk(P[BASE + 4], P[BASE + 5]), b1 = cvtpk(P[BASE + 6], P[BASE + 7]);                              \
    auto r0 = __builtin_amdgcn_permlane32_swap(a0, b0, false, false); auto r1 = __builtin_amdgcn_permlane32_swap(a1, b1, false, false); \
    u32x4 w = {r0[0], r1[0], r0[1], r1[1]}; OUT = *reinterpret_cast<bf16x8*>(&w); } while (0)
  PK4(p0, 0, pa0); PK4(p0, 8, pa1); PK4(p1, 0, pa2); PK4(p1, 8, pa3);
#undef PK4
}
__device__ __forceinline__ void qkt(f32x16& p0, f32x16& p1, const char* Ks, const bf16x8* qr, int r32, int hi) {
  p0 = f32x16{}; p1 = f32x16{};
#pragma unroll
  for (int d0 = 0; d0 < 4; ++d0) { const int cb = d0 * 32 + hi * 16;
    const bf16x8 b0 = *reinterpret_cast<const bf16x8*>(Ks + KSWZ(r32, cb));
    const bf16x8 b1 = *reinterpret_cast<const bf16x8*>(Ks + KSWZ(32 + r32, cb));
    p0 = __builtin_amdgcn_mfma_f32_32x32x16_bf16(b0, qr[d0], p0, 0, 0, 0);
    p1 = __builtin_amdgcn_mfma_f32_32x32x16_bf16(b1, qr[d0], p1, 0, 0, 0); }
}
__device__ __forceinline__ int v_st(int k, int c) { const int kk = (k & ~0xC) | ((k & 4) << 1) | ((k & 8) >> 1); return ((kk >> 3) * 4 + (c >> 5)) * 512 + ((kk & 7) * 32 + (c & 31)) * 2; }
__device__ __forceinline__ int v_rd_base(int lane) { return ((lane & 3) << 3) | (((lane >> 2) & 3) << 6) | (((lane >> 4) & 1) << 5) | (((lane >> 5) & 1) << 8); }
constexpr int v_rd_off(int d0, int ks, int half) { return d0 * 512 + ks * 4096 + half * 2048; }
template <int OFF> __device__ __forceinline__ s16x4 tr_read(int vb) {
  s16x4 r; asm volatile("ds_read_b64_tr_b16 %0, %1 offset:%2" : "=&v"(r) : "v"(vb), "i"(OFF) : "memory"); return r;
}
template <int KS> __device__ __forceinline__ void pv_ks(f32x16* o, int vb, bf16x8 pa) {
  const s16x4 l0 = tr_read<v_rd_off(0, KS, 0)>(vb), h0 = tr_read<v_rd_off(0, KS, 1)>(vb), l1 = tr_read<v_rd_off(1, KS, 0)>(vb), h1 = tr_read<v_rd_off(1, KS, 1)>(vb);
  const s16x4 l2 = tr_read<v_rd_off(2, KS, 0)>(vb), h2 = tr_read<v_rd_off(2, KS, 1)>(vb), l3 = tr_read<v_rd_off(3, KS, 0)>(vb), h3 = tr_read<v_rd_off(3, KS, 1)>(vb);
  asm volatile("s_waitcnt lgkmcnt(0)" ::: "memory"); SBAR();
#define PK(L, H) (bf16x8){L[0], L[1], L[2], L[3], H[0], H[1], H[2], H[3]}
  o[0] = __builtin_amdgcn_mfma_f32_32x32x16_bf16(pa, PK(l0, h0), o[0], 0, 0, 0);
  o[1] = __builtin_amdgcn_mfma_f32_32x32x16_bf16(pa, PK(l1, h1), o[1], 0, 0, 0);
  o[2] = __builtin_amdgcn_mfma_f32_32x32x16_bf16(pa, PK(l2, h2), o[2], 0, 0, 0);
  o[3] = __builtin_amdgcn_mfma_f32_32x32x16_bf16(pa, PK(l3, h3), o[3], 0, 0, 0);
#undef PK
}
__device__ __forceinline__ void pv_d0(f32x16* o, int vb, bf16x8 pa0, bf16x8 pa1, bf16x8 pa2, bf16x8 pa3) {
  pv_ks<0>(o, vb, pa0); pv_ks<1>(o, vb, pa1); pv_ks<2>(o, vb, pa2); pv_ks<3>(o, vb, pa3);
}
__device__ __forceinline__ void attn_unit(char* lds, const bf16_t* __restrict__ P, bf16_t* __restrict__ Y, int b, int h, int qb, float lam, const float* __restrict__ gattn, float oscale) {
  int tid_ = threadIdx.x; asm volatile("" : "+v"(tid_));
  const int tid = tid_, wid = tid >> 6, lane = tid & 63, r32 = lane & 31, hi = lane >> 5;
  const unsigned rowb = (unsigned)b * TB, q0 = rowb + (unsigned)qb * 256;
  const int seq = (qb == 0) ? CTXL : TB, NT = seq / 64;
  char* V_lds = lds + OFF_V; char* K_lds = lds + OFF_K;
  float* ws = (float*)(lds + OFF_WS) + wid * 64; float* li_l = ws; float* al_l = ws + 32;
  unsigned* stash = (unsigned*)(lds + OFF_ST) + wid * 2048;
  const int sr = tid >> 4, sc = (tid & 15) * 8, vst0 = v_st(sr, sc), vst1 = v_st(32 + sr, sc);
  const int kr = tid >> 3, kc = (tid & 7) * 8, kst = KSWZ(kr, kc * 2);
  const int vb0 = (int)(uintptr_t)V_lds + v_rd_base(lane);
  const char* Pc = (const char*)P;
  const unsigned voff = ((rowb + sr) * PW + V0c + h * 128 + sc) * 2u;
#pragma unroll 1
  for (int map = 0; map < 2; ++map) {
    const unsigned qoff = ((q0 + wid * 32 + r32) * PW + Q0c + h * 128 + map * 64 + hi * 8) * 2u;
    const unsigned koff = ((rowb + kr) * PW + K0c + h * 128 + map * 64 + kc) * 2u;
    bf16x8 qr[4];
#pragma unroll
    for (int d0 = 0; d0 < 4; ++d0) qr[d0] = *reinterpret_cast<const bf16x8*>(Pc + (qoff + d0 * 32));
    float m_reg = -1e30f, l_reg = 0; f32x16 o[4] = {};
    struct { bf16x8 vs0, vs1, ks; } sr_[1];
#define SLOAD(i, k0) do { const unsigned ko_ = (unsigned)(k0) * (PW * 2u); sr_[i].vs0 = *reinterpret_cast<const bf16x8*>(Pc + (voff + ko_)); sr_[i].vs1 = *reinterpret_cast<const bf16x8*>(Pc + (voff + ko_ + 32u * PW * 2u)); \
    sr_[i].ks = *reinterpret_cast<const bf16x8*>(Pc + (koff + ko_)); } while (0)
#define SWRITE(bf, i) do { *(bf16x8*)(V_lds + (bf) * SHM_V + vst0) = sr_[i].vs0; *(bf16x8*)(V_lds + (bf) * SHM_V + vst1) = sr_[i].vs1; \
    *(bf16x8*)(K_lds + (bf) * SHM_K + kst) = sr_[i].ks; } while (0)
#define SWAIT() asm volatile("s_waitcnt vmcnt(0)" ::: "memory")
#define RESC(a) do { if (__any((a) < 1.f)) { if (hi == 0) al_l[r32] = (a); asm volatile("s_waitcnt lgkmcnt(0)" ::: "memory"); \
    _Pragma("unroll") for (int d = 0; d < 4; ++d) _Pragma("unroll") for (int r = 0; r < 16; ++r) o[d][r] *= al_l[crow(r, hi)]; } } while (0)
    f32x16 pA0, pA1, pB0, pB1; float mnA, mnB, alA, alB; bf16x8 pa0, pa1, pa2, pa3;
    constexpr int SE = 0, SO = 0;
    SLOAD(SE, 0); asm volatile("s_waitcnt vmcnt(0)" ::: "memory"); SWRITE(0, SE); __syncthreads();
    qkt(pA0, pA1, K_lds, qr, r32, hi); partialSM(pA0, pA1, m_reg, mnA, alA);
    SLOAD(SO, 64);
    SWAIT(); SWRITE(1, SO); __syncthreads();
    for (int j = 1; j + 1 < NT; j += 2) {
      SBAR(); qkt(pB0, pB1, K_lds + SHM_K, qr, r32, hi);
      finishSM(pA0, pA1, alA, l_reg, pa0, pa1, pa2, pa3); SBAR();
      SLOAD(SO, (j + 1) * 64); SBAR();
      pv_d0(o, vb0, pa0, pa1, pa2, pa3); partialSM(pB0, pB1, m_reg, mnB, alB);
      __syncthreads(); SWAIT(); SWRITE(0, SE);
      RESC(alB); __syncthreads();
      SBAR(); qkt(pA0, pA1, K_lds, qr, r32, hi);
      finishSM(pB0, pB1, alB, l_reg, pa0, pa1, pa2, pa3); SBAR();
      SLOAD(SE, (j + 2) * 64); SBAR();
      pv_d0(o, vb0 + SHM_V, pa0, pa1, pa2, pa3); partialSM(pA0, pA1, m_reg, mnA, alA);
      __syncthreads(); SWAIT(); SWRITE(1, SO);
      RESC(alA); __syncthreads();
    }
    SBAR(); qkt(pB0, pB1, K_lds + SHM_K, qr, r32, hi);
    finishSM(pA0, pA1, alA, l_reg, pa0, pa1, pa2, pa3); SBAR();
    pv_d0(o, vb0, pa0, pa1, pa2, pa3); partialSM(pB0, pB1, m_reg, mnB, alB);
    __syncthreads(); RESC(alB);
    finishSM(pB0, pB1, alB, l_reg, pa0, pa1, pa2, pa3); SBAR();
    pv_d0(o, vb0 + SHM_V, pa0, pa1, pa2, pa3);
    if (hi == 0) li_l[r32] = l_reg; asm volatile("s_waitcnt lgkmcnt(0)" ::: "memory");
    if (map == 0) {
#pragma unroll
      for (int r = 0; r < 16; ++r) { const float rl = __builtin_amdgcn_rcpf(li_l[crow(r, hi)]);
        stash[(r * 2 + 0) * 64 + lane] = cvtpk(o[0][r] * rl, o[1][r] * rl); stash[(r * 2 + 1) * 64 + lane] = cvtpk(o[2][r] * rl, o[3][r] * rl); SBAR(); }
    } else if (ATT_VAR != 1) {
      char* Yc = (char*)Y; const unsigned yoff = ((q0 + wid * 32) * DM + h * 128 + r32) * 2u;
      float gv[4];
#pragma unroll
      for (int d0 = 0; d0 < 4; ++d0) gv[d0] = gattn[d0 * 32 + r32] * oscale;
      SBAR();
#pragma unroll
      for (int r = 0; r < 16; ++r) { const float rl = lam * __builtin_amdgcn_rcpf(li_l[crow(r, hi)]);
        const unsigned w0 = stash[(r * 2 + 0) * 64 + lane], w1 = stash[(r * 2 + 1) * 64 + lane];
        const float e0 = bflo(w0) - o[0][r] * rl, e1 = bfhi(w0) - o[1][r] * rl, e2 = bflo(w1) - o[2][r] * rl, e3 = bfhi(w1) - o[3][r] * rl;
        float ssq = (e0 * e0 + e1 * e1) + (e2 * e2 + e3 * e3);
        if (ATT_VAR != 3) { ssq += __shfl_xor(ssq, 1); ssq += __shfl_xor(ssq, 2); ssq += __shfl_xor(ssq, 4); ssq += __shfl_xor(ssq, 8); ssq += __shfl_xor(ssq, 16); }
        const float rs = rsqrtf(ssq * (1.f / 128.f) + 1e-6f);
        bf16_t* yr = (bf16_t*)(Yc + (yoff + (unsigned)crow(r, hi) * (DM * 2u)));
        if (ATT_VAR != 4) { yr[0] = f2bf(e0 * rs * gv[0]); yr[32] = f2bf(e1 * rs * gv[1]); yr[64] = f2bf(e2 * rs * gv[2]); yr[96] = f2bf(e3 * rs * gv[3]); } else { yr[0] = f2bf(e0 * rs + e1 + e2 + e3); } SBAR(); }
    }
    __syncthreads();
#undef SLOAD
#undef SWRITE
#undef SWAIT
#undef RESC
  }
}
#undef KSWZ
}
namespace lru {
using att::f32x16; using att::crow;
constexpr int RS = 528;
constexpr int OFF_CL = 0, OFF_YS = 128 * RS, OFF_CY = 2 * 128 * RS;
template <int CTRL, int RMASK> __device__ __forceinline__ float dppf(float oldv, float src) {
  return __int_as_float(__builtin_amdgcn_update_dpp(__float_as_int(oldv), __float_as_int(src), CTRL, RMASK, 0xF, false));
}
template <bool PASS2>
__device__ __forceinline__ void lru_unit(char* lds, const bf16_t* __restrict__ P, bf16_t* __restrict__ Y, int b, int c, const float* __restrict__ convw, const float* __restrict__ convb,
                                         const bf16_t* __restrict__ wrg, const float* __restrict__ ba, const float* __restrict__ bx, const float* __restrict__ c8, float* lrus, int d_lo, int d_hi) {
  int tid_ = threadIdx.x; asm volatile("" : "+v"(tid_));
  const int tid = tid_, wid = tid >> 6, lane = tid & 63, r32 = lane & 31, hi = lane >> 5;
  const unsigned R0 = (unsigned)b * TB + (unsigned)c * 128;
  const int seg_lo = (c < 2) ? 0 : CTXL, seg_hi = (c < 2) ? CTXL : TB;
  const char* Pc = (const char*)P;
  {
    const int ch8 = (tid & 31) * 8, t0 = (tid >> 5) * 8;
    u32x4 xr[11];
#pragma unroll
    for (int i = 0; i < 11; ++i) { const int tt = c * 128 + t0 - 1 + i;
      if (tt >= seg_lo && tt < seg_hi) xr[i] = *(const u32x4*)(Pc + (((unsigned)b * TB + (unsigned)tt) * PW + LX0 + ch8) * 2u); else xr[i] = (u32x4){0u, 0u, 0u, 0u}; }
    float w[4][8], bb[8];
#pragma unroll
    for (int k = 0; k < 4; ++k) { const f32x4 a = *(const f32x4*)(convw + k * 256 + ch8), d = *(const f32x4*)(convw + k * 256 + ch8 + 4);
      w[k][0] = a.x; w[k][1] = a.y; w[k][2] = a.z; w[k][3] = a.w; w[k][4] = d.x; w[k][5] = d.y; w[k][6] = d.z; w[k][7] = d.w; }
    { const f32x4 a = *(const f32x4*)(convb + ch8), d = *(const f32x4*)(convb + ch8 + 4); bb[0] = a.x; bb[1] = a.y; bb[2] = a.z; bb[3] = a.w; bb[4] = d.x; bb[5] = d.y; bb[6] = d.z; bb[7] = d.w; }
#pragma unroll
    for (int i = 0; i < 8; ++i) { float acc[8];
#pragma unroll
      for (int e = 0; e < 8; ++e) acc[e] = bb[e];
#pragma unroll
      for (int k = 0; k < 4; ++k) { const u32x4 xv = xr[i + k];
        acc[0] += bflo(xv.x) * w[k][0]; acc[1] += bfhi(xv.x) * w[k][1]; acc[2] += bflo(xv.y) * w[k][2]; acc[3] += bfhi(xv.y) * w[k][3];
        acc[4] += bflo(xv.z) * w[k][4]; acc[5] += bfhi(xv.z) * w[k][5]; acc[6] += bflo(xv.w) * w[k][6]; acc[7] += bfhi(xv.w) * w[k][7]; }
      u32x4 o; o.x = cvtpk(acc[0], acc[1]); o.y = cvtpk(acc[2], acc[3]); o.z = cvtpk(acc[4], acc[5]); o.w = cvtpk(acc[6], acc[7]);
      *(u32x4*)(lds + OFF_CL + (t0 + i) * RS + ch8 * 2) = o; }
  }
  if (PASS2) {
    const int d = tid >> 8, ch = tid & 255;
    const int np = d ? (c < 2 ? 1 - c : NCHUNK + 1 - c) : c;
    float cy = 0.f;
    const float* sb = lrus + ((size_t)b * NCHUNK * 4 + (size_t)d * 2) * 256 + ch;
    if (np > 0) { float A[NCHUNK], H[NCHUNK];
#pragma unroll
      for (int i = 0; i < NCHUNK; ++i) { int p = i < np ? i : np - 1;
        const int u = d ? (c < 2 ? 1 - p : (p == 0 ? 1 : (p == 1 ? 0 : NCHUNK + 1 - p))) : p;
        A[i] = sb[(size_t)u * 1024]; H[i] = sb[(size_t)u * 1024 + 256]; }
#pragma unroll
      for (int i = 0; i < NCHUNK; ++i) if (i < np) cy = A[i] * cy + H[i];
    }
    ((float*)(lds + OFF_CY))[tid] = cy;
  }
  __syncthreads();
  const int hh = wid >> 1, jh = wid & 1, chb = hh * 64 + jh * 32;
#pragma unroll 1
  for (int d = d_lo; d < d_hi; ++d) {
    const bf16_t* wa = wrg + ((0 * 2 + d) * 4 + hh) * 4096 + (jh * 32 + r32) * 64 + hi * 8;
    const bf16_t* wx = wrg + ((1 * 2 + d) * 4 + hh) * 4096 + (jh * 32 + r32) * 64 + hi * 8;
    bf16x8 fa[4], fx[4];
#pragma unroll
    for (int k = 0; k < 4; ++k) { fa[k] = *reinterpret_cast<const bf16x8*>(wa + k * 16); fx[k] = *reinterpret_cast<const bf16x8*>(wx + k * 16); }
    float carry[16], Pc_[16], bav[16], bxv[16], c8v[16];
#pragma unroll
    for (int q = 0; q < 4; ++q) { const int co = d * 256 + chb + 8 * q + 4 * hi;
      const f32x4 b4 = *(const f32x4*)(ba + co), x4 = *(const f32x4*)(bx + co), c4 = *(const f32x4*)(c8 + co);
      bav[4 * q] = b4.x; bav[4 * q + 1] = b4.y; bav[4 * q + 2] = b4.z; bav[4 * q + 3] = b4.w; bxv[4 * q] = x4.x; bxv[4 * q + 1] = x4.y; bxv[4 * q + 2] = x4.z; bxv[4 * q + 3] = x4.w;
      c8v[4 * q] = c4.x; c8v[4 * q + 1] = c4.y; c8v[4 * q + 2] = c4.z; c8v[4 * q + 3] = c4.w; }
#pragma unroll
    for (int r = 0; r < 16; ++r) { carry[r] = 0.f; Pc_[r] = 1.f; }
    if (PASS2) { const float* cyp = (const float*)(lds + OFF_CY) + d * 256 + chb + 4 * hi;
#pragma unroll
      for (int q = 0; q < 4; ++q) { const f32x4 v = *(const f32x4*)(cyp + 8 * q); carry[4 * q] = v.x; carry[4 * q + 1] = v.y; carry[4 * q + 2] = v.z; carry[4 * q + 3] = v.w; } }
    const int tokl = d ? 31 - r32 : r32;
#pragma unroll 1
    for (int ti = 0; ti < 4; ++ti) {
      const int tt = d ? 3 - ti : ti;
      char* rowp = lds + OFF_CL + (tt * 32 + tokl) * RS;
      f32x16 za = {}, zx = {};
#pragma unroll
      for (int k = 0; k < 4; ++k) { const bf16x8 xb = *reinterpret_cast<const bf16x8*>(rowp + (hh * 64 + k * 16 + hi * 8) * 2);
        za = __builtin_amdgcn_mfma_f32_32x32x16_bf16(fa[k], xb, za, 0, 0, 0); zx = __builtin_amdgcn_mfma_f32_32x32x16_bf16(fx[k], xb, zx, 0, 0, 0); }
      float av[16], bv[16];
#pragma unroll
      for (int q = 0; q < 4; ++q) { const u32x2 cw = *(const u32x2*)(rowp + (chb + 8 * q + 4 * hi) * 2);
        const float clv[4] = {bflo(cw.x), bfhi(cw.x), bflo(cw.y), bfhi(cw.y)};
#pragma unroll
        for (int i = 0; i < 4; ++i) { const int r = 4 * q + i;
          const float rg = sigm(za[r] + bav[r]), ig = sigm(zx[r] + bxv[r]);
          const float a = fexp(-c8v[r] * rg);
          av[r] = a; bv[r] = __builtin_amdgcn_sqrtf(fmaxf(1.f - a * a, 0.f)) * ig * clv[i]; } }
#define LRU_SCAN(CTRL, RM) _Pragma("unroll") for (int r = 0; r < 16; ++r) { const float ap = dppf<CTRL, RM>(1.f, av[r]), bp = dppf<CTRL, RM>(0.f, bv[r]); bv[r] = av[r] * bp + bv[r]; av[r] = av[r] * ap; }
      LRU_SCAN(0x111, 0xF) LRU_SCAN(0x112, 0xF) LRU_SCAN(0x114, 0xF) LRU_SCAN(0x118, 0xF) LRU_SCAN(0x142, 0xA)
#undef LRU_SCAN
#pragma unroll
      for (int q = 0; q < 4; ++q) { float hv[4];
#pragma unroll
        for (int i = 0; i < 4; ++i) { const int r = 4 * q + i; hv[i] = bv[r] + av[r] * carry[r];
          carry[r] = __shfl(hv[i], 31, 32);
          if (!PASS2) Pc_[r] *= __shfl(av[r], 31, 32); }
        if (PASS2) { u32x2* yp = (u32x2*)(lds + OFF_YS + (tt * 32 + tokl) * RS + (chb + 8 * q + 4 * hi) * 2);
          if (d) { const u32x2 o = *yp; hv[0] += bflo(o.x); hv[1] += bfhi(o.x); hv[2] += bflo(o.y); hv[3] += bfhi(o.y); }
          u32x2 w; w.x = cvtpk(hv[0], hv[1]); w.y = cvtpk(hv[2], hv[3]); *yp = w; } }
    }
    if (!PASS2) { if (r32 == 0) { float* sb = lrus + ((((size_t)b * NCHUNK + c) * 2 + d) * 2) * 256 + chb + 4 * hi;
#pragma unroll
        for (int q = 0; q < 4; ++q) { *(f32x4*)(sb + 8 * q) = (f32x4){Pc_[4 * q], Pc_[4 * q + 1], Pc_[4 * q + 2], Pc_[4 * q + 3]};
          *(f32x4*)(sb + 256 + 8 * q) = (f32x4){carry[4 * q], carry[4 * q + 1], carry[4 * q + 2], carry[4 * q + 3]}; } } }
  }
  if (PASS2) {
    __syncthreads();
    const int ch8 = (tid & 31) * 8;
#pragma unroll
    for (int i = 0; i < 8; ++i) { const int t = (tid >> 5) + 16 * i;
      const u32x4 hv = *(const u32x4*)(lds + OFF_YS + t * RS + ch8 * 2), gv = *(const u32x4*)(Pc + ((R0 + t) * PW + LG0 + ch8) * 2u);
      u32x4 o; o.x = cvtpk(bflo(hv.x) * bflo(gv.x), bfhi(hv.x) * bfhi(gv.x)); o.y = cvtpk(bflo(hv.y) * bflo(gv.y), bfhi(hv.y) * bfhi(gv.y));
      o.z = cvtpk(bflo(hv.z) * bflo(gv.z), bfhi(hv.z) * bfhi(gv.z)); o.w = cvtpk(bflo(hv.w) * bflo(gv.w), bfhi(hv.w) * bfhi(gv.w));
      *(u32x4*)((char*)Y + ((R0 + t) * DM + 512 + ch8) * 2u) = o; }
  }
  __syncthreads();
}
}

namespace sgu {
using att::f32x16; using att::crow;
constexpr int VS = 272;
__device__ __forceinline__ void sgu_unit(char* lds, const bf16_t* __restrict__ P, bf16_t* __restrict__ Y, int b, int c, const bf16_t* __restrict__ wsp, const float* __restrict__ gsgu, const float* __restrict__ bsp) {
  int tid_ = threadIdx.x; asm volatile("" : "+v"(tid_));
  const int tid = tid_, wid = tid >> 6, lane = tid & 63, r32 = lane & 31, hi = lane >> 5;
  const unsigned R0 = (unsigned)b * TB + (unsigned)c * 128;
  const char* Pc = (const char*)P;
  const int gg = wid >> 1, chalf = wid & 1, cc = gg * 64 + chalf * 32 + r32;
  bf16x8 Af[4][8];
  u32x4 xv[8];
  { const int q = tid & 127, g = tid >> 7;
    const char* vp = Pc + ((R0 + q) * PW + SV0 + g * 64) * 2u;
#pragma unroll
    for (int i = 0; i < 8; ++i) xv[i] = *(const u32x4*)(vp + i * 16); }
#pragma unroll
  for (int pt = 0; pt < 4; ++pt) { const bf16_t* ap = wsp + (gg * 128 + pt * 32 + r32) * 128 + hi * 8;
#pragma unroll
    for (int k = 0; k < 8; ++k) Af[pt][k] = *reinterpret_cast<const bf16x8*>(ap + k * 16); }
  { const int q = tid & 127, g = tid >> 7; float ss = 0.f;
#pragma unroll
    for (int i = 0; i < 8; ++i) {
      const float a0 = bflo(xv[i].x), a1 = bfhi(xv[i].x), a2 = bflo(xv[i].y), a3 = bfhi(xv[i].y), a4 = bflo(xv[i].z), a5 = bfhi(xv[i].z), a6 = bflo(xv[i].w), a7 = bfhi(xv[i].w);
      ss += (a0 * a0 + a1 * a1) + (a2 * a2 + a3 * a3) + (a4 * a4 + a5 * a5) + (a6 * a6 + a7 * a7); }
    const float rs = rsqrtf(ss * (1.f / 64.f) + 1e-6f);
    char* dst = lds + (g * 64) * VS + q * 2;
#pragma unroll
    for (int i = 0; i < 8; ++i) { const float* gp = gsgu + g * 64 + i * 8; const f32x4 g0 = *(const f32x4*)gp, g1 = *(const f32x4*)(gp + 4);
      *(bf16_t*)(dst + (i * 8 + 0) * VS) = f2bf(bflo(xv[i].x) * rs * g0.x); *(bf16_t*)(dst + (i * 8 + 1) * VS) = f2bf(bfhi(xv[i].x) * rs * g0.y);
      *(bf16_t*)(dst + (i * 8 + 2) * VS) = f2bf(bflo(xv[i].y) * rs * g0.z); *(bf16_t*)(dst + (i * 8 + 3) * VS) = f2bf(bfhi(xv[i].y) * rs * g0.w);
      *(bf16_t*)(dst + (i * 8 + 4) * VS) = f2bf(bflo(xv[i].z) * rs * g1.x); *(bf16_t*)(dst + (i * 8 + 5) * VS) = f2bf(bfhi(xv[i].z) * rs * g1.y);
      *(bf16_t*)(dst + (i * 8 + 6) * VS) = f2bf(bflo(xv[i].w) * rs * g1.z); *(bf16_t*)(dst + (i * 8 + 7) * VS) = f2bf(bfhi(xv[i].w) * rs * g1.w); }
  }
  __syncthreads();
  { bf16x8 vb[8];
#pragma unroll
    for (int k = 0; k < 8; ++k) vb[k] = *reinterpret_cast<const bf16x8*>(lds + cc * VS + (k * 16 + hi * 8) * 2);
    unsigned short uu[2][16]; f32x4 bsv[2][4];
#define SGU_LD(pt_, s_) do { _Pragma("unroll") for (int r = 0; r < 16; ++r) uu[s_][r] = *(const unsigned short*)(Pc + ((R0 + (pt_) * 32 + crow(r, hi)) * PW + SU0 + cc) * 2u); \
      _Pragma("unroll") for (int q4 = 0; q4 < 4; ++q4) bsv[s_][q4] = *(const f32x4*)(bsp + gg * 128 + (pt_) * 32 + 8 * q4 + 4 * hi); } while (0)
    SGU_LD(0, 0);
#pragma unroll
    for (int pt = 0; pt < 4; ++pt) { f32x16 acc = {};
      if (pt + 1 < 4) SGU_LD(pt + 1, (pt + 1) & 1);
#pragma unroll
      for (int k = 0; k < 8; ++k) acc = __builtin_amdgcn_mfma_f32_32x32x16_bf16(Af[pt][k], vb[k], acc, 0, 0, 0);
#pragma unroll
      for (int r = 0; r < 16; ++r) { const int p = pt * 32 + crow(r, hi); const float m = acc[r] + bsv[pt & 1][r >> 2][r & 3];
        *(bf16_t*)((char*)Y + ((R0 + p) * DM + 768 + cc) * 2u) = f2bf(bf2f(uu[pt & 1][r]) * m); } }
#undef SGU_LD
  }
  __syncthreads();
}
}
__device__ __forceinline__ unsigned pk2(float lo, float hi) { return cvtpk(lo, hi); }
__device__ __forceinline__ void transpose_item(const float* __restrict__ W, int K, int N, bf16_t* __restrict__ WT, int row_base, LAS float* scr, int kb, int nb, int lane) {
    const int k0 = 64 * kb, n0 = 32 * nb;
#pragma unroll 8
    for (int i = 0; i < 32; ++i) { const int kk = 2 * i + (lane >> 5); scr[kk * 33 + (lane & 31)] = W[(size_t)(k0 + kk) * N + n0 + (lane & 31)]; }
    asm volatile("s_waitcnt lgkmcnt(0)" ::: "memory");
    const int c = lane & 7;
#pragma unroll
    for (int j = 0; j < 4; ++j) { const int n = (lane >> 3) + 8 * j; const LAS float* s = scr + (8 * c) * 33 + n;
        u32x4 o; o.x = pk2(s[0 * 33], s[1 * 33]); o.y = pk2(s[2 * 33], s[3 * 33]); o.z = pk2(s[4 * 33], s[5 * 33]); o.w = pk2(s[6 * 33], s[7 * 33]);
        *(u32x4*)(WT + (size_t)(row_base + n) * K + k0 + 8 * c) = o; }
    asm volatile("s_waitcnt lgkmcnt(0)" ::: "memory");
}
__device__ __forceinline__ void gemv_item(const LAS float* a_lds, LAS float* red, const float* __restrict__ W, int N, int n0, float* __restrict__ out, int ldo, int obase, const float* __restrict__ bias) {
    const int tid = threadIdx.x, wid = tid >> 6, lane = tid & 63, c4 = (lane & 15) * 4, ks = lane >> 4;
    f32x4 acc[NMS];
#pragma unroll
    for (int ms = 0; ms < NMS; ++ms) acc[ms] = (f32x4){0.f, 0.f, 0.f, 0.f};
    const float* wp = W + (size_t)(wid * 128 + ks) * N + n0 + c4;
#pragma unroll 8
    for (int st = 0; st < 32; ++st) { const f32x4 wv = *(const f32x4*)(wp + (size_t)st * 4 * N); const int k = wid * 128 + st * 4 + ks;
#pragma unroll
        for (int ms = 0; ms < NMS; ++ms) acc[ms] += wv * a_lds[ms * 1024 + k]; }
#pragma unroll
    for (int ms = 0; ms < NMS; ++ms) {
        f32x4 v = acc[ms];
        v.x += __shfl_xor(v.x, 16); v.y += __shfl_xor(v.y, 16); v.z += __shfl_xor(v.z, 16); v.w += __shfl_xor(v.w, 16);
        v.x += __shfl_xor(v.x, 32); v.y += __shfl_xor(v.y, 32); v.z += __shfl_xor(v.z, 32); v.w += __shfl_xor(v.w, 32);
        if (ks == 0) { LAS float* rp = red + (wid * NMS + ms) * 64 + c4; rp[0] = v.x; rp[1] = v.y; rp[2] = v.z; rp[3] = v.w; }
    }
    __syncthreads();
    for (int i = tid; i < NMS * 64; i += 512) { const int ms = i >> 6, c = i & 63; float s = 0.f;
#pragma unroll
        for (int w = 0; w < 8; ++w) s += red[(w * NMS + ms) * 64 + c];
        if (bias) s += bias[n0 + c];
        out[(size_t)ms * ldo + obase + c] = s; }
    __syncthreads();
}
__device__ __forceinline__ float wave_sum(float v) {
#pragma unroll
    for (int o = 1; o < 64; o <<= 1) v += __shfl_xor(v, o);
    return v;
}

#define XB_TMO      128
#define XB_XCNT(j)  (256  + 64 * (j))
#define XB_XSUB(j)  (1280 + 64 * (j))
#define XB_XGEN(j)  (2304 + 64 * (j))
#define XB_TOP      3328
#define XB_TOPGEN   3392
#define XCD_BAR_WORDS 3456
#define XB_SPIN_CAP (1u << 18)

__device__ __forceinline__ unsigned xb_ld(unsigned* p)              { return __hip_atomic_load(p, __ATOMIC_RELAXED, __HIP_MEMORY_SCOPE_AGENT); }
__device__ __forceinline__ unsigned xb_add(unsigned* p, unsigned v) { return __hip_atomic_fetch_add(p, v, __ATOMIC_RELAXED, __HIP_MEMORY_SCOPE_AGENT); }
__device__ __forceinline__ unsigned xb_xcc_id() { return (unsigned)__builtin_amdgcn_s_getreg((3 << 11) | 20) & 0xFu; }
#define XB_SPIN(cond, bar) do { unsigned _sp = 0; while (cond) { __builtin_amdgcn_s_sleep(1); \
    if ((++_sp & 255u) == 0u) { if (xb_ld(&(bar)[XB_TMO])) break; if (_sp > XB_SPIN_CAP) { atomicAdd(&(bar)[XB_TMO], 1u); break; } } } } while (0)

struct XcdBarrier {
    unsigned* bar; unsigned x;
    volatile LAS unsigned* st;
};

__device__ __forceinline__ XcdBarrier xcd_barrier_post(unsigned* bar, volatile LAS unsigned* st) {
    XcdBarrier b; b.bar = bar; b.x = xb_xcc_id(); b.st = st;
    if (threadIdx.x == 0) (void)xb_add(&bar[XB_XCNT(b.x)], 1u);
    return b;
}
__device__ __forceinline__ void xcd_barrier_complete(unsigned* bar, unsigned x, unsigned& nloc, unsigned& nx) {
    const unsigned G = gridDim.x * gridDim.y * gridDim.z;
    unsigned sum, cnt, mine, sp = 0u;
    for (;;) {
        sum = 0u; cnt = 0u; mine = 0u;
#pragma unroll
        for (unsigned j = 0; j < 16; ++j) { const unsigned c = xb_ld(&bar[XB_XCNT(j)]); sum += c; cnt += (c > 0u) ? 1u : 0u; mine = (j == x) ? c : mine; }
        if (sum == G) break;
        __builtin_amdgcn_s_sleep(1);
        if ((++sp & 255u) == 0u) { if (xb_ld(&bar[XB_TMO])) break; if (sp > XB_SPIN_CAP) { atomicAdd(&bar[XB_TMO], 1u); break; } }
    }
    nloc = mine > 0u ? mine : 1u; nx = cnt > 0u ? cnt : 1u;
}

__device__ __forceinline__ void xcd_barrier(const XcdBarrier& b) {
    asm volatile("s_waitcnt vmcnt(0)" ::: "memory");
    __syncthreads();
    if (threadIdx.x == 0) {
        unsigned* bar = b.bar;
        __builtin_amdgcn_s_waitcnt(0);
        unsigned nloc = b.st[0], nx = b.st[1];
        if (nloc == 0u) { xcd_barrier_complete(bar, b.x, nloc, nx); b.st[0] = nloc; b.st[1] = nx; }
        const unsigned old = xb_add(&bar[XB_XSUB(b.x)], 1u);
        const unsigned gen = old / nloc;
        if (old + 1u == (gen + 1u) * nloc) {
            __builtin_amdgcn_fence(__ATOMIC_RELEASE, "agent");
            asm volatile("s_waitcnt vmcnt(0)" ::: "memory");
            const unsigned og = xb_add(&bar[XB_TOP], 1u);
            const unsigned tg = og / nx;
            if (og + 1u == (tg + 1u) * nx) xb_add(&bar[XB_TOPGEN], 1u);
            else XB_SPIN(xb_ld(&bar[XB_TOPGEN]) == tg, bar);
            __builtin_amdgcn_fence(__ATOMIC_ACQUIRE, "agent");
            xb_add(&bar[XB_XGEN(b.x)], 1u);
            asm volatile("s_waitcnt vmcnt(0)" ::: "memory");
        } else {
            XB_SPIN(xb_ld(&bar[XB_XGEN(b.x)]) == gen, bar);
            __builtin_amdgcn_fence(__ATOMIC_ACQUIRE, "agent");
            asm volatile("s_waitcnt vmcnt(0)" ::: "memory");
        }
    }
    __syncthreads();
}
typedef __attribute__((address_space(1))) unsigned char g_u8;
__device__ __forceinline__ unsigned char* lau(unsigned char* p) { asm volatile("" : "+s"(p)); return (unsigned char*)(g_u8*)p; }
constexpr int NPHASE = 15;
constexpr int LDS_BYTES = 147456;
struct Args { const float* in[27]; float* out; unsigned char* ws; int ph_lo, ph_hi; };
__global__ void __launch_bounds__(512, 2) hybrid_fwd(Args args) {
    extern __shared__ __attribute__((aligned(16))) unsigned char lds_raw[];
    char* lds = (char*)lds_raw;
    LAS unsigned char* ldsl = (LAS unsigned char*)lds_raw;
    const int tid = threadIdx.x, wave = __builtin_amdgcn_readfirstlane(tid >> 6);
#define LANE_LOCAL int lane_ = threadIdx.x; asm volatile("" : "+v"(lane_)); const int lane = lane_ & 63;
    const int G = gridDim.x, bx = blockIdx.x, vcu = (G % 8 == 0) ? (bx % 8) * (G / 8) + bx / 8 : bx;
    unsigned char* ws = args.ws;
    const float* const* in = args.in;
#define mods ((float*)(ws + WS_MODS))
#define shwin ((float*)(ws + WS_SHWIN))
#define shwf ((float*)(ws + WS_SHWF))
#define ropeC ((float*)(ws + WS_ROPE))
#define ropeS ((float*)(ws + WS_ROPE + 4096))
#define c8 ((float*)(ws + WS_C8))
#define lamv ((float*)(ws + WS_LAM))
#define rowss ((float*)(ws + WS_ROWSS))
#define lrus ((float*)(ws + WS_LRUS))
#define xc ((float*)(ws + WS_XC))
#define AP ((bf16_t*)(ws + WS_AP))
#define Pb ((bf16_t*)(ws + WS_P))
#define Yb ((bf16_t*)(ws + WS_Y))
#define HM ((bf16_t*)(ws + WS_HMID))
#define WSP ((bf16_t*)(ws + WS_WSP))
#define WRG ((bf16_t*)(ws + WS_WRG))
    const int lo = args.ph_lo, hi_ = args.ph_hi;
    volatile LAS unsigned* MISC = (volatile LAS unsigned*)(ldsl + LDS_BYTES - 64);
    if (tid < 16) MISC[tid] = 0u;
    __syncthreads();
    XcdBarrier bar; bar.bar = (unsigned*)(ws + WS_CTL); bar.x = 0; bar.st = nullptr;
    if (hi_ - lo > 1) bar = xcd_barrier_post((unsigned*)(ws + WS_CTL), MISC);
#define IN(k) (lo <= (k) && (k) < hi_)
#define SEAM(k) do { if (IN(k) && IN((k) + 1)) { if ((k) == 0) cg::this_grid().sync(); else xcd_barrier(bar); } } while (0)

    if (EN(0) && IN(0)) {
        { LANE_LOCAL LAS float* scr = (LAS float*)(ldsl + wave * 16384);
          const int gw = vcu * 8 + wave, NGW = G * 8;
          constexpr int I_IN = 16 * 80, I_OUT = 16 * 32, I_G = 16 * 88, I_D = 44 * 32, I_L = I_IN + I_OUT + 2 * I_G + I_D;
          for (int it = gw; it < NLAYER * I_L; it += NGW) {
              const int l = it / I_L; int r = it - l * I_L;
              if (r < I_IN) { transpose_item(in[8] + (size_t)l * DM * PW, DM, PW, (bf16_t*)(ws + WS_WIN + l * SZ_WIN), 32 * (r % 80), scr, r / 80, r % 80, lane); continue; } r -= I_IN;
              if (r < I_OUT) { transpose_item(in[22] + (size_t)l * DM * DM, DM, DM, (bf16_t*)(ws + WS_WOUT + l * SZ_WOUT), 32 * (r % 32), scr, r / 32, r % 32, lane); continue; } r -= I_OUT;
              if (r < 2 * I_G) { const int up = r >= I_G; if (up) r -= I_G; const int nb = r % 88, n0 = 32 * nb;
                  transpose_item(in[up ? 24 : 23] + (size_t)l * DM * FH, DM, FH, (bf16_t*)(ws + WS_WFFN + l * SZ_WFFN), (n0 / 128) * 256 + (n0 % 128) + (up ? 128 : 0), scr, r / 88, nb, lane); continue; } r -= 2 * I_G;
              transpose_item(in[25] + (size_t)l * FH * DM, FH, DM, (bf16_t*)(ws + WS_WDN + l * SZ_WDN), 32 * (r % 32), scr, r / 32, r % 32, lane);
          }
        }
        { const int gt = vcu * 512 + tid, NT = G * 512;
          for (int i = gt; i < 131072; i += NT) WSP[i] = f2bf(in[20][i]);
          for (int i = gt; i < 131072; i += NT) { const int ii = i & 63, j = (i >> 6) & 63, h = (i >> 12) & 3, d = (i >> 14) & 1, mat = (i >> 15) & 1, l = i >> 16;
              WRG[i] = f2bf(in[mat ? 16 : 14][((((size_t)l * 2 + d) * 4 + h) * 64 + ii) * 64 + j]); }
          if (gt < 1024) { const int pos = gt >> 4, j = gt & 15; const float inv = powf(10000.f, -(float)j / 16.f); const float ang = (float)pos * inv; ropeC[gt] = cosf(ang); ropeS[gt] = sinf(ang);
              const float lv = in[18][gt]; c8[gt] = 8.f * log1pf(expf(-lv)); }
          if (gt < NLAYER) { float s0 = 0.f, s1 = 0.f; for (int k = 0; k < 64; ++k) { s0 += in[9][(gt * 2 + 0) * 64 + k] * in[10][(gt * 2 + 0) * 64 + k]; s1 += in[9][(gt * 2 + 1) * 64 + k] * in[10][(gt * 2 + 1) * 64 + k]; }
              lamv[gt] = expf(s0) - expf(s1) + (0.8f - 0.6f * expf(-0.3f * (float)gt)); }
        }
        __syncthreads();
        { LAS float* a_lds = (LAS float*)ldsl; LAS float* red = (LAS float*)(ldsl + 36864);
          for (int i = tid; i < NMS * 1024; i += 512) { const int ms = i >> 10, k = i & 1023; const float v = (ms < 8) ? in[1][ms * 1024 + k] : in[3][k]; a_lds[i] = silu_f(v); }
          __syncthreads();
          for (int it = vcu; it < NLAYER * 96; it += G) { const int l = it / 96, n0 = (it % 96) * 64;
              gemv_item(a_lds, red, in[4] + (size_t)l * DM * NMOD, NMOD, n0, mods + (size_t)l * NMS * NMOD, NMOD, n0, in[5] + (size_t)l * NMOD); }
        }
    }
    SEAM(0);
    if (EN(1) && IN(1)) {
        { LAS float* a_lds = (LAS float*)ldsl; LAS float* red = (LAS float*)(ldsl + 36864);
          for (int it = vcu; it < NLAYER * 128; it += G) { const int l = it / 128, r = it % 128; const int soff = (r < 40) ? 0 : 3 * DM;
              __syncthreads();
              for (int i = tid; i < NMS * 1024; i += 512) a_lds[i] = mods[((size_t)l * NMS + (i >> 10)) * NMOD + soff + (i & 1023)];
              __syncthreads();
              if (r < 40) gemv_item(a_lds, red, in[8] + (size_t)l * DM * PW, PW, r * 64, shwin + (size_t)l * NMS * PW, PW, r * 64, nullptr);
              else { const int up = r >= 84, nb = (r - 40) % 44, n0 = nb * 64;
                  gemv_item(a_lds, red, in[up ? 24 : 23] + (size_t)l * DM * FH, FH, n0, shwf + (size_t)l * NMS * NF, NF, (n0 / 128) * 256 + (n0 % 128) + (up ? 128 : 0), nullptr); } }
        }
        { LANE_LOCAL const int gw = vcu * 8 + wave, NGW = G * 8;
          for (int m = gw; m < MROWS; m += NGW) { const int b = m / TB, t = m - b * TB; const bool ctx = t < CTXL; const int ms = ctx ? 8 : b;
              const float* xr = ctx ? in[2] + ((size_t)b * CTXL + t) * DM : in[0] + ((size_t)b * SEQ + (t - CTXL)) * DM;
              f32x4 v[4]; float s = 0.f;
#pragma unroll
              for (int j = 0; j < 4; ++j) { v[j] = ((const f32x4*)xr)[lane + 64 * j]; s += (v[j].x * v[j].x + v[j].y * v[j].y) + (v[j].z * v[j].z + v[j].w * v[j].w); }
              s = wave_sum(s);
#pragma unroll
              for (int j = 0; j < 4; ++j) { const int col = 4 * lane + 256 * j; const f32x4 g = *(const f32x4*)(in[6] + col), sc = *(const f32x4*)(mods + (size_t)ms * NMOD + DM + col);
                  const f32x4 a = v[j] * g * (sc + 1.f); u32x2 w; w.x = cvtpk(a.x, a.y); w.y = cvtpk(a.z, a.w); *(u32x2*)(AP + (size_t)m * DM + col) = w; }
              if (lane < 16) rowss[(size_t)m * 16 + lane] = (lane == 0) ? s : 0.f; }
        }
    }
    SEAM(1);
#pragma unroll 1
    for (int l = 0; l < NLAYER; ++l) {
        const int pb = 2 + 6 * l; const bool last = (l == NLAYER - 1);
        const float* modl = mods + (size_t)l * NMS * NMOD;
        if (EN(2) && IN(pb)) {
            pg8::Gemm g{AP, (const bf16_t*)(ws + WS_WIN + l * SZ_WIN), MROWS, PW, DM}; pg8::Order S; S.init(MROWS / 256, PW, G, bx, 0);
            EpiInProj E{Pb, rowss, shwin + (size_t)l * NMS * PW, ropeC, ropeS};
            pg8::gemm_phase<EpiInProj, pg8::Order, true, true>(ldsl, g, S, E);
        }
        SEAM(pb);
        if (IN(pb + 1)) {
            if (EN(3)) for (int i = 0; i < 2; ++i) {
                int u, dlo = 0, dhi = 2;
                if (i == 0) u = vcu; else if (G == 256) { if (vcu < 16 || vcu >= 48) break; u = 256 + ((vcu - 16) >> 1); dlo = (vcu - 16) & 1; dhi = dlo + 1; } else u = vcu + G;
                if (u >= NB * NCHUNK) break;
                lru::lru_unit<false>(lds, Pb, Yb, u / NCHUNK, u % NCHUNK, in[12] + l * 1024, in[13] + l * 256, WRG + (size_t)l * 65536, in[15] + l * 512, in[17] + l * 512, c8 + l * 512, lrus, dlo, dhi); }
            const float lam = lamv[l], li = 0.8f - 0.6f * __expf(-0.3f * (float)l);
            if (EN(5)) { const int nu = last ? NB * 4 * 16 : NB * 4 * 17;
#pragma unroll 1
                for (int rep_ = 0; rep_ < PROBE_ATTREP; ++rep_)
                for (int u = vcu; u < nu; u += G) { int bh, qb; if (u < NB * 4 * 16) { bh = u >> 4; qb = (u & 15) + 1; } else { bh = u - NB * 4 * 16; qb = 0; }
                    att::attn_unit(lds, Pb, Yb, bh >> 2, bh & 3, qb, lam, in[11] + l * 128, 1.f - li); } }
        }
        SEAM(pb + 1);
        if (EN(6) && IN(pb + 2)) {
            const int nu2 = last ? NB * 32 : NB * NCHUNK;
            for (int u = vcu; u < nu2; u += G) { const int b_ = last ? (u >> 5) : u / NCHUNK, c = last ? 2 + (u & 31) : u % NCHUNK;
                lru::lru_unit<true>(lds, Pb, Yb, b_, c, in[12] + l * 1024, in[13] + l * 256, WRG + (size_t)l * 65536, in[15] + l * 512, in[17] + l * 512, c8 + l * 512, lrus, 0, 2); }
            if (EN(4)) { const int ns = last ? NB * 32 : NB * NCHUNK, s0 = last ? vcu : vcu - 16, sg = last ? G : G - 16;
                for (int u = s0; u >= 0 && u < ns; u += sg) { const int b_ = last ? (u >> 5) : u / NCHUNK, c = last ? 2 + (u & 31) : u % NCHUNK;
                    sgu::sgu_unit(lds, Pb, Yb, b_, c, WSP + (size_t)l * 65536, in[19] + l * 256, in[21] + l * 512); } }
        }
        SEAM(pb + 2);
        if (EN(7) && IN(pb + 3)) {
            pg8::Gemm g{Yb, (const bf16_t*)(ws + WS_WOUT + l * SZ_WOUT), MROWS, DM, DM}; pg8::Order S; S.init(last ? 128 : 136, DM, G, bx, last ? 1 : 0);
            EpiRes E{in[0], in[2], args.out, 1, modl + 2 * DM, in[6] + l * DM, modl + DM, in[7] + l * DM, modl + 4 * DM, AP, rowss, 1, 0};
            pg8::gemm_phase<EpiRes, pg8::Order, true, true>(ldsl, g, S, E);
        }
        SEAM(pb + 3);
        if (EN(8) && IN(pb + 4)) {
            pg8::Gemm g{AP, (const bf16_t*)(ws + WS_WFFN + l * SZ_WFFN), MROWS, NF, DM}; pg8::Order S; S.init(last ? 128 : 136, NF, G, bx, last ? 1 : 0);
            EpiSwiGLU E{HM, rowss, shwf + (size_t)l * NMS * NF};
            pg8::gemm_phase<EpiSwiGLU, pg8::Order, true, true>(ldsl, g, S, E);
        }
        SEAM(pb + 4);
        if (EN(9) && IN(pb + 5)) {
            pg8::Gemm g{HM, (const bf16_t*)(ws + WS_WDN + l * SZ_WDN), MROWS, DM, FH}; pg8::Order S; S.init(last ? 128 : 136, DM, G, bx, last ? 1 : 0);
            const int ln = last ? l : l + 1;
            EpiRes E{in[0], in[2], args.out, 1, modl + 5 * DM, in[7] + l * DM, modl + 4 * DM, in[6] + ln * DM, mods + (size_t)ln * NMS * NMOD + DM, AP, rowss, last ? 0 : 1, last ? 1 : 0};
            pg8::gemm_phase<EpiRes, pg8::Order, true, true>(ldsl, g, S, E);
        }
        SEAM(pb + 5);
    }
    if (EN(10) && IN(14)) {
        LANE_LOCAL const int gw = vcu * 8 + wave, NGW = G * 8;
        for (int m = gw; m < NB * SEQ; m += NGW) { const int b = m / SEQ, t = m - b * SEQ; const size_t row = (size_t)b * TB + CTXL + t;
            const float rstd = row_rstd(rowss, row); f32x4* xr = (f32x4*)(args.out + (size_t)m * DM);
            u32x2 w[4];
#pragma unroll
            for (int j = 0; j < 4; ++j) w[j] = ((const u32x2*)xr)[lane + 64 * j];
            asm volatile("s_waitcnt vmcnt(0)" ::: "memory");
#pragma unroll
            for (int j = 0; j < 4; ++j) { const f32x4 g = *(const f32x4*)(in[26] + 4 * lane + 256 * j);
                const f32x4 xv = (f32x4){bflo(w[j].x), bfhi(w[j].x), bflo(w[j].y), bfhi(w[j].y)}; xr[lane + 64 * j] = xv * rstd * g; } }
    }
#undef IN
#undef SEAM
#undef mods
#undef shwin
#undef shwf
#undef ropeC
#undef ropeS
#undef c8
#undef lamv
#undef rowss
#undef lrus
#undef xc
#undef AP
#undef Pb
#undef Yb
#undef HM
#undef WSP
#undef WRG
}

extern "C" void kernel_launch(void* const* d_in, const int* in_sizes, int n_in, void* d_out, int out_size, void* d_ws, size_t ws_size, hipStream_t stream) {
    static int grid = 0;
    if (grid == 0) {
        if (n_in != 27 || out_size != NB * SEQ * DM || ws_size < WS_TOTAL) { fprintf(stderr, "kernel_launch: unexpected shapes (n_in %d out %d ws %zu need %zu)\n", n_in, out_size, ws_size, (size_t)WS_END); grid = -1; return; }
        int dev = 0, cus = 0, per_cu = 0;
        (void)hipGetDevice(&dev); (void)hipDeviceGetAttribute(&cus, hipDeviceAttributeMultiprocessorCount, dev);
        if (hipFuncSetAttribute((const void*)hybrid_fwd, hipFuncAttributeMaxDynamicSharedMemorySize, LDS_BYTES) != hipSuccess) { fprintf(stderr, "kernel_launch: hipFuncSetAttribute failed\n"); grid = -1; return; }
        (void)hipOccupancyMaxActiveBlocksPerMultiprocessor(&per_cu, (const void*)hybrid_fwd, 512, LDS_BYTES);
        if (per_cu < 1) { fprintf(stderr, "kernel_launch: occupancy query says %d blocks per CU\n", per_cu); per_cu = 1; }
        (void)hipGetLastError();
        grid = cus;
    }
    if (grid < 0) return;
    if (hipMemsetAsync((char*)d_ws + WS_CTL, 0, WS_CTL_BYTES, stream) != hipSuccess) { fprintf(stderr, "kernel_launch: memset failed\n"); return; }
    Args a{};
    for (int i = 0; i < 27; ++i) a.in[i] = (const float*)d_in[i];
    a.out = (float*)d_out; a.ws = (unsigned char*)d_ws;
#if MK_SINGLE
    a.ph_lo = 0; a.ph_hi = NPHASE;
    { void* kargs[] = {&a}; hipError_t e = hipLaunchCooperativeKernel((const void*)hybrid_fwd, dim3(grid), dim3(512), kargs, LDS_BYTES, stream);
      if (e != hipSuccess) fprintf(stderr, "cooperative launch failed: %s (grid %d)\n", hipGetErrorString(e), grid); }
#else
    for (int pp = 0; pp < NPHASE + PROBE_NDUP; ++pp) { const int p = pp < NPHASE ? pp : PROBE_DUP0 + (pp - NPHASE) * PROBE_DUPSTEP; a.ph_lo = p; a.ph_hi = p + 1;
        void* kargs[] = {&a}; hipError_t e = hipLaunchCooperativeKernel((const void*)hybrid_fwd, dim3(grid), dim3(512), kargs, LDS_BYTES, stream);
        if (e != hipSuccess) { fprintf(stderr, "cooperative launch %d failed: %s (grid %d)\n", p, hipGetErrorString(e), grid); break; } }
#endif
}
```
